# Optimizing an MI355X kernel written in HIP

```python
import jax, jax.numpy as jnp
from jax import lax
import numpy as np

D_MODEL = 1024
BATCH = 2
SEQ = 8192
DEPTH = 1

CHUNK = 64
N_META = 16
Q_BLOCK = 128
HEAD_DIM = 64
N_HEADS_FOX = 8
N_HEADS_SB = 8
WIDTH_FOX = N_HEADS_FOX * HEAD_DIM
WIDTH_SB = N_HEADS_SB * HEAD_DIM
D_FF = 2816
CONV_WIDTH = 3
EPS = 1e-6

SPLIT_SIZES = (WIDTH_FOX, WIDTH_FOX, WIDTH_FOX, N_HEADS_FOX,
               WIDTH_SB, WIDTH_SB, WIDTH_SB, D_MODEL, D_MODEL)
PROJ_WIDTH = sum(SPLIT_SIZES)
SPLIT_POINTS = tuple(sum(SPLIT_SIZES[:i + 1]) for i in range(len(SPLIT_SIZES) - 1))

kernel_name = "hybrid_fox_stickbreak_convffn_block"


def rms_norm(x, g):
    xf = x.astype(jnp.float32)
    y = xf * lax.rsqrt(jnp.mean(xf * xf, axis=-1, keepdims=True) + EPS)
    return (y * g.astype(jnp.float32)).astype(x.dtype)


def _split_heads(t, n_heads):
    b, l, _ = t.shape
    return t.reshape(b, l, n_heads, HEAD_DIM).transpose(0, 2, 1, 3)


def _merge_heads(t):
    b, h, l, d = t.shape
    return t.transpose(0, 2, 1, 3).reshape(b, l, h * d)


def forgetting_attention(q, k, v, log_f):
    seq_len = q.shape[2]
    scale = HEAD_DIM ** -0.5
    c = jnp.cumsum(log_f, axis=-1)
    outs = []
    for start in range(0, seq_len, Q_BLOCK):
        end = min(start + Q_BLOCK, seq_len)
        s = jnp.einsum('bhqd,bhkd->bhqk', q[:, :, start:end], k[:, :, :end],
                       preferred_element_type=jnp.float32) * scale
        s = s + c[:, :, start:end, None] - c[:, :, None, :end]
        t_pos = jnp.arange(start, end)[:, None]
        s_pos = jnp.arange(end)[None, :]
        s = jnp.where(s_pos <= t_pos, s, -jnp.inf)
        p = jax.nn.softmax(s, axis=-1)
        outs.append(jnp.einsum('bhqk,bhkd->bhqd', p.astype(v.dtype), v[:, :, :end]))
    return jnp.concatenate(outs, axis=2)


def stick_breaking_attention(q, k, v):
    seq_len = q.shape[2]
    scale = HEAD_DIM ** -0.5
    outs = []
    for start in range(0, seq_len, Q_BLOCK):
        end = min(start + Q_BLOCK, seq_len)
        z = jnp.einsum('bhqd,bhkd->bhqk', q[:, :, start:end], k[:, :, :end],
                       preferred_element_type=jnp.float32) * scale
        t_pos = jnp.arange(start, end)[:, None]
        s_pos = jnp.arange(end)[None, :]
        causal = s_pos < t_pos
        log_keep = jnp.where(causal, jax.nn.log_sigmoid(-z), 0.0)
        later = lax.cumsum(log_keep, axis=3, reverse=True) - log_keep
        a = jnp.where(causal, jnp.exp(jax.nn.log_sigmoid(z) + later), 0.0)
        outs.append(jnp.einsum('bhqk,bhkd->bhqd', a.astype(v.dtype), v[:, :, :end]))
    return jnp.concatenate(outs, axis=2)


def causal_depthwise_conv(u, w, b):
    seq_len = u.shape[1]
    up = jnp.pad(u, ((0, 0), (CONV_WIDTH - 1, 0), (0, 0)))
    out = b.astype(u.dtype)
    for i in range(CONV_WIDTH):
        out = out + w[i] * up[:, i:i + seq_len]
    return out


def setup_inputs(seed: int = 0) -> dict:
    key = jax.random.key(seed)
    ks = jax.random.split(key, 13)
    x = jax.random.normal(ks[0], (BATCH, SEQ, D_MODEL), jnp.float32)
    meta_tokens = jax.random.normal(ks[1], (N_META, D_MODEL), jnp.float32)
    norm_gains = 1.0 + 0.05 * jax.random.normal(ks[2], (DEPTH, 4, D_MODEL), jnp.float32)
    w_in = jax.random.normal(ks[3], (DEPTH, D_MODEL, PROJ_WIDTH), jnp.float32) * D_MODEL ** -0.5
    b_forget = jax.random.uniform(ks[4], (DEPTH, N_HEADS_FOX), jnp.float32, minval=1.0, maxval=6.0)
    w_o_fox = jax.random.normal(ks[5], (DEPTH, WIDTH_FOX, D_MODEL), jnp.float32) * WIDTH_FOX ** -0.5
    w_o_sb = jax.random.normal(ks[6], (DEPTH, WIDTH_SB, D_MODEL), jnp.float32) * WIDTH_SB ** -0.5
    w_out = jax.random.normal(ks[7], (DEPTH, D_MODEL, D_MODEL), jnp.float32) * D_MODEL ** -0.5
    w_up = jax.random.normal(ks[8], (DEPTH, D_MODEL, 2 * D_FF), jnp.float32) * D_MODEL ** -0.5
    conv_w = jax.random.normal(ks[9], (DEPTH, CONV_WIDTH, 2 * D_FF), jnp.float32) * CONV_WIDTH ** -0.5
    conv_b = 0.02 * jax.random.normal(ks[10], (DEPTH, 2 * D_FF), jnp.float32)
    w_down = jax.random.normal(ks[11], (DEPTH, D_FF, D_MODEL), jnp.float32) * D_FF ** -0.5
    return {"x": x, "meta_tokens": meta_tokens, "norm_gains": norm_gains, "w_in": w_in,
            "b_forget": b_forget, "w_o_fox": w_o_fox, "w_o_sb": w_o_sb, "w_out": w_out,
            "w_up": w_up, "conv_w": conv_w, "conv_b": conv_b, "w_down": w_down}


def reference(x, meta_tokens, norm_gains, w_in, b_forget, w_o_fox, w_o_sb, w_out,
              w_up, conv_w, conv_b, w_down):
    batch = x.shape[0]
    meta = jnp.broadcast_to(meta_tokens[None].astype(x.dtype), (batch, N_META, D_MODEL))
    h = jnp.concatenate([meta, x], axis=1)
    for layer in range(DEPTH):
        xn = rms_norm(h, norm_gains[layer, 0])
        proj = xn @ w_in[layer]
        q_a, k_a, v_a, f_a, q_b, k_b, v_b, g_a, g_b = jnp.split(proj, SPLIT_POINTS, axis=-1)
        log_f = jax.nn.log_sigmoid((f_a + b_forget[layer]).astype(jnp.float32))
        o_a = forgetting_attention(_split_heads(q_a, N_HEADS_FOX), _split_heads(k_a, N_HEADS_FOX),
                                   _split_heads(v_a, N_HEADS_FOX), log_f.transpose(0, 2, 1))
        o_b = stick_breaking_attention(_split_heads(q_b, N_HEADS_SB), _split_heads(k_b, N_HEADS_SB),
                                       _split_heads(v_b, N_HEADS_SB))
        y_a = _merge_heads(o_a) @ w_o_fox[layer]
        y_b = _merge_heads(o_b) @ w_o_sb[layer]
        mixed = (jax.nn.sigmoid(g_a) * y_a + jax.nn.sigmoid(g_b) * y_b) @ w_out[layer]
        h = h + rms_norm(mixed, norm_gains[layer, 1])
        xn = rms_norm(h, norm_gains[layer, 2])
        u = causal_depthwise_conv(xn @ w_up[layer], conv_w[layer], conv_b[layer])
        u_gate, u_val = jnp.split(u, 2, axis=-1)
        ffn = (jax.nn.gelu(u_gate, approximate=True) * u_val) @ w_down[layer]
        h = h + rms_norm(ffn, norm_gains[layer, 3])
    return h[:, N_META:]
```

```cpp
#include <hip/hip_runtime.h>
#include <hip/hip_cooperative_groups.h>
#include <cstdio>
#include <cstdint>
namespace cg = cooperative_groups;

#define DUMP 0
#define ABTEST 0
#define AB_FROM 0
#define AB_SRC WS_SSP2
#define AB_BYTES (2 * MiB)
#ifndef SINGLE_LAUNCH
#define SINGLE_LAUNCH 1
#endif

#define LAS __attribute__((address_space(3)))
typedef unsigned short bf16_t;
typedef short bf16x8 __attribute__((ext_vector_type(8)));
typedef float f32x4 __attribute__((ext_vector_type(4)));
typedef float f32x16 __attribute__((ext_vector_type(16)));
typedef unsigned u32x4 __attribute__((ext_vector_type(4)));
typedef unsigned u32x2 __attribute__((ext_vector_type(2)));

constexpr int D = 1024, SEQ = 8192, NMETA = 16, NB = 2;
constexpr int MX = NB * SEQ;
constexpr int MV = MX + NB * NMETA;
constexpr int M = 16512;
constexpr int LPK = 8256;
constexpr int PROJW = 5128, NPROJ = 5120, DFF = 2816, NUP = 5632;
constexpr float EPS = 1e-6f;
constexpr float LOG2E = 1.4426950408889634f, LN2 = 0.6931471805599453f;
constexpr int NTHREADS = 256;
constexpr int LDS_BYTES = 65536;
constexpr int NPHASE = 13;

constexpr size_t MiB = 1u << 20;
constexpr size_t WS_CTL = 0;
constexpr size_t WS_R1 = 4096, WS_R2 = WS_R1 + 69632, WS_SS2 = WS_R2 + 69632, WS_SS4 = WS_SS2 + 69632;
constexpr size_t WS_LOGF = WS_SS4 + 69632, WS_CK = WS_LOGF + 528384, WS_UPMETA = WS_CK + 528384;
constexpr size_t WS_BTIN = 2 * MiB, WS_BTOF = WS_BTIN + 10 * MiB, WS_BTOS = WS_BTOF + 1 * MiB, WS_BTOUT = WS_BTOS + 1 * MiB,
                 WS_BTUP = WS_BTOUT + 2 * MiB, WS_BTDN = WS_BTUP + 11 * MiB;
constexpr size_t SZ_M1024 = (size_t)M * 1024 * 2, SZ_M512 = (size_t)M * 512 * 2;
constexpr size_t WS_A = 33 * MiB;
constexpr size_t WS_B = WS_A + SZ_M1024;
constexpr size_t WS_C = WS_B + 2 * SZ_M1024;
constexpr size_t WS_QF = WS_C, WS_KF = WS_QF + SZ_M512, WS_QS = WS_KF + SZ_M512, WS_KS = WS_QS + SZ_M512, WS_VFT = WS_KS + SZ_M512, WS_VST = WS_VFT + SZ_M512;
constexpr size_t WS_GATED = WS_C, WS_MIXED = WS_B + SZ_M1024;
constexpr size_t WS_UP = WS_B;
constexpr size_t WS_ACT = WS_UP + 88 * MiB;
constexpr size_t WS_FFN = WS_ACT + 44 * MiB;
constexpr size_t WS_SSP2 = 230 * MiB, WS_SSP4 = 232 * MiB;
constexpr size_t WS_END = 234 * MiB;

struct Params {
    const float *x, *meta, *gains, *w_in, *b_forget, *w_o_fox, *w_o_sb, *w_out, *w_up, *conv_w, *conv_b, *w_down;
    float* out; unsigned char* ws; int ph_lo, ph_hi;
};

typedef __bf16 bf16x2_t __attribute__((ext_vector_type(2)));
__device__ __forceinline__ unsigned pk_bf16(float lo, float hi) { bf16x2_t v = {(__bf16)lo, (__bf16)hi}; return __builtin_bit_cast(unsigned, v); }
__device__ __forceinline__ float bf_lo(unsigned u) { return __uint_as_float(u << 16); }
__device__ __forceinline__ float bf_hi(unsigned u) { return __uint_as_float(u & 0xffff0000u); }
__device__ __forceinline__ float ex2(float x) { return __builtin_amdgcn_exp2f(x); }
__device__ __forceinline__ float lg2(float x) { return __builtin_amdgcn_logf(x); }
__device__ __forceinline__ float rcp(float x) { return __builtin_amdgcn_rcpf(x); }
__device__ __forceinline__ float sigmoidf_(float v) { return rcp(1.0f + ex2(-v * LOG2E)); }
__device__ __forceinline__ float wave_sum(float v) {
#pragma unroll
    for (int o = 32; o > 0; o >>= 1) v += __shfl_xor(v, o);
    return v;
}
__device__ __forceinline__ int wave_id() { return __builtin_amdgcn_readfirstlane((int)(threadIdx.x >> 6)); }

__device__ __forceinline__ void transpose_tile(LAS char* lds, const float* src, int ldsrc, int srccol, int k0, const float* gain, bf16_t* dst, int K, int n0) {
    LAS bf16_t* T = (LAS bf16_t*)lds;
    const int tid = threadIdx.x, r = tid >> 4, c4 = tid & 15;
#pragma unroll
    for (int p = 0; p < 4; ++p) {
        const int k = r + 16 * p;
        f32x4 v = *(const f32x4*)(src + (size_t)(k0 + k) * ldsrc + srccol + c4 * 4);
        const float g = gain ? gain[k0 + k] : 1.0f;
        const unsigned a = pk_bf16(v[0] * g, v[1] * g), b = pk_bf16(v[2] * g, v[3] * g);
        T[(c4 * 4 + 0) * 72 + k] = (bf16_t)(a & 0xffff); T[(c4 * 4 + 1) * 72 + k] = (bf16_t)(a >> 16);
        T[(c4 * 4 + 2) * 72 + k] = (bf16_t)(b & 0xffff); T[(c4 * 4 + 3) * 72 + k] = (bf16_t)(b >> 16);
    }
    __syncthreads();
    const int n = tid >> 2, kq = tid & 3;
    const u32x4 lo = *(LAS u32x4*)(T + n * 72 + kq * 16), hi = *(LAS u32x4*)(T + n * 72 + kq * 16 + 8);
    bf16_t* d = dst + (size_t)(n0 + n) * K + k0 + kq * 16;
    *(u32x4*)d = lo; *(u32x4*)(d + 8) = hi;
    __syncthreads();
}

__device__ __forceinline__ void phase0(const Params& p, LAS char* lds) {
    unsigned char* ws = p.ws;
    const int tid = threadIdx.x, lane = tid & 63, w = wave_id();
    LAS float* wfT = (LAS float*)lds;
    const float* g0 = p.gains;
    for (int idx = tid; idx < 8192; idx += NTHREADS) { const int h = idx & 7, k = idx >> 3; wfT[h * 1024 + k] = p.w_in[(size_t)k * PROJW + 1536 + h] * g0[k]; }
    __syncthreads();
    bf16_t* xb = (bf16_t*)(ws + WS_A);
    float* r1 = (float*)(ws + WS_R1);
    float* logf_ = (float*)(ws + WS_LOGF);
    for (int r_ = blockIdx.x * 32 + w; r_ < M; r_ += (r_ & 31) < 28 ? 4 : gridDim.x * 32 - 28) {
        const int r = r_;
        if (r >= MV) {
#pragma unroll
            for (int i = 0; i < 4; ++i) *(u32x2*)(xb + (size_t)r * D + lane * 4 + 256 * i) = (u32x2){0u, 0u};
            if (lane == 0) r1[r] = 0.f;
            continue;
        }
        const float* src = r < MX ? p.x + (size_t)r * D : p.meta + (size_t)((r - MX) & 15) * D;
        f32x4 v[4]; float ss = 0.f;
#pragma unroll
        for (int i = 0; i < 4; ++i) { v[i] = *(const f32x4*)(src + lane * 4 + 256 * i); ss += v[i][0] * v[i][0] + v[i][1] * v[i][1] + v[i][2] * v[i][2] + v[i][3] * v[i][3]; }
#pragma unroll
        for (int i = 0; i < 4; ++i) *(u32x2*)(xb + (size_t)r * D + lane * 4 + 256 * i) = (u32x2){pk_bf16(v[i][0], v[i][1]), pk_bf16(v[i][2], v[i][3])};
        ss = wave_sum(ss);
        const float rs = 1.0f / sqrtf(ss * (1.0f / D) + EPS);
        if (lane == 0) r1[r] = rs;
        float mine = 0.f;
#pragma unroll
        for (int h = 0; h < 8; ++h) {
            float a = 0.f;
#pragma unroll
            for (int i = 0; i < 4; ++i) { const f32x4 wv = *(LAS f32x4*)(wfT + h * 1024 + lane * 4 + 256 * i); a += v[i][0] * wv[0] + v[i][1] * wv[1] + v[i][2] * wv[2] + v[i][3] * wv[3]; }
            a = wave_sum(a);
            if (lane == h) mine = a;
        }
        if (lane < 8) {
            const float f = mine * rs + p.b_forget[lane];
            const float lf = fminf(f, 0.f) - log1pf(expf(-fabsf(f)));
            int b, kidx; if (r < MX) { b = r >> 13; kidx = r & 8191; } else { const int j = r - MX; b = j >> 4; kidx = 8192 + (j & 15); }
            logf_[(size_t)(b * 8 + lane) * LPK + kidx] = lf;
        }
    }
    __syncthreads();
    LAS char* tl = lds + 32768;
    const float* g2 = p.gains + 2 * D;
    constexpr int T_IN = 16 * 80, T_OF = 8 * 16, T_OS = 8 * 16, T_OUT = 16 * 16, T_UP = 16 * 88, T_DN = 44 * 16;
    constexpr int T_ALL = T_IN + T_OF + T_OS + T_OUT + T_UP + T_DN;
    for (int t = blockIdx.x; t < T_ALL; t += gridDim.x) {
        int u = t;
        if (u < T_IN) { const int nt = u % 80, kt = u / 80; const int sc = nt * 64 + (nt * 64 >= 1536 ? 8 : 0); transpose_tile(tl, p.w_in, PROJW, sc, kt * 64, g0, (bf16_t*)(ws + WS_BTIN), 1024, nt * 64); continue; }
        u -= T_IN;
        if (u < T_OF) { const int nt = u % 16, kt = u / 16; transpose_tile(tl, p.w_o_fox, 1024, nt * 64, kt * 64, nullptr, (bf16_t*)(ws + WS_BTOF), 512, nt * 64); continue; }
        u -= T_OF;
        if (u < T_OS) { const int nt = u % 16, kt = u / 16; transpose_tile(tl, p.w_o_sb, 1024, nt * 64, kt * 64, nullptr, (bf16_t*)(ws + WS_BTOS), 512, nt * 64); continue; }
        u -= T_OS;
        if (u < T_OUT) { const int nt = u % 16, kt = u / 16; transpose_tile(tl, p.w_out, 1024, nt * 64, kt * 64, nullptr, (bf16_t*)(ws + WS_BTOUT), 1024, nt * 64); continue; }
        u -= T_OUT;
        if (u < T_UP) { const int nt = u % 88, kt = u / 88; transpose_tile(tl, p.w_up, NUP, nt * 64, kt * 64, g2, (bf16_t*)(ws + WS_BTUP), 1024, nt * 64); continue; }
        u -= T_UP;
        { const int nt = u % 16, kt = u / 16; transpose_tile(tl, p.w_down, 1024, nt * 64, kt * 64, nullptr, (bf16_t*)(ws + WS_BTDN), DFF, nt * 64); }
    }
}

template <bool SWAP>
__device__ __forceinline__ void gemm_main(LAS char* lds, const bf16_t* Ag, int lda, const bf16_t* Bg, int ldb, int nk, f32x4 (&acc)[4][4]) {
    const int tid = threadIdx.x, lane = tid & 63, w = wave_id(), wr = w >> 1, wc = w & 1;
    const int row_0 = w * 8 + (lane >> 3), c_0 = (lane & 7) ^ ((row_0 >> 1) & 7);
    const bf16_t* pa0 = Ag + (size_t)row_0 * lda + c_0 * 8; const bf16_t* pb0 = Bg + (size_t)row_0 * ldb + c_0 * 8;
    const size_t sa = (size_t)32 * lda, sb_ = (size_t)32 * ldb;
    const int swz = (lane >> 1) & 7;
    int aoff[2], boff[2];
#pragma unroll
    for (int kh = 0; kh < 2; ++kh) {
        aoff[kh] = (wr * 64 + (lane & 15)) * 128 + (((kh * 4 + (lane >> 4)) ^ swz) << 4);
        boff[kh] = 16384 + (wc * 64 + (lane & 15)) * 128 + (((kh * 4 + (lane >> 4)) ^ swz) << 4);
    }
    u32x4 ra[4], rb[4];
#define GM_LOAD(kt) do { _Pragma("unroll") for (int i_ = 0; i_ < 4; ++i_) { ra[i_] = *(const u32x4*)(pa0 + i_ * sa + (kt) * 64); rb[i_] = *(const u32x4*)(pb0 + i_ * sb_ + (kt) * 64); } } while (0)
#define GM_WRITE(s) do { _Pragma("unroll") for (int i_ = 0; i_ < 4; ++i_) { \
        *(LAS u32x4*)(lds + (s) * 32768 + (i_ * 4 + w) * 1024 + lane * 16) = ra[i_]; \
        *(LAS u32x4*)(lds + (s) * 32768 + 16384 + (i_ * 4 + w) * 1024 + lane * 16) = rb[i_]; } } while (0)
    GM_LOAD(0); GM_WRITE(0);
    __syncthreads();
    for (int kt = 0; kt < nk; ++kt) {
        const int s = kt & 1;
        if (kt + 1 < nk) GM_LOAD(kt + 1);
#pragma unroll
        for (int kh = 0; kh < 2; ++kh) {
            bf16x8 af[4], bf[4];
#pragma unroll
            for (int m = 0; m < 4; ++m) af[m] = *(LAS bf16x8*)(lds + s * 32768 + aoff[kh] + m * 2048);
#pragma unroll
            for (int n = 0; n < 4; ++n) bf[n] = *(LAS bf16x8*)(lds + s * 32768 + boff[kh] + n * 2048);
#pragma unroll
            for (int m = 0; m < 4; ++m)
#pragma unroll
                for (int n = 0; n < 4; ++n)
                    acc[m][n] = SWAP ? __builtin_amdgcn_mfma_f32_16x16x32_bf16(bf[n], af[m], acc[m][n], 0, 0, 0)
                                     : __builtin_amdgcn_mfma_f32_16x16x32_bf16(af[m], bf[n], acc[m][n], 0, 0, 0);
        }
        if (kt + 1 < nk) GM_WRITE(s ^ 1);
        __syncthreads();
    }
#undef GM_LOAD
#undef GM_WRITE
}
__device__ __forceinline__ void zero_acc(f32x4 (&acc)[4][4]) {
#pragma unroll
    for (int m = 0; m < 4; ++m)
#pragma unroll
        for (int n = 0; n < 4; ++n) acc[m][n] = (f32x4){0.f, 0.f, 0.f, 0.f};
}

__device__ __forceinline__ void cumsum_block(const Params& p, LAS char* lds, int bh) {
    const float* lf = (const float*)(p.ws + WS_LOGF) + (size_t)bh * LPK; float* ck = (float*)(p.ws + WS_CK) + (size_t)bh * LPK;
    LAS float* sums = (LAS float*)lds;
    const int tid = threadIdx.x; constexpr int PER = 33, L = SEQ + NMETA;
    float loc = 0.f;
    for (int e = 0; e < PER; ++e) { const int t = tid * PER + e; if (t < L) loc += lf[t < 16 ? 8192 + t : t - 16]; }
    sums[tid] = loc;
    __syncthreads();
    float run = 0.f;
    for (int i = 0; i < tid; ++i) run += sums[i];
    for (int e = 0; e < PER; ++e) { const int t = tid * PER + e; if (t < L) { const int kx = t < 16 ? 8192 + t : t - 16; run += lf[kx]; ck[kx] = run * LOG2E; } }
    __syncthreads();
}

__device__ __forceinline__ void phase1(const Params& p, LAS char* lds) {
    unsigned char* ws = p.ws;
    if (blockIdx.x < 16) cumsum_block(p, lds, blockIdx.x);
    const int lane = threadIdx.x & 63, w = wave_id(), wr = w >> 1, wc = w & 1;
    const bf16_t* xb = (const bf16_t*)(ws + WS_A); const bf16_t* Bt = (const bf16_t*)(ws + WS_BTIN);
    const float* r1 = (const float*)(ws + WS_R1);
    constexpr int NTN = 40, NTM = 129;
    for (int t = blockIdx.x; t < NTN * NTM; t += gridDim.x) {
        const int tn = t % NTN, tm = t / NTN, row0 = tm * 128, col0 = tn * 128;
        const bool vtile = (tn >= 8 && tn < 12) || (tn >= 20 && tn < 24);
        f32x4 acc[4][4]; zero_acc(acc);
        if (vtile) {
            gemm_main<false>(lds, xb + (size_t)row0 * D, D, Bt + (size_t)col0 * D, D, 16, acc);
            bf16_t* vT = (bf16_t*)(ws + (tn < 12 ? WS_VFT : WS_VST)); const int cb = tn < 12 ? 1024 : 2560;
            const int g = lane >> 4, gp = ((g & 1) << 1) | (g >> 1);
#pragma unroll
            for (int m = 0; m < 4; ++m) {
                const int rb = row0 + wr * 64 + m * 16; int b, kb16;
                if (rb < MX) { b = rb >> 13; kb16 = rb & 8191; } else { const int j = rb - MX; if (j >= 32) continue; b = j >> 4; kb16 = 8192; }
                const f32x4 rs = *(const f32x4*)(r1 + rb + g * 4);
#pragma unroll
                for (int n = 0; n < 4; ++n) {
                    const int dc = col0 + wc * 64 + n * 16 + (lane & 15) - cb, h = dc >> 6, d = dc & 63;
                    const f32x4 v = acc[m][n] * rs;
                    *(u32x2*)(vT + ((size_t)(b * 8 + h) * 64 + d) * LPK + kb16 + gp * 4) = (u32x2){pk_bf16(v[0], v[1]), pk_bf16(v[2], v[3])};
                }
            }
        } else {
            gemm_main<true>(lds, xb + (size_t)row0 * D, D, Bt + (size_t)col0 * D, D, 16, acc);
            bf16_t* dst; int ld, cb; float sc = 1.f; bool sg = false;
            if (tn < 4) { dst = (bf16_t*)(ws + WS_QF); ld = 512; cb = 0; sc = 0.125f * LOG2E; }
            else if (tn < 8) { dst = (bf16_t*)(ws + WS_KF); ld = 512; cb = 512; }
            else if (tn < 16) { dst = (bf16_t*)(ws + WS_QS); ld = 512; cb = 1536; sc = 0.125f; }
            else if (tn < 20) { dst = (bf16_t*)(ws + WS_KS); ld = 512; cb = 2048; }
            else if (tn < 32) { dst = (bf16_t*)(ws + WS_B); ld = 1024; cb = 3072; sg = true; }
            else { dst = (bf16_t*)(ws + WS_B + SZ_M1024); ld = 1024; cb = 4096; sg = true; }
#pragma unroll
            for (int m = 0; m < 4; ++m) {
                const int row = row0 + wr * 64 + m * 16 + (lane & 15); const float rs = r1[row] * sc;
#pragma unroll
                for (int n = 0; n < 4; ++n) {
                    const int col = col0 + wc * 64 + n * 16 + (lane >> 4) * 4 - cb;
                    f32x4 v = acc[m][n] * rs;
                    if (sg) { v[0] = sigmoidf_(v[0]); v[1] = sigmoidf_(v[1]); v[2] = sigmoidf_(v[2]); v[3] = sigmoidf_(v[3]); }
                    *(u32x2*)(dst + (size_t)row * ld + col) = (u32x2){pk_bf16(v[0], v[1]), pk_bf16(v[2], v[3])};
                }
            }
        }
    }
}

constexpr int AT_STAGE = 16640;
template <int TYPE>
__device__ __forceinline__ void attn_unit(LAS char* lds, const Params& p, int b, int h, int qb) {
    unsigned char* ws = p.ws;
    const int tid = threadIdx.x, lane = tid & 63, w = wave_id(), ql = lane & 31, hi = lane >> 5;
    const bf16_t* Q = (const bf16_t*)(ws + (TYPE == 0 ? WS_QF : WS_QS));
    const bf16_t* Kp = (const bf16_t*)(ws + (TYPE == 0 ? WS_KF : WS_KS));
    const bf16_t* VT = (const bf16_t*)(ws + (TYPE == 0 ? WS_VFT : WS_VST)) + (size_t)(b * 8 + h) * 64 * LPK;
    const float* cK = (const float*)(ws + WS_CK) + (size_t)(b * 8 + h) * LPK;
    bf16_t* Oo = (bf16_t*)(ws + WS_A + (TYPE == 0 ? 0 : SZ_M512));
    const bool meta_unit = qb < 0;
    const int qrow0 = meta_unit ? MX + 16 * b : b * SEQ + qb * 128;
    const int nt = meta_unit ? 1 : 2 * qb + 3;
    int qrow = qrow0 + 32 * w + ql; if (qrow > M - 1) qrow = M - 1;
    bf16x8 qf[4];
#pragma unroll
    for (int ds = 0; ds < 4; ++ds) qf[ds] = *(const bf16x8*)(Q + (size_t)qrow * 512 + h * 64 + ds * 16 + hi * 8);
    f32x16 O0, O1;
#pragma unroll
    for (int i = 0; i < 16; ++i) { O0[i] = 0.f; O1[i] = 0.f; }
    float m_run = -INFINITY, lsum = 0.f, R = 0.f;
    u32x4 kreg[2], vreg[2]; float creg = 0.f;
    const int srow = tid >> 3, spos = tid & 7;
    const int swz_st = (spos ^ ((srow >> 1) & 7)) << 4;
    const int swz = (lane >> 1) & 7;
    LAS unsigned* flags = (LAS unsigned*)(lds + 2 * AT_STAGE);
#define AT_LOAD(j) do { int krow0_, kidx0_; if (!meta_unit && (j) < nt - 1) { const int kt_ = nt - 2 - (j); krow0_ = b * SEQ + 64 * kt_; kidx0_ = 64 * kt_; } else { krow0_ = MX + 16 * b; kidx0_ = 8192; } \
        _Pragma("unroll") for (int i_ = 0; i_ < 2; ++i_) { \
            kreg[i_] = *(const u32x4*)(Kp + (size_t)(krow0_ + srow + 32 * i_) * 512 + h * 64 + spos * 8); \
            vreg[i_] = *(const u32x4*)(VT + (size_t)(srow + 32 * i_) * LPK + kidx0_ + spos * 8); } \
        if (TYPE == 0 && tid < 64) creg = cK[kidx0_ + tid]; } while (0)
#define AT_WRITE(s) do { _Pragma("unroll") for (int i_ = 0; i_ < 2; ++i_) { \
            *(LAS u32x4*)(lds + (s) * AT_STAGE + (srow + 32 * i_) * 128 + swz_st) = kreg[i_]; \
            *(LAS u32x4*)(lds + (s) * AT_STAGE + 8192 + (srow + 32 * i_) * 128 + swz_st) = vreg[i_]; } \
        if (TYPE == 0 && tid < 64) *(LAS float*)(lds + (s) * AT_STAGE + 16384 + tid * 4) = creg; } while (0)
    AT_LOAD(0); AT_WRITE(0);
    __syncthreads();
    for (int j = 0; j < nt; ++j) {
        const bool more = j + 1 < nt;
        if (more) AT_LOAD(j + 1);
        int klim, d0;
        if (meta_unit) { klim = 16; d0 = 0; }
        else if (j == nt - 1) { klim = 16; d0 = 1 << 20; }
        else { klim = 64; d0 = 128 * qb - 64 * (nt - 2 - j); if (d0 >= 64) d0 = 1 << 20; }
        const int limw = 32 * w + d0 - TYPE;
        bool wdone = false;
        if (limw + 31 >= 0) {
            const LAS char* sb = lds + (j & 1) * AT_STAGE;
            int kmax = limw + ql; if (kmax > klim - 1) kmax = klim - 1;
            const bool needmask = (klim < 64) || (limw < 63);
            f32x16 S0, S1;
#pragma unroll
            for (int i = 0; i < 16; ++i) { S0[i] = 0.f; S1[i] = 0.f; }
#pragma unroll
            for (int ds = 0; ds < 4; ++ds) {
                const bf16x8 k0 = *(const LAS bf16x8*)(sb + ql * 128 + (((2 * ds + hi) ^ swz) << 4));
                const bf16x8 k1 = *(const LAS bf16x8*)(sb + (32 + ql) * 128 + (((2 * ds + hi) ^ swz) << 4));
                S0 = __builtin_amdgcn_mfma_f32_32x32x16_bf16(k0, qf[ds], S0, 0, 0, 0);
                S1 = __builtin_amdgcn_mfma_f32_32x32x16_bf16(k1, qf[ds], S1, 0, 0, 0);
            }
            if (TYPE == 0) {
#pragma unroll
                for (int g = 0; g < 4; ++g) {
                    const f32x4 c0 = *(const LAS f32x4*)(sb + 16384 + (8 * g + 4 * hi) * 4), c1 = *(const LAS f32x4*)(sb + 16384 + (32 + 8 * g + 4 * hi) * 4);
#pragma unroll
                    for (int i = 0; i < 4; ++i) { S0[4 * g + i] -= c0[i]; S1[4 * g + i] -= c1[i]; }
                }
                if (needmask) {
#pragma unroll
                    for (int r = 0; r < 16; ++r) { const int kl = (r & 3) + 8 * (r >> 2) + 4 * hi; if (kl > kmax) S0[r] = -INFINITY; if (kl + 32 > kmax) S1[r] = -INFINITY; }
                }
                float mx = -INFINITY;
#pragma unroll
                for (int r = 0; r < 16; ++r) mx = fmaxf(mx, fmaxf(S0[r], S1[r]));
                mx = fmaxf(mx, __shfl_xor(mx, 32));
                const float m_new = fmaxf(m_run, mx), alpha = ex2(m_run - m_new);
                m_run = m_new;
                float ps = 0.f;
#pragma unroll
                for (int r = 0; r < 16; ++r) { S0[r] = ex2(S0[r] - m_new); S1[r] = ex2(S1[r] - m_new); ps += S0[r] + S1[r]; }
                lsum = lsum * alpha + ps;
#pragma unroll
                for (int r = 0; r < 16; ++r) { O0[r] *= alpha; O1[r] *= alpha; }
            } else {
                float G0[4], G1[4];
                f32x16 L0, L1;
#pragma unroll
                for (int r = 0; r < 16; ++r) {
                    const int kl = (r & 3) + 8 * (r >> 2) + 4 * hi;
                    const float z0 = S0[r], z1 = S1[r];
                    const float sp0 = fmaxf(z0, 0.f) + lg2(1.0f + ex2(-fabsf(z0) * LOG2E)) * LN2;
                    const float sp1 = fmaxf(z1, 0.f) + lg2(1.0f + ex2(-fabsf(z1) * LOG2E)) * LN2;
                    L0[r] = (!needmask || kl <= kmax) ? -sp0 : 0.f;
                    L1[r] = (!needmask || kl + 32 <= kmax) ? -sp1 : 0.f;
                }
#pragma unroll
                for (int g = 0; g < 4; ++g) {
                    L0[4 * g + 2] += L0[4 * g + 3]; L0[4 * g + 1] += L0[4 * g + 2]; L0[4 * g] += L0[4 * g + 1]; G0[g] = L0[4 * g];
                    L1[4 * g + 2] += L1[4 * g + 3]; L1[4 * g + 1] += L1[4 * g + 2]; L1[4 * g] += L1[4 * g + 1]; G1[g] = L1[4 * g];
                }
                float run = R;
#pragma unroll
                for (int g = 3; g >= 0; --g) {
                    const float gp = __shfl_xor(G1[g], 32);
                    const float off = hi ? run : run + gp;
#pragma unroll
                    for (int i = 0; i < 4; ++i) { const int r = 4 * g + i; const int kl = 32 + i + 8 * g + 4 * hi;
                        const float a = ex2((S1[r] + L1[r] + off) * LOG2E); S1[r] = (!needmask || kl <= kmax) ? a : 0.f; }
                    run += G1[g] + gp;
                }
#pragma unroll
                for (int g = 3; g >= 0; --g) {
                    const float gp = __shfl_xor(G0[g], 32);
                    const float off = hi ? run : run + gp;
#pragma unroll
                    for (int i = 0; i < 4; ++i) { const int r = 4 * g + i; const int kl = i + 8 * g + 4 * hi;
                        const float a = ex2((S0[r] + L0[r] + off) * LOG2E); S0[r] = (!needmask || kl <= kmax) ? a : 0.f; }
                    run += G0[g] + gp;
                }
                R = run;
                wdone = __all(R < -120.0f) != 0;
            }
#pragma unroll
            for (int ks = 0; ks < 4; ++ks) {
                bf16x8 pf; u32x4 pu;
                if (ks < 2) { pu = (u32x4){pk_bf16(S0[8 * ks + 0], S0[8 * ks + 1]), pk_bf16(S0[8 * ks + 2], S0[8 * ks + 3]), pk_bf16(S0[8 * ks + 4], S0[8 * ks + 5]), pk_bf16(S0[8 * ks + 6], S0[8 * ks + 7])}; }
                else { const int k2 = ks - 2; pu = (u32x4){pk_bf16(S1[8 * k2 + 0], S1[8 * k2 + 1]), pk_bf16(S1[8 * k2 + 2], S1[8 * k2 + 3]), pk_bf16(S1[8 * k2 + 4], S1[8 * k2 + 5]), pk_bf16(S1[8 * k2 + 6], S1[8 * k2 + 7])}; }
                pf = __builtin_bit_cast(bf16x8, pu);
                const bf16x8 v0 = *(const LAS bf16x8*)(sb + 8192 + ql * 128 + (((2 * ks + hi) ^ swz) << 4));
                const bf16x8 v1 = *(const LAS bf16x8*)(sb + 8192 + (32 + ql) * 128 + (((2 * ks + hi) ^ swz) << 4));
                O0 = __builtin_amdgcn_mfma_f32_32x32x16_bf16(v0, pf, O0, 0, 0, 0);
                O1 = __builtin_amdgcn_mfma_f32_32x32x16_bf16(v1, pf, O1, 0, 0, 0);
            }
        }
        if (more) AT_WRITE((j + 1) & 1);
        if (TYPE == 1 && lane == 0) flags[(j & 1) * 4 + w] = wdone ? 1u : 0u;
        __syncthreads();
        if (TYPE == 1) { const LAS unsigned* fl = flags + (j & 1) * 4; const unsigned f = fl[0] & fl[1] & fl[2] & fl[3]; if (f) break; }
    }
    float inv = 1.0f;
    if (TYPE == 0) { const float l = lsum + __shfl_xor(lsum, 32); inv = 1.0f / l; }
    const bool qvalid = meta_unit ? (w == 0 && ql < 16) : true;
    if (qvalid) {
        bf16_t* op = Oo + (size_t)qrow * 512 + h * 64 + 4 * hi;
#pragma unroll
        for (int g = 0; g < 4; ++g) {
            *(u32x2*)(op + 8 * g) = (u32x2){pk_bf16(O0[4 * g] * inv, O0[4 * g + 1] * inv), pk_bf16(O0[4 * g + 2] * inv, O0[4 * g + 3] * inv)};
            *(u32x2*)(op + 32 + 8 * g) = (u32x2){pk_bf16(O1[4 * g] * inv, O1[4 * g + 1] * inv), pk_bf16(O1[4 * g + 2] * inv, O1[4 * g + 3] * inv)};
        }
    }
    __syncthreads();
#undef AT_LOAD
#undef AT_WRITE
}

__device__ __forceinline__ void phase2(const Params& p, LAS char* lds) {
    unsigned* ctr = (unsigned*)(p.ws + WS_CTL);
    LAS unsigned* shu = (LAS unsigned*)(lds + 2 * AT_STAGE + 64);
    constexpr int NU = 2048 + 32;
    const int G = gridDim.x;
    for (int it = blockIdx.x; it < NU; it += G) {
        int u = it;
        if (it < 1024 && (1024 % (2 * G)) == 0) { const int rnd = it / G, pos = it - rnd * G; u = (rnd & 1) ? ((rnd + 1) * G - 1 - pos) : it; }
        if (u < 1024) attn_unit<0>(lds, p, (u & 15) >> 3, u & 7, 63 - (u >> 4));
        else if (u < 2048) { const int v = u - 1024; attn_unit<1>(lds, p, (v & 15) >> 3, v & 7, 63 - (v >> 4)); }
        else if (u < 2064) { const int v = u - 2048; attn_unit<0>(lds, p, v >> 3, v & 7, -1); }
        else { const int v = u - 2064; attn_unit<1>(lds, p, v >> 3, v & 7, -1); }
    }
}

__device__ __forceinline__ void phase3a(const Params& p, LAS char* lds) {
    unsigned char* ws = p.ws;
    const int lane = threadIdx.x & 63, w = wave_id(), wr = w >> 1, wc = w & 1;
    const bf16_t* oa = (const bf16_t*)(ws + WS_A); const bf16_t* ob = oa + (size_t)M * 512;
    const bf16_t* ga = (const bf16_t*)(ws + WS_B); const bf16_t* gb = ga + (size_t)M * 1024;
    bf16_t* gated = (bf16_t*)(ws + WS_GATED);
    for (int t = blockIdx.x; t < 129 * 8; t += gridDim.x) {
        const int tn = t & 7, tm = t >> 3, row0 = tm * 128, col0 = tn * 128;
        f32x4 acc[4][4]; zero_acc(acc);
        gemm_main<true>(lds, oa + (size_t)row0 * 512, 512, (const bf16_t*)(ws + WS_BTOF) + (size_t)col0 * 512, 512, 8, acc);
#pragma unroll
        for (int m = 0; m < 4; ++m) {
            const int row = row0 + wr * 64 + m * 16 + (lane & 15);
#pragma unroll
            for (int n = 0; n < 4; ++n) {
                const int col = col0 + wc * 64 + n * 16 + (lane >> 4) * 4;
                const u32x2 a = *(const u32x2*)(ga + (size_t)row * 1024 + col);
                const f32x4 x = acc[m][n];
                *(u32x2*)(gated + (size_t)row * 1024 + col) = (u32x2){pk_bf16(bf_lo(a[0]) * x[0], bf_hi(a[0]) * x[1]), pk_bf16(bf_lo(a[1]) * x[2], bf_hi(a[1]) * x[3])};
            }
        }
        zero_acc(acc);
        gemm_main<true>(lds, ob + (size_t)row0 * 512, 512, (const bf16_t*)(ws + WS_BTOS) + (size_t)col0 * 512, 512, 8, acc);
#pragma unroll
        for (int m = 0; m < 4; ++m) {
            const int row = row0 + wr * 64 + m * 16 + (lane & 15);
#pragma unroll
            for (int n = 0; n < 4; ++n) {
                const int col = col0 + wc * 64 + n * 16 + (lane >> 4) * 4;
                const u32x2 b = *(const u32x2*)(gb + (size_t)row * 1024 + col);
                const f32x4 y = acc[m][n]; const u32x2 q = *(const u32x2*)(gated + (size_t)row * 1024 + col);
                const float o0 = bf_lo(q[0]) + bf_lo(b[0]) * y[0], o1 = bf_hi(q[0]) + bf_hi(b[0]) * y[1];
                const float o2 = bf_lo(q[1]) + bf_lo(b[1]) * y[2], o3 = bf_hi(q[1]) + bf_hi(b[1]) * y[3];
                *(u32x2*)(gated + (size_t)row * 1024 + col) = (u32x2){pk_bf16(o0, o1), pk_bf16(o2, o3)};
            }
        }
    }
}
__device__ __forceinline__ void epi_store_ss(const f32x4 (&acc)[4][4], bf16_t* out, int ldo, int orow0, int col0, float* ssp, int ssrow0, int wr, int wc, int lane) {
#pragma unroll
    for (int m = 0; m < 4; ++m) {
        const int rl = wr * 64 + m * 16 + (lane & 15);
        float s = 0.f;
#pragma unroll
        for (int n = 0; n < 4; ++n) {
            const int col = col0 + wc * 64 + n * 16 + (lane >> 4) * 4;
            const f32x4 v = acc[m][n];
            s += v[0] * v[0] + v[1] * v[1] + v[2] * v[2] + v[3] * v[3];
            *(u32x2*)(out + (size_t)(orow0 + rl) * ldo + col) = (u32x2){pk_bf16(v[0], v[1]), pk_bf16(v[2], v[3])};
        }
#if 1
        s += __shfl_xor(s, 16); s += __shfl_xor(s, 32);
        if (lane < 16) ssp[(size_t)((col0 >> 7) * 2 + wc) * M + ssrow0 + rl] = s;
#endif
    }
}
__device__ __forceinline__ void phase3b(const Params& p, LAS char* lds) {
    unsigned char* ws = p.ws;
    const int lane = threadIdx.x & 63, w = wave_id(), wr = w >> 1, wc = w & 1;
    const bf16_t* gated = (const bf16_t*)(ws + WS_GATED); bf16_t* mixed = (bf16_t*)(ws + WS_MIXED);
    for (int t = blockIdx.x; t < 129 * 8; t += gridDim.x) {
        const int tn = t & 7, tm = t >> 3, row0 = tm * 128, col0 = tn * 128;
        f32x4 acc[4][4]; zero_acc(acc);
        gemm_main<true>(lds, gated + (size_t)row0 * 1024, 1024, (const bf16_t*)(ws + WS_BTOUT) + (size_t)col0 * 1024, 1024, 16, acc);
        epi_store_ss(acc, mixed, 1024, row0, col0, (float*)(ws + WS_SSP2), row0, wr, wc, lane);
    }
}
__device__ __forceinline__ void phase3c(const Params& p) {
    unsigned char* ws = p.ws;
    const int lane = threadIdx.x & 63, w = wave_id();
    const bf16_t* mixed = (const bf16_t*)(ws + WS_MIXED); bf16_t* hb = (bf16_t*)(ws + WS_A);
    const float* ssp2 = (const float*)(ws + WS_SSP2); float* r2 = (float*)(ws + WS_R2);
    const float* g1 = p.gains + D;
    for (int r_ = blockIdx.x * 32 + w; r_ < M; r_ += (r_ & 31) < 28 ? 4 : gridDim.x * 32 - 28) {
        const int r = r_;
        if (r >= MV) continue;
        const float* src = r < MX ? p.x + (size_t)r * D : p.meta + (size_t)((r - MX) & 15) * D;
        float sq = lane < 16 ? ssp2[(size_t)lane * M + r] : 0.f;
        sq = wave_sum(sq);
        const float a = 1.0f / sqrtf(sq * (1.0f / D) + EPS);
        float ss = 0.f;
#pragma unroll
        for (int i = 0; i < 4; ++i) {
            const int col = lane * 4 + 256 * i;
            const f32x4 v = *(const f32x4*)(src + col), g = *(const f32x4*)(g1 + col);
            const u32x2 mx = *(const u32x2*)(mixed + (size_t)r * D + col);
            f32x4 hh;
            hh[0] = v[0] + bf_lo(mx[0]) * a * g[0]; hh[1] = v[1] + bf_hi(mx[0]) * a * g[1];
            hh[2] = v[2] + bf_lo(mx[1]) * a * g[2]; hh[3] = v[3] + bf_hi(mx[1]) * a * g[3];
            ss += hh[0] * hh[0] + hh[1] * hh[1] + hh[2] * hh[2] + hh[3] * hh[3];
            *(u32x2*)(hb + (size_t)r * D + col) = (u32x2){pk_bf16(hh[0], hh[1]), pk_bf16(hh[2], hh[3])};
            if (r < MX) *(f32x4*)(p.out + (size_t)r * D + col) = hh;
        }
        ss = wave_sum(ss);
        if (lane == 0) r2[r] = 1.0f / sqrtf(ss * (1.0f / D) + EPS);
    }
}
__device__ __forceinline__ void phase4(const Params& p, LAS char* lds, int b) {
    unsigned char* ws = p.ws;
    const int lane = threadIdx.x & 63, w = wave_id(), wr = w >> 1, wc = w & 1;
    const bf16_t* hb = (const bf16_t*)(ws + WS_A); const bf16_t* Bt = (const bf16_t*)(ws + WS_BTUP);
    const float* r2 = (const float*)(ws + WS_R2);
    bf16_t* up = (bf16_t*)(ws + WS_UP); bf16_t* upm = (bf16_t*)(ws + WS_UPMETA);
    const int ntm = b == 0 ? 65 : 64;
    for (int t = blockIdx.x; t < ntm * 44; t += gridDim.x) {
        const int tn = t % 44, tm = t / 44, col0 = tn * 128;
        const bool mt = tm == 64; const int row0 = mt ? MX : b * SEQ + tm * 128;
        f32x4 acc[4][4]; zero_acc(acc);
        gemm_main<true>(lds, hb + (size_t)row0 * D, D, Bt + (size_t)col0 * D, D, 16, acc);
#pragma unroll
        for (int m = 0; m < 4; ++m) {
            const int rl = wr * 64 + m * 16 + (lane & 15), row = row0 + rl;
            if (mt && rl >= 32) continue;
            const float rs = r2[row];
            bf16_t* orow = mt ? upm + (size_t)rl * NUP : up + (size_t)(tm * 128 + rl) * NUP;
#pragma unroll
            for (int n = 0; n < 4; ++n) {
                const int col = col0 + wc * 64 + n * 16 + (lane >> 4) * 4;
                const f32x4 v = acc[m][n] * rs;
                *(u32x2*)(orow + col) = (u32x2){pk_bf16(v[0], v[1]), pk_bf16(v[2], v[3])};
            }
        }
    }
}
__device__ __forceinline__ void unpack8(const u32x4 u, float (&f)[8]) {
    f[0] = bf_lo(u[0]); f[1] = bf_hi(u[0]); f[2] = bf_lo(u[1]); f[3] = bf_hi(u[1]); f[4] = bf_lo(u[2]); f[5] = bf_hi(u[2]); f[6] = bf_lo(u[3]); f[7] = bf_hi(u[3]);
}
__device__ __forceinline__ void phase5(const Params& p, int b) {
    unsigned char* ws = p.ws;
    const bf16_t* up = (const bf16_t*)(ws + WS_UP); const bf16_t* upm = (const bf16_t*)(ws + WS_UPMETA);
    bf16_t* act = (bf16_t*)(ws + WS_ACT);
    constexpr int NCH = DFF / 8, NIT = (SEQ / 8) * NCH;
    for (int it = blockIdx.x * NTHREADS + threadIdx.x; it < NIT; it += gridDim.x * NTHREADS) {
        const int ch = it % NCH, grp = it / NCH, c8 = ch * 8, i0 = grp * 8;
        float w0g[8], w1g[8], w2g[8], bg[8], w0v[8], w1v[8], w2v[8], bv[8];
#pragma unroll
        for (int e = 0; e < 8; e += 4) {
            *(f32x4*)(w0g + e) = *(const f32x4*)(p.conv_w + c8 + e); *(f32x4*)(w1g + e) = *(const f32x4*)(p.conv_w + NUP + c8 + e); *(f32x4*)(w2g + e) = *(const f32x4*)(p.conv_w + 2 * NUP + c8 + e);
            *(f32x4*)(bg + e) = *(const f32x4*)(p.conv_b + c8 + e);
            *(f32x4*)(w0v + e) = *(const f32x4*)(p.conv_w + DFF + c8 + e); *(f32x4*)(w1v + e) = *(const f32x4*)(p.conv_w + NUP + DFF + c8 + e); *(f32x4*)(w2v + e) = *(const f32x4*)(p.conv_w + 2 * NUP + DFF + c8 + e);
            *(f32x4*)(bv + e) = *(const f32x4*)(p.conv_b + DFF + c8 + e);
        }
        const bf16_t* r2p = i0 == 0 ? upm + (size_t)(b * 16 + 14) * NUP : up + (size_t)(i0 - 2) * NUP;
        const bf16_t* r1p = i0 == 0 ? upm + (size_t)(b * 16 + 15) * NUP : up + (size_t)(i0 - 1) * NUP;
        float p2g[8], p1g[8], p2v[8], p1v[8];
        unpack8(*(const u32x4*)(r2p + c8), p2g); unpack8(*(const u32x4*)(r2p + DFF + c8), p2v);
        unpack8(*(const u32x4*)(r1p + c8), p1g); unpack8(*(const u32x4*)(r1p + DFF + c8), p1v);
#pragma unroll
        for (int r = 0; r < 8; ++r) {
            float cg_[8], cv_[8];
            unpack8(*(const u32x4*)(up + (size_t)(i0 + r) * NUP + c8), cg_); unpack8(*(const u32x4*)(up + (size_t)(i0 + r) * NUP + DFF + c8), cv_);
            float o[8];
#pragma unroll
            for (int e = 0; e < 8; ++e) {
                const float ug = bg[e] + w0g[e] * p2g[e] + w1g[e] * p1g[e] + w2g[e] * cg_[e];
                const float uv = bv[e] + w0v[e] * p2v[e] + w1v[e] * p1v[e] + w2v[e] * cv_[e];
                const float t = 0.7978845608028654f * (ug + 0.044715f * ug * ug * ug);
                const float ge = ug * rcp(1.0f + ex2(-2.0f * LOG2E * t));
                o[e] = ge * uv;
                p2g[e] = p1g[e]; p1g[e] = cg_[e]; p2v[e] = p1v[e]; p1v[e] = cv_[e];
            }
            *(u32x4*)(act + (size_t)(i0 + r) * DFF + c8) = (u32x4){pk_bf16(o[0], o[1]), pk_bf16(o[2], o[3]), pk_bf16(o[4], o[5]), pk_bf16(o[6], o[7])};
        }
    }
}
__device__ __forceinline__ void phase6(const Params& p, LAS char* lds, int b) {
    unsigned char* ws = p.ws;
    const int lane = threadIdx.x & 63, w = wave_id(), wr = w >> 1, wc = w & 1;
    const bf16_t* act = (const bf16_t*)(ws + WS_ACT); bf16_t* ffn = (bf16_t*)(ws + WS_FFN);
    for (int t = blockIdx.x; t < 64 * 8; t += gridDim.x) {
        const int tn = t & 7, tm = t >> 3, col0 = tn * 128;
        f32x4 acc[4][4]; zero_acc(acc);
        gemm_main<true>(lds, act + (size_t)(tm * 128) * DFF, DFF, (const bf16_t*)(ws + WS_BTDN) + (size_t)col0 * DFF, DFF, 44, acc);
        epi_store_ss(acc, ffn, 1024, b * SEQ + tm * 128, col0, (float*)(ws + WS_SSP4), b * SEQ + tm * 128, wr, wc, lane);
    }
}
__device__ __forceinline__ void phase7(const Params& p) {
    unsigned char* ws = p.ws;
    const bf16_t* ffn = (const bf16_t*)(ws + WS_FFN); const float* ssp4 = (const float*)(ws + WS_SSP4); const float* g3 = p.gains + 3 * D;
    for (int it = blockIdx.x * NTHREADS + threadIdx.x; it < MX * 256; it += gridDim.x * NTHREADS) {
        const int row = it >> 8, col = (it & 255) * 4;
        float sq = 0.f;
#pragma unroll
        for (int sl = 0; sl < 16; ++sl) sq += ssp4[(size_t)sl * M + row];
        const float a = 1.0f / sqrtf(sq * (1.0f / D) + EPS);
        const f32x4 hh = *(const f32x4*)(p.out + (size_t)row * D + col), g = *(const f32x4*)(g3 + col);
        const u32x2 f = *(const u32x2*)(ffn + (size_t)row * D + col);
        f32x4 o;
        o[0] = hh[0] + bf_lo(f[0]) * a * g[0]; o[1] = hh[1] + bf_hi(f[0]) * a * g[1];
        o[2] = hh[2] + bf_lo(f[1]) * a * g[2]; o[3] = hh[3] + bf_hi(f[1]) * a * g[3];
        *(f32x4*)(p.out + (size_t)row * D + col) = o;
    }
}


#ifndef DUMP
#define DUMP 0
#endif
__device__ __forceinline__ void phase_dump(const Params& p) {
    unsigned char* ws = p.ws;
    const bf16_t* s0; const bf16_t* s1; int ld;
    if (DUMP == 1) { s0 = (const bf16_t*)(ws + WS_B); s1 = s0 + 512; ld = 1024; }
    else if (DUMP == 2) { s0 = (const bf16_t*)(ws + WS_QF); s1 = (const bf16_t*)(ws + WS_KF); ld = 512; }
    else if (DUMP == 3) { s0 = (const bf16_t*)(ws + WS_A); s1 = s0 + (size_t)M * 512; ld = 512; }
    else if (DUMP == 4) { s0 = (const bf16_t*)(ws + WS_GATED); s1 = s0 + 512; ld = 1024; }
    else if (DUMP == 8) { s0 = (const bf16_t*)(ws + WS_A); s1 = s0 + 512; ld = 1024; }
    else if (DUMP == 9) { s0 = (const bf16_t*)(ws + WS_ACT) + 1024; s1 = (const bf16_t*)(ws + WS_ACT) + 2304 - 512 + 512; ld = DFF; }
    else if (DUMP == 10) { s0 = (const bf16_t*)(ws + WS_FFN); s1 = s0 + 512; ld = 1024; }
    else if (DUMP == 11) { s0 = (const bf16_t*)(ws + WS_UP); s1 = s0 + 512; ld = NUP; }
    else if (DUMP == 6) { s0 = (const bf16_t*)(ws + WS_QS); s1 = (const bf16_t*)(ws + WS_KS); ld = 512; }
    else { s0 = (const bf16_t*)(ws + WS_MIXED); s1 = s0 + 512; ld = 1024; }
    for (int it = blockIdx.x * NTHREADS + threadIdx.x; it < MX * 1024; it += gridDim.x * NTHREADS) {
        const int row = it >> 10, col = it & 1023;
        if (DUMP >= 9 && row >= 8192) { p.out[it] = 0.f; continue; }
        const bf16_t v = col < 512 ? s0[(size_t)row * ld + col] : s1[(size_t)row * ld + col - 512];
        p.out[it] = __uint_as_float((unsigned)v << 16);
    }
}

__device__ __forceinline__ void l2_scrub(const Params& p) {
    const f32x4* src = (const f32x4*)p.x + (size_t)(blockIdx.x & 511) * 8192;
    f32x4 a = (f32x4){0.f, 0.f, 0.f, 0.f};
    for (int i = threadIdx.x; i < 8192; i += NTHREADS) a += src[i];
    if (a[0] + a[1] + a[2] + a[3] == 1.2345e-30f) ((float*)(p.ws + WS_CTL))[32 + (threadIdx.x & 7)] = a[0];
}

__device__ __forceinline__ void my_grid_sync(const Params& p, unsigned& target) {
    unsigned* bar = (unsigned*)(p.ws + WS_CTL) + 16;
    asm volatile("s_waitcnt vmcnt(0)" ::: "memory");
    __syncthreads();
    target += gridDim.x;
    if (threadIdx.x == 0) {
        __builtin_amdgcn_fence(__ATOMIC_RELEASE, "agent");
        asm volatile("s_waitcnt vmcnt(0)" ::: "memory");
        __hip_atomic_fetch_add(bar, 1u, __ATOMIC_RELAXED, __HIP_MEMORY_SCOPE_AGENT);
        while (__hip_atomic_load(bar, __ATOMIC_RELAXED, __HIP_MEMORY_SCOPE_AGENT) < target) __builtin_amdgcn_s_sleep(2);
        __builtin_amdgcn_fence(__ATOMIC_ACQUIRE, "agent");
        asm volatile("s_waitcnt vmcnt(0)" ::: "memory");
    }
    __syncthreads();
}
__global__ void __launch_bounds__(NTHREADS, 2) fwd_kernel(Params p) {
    extern __shared__ __attribute__((aligned(16))) unsigned char lds_raw[];
    LAS char* lds = (LAS char*)lds_raw;
    cg::grid_group grid = cg::this_grid();
#define IN(k) (p.ph_lo <= (k) && (k) < p.ph_hi)
#define SEAM(k) do { if (IN(k) && IN((k) + 1)) { if (p.ph_hi > 1000) grid.sync(); my_grid_sync(p, bar_target); } } while (0)
    unsigned bar_target = 0u;
    if (IN(0)) phase0(p, lds);
    SEAM(0);
    if (IN(1)) phase1(p, lds);
    SEAM(1);
    if (IN(2)) phase2(p, lds);
    SEAM(2);
    if (IN(3)) phase3a(p, lds);
    SEAM(3);
    if (IN(4)) phase3b(p, lds);
    SEAM(4);
    if (IN(5)) phase3c(p);
    SEAM(5);
    for (int b = 0; b < 2; ++b) {
        const int k0 = 6 + 3 * b;
        if (IN(k0)) phase4(p, lds, b);
        SEAM(k0);
        if (IN(k0 + 1)) phase5(p, b);
        SEAM(k0 + 1);
        if (IN(k0 + 2)) phase6(p, lds, b);
        SEAM(k0 + 2);
    }
    if (IN(12)) phase7(p);
    if (IN(13)) phase_dump(p);
#undef IN
#undef SEAM
}


__global__ void ab_save(const unsigned char* ws, float* out) {
    const u32x4* src = (const u32x4*)(ws + AB_SRC); u32x4* dst = (u32x4*)((unsigned char*)out + (size_t)32 * MiB);
    for (size_t i = blockIdx.x * (size_t)blockDim.x + threadIdx.x; i < (size_t)AB_BYTES / 16; i += (size_t)gridDim.x * blockDim.x) dst[i] = src[i];
}
__global__ void ab_diff(const unsigned char* ws, float* out) {
    const bf16_t* src = (const bf16_t*)(ws + AB_SRC); const bf16_t* sav = (const bf16_t*)((unsigned char*)out + (size_t)32 * MiB);
    for (size_t i = blockIdx.x * (size_t)blockDim.x + threadIdx.x; i < (size_t)8192 * 1024; i += (size_t)gridDim.x * blockDim.x) {
        if (i >= (size_t)AB_BYTES / 2) { out[i] = 0.f; continue; }
        out[i] = src[i] != sav[i] ? 1000.0f : 0.f;
    }
}
__global__ void ab_zero(float* out) {
    for (size_t i = blockIdx.x * (size_t)blockDim.x + threadIdx.x; i < (size_t)8192 * 1024; i += (size_t)gridDim.x * blockDim.x) out[(size_t)8192 * 1024 + i] = 0.f;
}
extern "C" void kernel_launch(void* const* d_in, const int* in_sizes, int n_in, void* d_out, int out_size, void* d_ws, size_t ws_size, hipStream_t stream) {
    static int grid_blocks = 0;
    if (grid_blocks == 0) {
        if (n_in != 12 || ws_size < WS_END) { fprintf(stderr, "kernel_launch: unexpected n_in %d or ws_size %zu (need %zu)\n", n_in, ws_size, (size_t)WS_END); grid_blocks = -1; return; }
        int dev = 0, cus = 0, per_cu = 0;
        (void)hipGetDevice(&dev);
        (void)hipDeviceGetAttribute(&cus, hipDeviceAttributeMultiprocessorCount, dev);
        (void)hipFuncSetAttribute((const void*)fwd_kernel, hipFuncAttributeMaxDynamicSharedMemorySize, LDS_BYTES);
        (void)hipOccupancyMaxActiveBlocksPerMultiprocessor(&per_cu, (const void*)fwd_kernel, NTHREADS, LDS_BYTES);
        if (per_cu < 1) per_cu = 1;
        if (per_cu > 2) per_cu = 2;
        grid_blocks = cus * per_cu;
        (void)hipGetLastError();
    }
    if (grid_blocks < 0) return;
    Params p{};
    p.x = (const float*)d_in[0]; p.meta = (const float*)d_in[1]; p.gains = (const float*)d_in[2]; p.w_in = (const float*)d_in[3];
    p.b_forget = (const float*)d_in[4]; p.w_o_fox = (const float*)d_in[5]; p.w_o_sb = (const float*)d_in[6]; p.w_out = (const float*)d_in[7];
    p.w_up = (const float*)d_in[8]; p.conv_w = (const float*)d_in[9]; p.conv_b = (const float*)d_in[10]; p.w_down = (const float*)d_in[11];
    p.out = (float*)d_out; p.ws = (unsigned char*)d_ws;
#if SINGLE_LAUNCH
    (void)hipMemsetAsync((unsigned char*)d_ws + WS_CTL, 0, 256, stream);
    p.ph_lo = 0; p.ph_hi = NPHASE;
    void* args[] = {&p};
    hipError_t e = hipLaunchCooperativeKernel((const void*)fwd_kernel, dim3(grid_blocks), dim3(NTHREADS), args, LDS_BYTES, stream);
    if (e != hipSuccess) fprintf(stderr, "cooperative launch failed: %s (grid %d)\n", hipGetErrorString(e), grid_blocks);
#else
#ifndef STOP_AT
#define STOP_AT NPHASE
#endif
    for (int k = 0; k < STOP_AT; ++k) {
        p.ph_lo = k; p.ph_hi = k + 1;
        hipLaunchKernelGGL(fwd_kernel, dim3(grid_blocks), dim3(NTHREADS), LDS_BYTES, stream, p);
    }
#if ABTEST
    ab_save<<<1024, 256, 0, stream>>>(p.ws, p.out);
    for (int k = AB_FROM; k < STOP_AT; ++k) {
        p.ph_lo = k; p.ph_hi = k + 1;
        hipLaunchKernelGGL(fwd_kernel, dim3(grid_blocks), dim3(NTHREADS), LDS_BYTES, stream, p);
    }
    ab_diff<<<1024, 256, 0, stream>>>(p.ws, p.out);
    ab_zero<<<1024, 256, 0, stream>>>(p.out);
#endif
    if (DUMP) { p.ph_lo = 13; p.ph_hi = 14; hipLaunchKernelGGL(fwd_kernel, dim3(grid_blocks), dim3(NTHREADS), LDS_BYTES, stream, p); }
#endif
}
```

```cpp
#include <hip/hip_runtime.h>
#include <hip/hip_cooperative_groups.h>
#include <cstdio>
#include <cstdint>
namespace cg = cooperative_groups;

#define DUMP 0
#define ABTEST 0
#define AB_FROM 0
#define AB_SRC WS_SSP2
#define AB_BYTES (2 * MiB)
#ifndef SINGLE_LAUNCH
#define SINGLE_LAUNCH 1
#endif

#define LAS __attribute__((address_space(3)))
typedef unsigned short bf16_t;
typedef short bf16x8 __attribute__((ext_vector_type(8)));
typedef float f32x4 __attribute__((ext_vector_type(4)));
typedef float f32x16 __attribute__((ext_vector_type(16)));
typedef unsigned u32x4 __attribute__((ext_vector_type(4)));
typedef unsigned u32x2 __attribute__((ext_vector_type(2)));

constexpr int D = 1024, SEQ = 8192, NMETA = 16, NB = 2;
constexpr int MX = NB * SEQ;
constexpr int MV = MX + NB * NMETA;
constexpr int M = 16512;
constexpr int LPK = 8256;
constexpr int PROJW = 5128, NPROJ = 5120, DFF = 2816, NUP = 5632;
constexpr float EPS = 1e-6f;
constexpr float LOG2E = 1.4426950408889634f, LN2 = 0.6931471805599453f;
constexpr int NTHREADS = 256;
constexpr int LDS_BYTES = 65536;
constexpr int NPHASE = 13;

constexpr size_t MiB = 1u << 20;
constexpr size_t WS_CTL = 0;
constexpr size_t WS_R1 = 4096, WS_R2 = WS_R1 + 69632, WS_SS2 = WS_R2 + 69632, WS_SS4 = WS_SS2 + 69632;
constexpr size_t WS_LOGF = WS_SS4 + 69632, WS_CK = WS_LOGF + 528384, WS_UPMETA = WS_CK + 528384;
constexpr size_t WS_BTIN = 2 * MiB, WS_BTOF = WS_BTIN + 10 * MiB, WS_BTOS = WS_BTOF + 1 * MiB, WS_BTOUT = WS_BTOS + 1 * MiB,
                 WS_BTUP = WS_BTOUT + 2 * MiB, WS_BTDN = WS_BTUP + 11 * MiB;
constexpr size_t SZ_M1024 = (size_t)M * 1024 * 2, SZ_M512 = (size_t)M * 512 * 2;
constexpr size_t WS_A = 33 * MiB;
constexpr size_t WS_B = WS_A + SZ_M1024;
constexpr size_t WS_C = WS_B + 2 * SZ_M1024;
constexpr size_t WS_QF = WS_C, WS_KF = WS_QF + SZ_M512, WS_QS = WS_KF + SZ_M512, WS_KS = WS_QS + SZ_M512, WS_VFT = WS_KS + SZ_M512, WS_VST = WS_VFT + SZ_M512;
constexpr size_t WS_GATED = WS_C, WS_MIXED = WS_B + SZ_M1024;
constexpr size_t WS_UP = WS_B;
constexpr size_t WS_ACT = WS_UP + 88 * MiB;
constexpr size_t WS_FFN = WS_ACT + 44 * MiB;
constexpr size_t WS_SSP2 = 230 * MiB, WS_SSP4 = 232 * MiB;
constexpr size_t WS_END = 234 * MiB;

struct Params {
    const float *x, *meta, *gains, *w_in, *b_forget, *w_o_fox, *w_o_sb, *w_out, *w_up, *conv_w, *conv_b, *w_down;
    float* out; unsigned char* ws; int ph_lo, ph_hi;
};

typedef __bf16 bf16x2_t __attribute__((ext_vector_type(2)));
__device__ __forceinline__ unsigned pk_bf16(float lo, float hi) { bf16x2_t v = {(__bf16)lo, (__bf16)hi}; return __builtin_bit_cast(unsigned, v); }
__device__ __forceinline__ float bf_lo(unsigned u) { return __uint_as_float(u << 16); }
__device__ __forceinline__ float bf_hi(unsigned u) { return __uint_as_float(u & 0xffff0000u); }
__device__ __forceinline__ float ex2(float x) { return __builtin_amdgcn_exp2f(x); }
__device__ __forceinline__ float lg2(float x) { return __builtin_amdgcn_logf(x); }
__device__ __forceinline__ float rcp(float x) { return __builtin_amdgcn_rcpf(x); }
__device__ __forceinline__ float sigmoidf_(float v) { return rcp(1.0f + ex2(-v * LOG2E)); }
__device__ __forceinline__ float wave_sum(float v) {
#pragma unroll
    for (int o = 32; o > 0; o >>= 1) v += __shfl_xor(v, o);
    return v;
}
__device__ __forceinline__ int wave_id() { return __builtin_amdgcn_readfirstlane((int)(threadIdx.x >> 6)); }

__device__ __forceinline__ void transpose_tile(LAS char* lds, const float* src, int ldsrc, int srccol, int k0, const float* gain, bf16_t* dst, int K, int n0) {
    LAS bf16_t* T = (LAS bf16_t*)lds;
    const int tid = threadIdx.x, r = tid >> 4, c4 = tid & 15;
#pragma unroll
    for (int p = 0; p < 4; ++p) {
        const int k = r + 16 * p;
        f32x4 v = *(const f32x4*)(src + (size_t)(k0 + k) * ldsrc + srccol + c4 * 4);
        const float g = gain ? gain[k0 + k] : 1.0f;
        const unsigned a = pk_bf16(v[0] * g, v[1] * g), b = pk_bf16(v[2] * g, v[3] * g);
        T[(c4 * 4 + 0) * 72 + k] = (bf16_t)(a & 0xffff); T[(c4 * 4 + 1) * 72 + k] = (bf16_t)(a >> 16);
        T[(c4 * 4 + 2) * 72 + k] = (bf16_t)(b & 0xffff); T[(c4 * 4 + 3) * 72 + k] = (bf16_t)(b >> 16);
    }
    __syncthreads();
    const int n = tid >> 2, kq = tid & 3;
    const u32x4 lo = *(LAS u32x4*)(T + n * 72 + kq * 16), hi = *(LAS u32x4*)(T + n * 72 + kq * 16 + 8);
    bf16_t* d = dst + (size_t)(n0 + n) * K + k0 + kq * 16;
    *(u32x4*)d = lo; *(u32x4*)(d + 8) = hi;
    __syncthreads();
}

__device__ __forceinline__ void phase0(const Params& p, LAS char* lds) {
    unsigned char* ws = p.ws;
    const int tid = threadIdx.x, lane = tid & 63, w = wave_id();
    LAS float* wfT = (LAS float*)lds;
    const float* g0 = p.gains;
    for (int idx = tid; idx < 8192; idx += NTHREADS) { const int h = idx & 7, k = idx >> 3; wfT[h * 1024 + k] = p.w_in[(size_t)k * PROJW + 1536 + h] * g0[k]; }
    __syncthreads();
    bf16_t* xb = (bf16_t*)(ws + WS_A);
    float* r1 = (float*)(ws + WS_R1);
    float* logf_ = (float*)(ws + WS_LOGF);
    for (int r_ = blockIdx.x * 32 + w; r_ < M; r_ += (r_ & 31) < 28 ? 4 : gridDim.x * 32 - 28) {
        const int r = r_;
        if (r >= MV) {
#pragma unroll
            for (int i = 0; i < 4; ++i) *(u32x2*)(xb + (size_t)r * D + lane * 4 + 256 * i) = (u32x2){0u, 0u};
            if (lane == 0) r1[r] = 0.f;
            continue;
        }
        const float* src = r < MX ? p.x + (size_t)r * D : p.meta + (size_t)((r - MX) & 15) * D;
        f32x4 v[4]; float ss = 0.f;
#pragma unroll
        for (int i = 0; i < 4; ++i) { v[i] = *(const f32x4*)(src + lane * 4 + 256 * i); ss += v[i][0] * v[i][0] + v[i][1] * v[i][1] + v[i][2] * v[i][2] + v[i][3] * v[i][3]; }
#pragma unroll
        for (int i = 0; i < 4; ++i) *(u32x2*)(xb + (size_t)r * D + lane * 4 + 256 * i) = (u32x2){pk_bf16(v[i][0], v[i][1]), pk_bf16(v[i][2], v[i][3])};
        ss = wave_sum(ss);
        const float rs = 1.0f / sqrtf(ss * (1.0f / D) + EPS);
        if (lane == 0) r1[r] = rs;
        float mine = 0.f;
#pragma unroll
        for (int h = 0; h < 8; ++h) {
            float a = 0.f;
#pragma unroll
            for (int i = 0; i < 4; ++i) { const f32x4 wv = *(LAS f32x4*)(wfT + h * 1024 + lane * 4 + 256 * i); a += v[i][0] * wv[0] + v[i][1] * wv[1] + v[i][2] * wv[2] + v[i][3] * wv[3]; }
            a = wave_sum(a);
            if (lane == h) mine = a;
        }
        if (lane < 8) {
            const float f = mine * rs + p.b_forget[lane];
            const float lf = fminf(f, 0.f) - log1pf(expf(-fabsf(f)));
            int b, kidx; if (r < MX) { b = r >> 13; kidx = r & 8191; } else { const int j = r - MX; b = j >> 4; kidx = 8192 + (j & 15); }
            logf_[(size_t)(b * 8 + lane) * LPK + kidx] = lf;
        }
    }
    __syncthreads();
    LAS char* tl = lds + 32768;
    const float* g2 = p.gains + 2 * D;
    constexpr int T_IN = 16 * 80, T_OF = 8 * 16, T_OS = 8 * 16, T_OUT = 16 * 16, T_UP = 16 * 88, T_DN = 44 * 16;
    constexpr int T_ALL = T_IN + T_OF + T_OS + T_OUT + T_UP + T_DN;
    for (int t = blockIdx.x; t < T_ALL; t += gridDim.x) {
        int u = t;
        if (u < T_IN) { const int nt = u % 80, kt = u / 80; const int sc = nt * 64 + (nt * 64 >= 1536 ? 8 : 0); transpose_tile(tl, p.w_in, PROJW, sc, kt * 64, g0, (bf16_t*)(ws + WS_BTIN), 1024, nt * 64); continue; }
        u -= T_IN;
        if (u < T_OF) { const int nt = u % 16, kt = u / 16; transpose_tile(tl, p.w_o_fox, 1024, nt * 64, kt * 64, nullptr, (bf16_t*)(ws + WS_BTOF), 512, nt * 64); continue; }
        u -= T_OF;
        if (u < T_OS) { const int nt = u % 16, kt = u / 16; transpose_tile(tl, p.w_o_sb, 1024, nt * 64, kt * 64, nullptr, (bf16_t*)(ws + WS_BTOS), 512, nt * 64); continue; }
        u -= T_OS;
        if (u < T_OUT) { const int nt = u % 16, kt = u / 16; transpose_tile(tl, p.w_out, 1024, nt * 64, kt * 64, nullptr, (bf16_t*)(ws + WS_BTOUT), 1024, nt * 64); continue; }
        u -= T_OUT;
        if (u < T_UP) { const int nt = u % 88, kt = u / 88; transpose_tile(tl, p.w_up, NUP, nt * 64, kt * 64, g2, (bf16_t*)(ws + WS_BTUP), 1024, nt * 64); continue; }
        u -= T_UP;
        { const int nt = u % 16, kt = u / 16; transpose_tile(tl, p.w_down, 1024, nt * 64, kt * 64, nullptr, (bf16_t*)(ws + WS_BTDN), DFF, nt * 64); }
    }
}

template <bool SWAP>
__device__ __forceinline__ void gemm_main(LAS char* lds, const bf16_t* Ag, int lda, const bf16_t* Bg, int ldb, int nk, f32x4 (&acc)[4][4]) {
    const int tid = threadIdx.x, lane = tid & 63, w = wave_id(), wr = w >> 1, wc = w & 1;
    const int row_0 = w * 8 + (lane >> 3), c_0 = (lane & 7) ^ ((row_0 >> 1) & 7);
    const bf16_t* pa0 = Ag + (size_t)row_0 * lda + c_0 * 8; const bf16_t* pb0 = Bg + (size_t)row_0 * ldb + c_0 * 8;
    const size_t sa = (size_t)32 * lda, sb_ = (size_t)32 * ldb;
    const int swz = (lane >> 1) & 7;
    int aoff[2], boff[2];
#pragma unroll
    for (int kh = 0; kh < 2; ++kh) {
        aoff[kh] = (wr * 64 + (lane & 15)) * 128 + (((kh * 4 + (lane >> 4)) ^ swz) << 4);
        boff[kh] = 16384 + (wc * 64 + (lane & 15)) * 128 + (((kh * 4 + (lane >> 4)) ^ swz) << 4);
    }
#define GM_STAGE(s, kt) do { _Pragma("unroll") for (int i_ = 0; i_ < 4; ++i_) { \
        __builtin_amdgcn_global_load_lds((const unsigned*)(pa0 + i_ * sa + (kt) * 64), (LAS unsigned*)(lds + (s) * 32768 + (i_ * 4 + w) * 1024), 16, 0, 0); \
        __builtin_amdgcn_global_load_lds((const unsigned*)(pb0 + i_ * sb_ + (kt) * 64), (LAS unsigned*)(lds + (s) * 32768 + 16384 + (i_ * 4 + w) * 1024), 16, 0, 0); } } while (0)
    GM_STAGE(0, 0);
    for (int kt = 0; kt < nk; ++kt) {
        asm volatile("s_waitcnt vmcnt(0)" ::: "memory");
        __syncthreads();
        const int s = kt & 1;
        if (kt + 1 < nk) GM_STAGE(s ^ 1, kt + 1);
        bf16x8 af[4][2], bf[4][2];
#pragma unroll
        for (int kh = 0; kh < 2; ++kh) {
#pragma unroll
            for (int m = 0; m < 4; ++m) af[m][kh] = *(LAS bf16x8*)(lds + s * 32768 + aoff[kh] + m * 2048);
#pragma unroll
            for (int n = 0; n < 4; ++n) bf[n][kh] = *(LAS bf16x8*)(lds + s * 32768 + boff[kh] + n * 2048);
        }
        __builtin_amdgcn_s_setprio(1);
#pragma unroll
        for (int kh = 0; kh < 2; ++kh)
#pragma unroll
            for (int m = 0; m < 4; ++m)
#pragma unroll
                for (int n = 0; n < 4; ++n)
                    acc[m][n] = SWAP ? __builtin_amdgcn_mfma_f32_16x16x32_bf16(bf[n][kh], af[m][kh], acc[m][n], 0, 0, 0)
                                     : __builtin_amdgcn_mfma_f32_16x16x32_bf16(af[m][kh], bf[n][kh], acc[m][n], 0, 0, 0);
        __builtin_amdgcn_s_setprio(0);
    }
    __syncthreads();
#undef GM_STAGE
}
__device__ __forceinline__ void zero_acc(f32x4 (&acc)[4][4]) {
#pragma unroll
    for (int m = 0; m < 4; ++m)
#pragma unroll
        for (int n = 0; n < 4; ++n) acc[m][n] = (f32x4){0.f, 0.f, 0.f, 0.f};
}


__device__ __forceinline__ int tile_at(int it, int ntm, int ntn, int& tm, int& tn) {
    const int G = gridDim.x;
    if (G % 256 != 0) { const int t = it * G + blockIdx.x; if (t >= ntm * ntn) return 0; tm = t / ntn; tn = t % ntn; return 1; }
    const int xcd = blockIdx.x & 7, j = blockIdx.x >> 3, ppx = G >> 8;
    const int pcols = (ntn + 3) >> 2, prows = (ntm + 7) >> 3;
    const int patch = (it * ppx + (j >> 5)) * 8 + xcd;
    if (patch >= prows * pcols) return 0;
    const int wi = j & 31;
    tm = (patch / pcols) * 8 + (wi >> 2); tn = (patch % pcols) * 4 + (wi & 3);
    return (tm < ntm && tn < ntn) ? 1 : 2;
}
__device__ __forceinline__ void cumsum_block(const Params& p, LAS char* lds, int bh) {
    const float* lf = (const float*)(p.ws + WS_LOGF) + (size_t)bh * LPK; float* ck = (float*)(p.ws + WS_CK) + (size_t)bh * LPK;
    LAS float* sums = (LAS float*)lds;
    const int tid = threadIdx.x; constexpr int PER = 33, L = SEQ + NMETA;
    float loc = 0.f;
    for (int e = 0; e < PER; ++e) { const int t = tid * PER + e; if (t < L) loc += lf[t < 16 ? 8192 + t : t - 16]; }
    sums[tid] = loc;
    __syncthreads();
    float run = 0.f;
    for (int i = 0; i < tid; ++i) run += sums[i];
    for (int e = 0; e < PER; ++e) { const int t = tid * PER + e; if (t < L) { const int kx = t < 16 ? 8192 + t : t - 16; run += lf[kx]; ck[kx] = run * LOG2E; } }
    __syncthreads();
}

__device__ __forceinline__ void phase1(const Params& p, LAS char* lds) {
    unsigned char* ws = p.ws;
    if (blockIdx.x < 16) cumsum_block(p, lds, blockIdx.x);
    const int lane = threadIdx.x & 63, w = wave_id(), wr = w >> 1, wc = w & 1;
    const bf16_t* xb = (const bf16_t*)(ws + WS_A); const bf16_t* Bt = (const bf16_t*)(ws + WS_BTIN);
    const float* r1 = (const float*)(ws + WS_R1);
    constexpr int NTN = 40, NTM = 129;
    for (int it = 0;; ++it) {
        int tm, tn; const int st = tile_at(it, NTM, NTN, tm, tn); if (st == 0) break; if (st == 2) continue;
        const int row0 = tm * 128, col0 = tn * 128;
        const bool vtile = (tn >= 8 && tn < 12) || (tn >= 20 && tn < 24);
        f32x4 acc[4][4]; zero_acc(acc);
        if (vtile) {
            gemm_main<false>(lds, xb + (size_t)row0 * D, D, Bt + (size_t)col0 * D, D, 16, acc);
            bf16_t* vT = (bf16_t*)(ws + (tn < 12 ? WS_VFT : WS_VST)); const int cb = tn < 12 ? 1024 : 2560;
            const int g = lane >> 4, gp = ((g & 1) << 1) | (g >> 1);
#pragma unroll
            for (int m = 0; m < 4; ++m) {
                const int rb = row0 + wr * 64 + m * 16; int b, kb16;
                if (rb < MX) { b = rb >> 13; kb16 = rb & 8191; } else { const int j = rb - MX; if (j >= 32) continue; b = j >> 4; kb16 = 8192; }
                const f32x4 rs = *(const f32x4*)(r1 + rb + g * 4);
#pragma unroll
                for (int n = 0; n < 4; ++n) {
                    const int dc = col0 + wc * 64 + n * 16 + (lane & 15) - cb, h = dc >> 6, d = dc & 63;
                    const f32x4 v = acc[m][n] * rs;
                    *(u32x2*)(vT + ((size_t)(b * 8 + h) * 64 + d) * LPK + kb16 + gp * 4) = (u32x2){pk_bf16(v[0], v[1]), pk_bf16(v[2], v[3])};
                }
            }
        } else {
            gemm_main<true>(lds, xb + (size_t)row0 * D, D, Bt + (size_t)col0 * D, D, 16, acc);
            bf16_t* dst; int ld, cb; float sc = 1.f; bool sg = false;
            if (tn < 4) { dst = (bf16_t*)(ws + WS_QF); ld = 512; cb = 0; sc = 0.125f * LOG2E; }
            else if (tn < 8) { dst = (bf16_t*)(ws + WS_KF); ld = 512; cb = 512; }
            else if (tn < 16) { dst = (bf16_t*)(ws + WS_QS); ld = 512; cb = 1536; sc = 0.125f; }
            else if (tn < 20) { dst = (bf16_t*)(ws + WS_KS); ld = 512; cb = 2048; }
            else if (tn < 32) { dst = (bf16_t*)(ws + WS_B); ld = 1024; cb = 3072; sg = true; }
            else { dst = (bf16_t*)(ws + WS_B + SZ_M1024); ld = 1024; cb = 4096; sg = true; }
#pragma unroll
            for (int m = 0; m < 4; ++m) {
                const int row = row0 + wr * 64 + m * 16 + (lane & 15); const float rs = r1[row] * sc;
#pragma unroll
                for (int n = 0; n < 4; ++n) {
                    const int col = col0 + wc * 64 + n * 16 + (lane >> 4) * 4 - cb;
                    f32x4 v = acc[m][n] * rs;
                    if (sg) { v[0] = sigmoidf_(v[0]); v[1] = sigmoidf_(v[1]); v[2] = sigmoidf_(v[2]); v[3] = sigmoidf_(v[3]); }
                    *(u32x2*)(dst + (size_t)row * ld + col) = (u32x2){pk_bf16(v[0], v[1]), pk_bf16(v[2], v[3])};
                }
            }
        }
    }
}

constexpr int AT_STAGE = 16640;
template <int TYPE>
__device__ __forceinline__ void attn_unit(LAS char* lds, const Params& p, int b, int h, int qb) {
    unsigned char* ws = p.ws;
    const int tid = threadIdx.x, lane = tid & 63, w = wave_id(), ql = lane & 31, hi = lane >> 5;
    const bf16_t* Q = (const bf16_t*)(ws + (TYPE == 0 ? WS_QF : WS_QS));
    const bf16_t* Kp = (const bf16_t*)(ws + (TYPE == 0 ? WS_KF : WS_KS));
    const bf16_t* VT = (const bf16_t*)(ws + (TYPE == 0 ? WS_VFT : WS_VST)) + (size_t)(b * 8 + h) * 64 * LPK;
    const float* cK = (const float*)(ws + WS_CK) + (size_t)(b * 8 + h) * LPK;
    bf16_t* Oo = (bf16_t*)(ws + WS_A + (TYPE == 0 ? 0 : SZ_M512));
    const bool meta_unit = qb < 0;
    const int qrow0 = meta_unit ? MX + 16 * b : b * SEQ + qb * 128;
    const int nt = meta_unit ? 1 : 2 * qb + 3;
    int qrow = qrow0 + 32 * w + ql; if (qrow > M - 1) qrow = M - 1;
    bf16x8 qf[4];
#pragma unroll
    for (int ds = 0; ds < 4; ++ds) qf[ds] = *(const bf16x8*)(Q + (size_t)qrow * 512 + h * 64 + ds * 16 + hi * 8);
    f32x16 O0, O1;
#pragma unroll
    for (int i = 0; i < 16; ++i) { O0[i] = 0.f; O1[i] = 0.f; }
    float m_run = -INFINITY, lsum = 0.f, R = 0.f;
    u32x4 kreg[2], vreg[2]; float creg = 0.f;
    const int srow = tid >> 3, spos = tid & 7;
    const int swz_st = (spos ^ ((srow >> 1) & 7)) << 4;
    const int swz = (lane >> 1) & 7;
    LAS unsigned* flags = (LAS unsigned*)(lds + 2 * AT_STAGE);
#define AT_LOAD(j) do { int krow0_, kidx0_; if (!meta_unit && (j) < nt - 1) { const int kt_ = nt - 2 - (j); krow0_ = b * SEQ + 64 * kt_; kidx0_ = 64 * kt_; } else { krow0_ = MX + 16 * b; kidx0_ = 8192; } \
        _Pragma("unroll") for (int i_ = 0; i_ < 2; ++i_) { \
            kreg[i_] = *(const u32x4*)(Kp + (size_t)(krow0_ + srow + 32 * i_) * 512 + h * 64 + spos * 8); \
            vreg[i_] = *(const u32x4*)(VT + (size_t)(srow + 32 * i_) * LPK + kidx0_ + spos * 8); } \
        if (TYPE == 0 && tid < 64) creg = cK[kidx0_ + tid]; } while (0)
#define AT_WRITE(s) do { _Pragma("unroll") for (int i_ = 0; i_ < 2; ++i_) { \
            *(LAS u32x4*)(lds + (s) * AT_STAGE + (srow + 32 * i_) * 128 + swz_st) = kreg[i_]; \
            *(LAS u32x4*)(lds + (s) * AT_STAGE + 8192 + (srow + 32 * i_) * 128 + swz_st) = vreg[i_]; } \
        if (TYPE == 0 && tid < 64) *(LAS float*)(lds + (s) * AT_STAGE + 16384 + tid * 4) = creg; } while (0)
    AT_LOAD(0); AT_WRITE(0);
    __syncthreads();
    for (int j = 0; j < nt; ++j) {
        const bool more = j + 1 < nt;
        if (more) AT_LOAD(j + 1);
        int klim, d0;
        if (meta_unit) { klim = 16; d0 = 0; }
        else if (j == nt - 1) { klim = 16; d0 = 1 << 20; }
        else { klim = 64; d0 = 128 * qb - 64 * (nt - 2 - j); if (d0 >= 64) d0 = 1 << 20; }
        const int limw = 32 * w + d0 - TYPE;
        bool wdone = false;
        if (limw + 31 >= 0) {
            const LAS char* sb = lds + (j & 1) * AT_STAGE;
            int kmax = limw + ql; if (kmax > klim - 1) kmax = klim - 1;
            const bool needmask = (klim < 64) || (limw < 63);
            f32x16 S0, S1;
#pragma unroll
            for (int i = 0; i < 16; ++i) { S0[i] = 0.f; S1[i] = 0.f; }
#pragma unroll
            for (int ds = 0; ds < 4; ++ds) {
                const bf16x8 k0 = *(const LAS bf16x8*)(sb + ql * 128 + (((2 * ds + hi) ^ swz) << 4));
                const bf16x8 k1 = *(const LAS bf16x8*)(sb + (32 + ql) * 128 + (((2 * ds + hi) ^ swz) << 4));
                S0 = __builtin_amdgcn_mfma_f32_32x32x16_bf16(k0, qf[ds], S0, 0, 0, 0);
                S1 = __builtin_amdgcn_mfma_f32_32x32x16_bf16(k1, qf[ds], S1, 0, 0, 0);
            }
            if (TYPE == 0) {
#pragma unroll
                for (int g = 0; g < 4; ++g) {
                    const f32x4 c0 = *(const LAS f32x4*)(sb + 16384 + (8 * g + 4 * hi) * 4), c1 = *(const LAS f32x4*)(sb + 16384 + (32 + 8 * g + 4 * hi) * 4);
#pragma unroll
                    for (int i = 0; i < 4; ++i) { S0[4 * g + i] -= c0[i]; S1[4 * g + i] -= c1[i]; }
                }
                if (needmask) {
#pragma unroll
                    for (int r = 0; r < 16; ++r) { const int kl = (r & 3) + 8 * (r >> 2) + 4 * hi; if (kl > kmax) S0[r] = -INFINITY; if (kl + 32 > kmax) S1[r] = -INFINITY; }
                }
                float mx = -INFINITY;
#pragma unroll
                for (int r = 0; r < 16; ++r) mx = fmaxf(mx, fmaxf(S0[r], S1[r]));
                mx = fmaxf(mx, __shfl_xor(mx, 32));
                const float m_new = fmaxf(m_run, mx), alpha = ex2(m_run - m_new);
                m_run = m_new;
                float ps = 0.f;
#pragma unroll
                for (int r = 0; r < 16; ++r) { S0[r] = ex2(S0[r] - m_new); S1[r] = ex2(S1[r] - m_new); ps += S0[r] + S1[r]; }
                lsum = lsum * alpha + ps;
#pragma unroll
                for (int r = 0; r < 16; ++r) { O0[r] *= alpha; O1[r] *= alpha; }
            } else {
                float G0[4], G1[4];
                f32x16 L0, L1;
#pragma unroll
                for (int r = 0; r < 16; ++r) {
                    const int kl = (r & 3) + 8 * (r >> 2) + 4 * hi;
                    const float z0 = S0[r], z1 = S1[r];
                    const float sp0 = fmaxf(z0, 0.f) + lg2(1.0f + ex2(-fabsf(z0) * LOG2E)) * LN2;
                    const float sp1 = fmaxf(z1, 0.f) + lg2(1.0f + ex2(-fabsf(z1) * LOG2E)) * LN2;
                    L0[r] = (!needmask || kl <= kmax) ? -sp0 : 0.f;
                    L1[r] = (!needmask || kl + 32 <= kmax) ? -sp1 : 0.f;
                }
#pragma unroll
                for (int g = 0; g < 4; ++g) {
                    L0[4 * g + 2] += L0[4 * g + 3]; L0[4 * g + 1] += L0[4 * g + 2]; L0[4 * g] += L0[4 * g + 1]; G0[g] = L0[4 * g];
                    L1[4 * g + 2] += L1[4 * g + 3]; L1[4 * g + 1] += L1[4 * g + 2]; L1[4 * g] += L1[4 * g + 1]; G1[g] = L1[4 * g];
                }
                float run = R;
#pragma unroll
                for (int g = 3; g >= 0; --g) {
                    const float gp = __shfl_xor(G1[g], 32);
                    const float off = hi ? run : run + gp;
#pragma unroll
                    for (int i = 0; i < 4; ++i) { const int r = 4 * g + i; const int kl = 32 + i + 8 * g + 4 * hi;
                        const float a = ex2((S1[r] + L1[r] + off) * LOG2E); S1[r] = (!needmask || kl <= kmax) ? a : 0.f; }
                    run += G1[g] + gp;
                }
#pragma unroll
                for (int g = 3; g >= 0; --g) {
                    const float gp = __shfl_xor(G0[g], 32);
                    const float off = hi ? run : run + gp;
#pragma unroll
                    for (int i = 0; i < 4; ++i) { const int r = 4 * g + i; const int kl = i + 8 * g + 4 * hi;
                        const float a = ex2((S0[r] + L0[r] + off) * LOG2E); S0[r] = (!needmask || kl <= kmax) ? a : 0.f; }
                    run += G0[g] + gp;
                }
                R = run;
                wdone = __all(R < -120.0f) != 0;
            }
#pragma unroll
            for (int ks = 0; ks < 4; ++ks) {
                bf16x8 pf; u32x4 pu;
                if (ks < 2) { pu = (u32x4){pk_bf16(S0[8 * ks + 0], S0[8 * ks + 1]), pk_bf16(S0[8 * ks + 2], S0[8 * ks + 3]), pk_bf16(S0[8 * ks + 4], S0[8 * ks + 5]), pk_bf16(S0[8 * ks + 6], S0[8 * ks + 7])}; }
                else { const int k2 = ks - 2; pu = (u32x4){pk_bf16(S1[8 * k2 + 0], S1[8 * k2 + 1]), pk_bf16(S1[8 * k2 + 2], S1[8 * k2 + 3]), pk_bf16(S1[8 * k2 + 4], S1[8 * k2 + 5]), pk_bf16(S1[8 * k2 + 6], S1[8 * k2 + 7])}; }
                pf = __builtin_bit_cast(bf16x8, pu);
                const bf16x8 v0 = *(const LAS bf16x8*)(sb + 8192 + ql * 128 + (((2 * ks + hi) ^ swz) << 4));
                const bf16x8 v1 = *(const LAS bf16x8*)(sb + 8192 + (32 + ql) * 128 + (((2 * ks + hi) ^ swz) << 4));
                O0 = __builtin_amdgcn_mfma_f32_32x32x16_bf16(v0, pf, O0, 0, 0, 0);
                O1 = __builtin_amdgcn_mfma_f32_32x32x16_bf16(v1, pf, O1, 0, 0, 0);
            }
        }
        if (more) AT_WRITE((j + 1) & 1);
        if (TYPE == 1 && lane == 0) flags[(j & 1) * 4 + w] = wdone ? 1u : 0u;
        __syncthreads();
        if (TYPE == 1) { const LAS unsigned* fl = flags + (j & 1) * 4; const unsigned f = fl[0] & fl[1] & fl[2] & fl[3]; if (f) break; }
    }
    float inv = 1.0f;
    if (TYPE == 0) { const float l = lsum + __shfl_xor(lsum, 32); inv = 1.0f / l; }
    const bool qvalid = meta_unit ? (w == 0 && ql < 16) : true;
    if (qvalid) {
        bf16_t* op = Oo + (size_t)qrow * 512 + h * 64 + 4 * hi;
#pragma unroll
        for (int g = 0; g < 4; ++g) {
            *(u32x2*)(op + 8 * g) = (u32x2){pk_bf16(O0[4 * g] * inv, O0[4 * g + 1] * inv), pk_bf16(O0[4 * g + 2] * inv, O0[4 * g + 3] * inv)};
            *(u32x2*)(op + 32 + 8 * g) = (u32x2){pk_bf16(O1[4 * g] * inv, O1[4 * g + 1] * inv), pk_bf16(O1[4 * g + 2] * inv, O1[4 * g + 3] * inv)};
        }
    }
    __syncthreads();
#undef AT_LOAD
#undef AT_WRITE
}

__device__ __forceinline__ void phase2(const Params& p, LAS char* lds) {
    unsigned* ctr = (unsigned*)(p.ws + WS_CTL);
    LAS unsigned* shu = (LAS unsigned*)(lds + 2 * AT_STAGE + 64);
    constexpr int NU = 2048 + 32;
    const int G = gridDim.x;
    for (int it = blockIdx.x; it < NU; it += G) {
        int u = it;
        if (it < 1024 && (1024 % (2 * G)) == 0) { const int rnd = it / G, pos = it - rnd * G; u = (rnd & 1) ? ((rnd + 1) * G - 1 - pos) : it; }
        if (u < 1024) attn_unit<0>(lds, p, (u & 15) >> 3, u & 7, 63 - (u >> 4));
        else if (u < 2048) { const int v = u - 1024; attn_unit<1>(lds, p, (v & 15) >> 3, v & 7, 63 - (v >> 4)); }
        else if (u < 2064) { const int v = u - 2048; attn_unit<0>(lds, p, v >> 3, v & 7, -1); }
        else { const int v = u - 2064; attn_unit<1>(lds, p, v >> 3, v & 7, -1); }
    }
}

__device__ __forceinline__ void phase3a(const Params& p, LAS char* lds) {
    unsigned char* ws = p.ws;
    const int lane = threadIdx.x & 63, w = wave_id(), wr = w >> 1, wc = w & 1;
    const bf16_t* oa = (const bf16_t*)(ws + WS_A); const bf16_t* ob = oa + (size_t)M * 512;
    const bf16_t* ga = (const bf16_t*)(ws + WS_B); const bf16_t* gb = ga + (size_t)M * 1024;
    bf16_t* gated = (bf16_t*)(ws + WS_GATED);
    for (int it = 0;; ++it) {
        int tm, tn; const int st = tile_at(it, 129, 8, tm, tn); if (st == 0) break; if (st == 2) continue;
        const int row0 = tm * 128, col0 = tn * 128;
        f32x4 acc[4][4]; zero_acc(acc);
        gemm_main<true>(lds, oa + (size_t)row0 * 512, 512, (const bf16_t*)(ws + WS_BTOF) + (size_t)col0 * 512, 512, 8, acc);
#pragma unroll
        for (int m = 0; m < 4; ++m) {
            const int row = row0 + wr * 64 + m * 16 + (lane & 15);
#pragma unroll
            for (int n = 0; n < 4; ++n) {
                const int col = col0 + wc * 64 + n * 16 + (lane >> 4) * 4;
                const u32x2 a = *(const u32x2*)(ga + (size_t)row * 1024 + col);
                const f32x4 x = acc[m][n];
                *(u32x2*)(gated + (size_t)row * 1024 + col) = (u32x2){pk_bf16(bf_lo(a[0]) * x[0], bf_hi(a[0]) * x[1]), pk_bf16(bf_lo(a[1]) * x[2], bf_hi(a[1]) * x[3])};
            }
        }
        zero_acc(acc);
        gemm_main<true>(lds, ob + (size_t)row0 * 512, 512, (const bf16_t*)(ws + WS_BTOS) + (size_t)col0 * 512, 512, 8, acc);
#pragma unroll
        for (int m = 0; m < 4; ++m) {
            const int row = row0 + wr * 64 + m * 16 + (lane & 15);
#pragma unroll
            for (int n = 0; n < 4; ++n) {
                const int col = col0 + wc * 64 + n * 16 + (lane >> 4) * 4;
                const u32x2 b = *(const u32x2*)(gb + (size_t)row * 1024 + col);
                const f32x4 y = acc[m][n]; const u32x2 q = *(const u32x2*)(gated + (size_t)row * 1024 + col);
                const float o0 = bf_lo(q[0]) + bf_lo(b[0]) * y[0], o1 = bf_hi(q[0]) + bf_hi(b[0]) * y[1];
                const float o2 = bf_lo(q[1]) + bf_lo(b[1]) * y[2], o3 = bf_hi(q[1]) + bf_hi(b[1]) * y[3];
                *(u32x2*)(gated + (size_t)row * 1024 + col) = (u32x2){pk_bf16(o0, o1), pk_bf16(o2, o3)};
            }
        }
    }
}
__device__ __forceinline__ void epi_store_ss(const f32x4 (&acc)[4][4], bf16_t* out, int ldo, int orow0, int col0, float* ssp, int ssrow0, int wr, int wc, int lane) {
#pragma unroll
    for (int m = 0; m < 4; ++m) {
        const int rl = wr * 64 + m * 16 + (lane & 15);
        float s = 0.f;
#pragma unroll
        for (int n = 0; n < 4; ++n) {
            const int col = col0 + wc * 64 + n * 16 + (lane >> 4) * 4;
            const f32x4 v = acc[m][n];
            s += v[0] * v[0] + v[1] * v[1] + v[2] * v[2] + v[3] * v[3];
            *(u32x2*)(out + (size_t)(orow0 + rl) * ldo + col) = (u32x2){pk_bf16(v[0], v[1]), pk_bf16(v[2], v[3])};
        }
#if 1
        s += __shfl_xor(s, 16); s += __shfl_xor(s, 32);
        if (lane < 16) ssp[(size_t)((col0 >> 7) * 2 + wc) * M + ssrow0 + rl] = s;
#endif
    }
}
__device__ __forceinline__ void phase3b(const Params& p, LAS char* lds) {
    unsigned char* ws = p.ws;
    const int lane = threadIdx.x & 63, w = wave_id(), wr = w >> 1, wc = w & 1;
    const bf16_t* gated = (const bf16_t*)(ws + WS_GATED); bf16_t* mixed = (bf16_t*)(ws + WS_MIXED);
    for (int it = 0;; ++it) {
        int tm, tn; const int st = tile_at(it, 129, 8, tm, tn); if (st == 0) break; if (st == 2) continue;
        const int row0 = tm * 128, col0 = tn * 128;
        f32x4 acc[4][4]; zero_acc(acc);
        gemm_main<true>(lds, gated + (size_t)row0 * 1024, 1024, (const bf16_t*)(ws + WS_BTOUT) + (size_t)col0 * 1024, 1024, 16, acc);
        epi_store_ss(acc, mixed, 1024, row0, col0, (float*)(ws + WS_SSP2), row0, wr, wc, lane);
    }
}
__device__ __forceinline__ void phase3c(const Params& p) {
    unsigned char* ws = p.ws;
    const int lane = threadIdx.x & 63, w = wave_id();
    const bf16_t* mixed = (const bf16_t*)(ws + WS_MIXED); bf16_t* hb = (bf16_t*)(ws + WS_A);
    const float* ssp2 = (const float*)(ws + WS_SSP2); float* r2 = (float*)(ws + WS_R2);
    const float* g1 = p.gains + D;
    for (int r_ = blockIdx.x * 32 + w; r_ < M; r_ += (r_ & 31) < 28 ? 4 : gridDim.x * 32 - 28) {
        const int r = r_;
        if (r >= MV) continue;
        const float* src = r < MX ? p.x + (size_t)r * D : p.meta + (size_t)((r - MX) & 15) * D;
        float sq = lane < 16 ? ssp2[(size_t)lane * M + r] : 0.f;
        sq = wave_sum(sq);
        const float a = 1.0f / sqrtf(sq * (1.0f / D) + EPS);
        float ss = 0.f;
#pragma unroll
        for (int i = 0; i < 4; ++i) {
            const int col = lane * 4 + 256 * i;
            const f32x4 v = *(const f32x4*)(src + col), g = *(const f32x4*)(g1 + col);
            const u32x2 mx = *(const u32x2*)(mixed + (size_t)r * D + col);
            f32x4 hh;
            hh[0] = v[0] + bf_lo(mx[0]) * a * g[0]; hh[1] = v[1] + bf_hi(mx[0]) * a * g[1];
            hh[2] = v[2] + bf_lo(mx[1]) * a * g[2]; hh[3] = v[3] + bf_hi(mx[1]) * a * g[3];
            ss += hh[0] * hh[0] + hh[1] * hh[1] + hh[2] * hh[2] + hh[3] * hh[3];
            *(u32x2*)(hb + (size_t)r * D + col) = (u32x2){pk_bf16(hh[0], hh[1]), pk_bf16(hh[2], hh[3])};
            if (r < MX) *(f32x4*)(p.out + (size_t)r * D + col) = hh;
        }
        ss = wave_sum(ss);
        if (lane == 0) r2[r] = 1.0f / sqrtf(ss * (1.0f / D) + EPS);
    }
}
__device__ __forceinline__ void phase4(const Params& p, LAS char* lds, int b) {
    unsigned char* ws = p.ws;
    const int lane = threadIdx.x & 63, w = wave_id(), wr = w >> 1, wc = w & 1;
    const bf16_t* hb = (const bf16_t*)(ws + WS_A); const bf16_t* Bt = (const bf16_t*)(ws + WS_BTUP);
    const float* r2 = (const float*)(ws + WS_R2);
    bf16_t* up = (bf16_t*)(ws + WS_UP); bf16_t* upm = (bf16_t*)(ws + WS_UPMETA);
    for (int it = 0;; ++it) {
        int tm, tn; int st = tile_at(it, 64, 44, tm, tn);
        if (st == 0) { if (b == 0 && it < (1 << 20) && (int)blockIdx.x < 44) { tm = 64; tn = blockIdx.x; it = 1 << 20; st = 1; } else break; }
        if (st == 2) continue;
        const int col0 = tn * 128;
        const bool mt = tm == 64; const int row0 = mt ? MX : b * SEQ + tm * 128;
        f32x4 acc[4][4]; zero_acc(acc);
        gemm_main<true>(lds, hb + (size_t)row0 * D, D, Bt + (size_t)col0 * D, D, 16, acc);
#pragma unroll
        for (int m = 0; m < 4; ++m) {
            const int rl = wr * 64 + m * 16 + (lane & 15), row = row0 + rl;
            if (mt && rl >= 32) continue;
            const float rs = r2[row];
            bf16_t* orow = mt ? upm + (size_t)rl * NUP : up + (size_t)(tm * 128 + rl) * NUP;
#pragma unroll
            for (int n = 0; n < 4; ++n) {
                const int col = col0 + wc * 64 + n * 16 + (lane >> 4) * 4;
                const f32x4 v = acc[m][n] * rs;
                *(u32x2*)(orow + col) = (u32x2){pk_bf16(v[0], v[1]), pk_bf16(v[2], v[3])};
            }
        }
    }
}
__device__ __forceinline__ void unpack8(const u32x4 u, float (&f)[8]) {
    f[0] = bf_lo(u[0]); f[1] = bf_hi(u[0]); f[2] = bf_lo(u[1]); f[3] = bf_hi(u[1]); f[4] = bf_lo(u[2]); f[5] = bf_hi(u[2]); f[6] = bf_lo(u[3]); f[7] = bf_hi(u[3]);
}
__device__ __forceinline__ void phase5(const Params& p, int b) {
    unsigned char* ws = p.ws;
    const bf16_t* up = (const bf16_t*)(ws + WS_UP); const bf16_t* upm = (const bf16_t*)(ws + WS_UPMETA);
    bf16_t* act = (bf16_t*)(ws + WS_ACT);
    constexpr int NCH = DFF / 8, NIT = (SEQ / 8) * NCH;
    for (int it = blockIdx.x * NTHREADS + threadIdx.x; it < NIT; it += gridDim.x * NTHREADS) {
        const int ch = it % NCH, grp = it / NCH, c8 = ch * 8, i0 = grp * 8;
        float w0g[8], w1g[8], w2g[8], bg[8], w0v[8], w1v[8], w2v[8], bv[8];
#pragma unroll
        for (int e = 0; e < 8; e += 4) {
            *(f32x4*)(w0g + e) = *(const f32x4*)(p.conv_w + c8 + e); *(f32x4*)(w1g + e) = *(const f32x4*)(p.conv_w + NUP + c8 + e); *(f32x4*)(w2g + e) = *(const f32x4*)(p.conv_w + 2 * NUP + c8 + e);
            *(f32x4*)(bg + e) = *(const f32x4*)(p.conv_b + c8 + e);
            *(f32x4*)(w0v + e) = *(const f32x4*)(p.conv_w + DFF + c8 + e); *(f32x4*)(w1v + e) = *(const f32x4*)(p.conv_w + NUP + DFF + c8 + e); *(f32x4*)(w2v + e) = *(const f32x4*)(p.conv_w + 2 * NUP + DFF + c8 + e);
            *(f32x4*)(bv + e) = *(const f32x4*)(p.conv_b + DFF + c8 + e);
        }
        const bf16_t* r2p = i0 == 0 ? upm + (size_t)(b * 16 + 14) * NUP : up + (size_t)(i0 - 2) * NUP;
        const bf16_t* r1p = i0 == 0 ? upm + (size_t)(b * 16 + 15) * NUP : up + (size_t)(i0 - 1) * NUP;
        float p2g[8], p1g[8], p2v[8], p1v[8];
        unpack8(*(const u32x4*)(r2p + c8), p2g); unpack8(*(const u32x4*)(r2p + DFF + c8), p2v);
        unpack8(*(const u32x4*)(r1p + c8), p1g); unpack8(*(const u32x4*)(r1p + DFF + c8), p1v);
#pragma unroll
        for (int r = 0; r < 8; ++r) {
            float cg_[8], cv_[8];
            unpack8(*(const u32x4*)(up + (size_t)(i0 + r) * NUP + c8), cg_); unpack8(*(const u32x4*)(up + (size_t)(i0 + r) * NUP + DFF + c8), cv_);
            float o[8];
#pragma unroll
            for (int e = 0; e < 8; ++e) {
                const float ug = bg[e] + w0g[e] * p2g[e] + w1g[e] * p1g[e] + w2g[e] * cg_[e];
                const float uv = bv[e] + w0v[e] * p2v[e] + w1v[e] * p1v[e] + w2v[e] * cv_[e];
                const float t = 0.7978845608028654f * (ug + 0.044715f * ug * ug * ug);
                const float ge = ug * rcp(1.0f + ex2(-2.0f * LOG2E * t));
                o[e] = ge * uv;
                p2g[e] = p1g[e]; p1g[e] = cg_[e]; p2v[e] = p1v[e]; p1v[e] = cv_[e];
            }
            *(u32x4*)(act + (size_t)(i0 + r) * DFF + c8) = (u32x4){pk_bf16(o[0], o[1]), pk_bf16(o[2], o[3]), pk_bf16(o[4], o[5]), pk_bf16(o[6], o[7])};
        }
    }
}
__device__ __forceinline__ void phase6(const Params& p, LAS char* lds, int b) {
    unsigned char* ws = p.ws;
    const int lane = threadIdx.x & 63, w = wave_id(), wr = w >> 1, wc = w & 1;
    const bf16_t* act = (const bf16_t*)(ws + WS_ACT); bf16_t* ffn = (bf16_t*)(ws + WS_FFN);
    for (int it = 0;; ++it) {
        int tm, tn; const int st = tile_at(it, 64, 8, tm, tn); if (st == 0) break; if (st == 2) continue;
        const int col0 = tn * 128;
        f32x4 acc[4][4]; zero_acc(acc);
        gemm_main<true>(lds, act + (size_t)(tm * 128) * DFF, DFF, (const bf16_t*)(ws + WS_BTDN) + (size_t)col0 * DFF, DFF, 44, acc);
        epi_store_ss(acc, ffn, 1024, b * SEQ + tm * 128, col0, (float*)(ws + WS_SSP4), b * SEQ + tm * 128, wr, wc, lane);
    }
}
__device__ __forceinline__ void phase7(const Params& p) {
    unsigned char* ws = p.ws;
    const bf16_t* ffn = (const bf16_t*)(ws + WS_FFN); const float* ssp4 = (const float*)(ws + WS_SSP4); const float* g3 = p.gains + 3 * D;
    for (int it = blockIdx.x * NTHREADS + threadIdx.x; it < MX * 256; it += gridDim.x * NTHREADS) {
        const int row = it >> 8, col = (it & 255) * 4;
        float sq = 0.f;
#pragma unroll
        for (int sl = 0; sl < 16; ++sl) sq += ssp4[(size_t)sl * M + row];
        const float a = 1.0f / sqrtf(sq * (1.0f / D) + EPS);
        const f32x4 hh = *(const f32x4*)(p.out + (size_t)row * D + col), g = *(const f32x4*)(g3 + col);
        const u32x2 f = *(const u32x2*)(ffn + (size_t)row * D + col);
        f32x4 o;
        o[0] = hh[0] + bf_lo(f[0]) * a * g[0]; o[1] = hh[1] + bf_hi(f[0]) * a * g[1];
        o[2] = hh[2] + bf_lo(f[1]) * a * g[2]; o[3] = hh[3] + bf_hi(f[1]) * a * g[3];
        *(f32x4*)(p.out + (size_t)row * D + col) = o;
    }
}


#ifndef DUMP
#define DUMP 0
#endif
__device__ __forceinline__ void phase_dump(const Params& p) {
    unsigned char* ws = p.ws;
    const bf16_t* s0; const bf16_t* s1; int ld;
    if (DUMP == 1) { s0 = (const bf16_t*)(ws + WS_B); s1 = s0 + 512; ld = 1024; }
    else if (DUMP == 2) { s0 = (const bf16_t*)(ws + WS_QF); s1 = (const bf16_t*)(ws + WS_KF); ld = 512; }
    else if (DUMP == 3) { s0 = (const bf16_t*)(ws + WS_A); s1 = s0 + (size_t)M * 512; ld = 512; }
    else if (DUMP == 4) { s0 = (const bf16_t*)(ws + WS_GATED); s1 = s0 + 512; ld = 1024; }
    else if (DUMP == 8) { s0 = (const bf16_t*)(ws + WS_A); s1 = s0 + 512; ld = 1024; }
    else if (DUMP == 9) { s0 = (const bf16_t*)(ws + WS_ACT) + 1024; s1 = (const bf16_t*)(ws + WS_ACT) + 2304 - 512 + 512; ld = DFF; }
    else if (DUMP == 10) { s0 = (const bf16_t*)(ws + WS_FFN); s1 = s0 + 512; ld = 1024; }
    else if (DUMP == 11) { s0 = (const bf16_t*)(ws + WS_UP); s1 = s0 + 512; ld = NUP; }
    else if (DUMP == 6) { s0 = (const bf16_t*)(ws + WS_QS); s1 = (const bf16_t*)(ws + WS_KS); ld = 512; }
    else { s0 = (const bf16_t*)(ws + WS_MIXED); s1 = s0 + 512; ld = 1024; }
    for (int it = blockIdx.x * NTHREADS + threadIdx.x; it < MX * 1024; it += gridDim.x * NTHREADS) {
        const int row = it >> 10, col = it & 1023;
        if (DUMP >= 9 && row >= 8192) { p.out[it] = 0.f; continue; }
        const bf16_t v = col < 512 ? s0[(size_t)row * ld + col] : s1[(size_t)row * ld + col - 512];
        p.out[it] = __uint_as_float((unsigned)v << 16);
    }
}

__device__ __forceinline__ void l2_scrub(const Params& p) {
    const f32x4* src = (const f32x4*)p.x + (size_t)(blockIdx.x & 511) * 8192;
    f32x4 a = (f32x4){0.f, 0.f, 0.f, 0.f};
    for (int i = threadIdx.x; i < 8192; i += NTHREADS) a += src[i];
    if (a[0] + a[1] + a[2] + a[3] == 1.2345e-30f) ((float*)(p.ws + WS_CTL))[32 + (threadIdx.x & 7)] = a[0];
}

__device__ __forceinline__ void my_grid_sync(const Params& p, unsigned& target) {
    unsigned* bar = (unsigned*)(p.ws + WS_CTL) + 16;
    asm volatile("s_waitcnt vmcnt(0)" ::: "memory");
    __syncthreads();
    target += gridDim.x;
    if (threadIdx.x == 0) {
        __builtin_amdgcn_fence(__ATOMIC_RELEASE, "agent");
        asm volatile("s_waitcnt vmcnt(0)" ::: "memory");
        __hip_atomic_fetch_add(bar, 1u, __ATOMIC_RELAXED, __HIP_MEMORY_SCOPE_AGENT);
        while (__hip_atomic_load(bar, __ATOMIC_RELAXED, __HIP_MEMORY_SCOPE_AGENT) < target) __builtin_amdgcn_s_sleep(2);
        __builtin_amdgcn_fence(__ATOMIC_ACQUIRE, "agent");
        asm volatile("s_waitcnt vmcnt(0)" ::: "memory");
    }
    __syncthreads();
}
__global__ void __launch_bounds__(NTHREADS, 2) fwd_kernel(Params p) {
    extern __shared__ __attribute__((aligned(16))) unsigned char lds_raw[];
    LAS char* lds = (LAS char*)lds_raw;
    cg::grid_group grid = cg::this_grid();
#define IN(k) (p.ph_lo <= (k) && (k) < p.ph_hi)
#define SEAM(k) do { if (IN(k) && IN((k) + 1)) { if (p.ph_hi > 1000) grid.sync(); my_grid_sync(p, bar_target); } } while (0)
    unsigned bar_target = 0u;
    if (IN(0)) phase0(p, lds);
    SEAM(0);
    if (IN(1)) phase1(p, lds);
    SEAM(1);
    if (IN(2)) phase2(p, lds);
    SEAM(2);
    if (IN(3)) phase3a(p, lds);
    SEAM(3);
    if (IN(4)) phase3b(p, lds);
    SEAM(4);
    if (IN(5)) phase3c(p);
    SEAM(5);
    for (int b = 0; b < 2; ++b) {
        const int k0 = 6 + 3 * b;
        if (IN(k0)) phase4(p, lds, b);
        SEAM(k0);
        if (IN(k0 + 1)) phase5(p, b);
        SEAM(k0 + 1);
        if (IN(k0 + 2)) phase6(p, lds, b);
        SEAM(k0 + 2);
    }
    if (IN(12)) phase7(p);
    if (IN(13)) phase_dump(p);
#undef IN
#undef SEAM
}


__global__ void ab_save(const unsigned char* ws, float* out) {
    const u32x4* src = (const u32x4*)(ws + AB_SRC); u32x4* dst = (u32x4*)((unsigned char*)out + (size_t)32 * MiB);
    for (size_t i = blockIdx.x * (size_t)blockDim.x + threadIdx.x; i < (size_t)AB_BYTES / 16; i += (size_t)gridDim.x * blockDim.x) dst[i] = src[i];
}
__global__ void ab_diff(const unsigned char* ws, float* out) {
    const bf16_t* src = (const bf16_t*)(ws + AB_SRC); const bf16_t* sav = (const bf16_t*)((unsigned char*)out + (size_t)32 * MiB);
    for (size_t i = blockIdx.x * (size_t)blockDim.x + threadIdx.x; i < (size_t)8192 * 1024; i += (size_t)gridDim.x * blockDim.x) {
        if (i >= (size_t)AB_BYTES / 2) { out[i] = 0.f; continue; }
        out[i] = src[i] != sav[i] ? 1000.0f : 0.f;
    }
}
__global__ void ab_zero(float* out) {
    for (size_t i = blockIdx.x * (size_t)blockDim.x + threadIdx.x; i < (size_t)8192 * 1024; i += (size_t)gridDim.x * blockDim.x) out[(size_t)8192 * 1024 + i] = 0.f;
}
extern "C" void kernel_launch(void* const* d_in, const int* in_sizes, int n_in, void* d_out, int out_size, void* d_ws, size_t ws_size, hipStream_t stream) {
    static int grid_blocks = 0;
    if (grid_blocks == 0) {
        if (n_in != 12 || ws_size < WS_END) { fprintf(stderr, "kernel_launch: unexpected n_in %d or ws_size %zu (need %zu)\n", n_in, ws_size, (size_t)WS_END); grid_blocks = -1; return; }
        int dev = 0, cus = 0, per_cu = 0;
        (void)hipGetDevice(&dev);
        (void)hipDeviceGetAttribute(&cus, hipDeviceAttributeMultiprocessorCount, dev);
        (void)hipFuncSetAttribute((const void*)fwd_kernel, hipFuncAttributeMaxDynamicSharedMemorySize, LDS_BYTES);
        (void)hipOccupancyMaxActiveBlocksPerMultiprocessor(&per_cu, (const void*)fwd_kernel, NTHREADS, LDS_BYTES);
        if (per_cu < 1) per_cu = 1;
        if (per_cu > 2) per_cu = 2;
        grid_blocks = cus * per_cu;
        (void)hipGetLastError();
    }
    if (grid_blocks < 0) return;
    Params p{};
    p.x = (const float*)d_in[0]; p.meta = (const float*)d_in[1]; p.gains = (const float*)d_in[2]; p.w_in = (const float*)d_in[3];
    p.b_forget = (const float*)d_in[4]; p.w_o_fox = (const float*)d_in[5]; p.w_o_sb = (const float*)d_in[6]; p.w_out = (const float*)d_in[7];
    p.w_up = (const float*)d_in[8]; p.conv_w = (const float*)d_in[9]; p.conv_b = (const float*)d_in[10]; p.w_down = (const float*)d_in[11];
    p.out = (float*)d_out; p.ws = (unsigned char*)d_ws;
#if SINGLE_LAUNCH
    (void)hipMemsetAsync((unsigned char*)d_ws + WS_CTL, 0, 256, stream);
    p.ph_lo = 0; p.ph_hi = NPHASE;
    void* args[] = {&p};
    hipError_t e = hipLaunchCooperativeKernel((const void*)fwd_kernel, dim3(grid_blocks), dim3(NTHREADS), args, LDS_BYTES, stream);
    if (e != hipSuccess) fprintf(stderr, "cooperative launch failed: %s (grid %d)\n", hipGetErrorString(e), grid_blocks);
#else
#ifndef STOP_AT
#define STOP_AT NPHASE
#endif
    for (int k = 0; k < STOP_AT; ++k) {
        p.ph_lo = k; p.ph_hi = k + 1;
        hipLaunchKernelGGL(fwd_kernel, dim3(grid_blocks), dim3(NTHREADS), LDS_BYTES, stream, p);
    }
#if ABTEST
    ab_save<<<1024, 256, 0, stream>>>(p.ws, p.out);
    for (int k = AB_FROM; k < STOP_AT; ++k) {
        p.ph_lo = k; p.ph_hi = k + 1;
        hipLaunchKernelGGL(fwd_kernel, dim3(grid_blocks), dim3(NTHREADS), LDS_BYTES, stream, p);
    }
    ab_diff<<<1024, 256, 0, stream>>>(p.ws, p.out);
    ab_zero<<<1024, 256, 0, stream>>>(p.out);
#endif
    if (DUMP) { p.ph_lo = 13; p.ph_hi = 14; hipLaunchKernelGGL(fwd_kernel, dim3(grid_blocks), dim3(NTHREADS), LDS_BYTES, stream, p); }
#endif
}
```

```cpp
#include <hip/hip_runtime.h>
#include <hip/hip_cooperative_groups.h>
#include <cstdio>
#include <cstdint>
namespace cg = cooperative_groups;

#define DUMP 0
#define ABTEST 0
#define AB_FROM 0
#define AB_SRC WS_SSP2
#define AB_BYTES (2 * MiB)
#ifndef SINGLE_LAUNCH
#define SINGLE_LAUNCH 1
#endif

#define LAS __attribute__((address_space(3)))
typedef unsigned short bf16_t;
typedef short bf16x8 __attribute__((ext_vector_type(8)));
typedef float f32x4 __attribute__((ext_vector_type(4)));
typedef float f32x16 __attribute__((ext_vector_type(16)));
typedef unsigned u32x4 __attribute__((ext_vector_type(4)));
typedef unsigned u32x2 __attribute__((ext_vector_type(2)));

constexpr int D = 1024, SEQ = 8192, NMETA = 16, NB = 2;
constexpr int MX = NB * SEQ;
constexpr int MV = MX + NB * NMETA;
constexpr int M = 16512;
constexpr int LPK = 8256;
constexpr int PROJW = 5128, NPROJ = 5120, DFF = 2816, NUP = 5632;
constexpr float EPS = 1e-6f;
constexpr float LOG2E = 1.4426950408889634f, LN2 = 0.6931471805599453f;
constexpr int NTHREADS = 256;
constexpr int LDS_BYTES = 65536;
constexpr int NPHASE = 13;

constexpr size_t MiB = 1u << 20;
constexpr size_t WS_CTL = 0;
constexpr size_t WS_R1 = 4096, WS_R2 = WS_R1 + 69632, WS_SS2 = WS_R2 + 69632, WS_SS4 = WS_SS2 + 69632;
constexpr size_t WS_LOGF = WS_SS4 + 69632, WS_CK = WS_LOGF + 528384, WS_UPMETA = WS_CK + 528384;
constexpr size_t WS_BTIN = 2 * MiB, WS_BTOF = WS_BTIN + 10 * MiB, WS_BTOS = WS_BTOF + 1 * MiB, WS_BTOUT = WS_BTOS + 1 * MiB,
                 WS_BTUP = WS_BTOUT + 2 * MiB, WS_BTDN = WS_BTUP + 11 * MiB;
constexpr size_t SZ_M1024 = (size_t)M * 1024 * 2, SZ_M512 = (size_t)M * 512 * 2;
constexpr size_t WS_A = 33 * MiB;
constexpr size_t WS_B = WS_A + SZ_M1024;
constexpr size_t WS_C = WS_B + 2 * SZ_M1024;
constexpr size_t WS_QF = WS_C, WS_KF = WS_QF + SZ_M512, WS_QS = WS_KF + SZ_M512, WS_KS = WS_QS + SZ_M512, WS_VFT = WS_KS + SZ_M512, WS_VST = WS_VFT + SZ_M512;
constexpr size_t WS_GATED = WS_C, WS_MIXED = WS_B + SZ_M1024;
constexpr size_t WS_UP = WS_B;
constexpr size_t WS_ACT = WS_UP + 88 * MiB;
constexpr size_t WS_FFN = WS_ACT + 44 * MiB;
constexpr size_t WS_SSP2 = 230 * MiB, WS_SSP4 = 232 * MiB;
constexpr size_t WS_END = 234 * MiB;

struct Params {
    const float *x, *meta, *gains, *w_in, *b_forget, *w_o_fox, *w_o_sb, *w_out, *w_up, *conv_w, *conv_b, *w_down;
    float* out; unsigned char* ws; int ph_lo, ph_hi;
};

typedef __bf16 bf16x2_t __attribute__((ext_vector_type(2)));
__device__ __forceinline__ unsigned pk_bf16(float lo, float hi) { bf16x2_t v = {(__bf16)lo, (__bf16)hi}; return __builtin_bit_cast(unsigned, v); }
__device__ __forceinline__ float bf_lo(unsigned u) { return __uint_as_float(u << 16); }
__device__ __forceinline__ float bf_hi(unsigned u) { return __uint_as_float(u & 0xffff0000u); }
__device__ __forceinline__ float ex2(float x) { return __builtin_amdgcn_exp2f(x); }
__device__ __forceinline__ float lg2(float x) { return __builtin_amdgcn_logf(x); }
__device__ __forceinline__ float rcp(float x) { return __builtin_amdgcn_rcpf(x); }
__device__ __forceinline__ float sigmoidf_(float v) { return rcp(1.0f + ex2(-v * LOG2E)); }
__device__ __forceinline__ float wave_sum(float v) {
#pragma unroll
    for (int o = 32; o > 0; o >>= 1) v += __shfl_xor(v, o);
    return v;
}
__device__ __forceinline__ int wave_id() { return __builtin_amdgcn_readfirstlane((int)(threadIdx.x >> 6)); }

__device__ __forceinline__ void transpose_tile(LAS char* lds, const float* src, int ldsrc, int srccol, int k0, const float* gain, bf16_t* dst, int K, int n0) {
    LAS bf16_t* T = (LAS bf16_t*)lds;
    const int tid = threadIdx.x, r = tid >> 4, c4 = tid & 15;
#pragma unroll
    for (int p = 0; p < 4; ++p) {
        const int k = r + 16 * p;
        f32x4 v = *(const f32x4*)(src + (size_t)(k0 + k) * ldsrc + srccol + c4 * 4);
        const float g = gain ? gain[k0 + k] : 1.0f;
        const unsigned a = pk_bf16(v[0] * g, v[1] * g), b = pk_bf16(v[2] * g, v[3] * g);
        T[(c4 * 4 + 0) * 72 + k] = (bf16_t)(a & 0xffff); T[(c4 * 4 + 1) * 72 + k] = (bf16_t)(a >> 16);
        T[(c4 * 4 + 2) * 72 + k] = (bf16_t)(b & 0xffff); T[(c4 * 4 + 3) * 72 + k] = (bf16_t)(b >> 16);
    }
    __syncthreads();
    const int n = tid >> 2, kq = tid & 3;
    const u32x4 lo = *(LAS u32x4*)(T + n * 72 + kq * 16), hi = *(LAS u32x4*)(T + n * 72 + kq * 16 + 8);
    bf16_t* d = dst + (size_t)(n0 + n) * K + k0 + kq * 16;
    *(u32x4*)d = lo; *(u32x4*)(d + 8) = hi;
    __syncthreads();
}

__device__ __forceinline__ void phase0(const Params& p, LAS char* lds) {
    unsigned char* ws = p.ws;
    const int tid = threadIdx.x, lane = tid & 63, w = wave_id();
    LAS float* wfT = (LAS float*)lds;
    const float* g0 = p.gains;
    for (int idx = tid; idx < 8192; idx += NTHREADS) { const int h = idx & 7, k = idx >> 3; wfT[h * 1024 + k] = p.w_in[(size_t)k * PROJW + 1536 + h] * g0[k]; }
    __syncthreads();
    bf16_t* xb = (bf16_t*)(ws + WS_A);
    float* r1 = (float*)(ws + WS_R1);
    float* logf_ = (float*)(ws + WS_LOGF);
    for (int r_ = blockIdx.x * 32 + w; r_ < M; r_ += (r_ & 31) < 28 ? 4 : gridDim.x * 32 - 28) {
        const int r = r_;
        if (r >= MV) {
#pragma unroll
            for (int i = 0; i < 4; ++i) *(u32x2*)(xb + (size_t)r * D + lane * 4 + 256 * i) = (u32x2){0u, 0u};
            if (lane == 0) r1[r] = 0.f;
            continue;
        }
        const float* src = r < MX ? p.x + (size_t)r * D : p.meta + (size_t)((r - MX) & 15) * D;
        f32x4 v[4]; float ss = 0.f;
#pragma unroll
        for (int i = 0; i < 4; ++i) { v[i] = *(const f32x4*)(src + lane * 4 + 256 * i); ss += v[i][0] * v[i][0] + v[i][1] * v[i][1] + v[i][2] * v[i][2] + v[i][3] * v[i][3]; }
#pragma unroll
        for (int i = 0; i < 4; ++i) *(u32x2*)(xb + (size_t)r * D + lane * 4 + 256 * i) = (u32x2){pk_bf16(v[i][0], v[i][1]), pk_bf16(v[i][2], v[i][3])};
        ss = wave_sum(ss);
        const float rs = 1.0f / sqrtf(ss * (1.0f / D) + EPS);
        if (lane == 0) r1[r] = rs;
        float mine = 0.f;
#pragma unroll
        for (int h = 0; h < 8; ++h) {
            float a = 0.f;
#pragma unroll
            for (int i = 0; i < 4; ++i) { const f32x4 wv = *(LAS f32x4*)(wfT + h * 1024 + lane * 4 + 256 * i); a += v[i][0] * wv[0] + v[i][1] * wv[1] + v[i][2] * wv[2] + v[i][3] * wv[3]; }
            a = wave_sum(a);
            if (lane == h) mine = a;
        }
        if (lane < 8) {
            const float f = mine * rs + p.b_forget[lane];
            const float lf = fminf(f, 0.f) - log1pf(expf(-fabsf(f)));
            int b, kidx; if (r < MX) { b = r >> 13; kidx = r & 8191; } else { const int j = r - MX; b = j >> 4; kidx = 8192 + (j & 15); }
            logf_[(size_t)(b * 8 + lane) * LPK + kidx] = lf;
        }
    }
    __syncthreads();
    LAS char* tl = lds + 32768;
    const float* g2 = p.gains + 2 * D;
    constexpr int T_IN = 16 * 80, T_OF = 8 * 16, T_OS = 8 * 16, T_OUT = 16 * 16, T_UP = 16 * 88, T_DN = 44 * 16;
    constexpr int T_ALL = T_IN + T_OF + T_OS + T_OUT + T_UP + T_DN;
    for (int t = blockIdx.x; t < T_ALL; t += gridDim.x) {
        int u = t;
        if (u < T_IN) { const int nt = u % 80, kt = u / 80; const int sc = nt * 64 + (nt * 64 >= 1536 ? 8 : 0); transpose_tile(tl, p.w_in, PROJW, sc, kt * 64, g0, (bf16_t*)(ws + WS_BTIN), 1024, nt * 64); continue; }
        u -= T_IN;
        if (u < T_OF) { const int nt = u % 16, kt = u / 16; transpose_tile(tl, p.w_o_fox, 1024, nt * 64, kt * 64, nullptr, (bf16_t*)(ws + WS_BTOF), 512, nt * 64); continue; }
        u -= T_OF;
        if (u < T_OS) { const int nt = u % 16, kt = u / 16; transpose_tile(tl, p.w_o_sb, 1024, nt * 64, kt * 64, nullptr, (bf16_t*)(ws + WS_BTOS), 512, nt * 64); continue; }
        u -= T_OS;
        if (u < T_OUT) { const int nt = u % 16, kt = u / 16; transpose_tile(tl, p.w_out, 1024, nt * 64, kt * 64, nullptr, (bf16_t*)(ws + WS_BTOUT), 1024, nt * 64); continue; }
        u -= T_OUT;
        if (u < T_UP) { const int nt = u % 88, kt = u / 88; transpose_tile(tl, p.w_up, NUP, nt * 64, kt * 64, g2, (bf16_t*)(ws + WS_BTUP), 1024, nt * 64); continue; }
        u -= T_UP;
        { const int nt = u % 16, kt = u / 16; transpose_tile(tl, p.w_down, 1024, nt * 64, kt * 64, nullptr, (bf16_t*)(ws + WS_BTDN), DFF, nt * 64); }
    }
}

template <bool SWAP>
__device__ __forceinline__ void gemm_main(LAS char* lds, const bf16_t* Ag, int lda, const bf16_t* Bg, int ldb, int nk, f32x4 (&acc)[4][4]) {
    const int tid = threadIdx.x, lane = tid & 63, w = wave_id(), wr = w >> 1, wc = w & 1;
    const int row_0 = w * 8 + (lane >> 3), c_0 = (lane & 7) ^ ((row_0 >> 1) & 7);
    const bf16_t* pa0 = Ag + (size_t)row_0 * lda + c_0 * 8; const bf16_t* pb0 = Bg + (size_t)row_0 * ldb + c_0 * 8;
    const size_t sa = (size_t)32 * lda, sb_ = (size_t)32 * ldb;
    const int swz = (lane >> 1) & 7;
    int aoff[2], boff[2];
#pragma unroll
    for (int kh = 0; kh < 2; ++kh) {
        aoff[kh] = (wr * 64 + (lane & 15)) * 128 + (((kh * 4 + (lane >> 4)) ^ swz) << 4);
        boff[kh] = 16384 + (wc * 64 + (lane & 15)) * 128 + (((kh * 4 + (lane >> 4)) ^ swz) << 4);
    }
#define GM_STAGE(s, kt) do { _Pragma("unroll") for (int i_ = 0; i_ < 4; ++i_) { \
        __builtin_amdgcn_global_load_lds((const unsigned*)(pa0 + i_ * sa + (kt) * 64), (LAS unsigned*)(lds + (s) * 32768 + (i_ * 4 + w) * 1024), 16, 0, 0); \
        __builtin_amdgcn_global_load_lds((const unsigned*)(pb0 + i_ * sb_ + (kt) * 64), (LAS unsigned*)(lds + (s) * 32768 + 16384 + (i_ * 4 + w) * 1024), 16, 0, 0); } } while (0)
    GM_STAGE(0, 0);
    for (int kt = 0; kt < nk; ++kt) {
        asm volatile("s_waitcnt vmcnt(0)" ::: "memory");
        __syncthreads();
        const int s = kt & 1;
        if (kt + 1 < nk) GM_STAGE(s ^ 1, kt + 1);
        bf16x8 af[4][2], bf[4][2];
#pragma unroll
        for (int kh = 0; kh < 2; ++kh) {
#pragma unroll
            for (int m = 0; m < 4; ++m) af[m][kh] = *(LAS bf16x8*)(lds + s * 32768 + aoff[kh] + m * 2048);
#pragma unroll
            for (int n = 0; n < 4; ++n) bf[n][kh] = *(LAS bf16x8*)(lds + s * 32768 + boff[kh] + n * 2048);
        }
        __builtin_amdgcn_s_setprio(1);
#pragma unroll
        for (int kh = 0; kh < 2; ++kh)
#pragma unroll
            for (int m = 0; m < 4; ++m)
#pragma unroll
                for (int n = 0; n < 4; ++n)
                    acc[m][n] = SWAP ? __builtin_amdgcn_mfma_f32_16x16x32_bf16(bf[n][kh], af[m][kh], acc[m][n], 0, 0, 0)
                                     : __builtin_amdgcn_mfma_f32_16x16x32_bf16(af[m][kh], bf[n][kh], acc[m][n], 0, 0, 0);
        __builtin_amdgcn_s_setprio(0);
    }
    __syncthreads();
#undef GM_STAGE
}
__device__ __forceinline__ void zero_acc(f32x4 (&acc)[4][4]) {
#pragma unroll
    for (int m = 0; m < 4; ++m)
#pragma unroll
        for (int n = 0; n < 4; ++n) acc[m][n] = (f32x4){0.f, 0.f, 0.f, 0.f};
}


__device__ __forceinline__ int tile_at(int it, int ntm, int ntn, int& tm, int& tn) {
    const int G = gridDim.x;
    if (G % 256 != 0) { const int t = it * G + blockIdx.x; if (t >= ntm * ntn) return 0; tm = t / ntn; tn = t % ntn; return 1; }
    const int xcd = blockIdx.x & 7, j = blockIdx.x >> 3, ppx = G >> 8;
    const int pcols = (ntn + 3) >> 2, prows = (ntm + 7) >> 3;
    const int patch = (it * ppx + (j >> 5)) * 8 + xcd;
    if (patch >= prows * pcols) return 0;
    const int wi = j & 31;
    tm = (patch / pcols) * 8 + (wi >> 2); tn = (patch % pcols) * 4 + (wi & 3);
    return (tm < ntm && tn < ntn) ? 1 : 2;
}
__device__ __forceinline__ void cumsum_block(const Params& p, LAS char* lds, int bh) {
    const float* lf = (const float*)(p.ws + WS_LOGF) + (size_t)bh * LPK; float* ck = (float*)(p.ws + WS_CK) + (size_t)bh * LPK;
    LAS float* sums = (LAS float*)lds;
    const int tid = threadIdx.x; constexpr int PER = 33, L = SEQ + NMETA;
    float loc = 0.f;
    for (int e = 0; e < PER; ++e) { const int t = tid * PER + e; if (t < L) loc += lf[t < 16 ? 8192 + t : t - 16]; }
    sums[tid] = loc;
    __syncthreads();
    float run = 0.f;
    for (int i = 0; i < tid; ++i) run += sums[i];
    for (int e = 0; e < PER; ++e) { const int t = tid * PER + e; if (t < L) { const int kx = t < 16 ? 8192 + t : t - 16; run += lf[kx]; ck[kx] = run * LOG2E; } }
    __syncthreads();
}

__device__ __forceinline__ void phase1(const Params& p, LAS char* lds) {
    unsigned char* ws = p.ws;
    if (blockIdx.x < 16) cumsum_block(p, lds, blockIdx.x);
    const int lane = threadIdx.x & 63, w = wave_id(), wr = w >> 1, wc = w & 1;
    const bf16_t* xb = (const bf16_t*)(ws + WS_A); const bf16_t* Bt = (const bf16_t*)(ws + WS_BTIN);
    const float* r1 = (const float*)(ws + WS_R1);
    constexpr int NTN = 40, NTM = 129;
    for (int it = 0;; ++it) {
        int tm, tn; const int st = tile_at(it, NTM, NTN, tm, tn); if (st == 0) break; if (st == 2) continue;
        const int row0 = tm * 128, col0 = tn * 128;
        const bool vtile = (tn >= 8 && tn < 12) || (tn >= 20 && tn < 24);
        f32x4 acc[4][4]; zero_acc(acc);
        if (vtile) {
            gemm_main<false>(lds, xb + (size_t)row0 * D, D, Bt + (size_t)col0 * D, D, 16, acc);
            bf16_t* vT = (bf16_t*)(ws + (tn < 12 ? WS_VFT : WS_VST)); const int cb = tn < 12 ? 1024 : 2560;
            const int g = lane >> 4, gp = ((g & 1) << 1) | (g >> 1);
#pragma unroll
            for (int m = 0; m < 4; ++m) {
                const int rb = row0 + wr * 64 + m * 16; int b, kb16;
                if (rb < MX) { b = rb >> 13; kb16 = rb & 8191; } else { const int j = rb - MX; if (j >= 32) continue; b = j >> 4; kb16 = 8192; }
                const f32x4 rs = *(const f32x4*)(r1 + rb + g * 4);
#pragma unroll
                for (int n = 0; n < 4; ++n) {
                    const int dc = col0 + wc * 64 + n * 16 + (lane & 15) - cb, h = dc >> 6, d = dc & 63;
                    const f32x4 v = acc[m][n] * rs;
                    *(u32x2*)(vT + ((size_t)(b * 8 + h) * 64 + d) * LPK + kb16 + gp * 4) = (u32x2){pk_bf16(v[0], v[1]), pk_bf16(v[2], v[3])};
                }
            }
        } else {
            gemm_main<true>(lds, xb + (size_t)row0 * D, D, Bt + (size_t)col0 * D, D, 16, acc);
            bf16_t* dst; int ld, cb; float sc = 1.f; bool sg = false;
            if (tn < 4) { dst = (bf16_t*)(ws + WS_QF); ld = 512; cb = 0; sc = 0.125f * LOG2E; }
            else if (tn < 8) { dst = (bf16_t*)(ws + WS_KF); ld = 512; cb = 512; }
            else if (tn < 16) { dst = (bf16_t*)(ws + WS_QS); ld = 512; cb = 1536; sc = 0.125f; }
            else if (tn < 20) { dst = (bf16_t*)(ws + WS_KS); ld = 512; cb = 2048; }
            else if (tn < 32) { dst = (bf16_t*)(ws + WS_B); ld = 1024; cb = 3072; sg = true; }
            else { dst = (bf16_t*)(ws + WS_B + SZ_M1024); ld = 1024; cb = 4096; sg = true; }
#pragma unroll
            for (int m = 0; m < 4; ++m) {
                const int row = row0 + wr * 64 + m * 16 + (lane & 15); const float rs = r1[row] * sc;
#pragma unroll
                for (int n = 0; n < 4; ++n) {
                    const int col = col0 + wc * 64 + n * 16 + (lane >> 4) * 4 - cb;
                    f32x4 v = acc[m][n] * rs;
                    if (sg) { v[0] = sigmoidf_(v[0]); v[1] = sigmoidf_(v[1]); v[2] = sigmoidf_(v[2]); v[3] = sigmoidf_(v[3]); }
                    *(u32x2*)(dst + (size_t)row * ld + col) = (u32x2){pk_bf16(v[0], v[1]), pk_bf16(v[2], v[3])};
                }
            }
        }
    }
}

constexpr int AT_STAGE = 16640;
template <int TYPE>
__device__ __forceinline__ void attn_unit(LAS char* lds, const Params& p, int b, int h, int qb) {
    unsigned char* ws = p.ws;
    const int tid = threadIdx.x, lane = tid & 63, w = wave_id(), ql = lane & 31, hi = lane >> 5;
    const bf16_t* Q = (const bf16_t*)(ws + (TYPE == 0 ? WS_QF : WS_QS));
    const bf16_t* Kp = (const bf16_t*)(ws + (TYPE == 0 ? WS_KF : WS_KS));
    const bf16_t* VT = (const bf16_t*)(ws + (TYPE == 0 ? WS_VFT : WS_VST)) + (size_t)(b * 8 + h) * 64 * LPK;
    const float* cK = (const float*)(ws + WS_CK) + (size_t)(b * 8 + h) * LPK;
    bf16_t* Oo = (bf16_t*)(ws + WS_A + (TYPE == 0 ? 0 : SZ_M512));
    const bool meta_unit = qb < 0;
    const int qrow0 = meta_unit ? MX + 16 * b : b * SEQ + qb * 128;
    const int nt = meta_unit ? 1 : 2 * qb + 3;
    int qrow = qrow0 + 32 * w + ql; if (qrow > M - 1) qrow = M - 1;
    bf16x8 qf[4];
#pragma unroll
    for (int ds = 0; ds < 4; ++ds) qf[ds] = *(const bf16x8*)(Q + (size_t)qrow * 512 + h * 64 + ds * 16 + hi * 8);
    f32x16 O0, O1;
#pragma unroll
    for (int i = 0; i < 16; ++i) { O0[i] = 0.f; O1[i] = 0.f; }
    float m_run = -INFINITY, lsum = 0.f, R = 0.f;
    u32x4 kreg[2], vreg[2]; float creg = 0.f;
    const int srow = tid >> 3, spos = tid & 7;
    const int swz_st = (spos ^ ((srow >> 1) & 7)) << 4;
    const int swz = (lane >> 1) & 7;
    LAS unsigned* flags = (LAS unsigned*)(lds + 2 * AT_STAGE);
#define AT_LOAD(j) do { int krow0_, kidx0_; if (!meta_unit && (j) < nt - 1) { const int kt_ = nt - 2 - (j); krow0_ = b * SEQ + 64 * kt_; kidx0_ = 64 * kt_; } else { krow0_ = MX + 16 * b; kidx0_ = 8192; } \
        _Pragma("unroll") for (int i_ = 0; i_ < 2; ++i_) { \
            kreg[i_] = *(const u32x4*)(Kp + (size_t)(krow0_ + srow + 32 * i_) * 512 + h * 64 + spos * 8); \
            vreg[i_] = *(const u32x4*)(VT + (size_t)(srow + 32 * i_) * LPK + kidx0_ + spos * 8); } \
        if (TYPE == 0 && tid < 64) creg = cK[kidx0_ + tid]; } while (0)
#define AT_WRITE(s) do { _Pragma("unroll") for (int i_ = 0; i_ < 2; ++i_) { \
            *(LAS u32x4*)(lds + (s) * AT_STAGE + (srow + 32 * i_) * 128 + swz_st) = kreg[i_]; \
            *(LAS u32x4*)(lds + (s) * AT_STAGE + 8192 + (srow + 32 * i_) * 128 + swz_st) = vreg[i_]; } \
        if (TYPE == 0 && tid < 64) *(LAS float*)(lds + (s) * AT_STAGE + 16384 + tid * 4) = creg; } while (0)
    AT_LOAD(0); AT_WRITE(0);
    __syncthreads();
    for (int j = 0; j < nt; ++j) {
        const bool more = j + 1 < nt;
        if (more) AT_LOAD(j + 1);
        int klim, d0;
        if (meta_unit) { klim = 16; d0 = 0; }
        else if (j == nt - 1) { klim = 16; d0 = 1 << 20; }
        else { klim = 64; d0 = 128 * qb - 64 * (nt - 2 - j); if (d0 >= 64) d0 = 1 << 20; }
        const int limw = 32 * w + d0 - TYPE;
        bool wdone = false;
        if (limw + 31 >= 0) {
            const LAS char* sb = lds + (j & 1) * AT_STAGE;
            int kmax = limw + ql; if (kmax > klim - 1) kmax = klim - 1;
            const bool needmask = (klim < 64) || (limw < 63);
            f32x16 S0, S1;
#pragma unroll
            for (int i = 0; i < 16; ++i) { S0[i] = 0.f; S1[i] = 0.f; }
#pragma unroll
            for (int ds = 0; ds < 4; ++ds) {
                const bf16x8 k0 = *(const LAS bf16x8*)(sb + ql * 128 + (((2 * ds + hi) ^ swz) << 4));
                const bf16x8 k1 = *(const LAS bf16x8*)(sb + (32 + ql) * 128 + (((2 * ds + hi) ^ swz) << 4));
                S0 = __builtin_amdgcn_mfma_f32_32x32x16_bf16(k0, qf[ds], S0, 0, 0, 0);
                S1 = __builtin_amdgcn_mfma_f32_32x32x16_bf16(k1, qf[ds], S1, 0, 0, 0);
            }
            if (TYPE == 0) {
#pragma unroll
                for (int g = 0; g < 4; ++g) {
                    const f32x4 c0 = *(const LAS f32x4*)(sb + 16384 + (8 * g + 4 * hi) * 4), c1 = *(const LAS f32x4*)(sb + 16384 + (32 + 8 * g + 4 * hi) * 4);
#pragma unroll
                    for (int i = 0; i < 4; ++i) { S0[4 * g + i] -= c0[i]; S1[4 * g + i] -= c1[i]; }
                }
                if (needmask) {
#pragma unroll
                    for (int r = 0; r < 16; ++r) { const int kl = (r & 3) + 8 * (r >> 2) + 4 * hi; if (kl > kmax) S0[r] = -INFINITY; if (kl + 32 > kmax) S1[r] = -INFINITY; }
                }
                float mx = -INFINITY;
#pragma unroll
                for (int r = 0; r < 16; ++r) mx = fmaxf(mx, fmaxf(S0[r], S1[r]));
                mx = fmaxf(mx, __shfl_xor(mx, 32));
                const float m_new = fmaxf(m_run, mx), alpha = ex2(m_run - m_new);
                m_run = m_new;
                float ps = 0.f;
#pragma unroll
                for (int r = 0; r < 16; ++r) { S0[r] = ex2(S0[r] - m_new); S1[r] = ex2(S1[r] - m_new); ps += S0[r] + S1[r]; }
                lsum = lsum * alpha + ps;
#pragma unroll
                for (int r = 0; r < 16; ++r) { O0[r] *= alpha; O1[r] *= alpha; }
            } else {
                float G0[4], G1[4];
                f32x16 L0, L1;
#pragma unroll
                for (int r = 0; r < 16; ++r) {
                    const int kl = (r & 3) + 8 * (r >> 2) + 4 * hi;
                    const float z0 = S0[r], z1 = S1[r];
                    const float sp0 = fmaxf(z0, 0.f) + lg2(1.0f + ex2(-fabsf(z0) * LOG2E)) * LN2;
                    const float sp1 = fmaxf(z1, 0.f) + lg2(1.0f + ex2(-fabsf(z1) * LOG2E)) * LN2;
                    L0[r] = (!needmask || kl <= kmax) ? -sp0 : 0.f;
                    L1[r] = (!needmask || kl + 32 <= kmax) ? -sp1 : 0.f;
                }
#pragma unroll
                for (int g = 0; g < 4; ++g) {
                    L0[4 * g + 2] += L0[4 * g + 3]; L0[4 * g + 1] += L0[4 * g + 2]; L0[4 * g] += L0[4 * g + 1]; G0[g] = L0[4 * g];
                    L1[4 * g + 2] += L1[4 * g + 3]; L1[4 * g + 1] += L1[4 * g + 2]; L1[4 * g] += L1[4 * g + 1]; G1[g] = L1[4 * g];
                }
                float run = R;
#pragma unroll
                for (int g = 3; g >= 0; --g) {
                    const float gp = __shfl_xor(G1[g], 32);
                    const float off = hi ? run : run + gp;
#pragma unroll
                    for (int i = 0; i < 4; ++i) { const int r = 4 * g + i; const int kl = 32 + i + 8 * g + 4 * hi;
                        const float a = ex2((S1[r] + L1[r] + off) * LOG2E); S1[r] = (!needmask || kl <= kmax) ? a : 0.f; }
                    run += G1[g] + gp;
                }
#pragma unroll
                for (int g = 3; g >= 0; --g) {
                    const float gp = __shfl_xor(G0[g], 32);
                    const float off = hi ? run : run + gp;
#pragma unroll
                    for (int i = 0; i < 4; ++i) { const int r = 4 * g + i; const int kl = i + 8 * g + 4 * hi;
                        const float a = ex2((S0[r] + L0[r] + off) * LOG2E); S0[r] = (!needmask || kl <= kmax) ? a : 0.f; }
                    run += G0[g] + gp;
                }
                R = run;
                wdone = __all(R < -120.0f) != 0;
            }
#pragma unroll
            for (int ks = 0; ks < 4; ++ks) {
                bf16x8 pf; u32x4 pu;
                if (ks < 2) { pu = (u32x4){pk_bf16(S0[8 * ks + 0], S0[8 * ks + 1]), pk_bf16(S0[8 * ks + 2], S0[8 * ks + 3]), pk_bf16(S0[8 * ks + 4], S0[8 * ks + 5]), pk_bf16(S0[8 * ks + 6], S0[8 * ks + 7])}; }
                else { const int k2 = ks - 2; pu = (u32x4){pk_bf16(S1[8 * k2 + 0], S1[8 * k2 + 1]), pk_bf16(S1[8 * k2 + 2], S1[8 * k2 + 3]), pk_bf16(S1[8 * k2 + 4], S1[8 * k2 + 5]), pk_bf16(S1[8 * k2 + 6], S1[8 * k2 + 7])}; }
                pf = __builtin_bit_cast(bf16x8, pu);
                const bf16x8 v0 = *(const LAS bf16x8*)(sb + 8192 + ql * 128 + (((2 * ks + hi) ^ swz) << 4));
                const bf16x8 v1 = *(const LAS bf16x8*)(sb + 8192 + (32 + ql) * 128 + (((2 * ks + hi) ^ swz) << 4));
                O0 = __builtin_amdgcn_mfma_f32_32x32x16_bf16(v0, pf, O0, 0, 0, 0);
                O1 = __builtin_amdgcn_mfma_f32_32x32x16_bf16(v1, pf, O1, 0, 0, 0);
            }
        }
        if (more) AT_WRITE((j + 1) & 1);
        if (TYPE == 1 && lane == 0) flags[(j & 1) * 4 + w] = wdone ? 1u : 0u;
        __syncthreads();
        if (TYPE == 1) { const LAS unsigned* fl = flags + (j & 1) * 4; const unsigned f = fl[0] & fl[1] & fl[2] & fl[3]; if (f) break; }
    }
    float inv = 1.0f;
    if (TYPE == 0) { const float l = lsum + __shfl_xor(lsum, 32); inv = 1.0f / l; }
    const bool qvalid = meta_unit ? (w == 0 && ql < 16) : true;
    if (qvalid) {
        bf16_t* op = Oo + (size_t)qrow * 512 + h * 64 + 4 * hi;
#pragma unroll
        for (int g = 0; g < 4; ++g) {
            *(u32x2*)(op + 8 * g) = (u32x2){pk_bf16(O0[4 * g] * inv, O0[4 * g + 1] * inv), pk_bf16(O0[4 * g + 2] * inv, O0[4 * g + 3] * inv)};
            *(u32x2*)(op + 32 + 8 * g) = (u32x2){pk_bf16(O1[4 * g] * inv, O1[4 * g + 1] * inv), pk_bf16(O1[4 * g + 2] * inv, O1[4 * g + 3] * inv)};
        }
    }
    __syncthreads();
#undef AT_LOAD
#undef AT_WRITE
}

__device__ __forceinline__ void phase2(const Params& p, LAS char* lds) {
    unsigned* ctr = (unsigned*)(p.ws + WS_CTL);
    LAS unsigned* shu = (LAS unsigned*)(lds + 2 * AT_STAGE + 64);
    constexpr int NU = 2048 + 32;
    const int G = gridDim.x;
    for (int it = blockIdx.x; it < NU; it += G) {
        int u = it;
        if (it < 1024 && (1024 % (2 * G)) == 0) { const int rnd = it / G, pos = it - rnd * G; u = (rnd & 1) ? ((rnd + 1) * G - 1 - pos) : it; }
        if (u < 1024) attn_unit<0>(lds, p, (u & 15) >> 3, u & 7, 63 - (u >> 4));
        else if (u < 2048) { const int v = u - 1024; attn_unit<1>(lds, p, (v & 15) >> 3, v & 7, 63 - (v >> 4)); }
        else if (u < 2064) { const int v = u - 2048; attn_unit<0>(lds, p, v >> 3, v & 7, -1); }
        else { const int v = u - 2064; attn_unit<1>(lds, p, v >> 3, v & 7, -1); }
    }
}

__device__ __forceinline__ void phase3a(const Params& p, LAS char* lds) {
    unsigned char* ws = p.ws;
    const int lane = threadIdx.x & 63, w = wave_id(), wr = w >> 1, wc = w & 1;
    const bf16_t* oa = (const bf16_t*)(ws + WS_A); const bf16_t* ob = oa + (size_t)M * 512;
    const bf16_t* ga = (const bf16_t*)(ws + WS_B); const bf16_t* gb = ga + (size_t)M * 1024;
    bf16_t* gated = (bf16_t*)(ws + WS_GATED);
    for (int it = 0;; ++it) {
        int tm, tn; const int st = tile_at(it, 129, 8, tm, tn); if (st == 0) break; if (st == 2) continue;
        const int row0 = tm * 128, col0 = tn * 128;
        f32x4 acc[4][4]; zero_acc(acc);
        gemm_main<true>(lds, oa + (size_t)row0 * 512, 512, (const bf16_t*)(ws + WS_BTOF) + (size_t)col0 * 512, 512, 8, acc);
#pragma unroll
        for (int m = 0; m < 4; ++m) {
            const int row = row0 + wr * 64 + m * 16 + (lane & 15);
#pragma unroll
            for (int n = 0; n < 4; ++n) {
                const int col = col0 + wc * 64 + n * 16 + (lane >> 4) * 4;
                const u32x2 a = *(const u32x2*)(ga + (size_t)row * 1024 + col);
                const f32x4 x = acc[m][n];
                *(u32x2*)(gated + (size_t)row * 1024 + col) = (u32x2){pk_bf16(bf_lo(a[0]) * x[0], bf_hi(a[0]) * x[1]), pk_bf16(bf_lo(a[1]) * x[2], bf_hi(a[1]) * x[3])};
            }
        }
        zero_acc(acc);
        gemm_main<true>(lds, ob + (size_t)row0 * 512, 512, (const bf16_t*)(ws + WS_BTOS) + (size_t)col0 * 512, 512, 8, acc);
#pragma unroll
        for (int m = 0; m < 4; ++m) {
            const int row = row0 + wr * 64 + m * 16 + (lane & 15);
#pragma unroll
            for (int n = 0; n < 4; ++n) {
                const int col = col0 + wc * 64 + n * 16 + (lane >> 4) * 4;
                const u32x2 b = *(const u32x2*)(gb + (size_t)row * 1024 + col);
                const f32x4 y = acc[m][n]; const u32x2 q = *(const u32x2*)(gated + (size_t)row * 1024 + col);
                const float o0 = bf_lo(q[0]) + bf_lo(b[0]) * y[0], o1 = bf_hi(q[0]) + bf_hi(b[0]) * y[1];
                const float o2 = bf_lo(q[1]) + bf_lo(b[1]) * y[2], o3 = bf_hi(q[1]) + bf_hi(b[1]) * y[3];
                *(u32x2*)(gated + (size_t)row * 1024 + col) = (u32x2){pk_bf16(o0, o1), pk_bf16(o2, o3)};
            }
        }
    }
}
__device__ __forceinline__ void epi_store_ss(const f32x4 (&acc)[4][4], bf16_t* out, int ldo, int orow0, int col0, float* ssp, int ssrow0, int wr, int wc, int lane) {
#pragma unroll
    for (int m = 0; m < 4; ++m) {
        const int rl = wr * 64 + m * 16 + (lane & 15);
        float s = 0.f;
#pragma unroll
        for (int n = 0; n < 4; ++n) {
            const int col = col0 + wc * 64 + n * 16 + (lane >> 4) * 4;
            const f32x4 v = acc[m][n];
            s += v[0] * v[0] + v[1] * v[1] + v[2] * v[2] + v[3] * v[3];
            *(u32x2*)(out + (size_t)(orow0 + rl) * ldo + col) = (u32x2){pk_bf16(v[0], v[1]), pk_bf16(v[2], v[3])};
        }
#if 1
        s += __shfl_xor(s, 16); s += __shfl_xor(s, 32);
        if (lane < 16) ssp[(size_t)((col0 >> 7) * 2 + wc) * M + ssrow0 + rl] = s;
#endif
    }
}
__device__ __forceinline__ void phase3b(const Params& p, LAS char* lds) {
    unsigned char* ws = p.ws;
    const int lane = threadIdx.x & 63, w = wave_id(), wr = w >> 1, wc = w & 1;
    const bf16_t* gated = (const bf16_t*)(ws + WS_GATED); bf16_t* mixed = (bf16_t*)(ws + WS_MIXED);
    for (int it = 0;; ++it) {
        int tm, tn; const int st = tile_at(it, 129, 8, tm, tn); if (st == 0) break; if (st == 2) continue;
        const int row0 = tm * 128, col0 = tn * 128;
        f32x4 acc[4][4]; zero_acc(acc);
        gemm_main<true>(lds, gated + (size_t)row0 * 1024, 1024, (const bf16_t*)(ws + WS_BTOUT) + (size_t)col0 * 1024, 1024, 16, acc);
        epi_store_ss(acc, mixed, 1024, row0, col0, (float*)(ws + WS_SSP2), row0, wr, wc, lane);
    }
}
__device__ __forceinline__ void phase3c(const Params& p) {
    unsigned char* ws = p.ws;
    const int lane = threadIdx.x & 63, w = wave_id();
    const bf16_t* mixed = (const bf16_t*)(ws + WS_MIXED); bf16_t* hb = (bf16_t*)(ws + WS_A);
    const float* ssp2 = (const float*)(ws + WS_SSP2); float* r2 = (float*)(ws + WS_R2);
    const float* g1 = p.gains + D;
    for (int r_ = blockIdx.x * 32 + w; r_ < M; r_ += (r_ & 31) < 28 ? 4 : gridDim.x * 32 - 28) {
        const int r = r_;
        if (r >= MV) continue;
        const float* src = r < MX ? p.x + (size_t)r * D : p.meta + (size_t)((r - MX) & 15) * D;
        float sq = lane < 16 ? ssp2[(size_t)lane * M + r] : 0.f;
        sq = wave_sum(sq);
        const float a = 1.0f / sqrtf(sq * (1.0f / D) + EPS);
        float ss = 0.f;
#pragma unroll
        for (int i = 0; i < 4; ++i) {
            const int col = lane * 4 + 256 * i;
            const f32x4 v = *(const f32x4*)(src + col), g = *(const f32x4*)(g1 + col);
            const u32x2 mx = *(const u32x2*)(mixed + (size_t)r * D + col);
            f32x4 hh;
            hh[0] = v[0] + bf_lo(mx[0]) * a * g[0]; hh[1] = v[1] + bf_hi(mx[0]) * a * g[1];
            hh[2] = v[2] + bf_lo(mx[1]) * a * g[2]; hh[3] = v[3] + bf_hi(mx[1]) * a * g[3];
            ss += hh[0] * hh[0] + hh[1] * hh[1] + hh[2] * hh[2] + hh[3] * hh[3];
            *(u32x2*)(hb + (size_t)r * D + col) = (u32x2){pk_bf16(hh[0], hh[1]), pk_bf16(hh[2], hh[3])};
            if (r < MX) *(f32x4*)(p.out + (size_t)r * D + col) = hh;
        }
        ss = wave_sum(ss);
        if (lane == 0) r2[r] = 1.0f / sqrtf(ss * (1.0f / D) + EPS);
    }
}
__device__ __forceinline__ void phase4(const Params& p, LAS char* lds, int b) {
    unsigned char* ws = p.ws;
    const int lane = threadIdx.x & 63, w = wave_id(), wr = w >> 1, wc = w & 1;
    const bf16_t* hb = (const bf16_t*)(ws + WS_A); const bf16_t* Bt = (const bf16_t*)(ws + WS_BTUP);
    const float* r2 = (const float*)(ws + WS_R2);
    bf16_t* up = (bf16_t*)(ws + WS_UP); bf16_t* upm = (bf16_t*)(ws + WS_UPMETA);
    for (int it = 0;; ++it) {
        int tm, tn; int st = tile_at(it, 64, 44, tm, tn);
        if (st == 0) { if (b == 0 && it < (1 << 20) && (int)blockIdx.x < 44) { tm = 64; tn = blockIdx.x; it = 1 << 20; st = 1; } else break; }
        if (st == 2) continue;
        const int col0 = tn * 128;
        const bool mt = tm == 64; const int row0 = mt ? MX : b * SEQ + tm * 128;
        f32x4 acc[4][4]; zero_acc(acc);
        gemm_main<true>(lds, hb + (size_t)row0 * D, D, Bt + (size_t)col0 * D, D, 16, acc);
#pragma unroll
        for (int m = 0; m < 4; ++m) {
            const int rl = wr * 64 + m * 16 + (lane & 15), row = row0 + rl;
            if (mt && rl >= 32) continue;
            const float rs = r2[row];
            bf16_t* orow = mt ? upm + (size_t)rl * NUP : up + (size_t)(tm * 128 + rl) * NUP;
#pragma unroll
            for (int n = 0; n < 4; ++n) {
                const int col = col0 + wc * 64 + n * 16 + (lane >> 4) * 4;
                const f32x4 v = acc[m][n] * rs;
                *(u32x2*)(orow + col) = (u32x2){pk_bf16(v[0], v[1]), pk_bf16(v[2], v[3])};
            }
        }
    }
}
__device__ __forceinline__ void unpack8(const u32x4 u, float (&f)[8]) {
    f[0] = bf_lo(u[0]); f[1] = bf_hi(u[0]); f[2] = bf_lo(u[1]); f[3] = bf_hi(u[1]); f[4] = bf_lo(u[2]); f[5] = bf_hi(u[2]); f[6] = bf_lo(u[3]); f[7] = bf_hi(u[3]);
}
__device__ __forceinline__ void phase5(const Params& p, int b) {
    unsigned char* ws = p.ws;
    const bf16_t* up = (const bf16_t*)(ws + WS_UP); const bf16_t* upm = (const bf16_t*)(ws + WS_UPMETA);
    bf16_t* act = (bf16_t*)(ws + WS_ACT);
    constexpr int NCH = DFF / 8, NGRP = SEQ / 8;
    const int gtid = blockIdx.x * NTHREADS + threadIdx.x, ncol = (gridDim.x * NTHREADS) / NCH;
    const int ch = gtid % NCH, q0 = gtid / NCH, c8 = ch * 8;
    if (q0 >= ncol) return;
    float w0g[8], w1g[8], w2g[8], bg[8], w0v[8], w1v[8], w2v[8], bv[8];
#pragma unroll
    for (int e = 0; e < 8; e += 4) {
        *(f32x4*)(w0g + e) = *(const f32x4*)(p.conv_w + c8 + e); *(f32x4*)(w1g + e) = *(const f32x4*)(p.conv_w + NUP + c8 + e); *(f32x4*)(w2g + e) = *(const f32x4*)(p.conv_w + 2 * NUP + c8 + e);
        *(f32x4*)(bg + e) = *(const f32x4*)(p.conv_b + c8 + e);
        *(f32x4*)(w0v + e) = *(const f32x4*)(p.conv_w + DFF + c8 + e); *(f32x4*)(w1v + e) = *(const f32x4*)(p.conv_w + NUP + DFF + c8 + e); *(f32x4*)(w2v + e) = *(const f32x4*)(p.conv_w + 2 * NUP + DFF + c8 + e);
        *(f32x4*)(bv + e) = *(const f32x4*)(p.conv_b + DFF + c8 + e);
    }
    for (int grp = q0; grp < NGRP; grp += ncol) {
        const int i0 = grp * 8;
        const bf16_t* r2p = i0 == 0 ? upm + (size_t)(b * 16 + 14) * NUP : up + (size_t)(i0 - 2) * NUP;
        const bf16_t* r1p = i0 == 0 ? upm + (size_t)(b * 16 + 15) * NUP : up + (size_t)(i0 - 1) * NUP;
        float p2g[8], p1g[8], p2v[8], p1v[8];
        unpack8(*(const u32x4*)(r2p + c8), p2g); unpack8(*(const u32x4*)(r2p + DFF + c8), p2v);
        unpack8(*(const u32x4*)(r1p + c8), p1g); unpack8(*(const u32x4*)(r1p + DFF + c8), p1v);
#pragma unroll
        for (int r = 0; r < 8; ++r) {
            float cg_[8], cv_[8];
            unpack8(*(const u32x4*)(up + (size_t)(i0 + r) * NUP + c8), cg_); unpack8(*(const u32x4*)(up + (size_t)(i0 + r) * NUP + DFF + c8), cv_);
            float o[8];
#pragma unroll
            for (int e = 0; e < 8; ++e) {
                const float ug = bg[e] + w0g[e] * p2g[e] + w1g[e] * p1g[e] + w2g[e] * cg_[e];
                const float uv = bv[e] + w0v[e] * p2v[e] + w1v[e] * p1v[e] + w2v[e] * cv_[e];
                const float t = 0.7978845608028654f * (ug + 0.044715f * ug * ug * ug);
                const float ge = ug * rcp(1.0f + ex2(-2.0f * LOG2E * t));
                o[e] = ge * uv;
                p2g[e] = p1g[e]; p1g[e] = cg_[e]; p2v[e] = p1v[e]; p1v[e] = cv_[e];
            }
            *(u32x4*)(act + (size_t)(i0 + r) * DFF + c8) = (u32x4){pk_bf16(o[0], o[1]), pk_bf16(o[2], o[3]), pk_bf16(o[4], o[5]), pk_bf16(o[6], o[7])};
        }
    }
}
__device__ __forceinline__ void phase6(const Params& p, LAS char* lds, int b) {
    unsigned char* ws = p.ws;
    const int lane = threadIdx.x & 63, w = wave_id(), wr = w >> 1, wc = w & 1;
    const bf16_t* act = (const bf16_t*)(ws + WS_ACT); bf16_t* ffn = (bf16_t*)(ws + WS_FFN);
    for (int it = 0;; ++it) {
        int tm, tn; const int st = tile_at(it, 64, 8, tm, tn); if (st == 0) break; if (st == 2) continue;
        const int col0 = tn * 128;
        f32x4 acc[4][4]; zero_acc(acc);
        gemm_main<true>(lds, act + (size_t)(tm * 128) * DFF, DFF, (const bf16_t*)(ws + WS_BTDN) + (size_t)col0 * DFF, DFF, 44, acc);
        epi_store_ss(acc, ffn, 1024, b * SEQ + tm * 128, col0, (float*)(ws + WS_SSP4), b * SEQ + tm * 128, wr, wc, lane);
    }
}
__device__ __forceinline__ void phase7(const Params& p) {
    unsigned char* ws = p.ws;
    const bf16_t* ffn = (const bf16_t*)(ws + WS_FFN); const float* ssp4 = (const float*)(ws + WS_SSP4); const float* g3 = p.gains + 3 * D;
    for (int it = blockIdx.x * NTHREADS + threadIdx.x; it < MX * 256; it += gridDim.x * NTHREADS) {
        const int row = it >> 8, col = (it & 255) * 4;
        float sq = 0.f;
#pragma unroll
        for (int sl = 0; sl < 16; ++sl) sq += ssp4[(size_t)sl * M + row];
        const float a = 1.0f / sqrtf(sq * (1.0f / D) + EPS);
        const f32x4 hh = *(const f32x4*)(p.out + (size_t)row * D + col), g = *(const f32x4*)(g3 + col);
        const u32x2 f = *(const u32x2*)(ffn + (size_t)row * D + col);
        f32x4 o;
        o[0] = hh[0] + bf_lo(f[0]) * a * g[0]; o[1] = hh[1] + bf_hi(f[0]) * a * g[1];
        o[2] = hh[2] + bf_lo(f[1]) * a * g[2]; o[3] = hh[3] + bf_hi(f[1]) * a * g[3];
        *(f32x4*)(p.out + (size_t)row * D + col) = o;
    }
}


#ifndef DUMP
#define DUMP 0
#endif
__device__ __forceinline__ void phase_dump(const Params& p) {
    unsigned char* ws = p.ws;
    const bf16_t* s0; const bf16_t* s1; int ld;
    if (DUMP == 1) { s0 = (const bf16_t*)(ws + WS_B); s1 = s0 + 512; ld = 1024; }
    else if (DUMP == 2) { s0 = (const bf16_t*)(ws + WS_QF); s1 = (const bf16_t*)(ws + WS_KF); ld = 512; }
    else if (DUMP == 3) { s0 = (const bf16_t*)(ws + WS_A); s1 = s0 + (size_t)M * 512; ld = 512; }
    else if (DUMP == 4) { s0 = (const bf16_t*)(ws + WS_GATED); s1 = s0 + 512; ld = 1024; }
    else if (DUMP == 8) { s0 = (const bf16_t*)(ws + WS_A); s1 = s0 + 512; ld = 1024; }
    else if (DUMP == 9) { s0 = (const bf16_t*)(ws + WS_ACT) + 1024; s1 = (const bf16_t*)(ws + WS_ACT) + 2304 - 512 + 512; ld = DFF; }
    else if (DUMP == 10) { s0 = (const bf16_t*)(ws + WS_FFN); s1 = s0 + 512; ld = 1024; }
    else if (DUMP == 11) { s0 = (const bf16_t*)(ws + WS_UP); s1 = s0 + 512; ld = NUP; }
    else if (DUMP == 6) { s0 = (const bf16_t*)(ws + WS_QS); s1 = (const bf16_t*)(ws + WS_KS); ld = 512; }
    else { s0 = (const bf16_t*)(ws + WS_MIXED); s1 = s0 + 512; ld = 1024; }
    for (int it = blockIdx.x * NTHREADS + threadIdx.x; it < MX * 1024; it += gridDim.x * NTHREADS) {
        const int row = it >> 10, col = it & 1023;
        if (DUMP >= 9 && row >= 8192) { p.out[it] = 0.f; continue; }
        const bf16_t v = col < 512 ? s0[(size_t)row * ld + col] : s1[(size_t)row * ld + col - 512];
        p.out[it] = __uint_as_float((unsigned)v << 16);
    }
}

__device__ __forceinline__ void l2_scrub(const Params& p) {
    const f32x4* src = (const f32x4*)p.x + (size_t)(blockIdx.x & 511) * 8192;
    f32x4 a = (f32x4){0.f, 0.f, 0.f, 0.f};
    for (int i = threadIdx.x; i < 8192; i += NTHREADS) a += src[i];
    if (a[0] + a[1] + a[2] + a[3] == 1.2345e-30f) ((float*)(p.ws + WS_CTL))[32 + (threadIdx.x & 7)] = a[0];
}

__device__ __forceinline__ void my_grid_sync(const Params& p, unsigned& target) {
    unsigned* bar = (unsigned*)(p.ws + WS_CTL) + 16;
    asm volatile("s_waitcnt vmcnt(0)" ::: "memory");
    __syncthreads();
    target += gridDim.x;
    if (threadIdx.x == 0) {
        __builtin_amdgcn_fence(__ATOMIC_RELEASE, "agent");
        asm volatile("s_waitcnt vmcnt(0)" ::: "memory");
        __hip_atomic_fetch_add(bar, 1u, __ATOMIC_RELAXED, __HIP_MEMORY_SCOPE_AGENT);
        while (__hip_atomic_load(bar, __ATOMIC_RELAXED, __HIP_MEMORY_SCOPE_AGENT) < target) __builtin_amdgcn_s_sleep(2);
        __builtin_amdgcn_fence(__ATOMIC_ACQUIRE, "agent");
        asm volatile("s_waitcnt vmcnt(0)" ::: "memory");
    }
    __syncthreads();
}
__global__ void __launch_bounds__(NTHREADS, 2) fwd_kernel(Params p) {
    extern __shared__ __attribute__((aligned(16))) unsigned char lds_raw[];
    LAS char* lds = (LAS char*)lds_raw;
    cg::grid_group grid = cg::this_grid();
#define IN(k) (p.ph_lo <= (k) && (k) < p.ph_hi)
#define SEAM(k) do { if (IN(k) && IN((k) + 1)) { if (p.ph_hi > 1000) grid.sync(); my_grid_sync(p, bar_target); } } while (0)
    unsigned bar_target = 0u;
    if (IN(0)) phase0(p, lds);
    SEAM(0);
    if (IN(1)) phase1(p, lds);
    SEAM(1);
    if (IN(2)) phase2(p, lds);
    SEAM(2);
    if (IN(3)) phase3a(p, lds);
    SEAM(3);
    if (IN(4)) phase3b(p, lds);
    SEAM(4);
    if (IN(5)) phase3c(p);
    SEAM(5);
    for (int b = 0; b < 2; ++b) {
        const int k0 = 6 + 3 * b;
        if (IN(k0)) phase4(p, lds, b);
        SEAM(k0);
        if (IN(k0 + 1)) phase5(p, b);
        SEAM(k0 + 1);
        if (IN(k0 + 2)) phase6(p, lds, b);
        SEAM(k0 + 2);
    }
    if (IN(12)) phase7(p);
    if (IN(13)) phase_dump(p);
#undef IN
#undef SEAM
}


__global__ void ab_save(const unsigned char* ws, float* out) {
    const u32x4* src = (const u32x4*)(ws + AB_SRC); u32x4* dst = (u32x4*)((unsigned char*)out + (size_t)32 * MiB);
    for (size_t i = blockIdx.x * (size_t)blockDim.x + threadIdx.x; i < (size_t)AB_BYTES / 16; i += (size_t)gridDim.x * blockDim.x) dst[i] = src[i];
}
__global__ void ab_diff(const unsigned char* ws, float* out) {
    const bf16_t* src = (const bf16_t*)(ws + AB_SRC); const bf16_t* sav = (const bf16_t*)((unsigned char*)out + (size_t)32 * MiB);
    for (size_t i = blockIdx.x * (size_t)blockDim.x + threadIdx.x; i < (size_t)8192 * 1024; i += (size_t)gridDim.x * blockDim.x) {
        if (i >= (size_t)AB_BYTES / 2) { out[i] = 0.f; continue; }
        out[i] = src[i] != sav[i] ? 1000.0f : 0.f;
    }
}
__global__ void ab_zero(float* out) {
    for (size_t i = blockIdx.x * (size_t)blockDim.x + threadIdx.x; i < (size_t)8192 * 1024; i += (size_t)gridDim.x * blockDim.x) out[(size_t)8192 * 1024 + i] = 0.f;
}
extern "C" void kernel_launch(void* const* d_in, const int* in_sizes, int n_in, void* d_out, int out_size, void* d_ws, size_t ws_size, hipStream_t stream) {
    static int grid_blocks = 0;
    if (grid_blocks == 0) {
        if (n_in != 12 || ws_size < WS_END) { fprintf(stderr, "kernel_launch: unexpected n_in %d or ws_size %zu (need %zu)\n", n_in, ws_size, (size_t)WS_END); grid_blocks = -1; return; }
        int dev = 0, cus = 0, per_cu = 0;
        (void)hipGetDevice(&dev);
        (void)hipDeviceGetAttribute(&cus, hipDeviceAttributeMultiprocessorCount, dev);
        (void)hipFuncSetAttribute((const void*)fwd_kernel, hipFuncAttributeMaxDynamicSharedMemorySize, LDS_BYTES);
        (void)hipOccupancyMaxActiveBlocksPerMultiprocessor(&per_cu, (const void*)fwd_kernel, NTHREADS, LDS_BYTES);
        if (per_cu < 1) per_cu = 1;
        if (per_cu > 2) per_cu = 2;
        grid_blocks = cus * per_cu;
        (void)hipGetLastError();
    }
    if (grid_blocks < 0) return;
    Params p{};
    p.x = (const float*)d_in[0]; p.meta = (const float*)d_in[1]; p.gains = (const float*)d_in[2]; p.w_in = (const float*)d_in[3];
    p.b_forget = (const float*)d_in[4]; p.w_o_fox = (const float*)d_in[5]; p.w_o_sb = (const float*)d_in[6]; p.w_out = (const float*)d_in[7];
    p.w_up = (const float*)d_in[8]; p.conv_w = (const float*)d_in[9]; p.conv_b = (const float*)d_in[10]; p.w_down = (const float*)d_in[11];
    p.out = (float*)d_out; p.ws = (unsigned char*)d_ws;
#if SINGLE_LAUNCH
    (void)hipMemsetAsync((unsigned char*)d_ws + WS_CTL, 0, 256, stream);
    p.ph_lo = 0; p.ph_hi = NPHASE;
    void* args[] = {&p};
    hipError_t e = hipLaunchCooperativeKernel((const void*)fwd_kernel, dim3(grid_blocks), dim3(NTHREADS), args, LDS_BYTES, stream);
    if (e != hipSuccess) fprintf(stderr, "cooperative launch failed: %s (grid %d)\n", hipGetErrorString(e), grid_blocks);
#else
#ifndef STOP_AT
#define STOP_AT NPHASE
#endif
    for (int k = 0; k < STOP_AT; ++k) {
        p.ph_lo = k; p.ph_hi = k + 1;
        hipLaunchKernelGGL(fwd_kernel, dim3(grid_blocks), dim3(NTHREADS), LDS_BYTES, stream, p);
    }
#if ABTEST
    ab_save<<<1024, 256, 0, stream>>>(p.ws, p.out);
    for (int k = AB_FROM; k < STOP_AT; ++k) {
        p.ph_lo = k; p.ph_hi = k + 1;
        hipLaunchKernelGGL(fwd_kernel, dim3(grid_blocks), dim3(NTHREADS), LDS_BYTES, stream, p);
    }
    ab_diff<<<1024, 256, 0, stream>>>(p.ws, p.out);
    ab_zero<<<1024, 256, 0, stream>>>(p.out);
#endif
    if (DUMP) { p.ph_lo = 13; p.ph_hi = 14; hipLaunchKernelGGL(fwd_kernel, dim3(grid_blocks), dim3(NTHREADS), LDS_BYTES, stream, p); }
#endif
}
```

```cpp
#include <hip/hip_runtime.h>
#include <hip/hip_cooperative_groups.h>
#include <cstdio>
#include <cstdint>
namespace cg = cooperative_groups;

#define DUMP 0
#define ABTEST 0
#define AB_FROM 0
#define AB_SRC WS_SSP2
#define AB_BYTES (2 * MiB)
#ifndef SINGLE_LAUNCH
#define SINGLE_LAUNCH 1
#endif

#define LAS __attribute__((address_space(3)))
typedef unsigned short bf16_t;
typedef short bf16x8 __attribute__((ext_vector_type(8)));
typedef float f32x4 __attribute__((ext_vector_type(4)));
typedef float f32x16 __attribute__((ext_vector_type(16)));
typedef unsigned u32x4 __attribute__((ext_vector_type(4)));
typedef unsigned u32x2 __attribute__((ext_vector_type(2)));

constexpr int D = 1024, SEQ = 8192, NMETA = 16, NB = 2;
constexpr int MX = NB * SEQ;
constexpr int MV = MX + NB * NMETA;
constexpr int M = 16512;
constexpr int LPK = 8256;
constexpr int PROJW = 5128, NPROJ = 5120, DFF = 2816, NUP = 5632;
constexpr float EPS = 1e-6f;
constexpr float LOG2E = 1.4426950408889634f, LN2 = 0.6931471805599453f;
constexpr int NTHREADS = 256;
constexpr int LDS_BYTES = 65536;
constexpr int NPHASE = 10;

constexpr size_t MiB = 1u << 20;
constexpr size_t WS_CTL = 0;
constexpr size_t WS_R1 = 4096, WS_R2 = WS_R1 + 69632, WS_SS2 = WS_R2 + 69632, WS_SS4 = WS_SS2 + 69632;
constexpr size_t WS_LOGF = WS_SS4 + 69632, WS_CK = WS_LOGF + 528384, WS_UPMETA = WS_CK + 528384;
constexpr size_t WS_BTIN = 2 * MiB, WS_BTOF = WS_BTIN + 10 * MiB, WS_BTOS = WS_BTOF + 1 * MiB, WS_BTOUT = WS_BTOS + 1 * MiB,
                 WS_BTUP = WS_BTOUT + 2 * MiB, WS_BTDN = WS_BTUP + 11 * MiB;
constexpr size_t SZ_M1024 = (size_t)M * 1024 * 2, SZ_M512 = (size_t)M * 512 * 2;
constexpr size_t WS_A = 33 * MiB;
constexpr size_t WS_B = WS_A + SZ_M1024;
constexpr size_t WS_C = WS_B + 2 * SZ_M1024;
constexpr size_t WS_QF = WS_C, WS_KF = WS_QF + SZ_M512, WS_QS = WS_KF + SZ_M512, WS_KS = WS_QS + SZ_M512, WS_VFT = WS_KS + SZ_M512, WS_VST = WS_VFT + SZ_M512;
constexpr size_t WS_GATED = WS_C, WS_MIXED = WS_B + SZ_M1024;
constexpr size_t WS_ACT = WS_B;
constexpr size_t WS_FFN = WS_ACT + 132 * MiB;
constexpr size_t WS_SSP2 = 230 * MiB, WS_SSP4 = 232 * MiB;
constexpr size_t WS_HAL = 234 * MiB;
constexpr size_t WS_END = 240 * MiB;

struct Params {
    const float *x, *meta, *gains, *w_in, *b_forget, *w_o_fox, *w_o_sb, *w_out, *w_up, *conv_w, *conv_b, *w_down;
    float* out; unsigned char* ws; int ph_lo, ph_hi;
};

typedef __bf16 bf16x2_t __attribute__((ext_vector_type(2)));
__device__ __forceinline__ unsigned pk_bf16(float lo, float hi) { bf16x2_t v = {(__bf16)lo, (__bf16)hi}; return __builtin_bit_cast(unsigned, v); }
__device__ __forceinline__ float bf_lo(unsigned u) { return __uint_as_float(u << 16); }
__device__ __forceinline__ float bf_hi(unsigned u) { return __uint_as_float(u & 0xffff0000u); }
__device__ __forceinline__ float ex2(float x) { return __builtin_amdgcn_exp2f(x); }
__device__ __forceinline__ float lg2(float x) { return __builtin_amdgcn_logf(x); }
__device__ __forceinline__ float rcp(float x) { return __builtin_amdgcn_rcpf(x); }
__device__ __forceinline__ float sigmoidf_(float v) { return rcp(1.0f + ex2(-v * LOG2E)); }
__device__ __forceinline__ float wave_sum(float v) {
#pragma unroll
    for (int o = 32; o > 0; o >>= 1) v += __shfl_xor(v, o);
    return v;
}
__device__ __forceinline__ int wave_id() { return __builtin_amdgcn_readfirstlane((int)(threadIdx.x >> 6)); }

__device__ __forceinline__ void transpose_tile(LAS char* lds, const float* src, int ldsrc, int srccol, int k0, const float* gain, bf16_t* dst, int K, int n0) {
    LAS bf16_t* T = (LAS bf16_t*)lds;
    const int tid = threadIdx.x, r = tid >> 4, c4 = tid & 15;
#pragma unroll
    for (int p = 0; p < 4; ++p) {
        const int k = r + 16 * p;
        f32x4 v = *(const f32x4*)(src + (size_t)(k0 + k) * ldsrc + srccol + c4 * 4);
        const float g = gain ? gain[k0 + k] : 1.0f;
        const unsigned a = pk_bf16(v[0] * g, v[1] * g), b = pk_bf16(v[2] * g, v[3] * g);
        T[(c4 * 4 + 0) * 72 + k] = (bf16_t)(a & 0xffff); T[(c4 * 4 + 1) * 72 + k] = (bf16_t)(a >> 16);
        T[(c4 * 4 + 2) * 72 + k] = (bf16_t)(b & 0xffff); T[(c4 * 4 + 3) * 72 + k] = (bf16_t)(b >> 16);
    }
    __syncthreads();
    const int n = tid >> 2, kq = tid & 3;
    const u32x4 lo = *(LAS u32x4*)(T + n * 72 + kq * 16), hi = *(LAS u32x4*)(T + n * 72 + kq * 16 + 8);
    bf16_t* d = dst + (size_t)(n0 + n) * K + k0 + kq * 16;
    *(u32x4*)d = lo; *(u32x4*)(d + 8) = hi;
    __syncthreads();
}

__device__ __forceinline__ void phase0(const Params& p, LAS char* lds) {
    unsigned char* ws = p.ws;
    const int tid = threadIdx.x, lane = tid & 63, w = wave_id();
    LAS float* wfT = (LAS float*)lds;
    const float* g0 = p.gains;
    for (int idx = tid; idx < 8192; idx += NTHREADS) { const int h = idx & 7, k = idx >> 3; wfT[h * 1024 + k] = p.w_in[(size_t)k * PROJW + 1536 + h] * g0[k]; }
    __syncthreads();
    bf16_t* xb = (bf16_t*)(ws + WS_A);
    float* r1 = (float*)(ws + WS_R1);
    float* logf_ = (float*)(ws + WS_LOGF);
    for (int r_ = blockIdx.x * 32 + w; r_ < M; r_ += (r_ & 31) < 28 ? 4 : gridDim.x * 32 - 28) {
        const int r = r_;
        if (r >= MV) {
#pragma unroll
            for (int i = 0; i < 4; ++i) *(u32x2*)(xb + (size_t)r * D + lane * 4 + 256 * i) = (u32x2){0u, 0u};
            if (lane == 0) r1[r] = 0.f;
            continue;
        }
        const float* src = r < MX ? p.x + (size_t)r * D : p.meta + (size_t)((r - MX) & 15) * D;
        f32x4 v[4]; float ss = 0.f;
#pragma unroll
        for (int i = 0; i < 4; ++i) { v[i] = *(const f32x4*)(src + lane * 4 + 256 * i); ss += v[i][0] * v[i][0] + v[i][1] * v[i][1] + v[i][2] * v[i][2] + v[i][3] * v[i][3]; }
#pragma unroll
        for (int i = 0; i < 4; ++i) *(u32x2*)(xb + (size_t)r * D + lane * 4 + 256 * i) = (u32x2){pk_bf16(v[i][0], v[i][1]), pk_bf16(v[i][2], v[i][3])};
        ss = wave_sum(ss);
        const float rs = 1.0f / sqrtf(ss * (1.0f / D) + EPS);
        if (lane == 0) r1[r] = rs;
        float mine = 0.f;
#pragma unroll
        for (int h = 0; h < 8; ++h) {
            float a = 0.f;
#pragma unroll
            for (int i = 0; i < 4; ++i) { const f32x4 wv = *(LAS f32x4*)(wfT + h * 1024 + lane * 4 + 256 * i); a += v[i][0] * wv[0] + v[i][1] * wv[1] + v[i][2] * wv[2] + v[i][3] * wv[3]; }
            a = wave_sum(a);
            if (lane == h) mine = a;
        }
        if (lane < 8) {
            const float f = mine * rs + p.b_forget[lane];
            const float lf = fminf(f, 0.f) - log1pf(expf(-fabsf(f)));
            int b, kidx; if (r < MX) { b = r >> 13; kidx = r & 8191; } else { const int j = r - MX; b = j >> 4; kidx = 8192 + (j & 15); }
            logf_[(size_t)(b * 8 + lane) * LPK + kidx] = lf;
        }
    }
    __syncthreads();
    LAS char* tl = lds + 32768;
    const float* g2 = p.gains + 2 * D;
    constexpr int T_IN = 16 * 80, T_OF = 8 * 16, T_OS = 8 * 16, T_OUT = 16 * 16, T_UP = 16 * 88, T_DN = 44 * 16;
    constexpr int T_ALL = T_IN + T_OF + T_OS + T_OUT + T_UP + T_DN;
    for (int t = blockIdx.x; t < T_ALL; t += gridDim.x) {
        int u = t;
        if (u < T_IN) { const int nt = u % 80, kt = u / 80; const int sc = nt * 64 + (nt * 64 >= 1536 ? 8 : 0); transpose_tile(tl, p.w_in, PROJW, sc, kt * 64, g0, (bf16_t*)(ws + WS_BTIN), 1024, nt * 64); continue; }
        u -= T_IN;
        if (u < T_OF) { const int nt = u % 16, kt = u / 16; transpose_tile(tl, p.w_o_fox, 1024, nt * 64, kt * 64, nullptr, (bf16_t*)(ws + WS_BTOF), 512, nt * 64); continue; }
        u -= T_OF;
        if (u < T_OS) { const int nt = u % 16, kt = u / 16; transpose_tile(tl, p.w_o_sb, 1024, nt * 64, kt * 64, nullptr, (bf16_t*)(ws + WS_BTOS), 512, nt * 64); continue; }
        u -= T_OS;
        if (u < T_OUT) { const int nt = u % 16, kt = u / 16; transpose_tile(tl, p.w_out, 1024, nt * 64, kt * 64, nullptr, (bf16_t*)(ws + WS_BTOUT), 1024, nt * 64); continue; }
        u -= T_OUT;
        if (u < T_UP) { const int nt = u % 88, kt = u / 88; transpose_tile(tl, p.w_up, NUP, (nt & 1) * DFF + (nt >> 1) * 64, kt * 64, g2, (bf16_t*)(ws + WS_BTUP), 1024, nt * 64); continue; }
        u -= T_UP;
        { const int nt = u % 16, kt = u / 16; transpose_tile(tl, p.w_down, 1024, nt * 64, kt * 64, nullptr, (bf16_t*)(ws + WS_BTDN), DFF, nt * 64); }
    }
}

template <bool SWAP>
__device__ __forceinline__ void gemm_main(LAS char* lds, const bf16_t* Ag, int lda, const bf16_t* Bg, int ldb, int nk, f32x4 (&acc)[4][4]) {
    const int tid = threadIdx.x, lane = tid & 63, w = wave_id(), wr = w >> 1, wc = w & 1;
    const int row_0 = w * 8 + (lane >> 3), c_0 = (lane & 7) ^ ((row_0 >> 1) & 7);
    const bf16_t* pa0 = Ag + (size_t)row_0 * lda + c_0 * 8; const bf16_t* pb0 = Bg + (size_t)row_0 * ldb + c_0 * 8;
    const size_t sa = (size_t)32 * lda, sb_ = (size_t)32 * ldb;
    const int swz = (lane >> 1) & 7;
    int aoff[2], boff[2];
#pragma unroll
    for (int kh = 0; kh < 2; ++kh) {
        aoff[kh] = (wr * 64 + (lane & 15)) * 128 + (((kh * 4 + (lane >> 4)) ^ swz) << 4);
        boff[kh] = 16384 + (wc * 64 + (lane & 15)) * 128 + (((kh * 4 + (lane >> 4)) ^ swz) << 4);
    }
#define GM_STAGE(s, kt) do { _Pragma("unroll") for (int i_ = 0; i_ < 4; ++i_) { \
        __builtin_amdgcn_global_load_lds((const unsigned*)(pa0 + i_ * sa + (kt) * 64), (LAS unsigned*)(lds + (s) * 32768 + (i_ * 4 + w) * 1024), 16, 0, 0); \
        __builtin_amdgcn_global_load_lds((const unsigned*)(pb0 + i_ * sb_ + (kt) * 64), (LAS unsigned*)(lds + (s) * 32768 + 16384 + (i_ * 4 + w) * 1024), 16, 0, 0); } } while (0)
    GM_STAGE(0, 0);
    for (int kt = 0; kt < nk; ++kt) {
        asm volatile("s_waitcnt vmcnt(0)" ::: "memory");
        __syncthreads();
        const int s = kt & 1;
        if (kt + 1 < nk) GM_STAGE(s ^ 1, kt + 1);
        bf16x8 af[4][2], bf[4][2];
#pragma unroll
        for (int kh = 0; kh < 2; ++kh) {
#pragma unroll
            for (int m = 0; m < 4; ++m) af[m][kh] = *(LAS bf16x8*)(lds + s * 32768 + aoff[kh] + m * 2048);
#pragma unroll
            for (int n = 0; n < 4; ++n) bf[n][kh] = *(LAS bf16x8*)(lds + s * 32768 + boff[kh] + n * 2048);
        }
        __builtin_amdgcn_s_setprio(1);
#pragma unroll
        for (int kh = 0; kh < 2; ++kh)
#pragma unroll
            for (int m = 0; m < 4; ++m)
#pragma unroll
                for (int n = 0; n < 4; ++n)
                    acc[m][n] = SWAP ? __builtin_amdgcn_mfma_f32_16x16x32_bf16(bf[n][kh], af[m][kh], acc[m][n], 0, 0, 0)
                                     : __builtin_amdgcn_mfma_f32_16x16x32_bf16(af[m][kh], bf[n][kh], acc[m][n], 0, 0, 0);
        __builtin_amdgcn_s_setprio(0);
    }
    __syncthreads();
#undef GM_STAGE
}
__device__ __forceinline__ void zero_acc(f32x4 (&acc)[4][4]) {
#pragma unroll
    for (int m = 0; m < 4; ++m)
#pragma unroll
        for (int n = 0; n < 4; ++n) acc[m][n] = (f32x4){0.f, 0.f, 0.f, 0.f};
}


__device__ __forceinline__ int tile_at(int it, int ntm, int ntn, int& tm, int& tn) {
    const int G = gridDim.x;
    if (G % 256 != 0) { const int t = it * G + blockIdx.x; if (t >= ntm * ntn) return 0; tm = t / ntn; tn = t % ntn; return 1; }
    const int xcd = blockIdx.x & 7, j = blockIdx.x >> 3, ppx = G >> 8;
    const int pcols = (ntn + 3) >> 2, prows = (ntm + 7) >> 3;
    const int patch = (it * ppx + (j >> 5)) * 8 + xcd;
    if (patch >= prows * pcols) return 0;
    const int wi = j & 31;
    tm = (patch / pcols) * 8 + (wi >> 2); tn = (patch % pcols) * 4 + (wi & 3);
    return (tm < ntm && tn < ntn) ? 1 : 2;
}
__device__ __forceinline__ void cumsum_block(const Params& p, LAS char* lds, int bh) {
    const float* lf = (const float*)(p.ws + WS_LOGF) + (size_t)bh * LPK; float* ck = (float*)(p.ws + WS_CK) + (size_t)bh * LPK;
    LAS float* sums = (LAS float*)lds;
    const int tid = threadIdx.x; constexpr int PER = 33, L = SEQ + NMETA;
    float loc = 0.f;
    for (int e = 0; e < PER; ++e) { const int t = tid * PER + e; if (t < L) loc += lf[t < 16 ? 8192 + t : t - 16]; }
    sums[tid] = loc;
    __syncthreads();
    float run = 0.f;
    for (int i = 0; i < tid; ++i) run += sums[i];
    for (int e = 0; e < PER; ++e) { const int t = tid * PER + e; if (t < L) { const int kx = t < 16 ? 8192 + t : t - 16; run += lf[kx]; ck[kx] = run * LOG2E; } }
    __syncthreads();
}

__device__ __forceinline__ void phase1(const Params& p, LAS char* lds) {
    unsigned char* ws = p.ws;
    if (blockIdx.x < 16) cumsum_block(p, lds, blockIdx.x);
    const int lane = threadIdx.x & 63, w = wave_id(), wr = w >> 1, wc = w & 1;
    const bf16_t* xb = (const bf16_t*)(ws + WS_A); const bf16_t* Bt = (const bf16_t*)(ws + WS_BTIN);
    const float* r1 = (const float*)(ws + WS_R1);
    constexpr int NTN = 40, NTM = 129;
    for (int it = 0;; ++it) {
        int tm, tn; const int st = tile_at(it, NTM, NTN, tm, tn); if (st == 0) break; if (st == 2) continue;
        const int row0 = tm * 128, col0 = tn * 128;
        const bool vtile = (tn >= 8 && tn < 12) || (tn >= 20 && tn < 24);
        f32x4 acc[4][4]; zero_acc(acc);
        if (vtile) {
            gemm_main<false>(lds, xb + (size_t)row0 * D, D, Bt + (size_t)col0 * D, D, 16, acc);
            bf16_t* vT = (bf16_t*)(ws + (tn < 12 ? WS_VFT : WS_VST)); const int cb = tn < 12 ? 1024 : 2560;
            const int g = lane >> 4, gp = ((g & 1) << 1) | (g >> 1);
#pragma unroll
            for (int m = 0; m < 4; ++m) {
                const int rb = row0 + wr * 64 + m * 16; int b, kb16;
                if (rb < MX) { b = rb >> 13; kb16 = rb & 8191; } else { const int j = rb - MX; if (j >= 32) continue; b = j >> 4; kb16 = 8192; }
                const f32x4 rs = *(const f32x4*)(r1 + rb + g * 4);
#pragma unroll
                for (int n = 0; n < 4; ++n) {
                    const int dc = col0 + wc * 64 + n * 16 + (lane & 15) - cb, h = dc >> 6, d = dc & 63;
                    const f32x4 v = acc[m][n] * rs;
                    *(u32x2*)(vT + ((size_t)(b * 8 + h) * 64 + d) * LPK + kb16 + gp * 4) = (u32x2){pk_bf16(v[0], v[1]), pk_bf16(v[2], v[3])};
                }
            }
        } else {
            gemm_main<true>(lds, xb + (size_t)row0 * D, D, Bt + (size_t)col0 * D, D, 16, acc);
            bf16_t* dst; int ld, cb; float sc = 1.f; bool sg = false;
            if (tn < 4) { dst = (bf16_t*)(ws + WS_QF); ld = 512; cb = 0; sc = 0.125f * LOG2E; }
            else if (tn < 8) { dst = (bf16_t*)(ws + WS_KF); ld = 512; cb = 512; }
            else if (tn < 16) { dst = (bf16_t*)(ws + WS_QS); ld = 512; cb = 1536; sc = 0.125f; }
            else if (tn < 20) { dst = (bf16_t*)(ws + WS_KS); ld = 512; cb = 2048; }
            else if (tn < 32) { dst = (bf16_t*)(ws + WS_B); ld = 1024; cb = 3072; sg = true; }
            else { dst = (bf16_t*)(ws + WS_B + SZ_M1024); ld = 1024; cb = 4096; sg = true; }
            const bool kfox = tn >= 4 && tn < 8;
            float wmax = 0.f;
#pragma unroll
            for (int m = 0; m < 4; ++m) {
                const int row = row0 + wr * 64 + m * 16 + (lane & 15); const float rs = r1[row] * sc;
                float s2 = 0.f;
#pragma unroll
                for (int n = 0; n < 4; ++n) {
                    const int col = col0 + wc * 64 + n * 16 + (lane >> 4) * 4 - cb;
                    f32x4 v = acc[m][n] * rs;
                    if (sg) { v[0] = sigmoidf_(v[0]); v[1] = sigmoidf_(v[1]); v[2] = sigmoidf_(v[2]); v[3] = sigmoidf_(v[3]); }
                    s2 += v[0] * v[0] + v[1] * v[1] + v[2] * v[2] + v[3] * v[3];
                    *(u32x2*)(dst + (size_t)row * ld + col) = (u32x2){pk_bf16(v[0], v[1]), pk_bf16(v[2], v[3])};
                }
                if (kfox) { s2 += __shfl_xor(s2, 16); s2 += __shfl_xor(s2, 32); wmax = fmaxf(wmax, s2); }
            }
            if (kfox) {
#pragma unroll
                for (int o = 1; o < 16; o <<= 1) wmax = fmaxf(wmax, __shfl_xor(wmax, o));
                if (lane == 0) {
                    unsigned* km = (unsigned*)(ws + WS_CTL) + 32; const int head = (tn - 4) * 2 + wc; const unsigned bits = __float_as_uint(wmax);
                    if (row0 < MX) atomicMax(km + (row0 >> 13) * 8 + head, bits);
                    else { atomicMax(km + head, bits); atomicMax(km + 8 + head, bits); }
                }
            }
        }
    }
}

constexpr int AT_STAGE = 16640;
template <int TYPE>
__device__ __forceinline__ void attn_unit(LAS char* lds, const Params& p, int b, int h, int qb) {
    unsigned char* ws = p.ws;
    const int tid = threadIdx.x, lane = tid & 63, w = wave_id(), ql = lane & 31, hi = lane >> 5;
    const bf16_t* Q = (const bf16_t*)(ws + (TYPE == 0 ? WS_QF : WS_QS));
    const bf16_t* Kp = (const bf16_t*)(ws + (TYPE == 0 ? WS_KF : WS_KS));
    const bf16_t* VT = (const bf16_t*)(ws + (TYPE == 0 ? WS_VFT : WS_VST)) + (size_t)(b * 8 + h) * 64 * LPK;
    const float* cK = (const float*)(ws + WS_CK) + (size_t)(b * 8 + h) * LPK;
    bf16_t* Oo = (bf16_t*)(ws + WS_A + (TYPE == 0 ? 0 : SZ_M512));
    const bool meta_unit = qb < 0;
    const int qrow0 = meta_unit ? MX + 16 * b : b * SEQ + qb * 128;
    const int nt = meta_unit ? 1 : 2 * qb + 3;
    int qrow = qrow0 + 32 * w + ql; if (qrow > M - 1) qrow = M - 1;
    bf16x8 qf[4];
#pragma unroll
    for (int ds = 0; ds < 4; ++ds) qf[ds] = *(const bf16x8*)(Q + (size_t)qrow * 512 + h * 64 + ds * 16 + hi * 8);
    f32x16 O0, O1;
#pragma unroll
    for (int i = 0; i < 16; ++i) { O0[i] = 0.f; O1[i] = 0.f; }
    float m_run = -INFINITY, lsum = 0.f, R = 0.f;
    float qbound = 0.f;
    if (TYPE == 0) {
        float q2 = 0.f;
#pragma unroll
        for (int ds = 0; ds < 4; ++ds)
#pragma unroll
            for (int e = 0; e < 8; ++e) { const float x = __uint_as_float((unsigned)(unsigned short)qf[ds][e] << 16); q2 += x * x; }
        q2 += __shfl_xor(q2, 32);
        const unsigned kb = __hip_atomic_load((unsigned*)(ws + WS_CTL) + 32 + b * 8 + h, __ATOMIC_RELAXED, __HIP_MEMORY_SCOPE_AGENT);
        qbound = sqrtf(q2) * sqrtf(__uint_as_float(kb)) * 1.02f + 1.0f;
    }
    u32x4 kreg[2], vreg[2]; float creg = 0.f;
    const int srow = tid >> 3, spos = tid & 7;
    const int swz_st = (spos ^ ((srow >> 1) & 7)) << 4;
    const int swz = (lane >> 1) & 7;
    LAS unsigned* flags = (LAS unsigned*)(lds + 2 * AT_STAGE);
#define AT_LOAD(j) do { int krow0_, kidx0_; if (!meta_unit && (j) < nt - 1) { const int kt_ = nt - 2 - (j); krow0_ = b * SEQ + 64 * kt_; kidx0_ = 64 * kt_; } else { krow0_ = MX + 16 * b; kidx0_ = 8192; } \
        _Pragma("unroll") for (int i_ = 0; i_ < 2; ++i_) { \
            kreg[i_] = *(const u32x4*)(Kp + (size_t)(krow0_ + srow + 32 * i_) * 512 + h * 64 + spos * 8); \
            vreg[i_] = *(const u32x4*)(VT + (size_t)(srow + 32 * i_) * LPK + kidx0_ + spos * 8); } \
        if (TYPE == 0 && tid < 64) creg = cK[kidx0_ + tid]; } while (0)
#define AT_WRITE(s) do { _Pragma("unroll") for (int i_ = 0; i_ < 2; ++i_) { \
            *(LAS u32x4*)(lds + (s) * AT_STAGE + (srow + 32 * i_) * 128 + swz_st) = kreg[i_]; \
            *(LAS u32x4*)(lds + (s) * AT_STAGE + 8192 + (srow + 32 * i_) * 128 + swz_st) = vreg[i_]; } \
        if (TYPE == 0 && tid < 64) *(LAS float*)(lds + (s) * AT_STAGE + 16384 + tid * 4) = creg; } while (0)
    AT_LOAD(0); AT_WRITE(0);
    __syncthreads();
    for (int j = 0; j < nt; ++j) {
        const bool more = j + 1 < nt;
        if (more) AT_LOAD(j + 1);
        int klim, d0;
        if (meta_unit) { klim = 16; d0 = 0; }
        else if (j == nt - 1) { klim = 16; d0 = 1 << 20; }
        else { klim = 64; d0 = 128 * qb - 64 * (nt - 2 - j); if (d0 >= 64) d0 = 1 << 20; }
        const int limw = 32 * w + d0 - TYPE;
        bool wdone = false;
        if (TYPE == 0) {
            const float clast = *(const LAS float*)(lds + (j & 1) * AT_STAGE + 16384 + (klim - 1) * 4);
            wdone = __all((qbound - clast - m_run) < -126.0f) != 0;
        }
        if (limw + 31 >= 0 && !(TYPE == 0 && wdone)) {
            const LAS char* sb = lds + (j & 1) * AT_STAGE;
            int kmax = limw + ql; if (kmax > klim - 1) kmax = klim - 1;
            const bool needmask = (klim < 64) || (limw < 63);
            f32x16 S0, S1;
#pragma unroll
            for (int i = 0; i < 16; ++i) { S0[i] = 0.f; S1[i] = 0.f; }
#pragma unroll
            for (int ds = 0; ds < 4; ++ds) {
                const bf16x8 k0 = *(const LAS bf16x8*)(sb + ql * 128 + (((2 * ds + hi) ^ swz) << 4));
                const bf16x8 k1 = *(const LAS bf16x8*)(sb + (32 + ql) * 128 + (((2 * ds + hi) ^ swz) << 4));
                S0 = __builtin_amdgcn_mfma_f32_32x32x16_bf16(k0, qf[ds], S0, 0, 0, 0);
                S1 = __builtin_amdgcn_mfma_f32_32x32x16_bf16(k1, qf[ds], S1, 0, 0, 0);
            }
            if (TYPE == 0) {
#pragma unroll
                for (int g = 0; g < 4; ++g) {
                    const f32x4 c0 = *(const LAS f32x4*)(sb + 16384 + (8 * g + 4 * hi) * 4), c1 = *(const LAS f32x4*)(sb + 16384 + (32 + 8 * g + 4 * hi) * 4);
#pragma unroll
                    for (int i = 0; i < 4; ++i) { S0[4 * g + i] -= c0[i]; S1[4 * g + i] -= c1[i]; }
                }
                if (needmask) {
#pragma unroll
                    for (int r = 0; r < 16; ++r) { const int kl = (r & 3) + 8 * (r >> 2) + 4 * hi; if (kl > kmax) S0[r] = -INFINITY; if (kl + 32 > kmax) S1[r] = -INFINITY; }
                }
                float mx = -INFINITY;
#pragma unroll
                for (int r = 0; r < 16; ++r) mx = fmaxf(mx, fmaxf(S0[r], S1[r]));
                mx = fmaxf(mx, __shfl_xor(mx, 32));
                const float m_new = fmaxf(m_run, mx), alpha = ex2(m_run - m_new);
                m_run = m_new;
                float ps = 0.f;
#pragma unroll
                for (int r = 0; r < 16; ++r) { S0[r] = ex2(S0[r] - m_new); S1[r] = ex2(S1[r] - m_new); ps += S0[r] + S1[r]; }
                lsum = lsum * alpha + ps;
#pragma unroll
                for (int r = 0; r < 16; ++r) { O0[r] *= alpha; O1[r] *= alpha; }
            } else {
                float G0[4], G1[4];
                f32x16 L0, L1;
#pragma unroll
                for (int r = 0; r < 16; ++r) {
                    const int kl = (r & 3) + 8 * (r >> 2) + 4 * hi;
                    const float z0 = S0[r], z1 = S1[r];
                    const float sp0 = fmaxf(z0, 0.f) + lg2(1.0f + ex2(-fabsf(z0) * LOG2E)) * LN2;
                    const float sp1 = fmaxf(z1, 0.f) + lg2(1.0f + ex2(-fabsf(z1) * LOG2E)) * LN2;
                    L0[r] = (!needmask || kl <= kmax) ? -sp0 : 0.f;
                    L1[r] = (!needmask || kl + 32 <= kmax) ? -sp1 : 0.f;
                }
#pragma unroll
                for (int g = 0; g < 4; ++g) {
                    L0[4 * g + 2] += L0[4 * g + 3]; L0[4 * g + 1] += L0[4 * g + 2]; L0[4 * g] += L0[4 * g + 1]; G0[g] = L0[4 * g];
                    L1[4 * g + 2] += L1[4 * g + 3]; L1[4 * g + 1] += L1[4 * g + 2]; L1[4 * g] += L1[4 * g + 1]; G1[g] = L1[4 * g];
                }
                float run = R;
#pragma unroll
                for (int g = 3; g >= 0; --g) {
                    const float gp = __shfl_xor(G1[g], 32);
                    const float off = hi ? run : run + gp;
#pragma unroll
                    for (int i = 0; i < 4; ++i) { const int r = 4 * g + i; const int kl = 32 + i + 8 * g + 4 * hi;
                        const float a = ex2((S1[r] + L1[r] + off) * LOG2E); S1[r] = (!needmask || kl <= kmax) ? a : 0.f; }
                    run += G1[g] + gp;
                }
#pragma unroll
                for (int g = 3; g >= 0; --g) {
                    const float gp = __shfl_xor(G0[g], 32);
                    const float off = hi ? run : run + gp;
#pragma unroll
                    for (int i = 0; i < 4; ++i) { const int r = 4 * g + i; const int kl = i + 8 * g + 4 * hi;
                        const float a = ex2((S0[r] + L0[r] + off) * LOG2E); S0[r] = (!needmask || kl <= kmax) ? a : 0.f; }
                    run += G0[g] + gp;
                }
                R = run;
                wdone = __all(R < -120.0f) != 0;
            }
#pragma unroll
            for (int ks = 0; ks < 4; ++ks) {
                bf16x8 pf; u32x4 pu;
                if (ks < 2) { pu = (u32x4){pk_bf16(S0[8 * ks + 0], S0[8 * ks + 1]), pk_bf16(S0[8 * ks + 2], S0[8 * ks + 3]), pk_bf16(S0[8 * ks + 4], S0[8 * ks + 5]), pk_bf16(S0[8 * ks + 6], S0[8 * ks + 7])}; }
                else { const int k2 = ks - 2; pu = (u32x4){pk_bf16(S1[8 * k2 + 0], S1[8 * k2 + 1]), pk_bf16(S1[8 * k2 + 2], S1[8 * k2 + 3]), pk_bf16(S1[8 * k2 + 4], S1[8 * k2 + 5]), pk_bf16(S1[8 * k2 + 6], S1[8 * k2 + 7])}; }
                pf = __builtin_bit_cast(bf16x8, pu);
                const bf16x8 v0 = *(const LAS bf16x8*)(sb + 8192 + ql * 128 + (((2 * ks + hi) ^ swz) << 4));
                const bf16x8 v1 = *(const LAS bf16x8*)(sb + 8192 + (32 + ql) * 128 + (((2 * ks + hi) ^ swz) << 4));
                O0 = __builtin_amdgcn_mfma_f32_32x32x16_bf16(v0, pf, O0, 0, 0, 0);
                O1 = __builtin_amdgcn_mfma_f32_32x32x16_bf16(v1, pf, O1, 0, 0, 0);
            }
        }
        if (more) AT_WRITE((j + 1) & 1);
        if (lane == 0) flags[(j & 1) * 4 + w] = wdone ? 1u : 0u;
        __syncthreads();
        { const LAS unsigned* fl = flags + (j & 1) * 4; const unsigned f = fl[0] & fl[1] & fl[2] & fl[3]; if (f) break; }
    }
    float inv = 1.0f;
    if (TYPE == 0) { const float l = lsum + __shfl_xor(lsum, 32); inv = 1.0f / l; }
    const bool qvalid = meta_unit ? (w == 0 && ql < 16) : true;
    if (qvalid) {
        bf16_t* op = Oo + (size_t)qrow * 512 + h * 64 + 4 * hi;
#pragma unroll
        for (int g = 0; g < 4; ++g) {
            *(u32x2*)(op + 8 * g) = (u32x2){pk_bf16(O0[4 * g] * inv, O0[4 * g + 1] * inv), pk_bf16(O0[4 * g + 2] * inv, O0[4 * g + 3] * inv)};
            *(u32x2*)(op + 32 + 8 * g) = (u32x2){pk_bf16(O1[4 * g] * inv, O1[4 * g + 1] * inv), pk_bf16(O1[4 * g + 2] * inv, O1[4 * g + 3] * inv)};
        }
    }
    __syncthreads();
#undef AT_LOAD
#undef AT_WRITE
}

__device__ __forceinline__ void phase2(const Params& p, LAS char* lds) {
    unsigned* ctr = (unsigned*)(p.ws + WS_CTL);
    LAS unsigned* shu = (LAS unsigned*)(lds + 2 * AT_STAGE + 64);
    constexpr int NU = 2048 + 32;
    const int G = gridDim.x;
    for (int it = blockIdx.x; it < NU; it += G) {
        int u = it;
        if (it < 1024 && (1024 % (2 * G)) == 0) { const int rnd = it / G, pos = it - rnd * G; u = (rnd & 1) ? ((rnd + 1) * G - 1 - pos) : it; }
        if (u < 1024) attn_unit<0>(lds, p, (u & 15) >> 3, u & 7, 63 - (u >> 4));
        else if (u < 2048) { const int v = u - 1024; attn_unit<1>(lds, p, (v & 15) >> 3, v & 7, 63 - (v >> 4)); }
        else if (u < 2064) { const int v = u - 2048; attn_unit<0>(lds, p, v >> 3, v & 7, -1); }
        else { const int v = u - 2064; attn_unit<1>(lds, p, v >> 3, v & 7, -1); }
    }
}

__device__ __forceinline__ void phase3a(const Params& p, LAS char* lds) {
    unsigned char* ws = p.ws;
    const int lane = threadIdx.x & 63, w = wave_id(), wr = w >> 1, wc = w & 1;
    const bf16_t* oa = (const bf16_t*)(ws + WS_A); const bf16_t* ob = oa + (size_t)M * 512;
    const bf16_t* ga = (const bf16_t*)(ws + WS_B); const bf16_t* gb = ga + (size_t)M * 1024;
    bf16_t* gated = (bf16_t*)(ws + WS_GATED);
    for (int it = 0;; ++it) {
        int tm, tn; const int st = tile_at(it, 129, 8, tm, tn); if (st == 0) break; if (st == 2) continue;
        const int row0 = tm * 128, col0 = tn * 128;
        f32x4 acc[4][4]; zero_acc(acc);
        gemm_main<true>(lds, oa + (size_t)row0 * 512, 512, (const bf16_t*)(ws + WS_BTOF) + (size_t)col0 * 512, 512, 8, acc);
#pragma unroll
        for (int m = 0; m < 4; ++m) {
            const int row = row0 + wr * 64 + m * 16 + (lane & 15);
#pragma unroll
            for (int n = 0; n < 4; ++n) {
                const int col = col0 + wc * 64 + n * 16 + (lane >> 4) * 4;
                const u32x2 a = *(const u32x2*)(ga + (size_t)row * 1024 + col);
                const f32x4 x = acc[m][n];
                *(u32x2*)(gated + (size_t)row * 1024 + col) = (u32x2){pk_bf16(bf_lo(a[0]) * x[0], bf_hi(a[0]) * x[1]), pk_bf16(bf_lo(a[1]) * x[2], bf_hi(a[1]) * x[3])};
            }
        }
        zero_acc(acc);
        gemm_main<true>(lds, ob + (size_t)row0 * 512, 512, (const bf16_t*)(ws + WS_BTOS) + (size_t)col0 * 512, 512, 8, acc);
#pragma unroll
        for (int m = 0; m < 4; ++m) {
            const int row = row0 + wr * 64 + m * 16 + (lane & 15);
#pragma unroll
            for (int n = 0; n < 4; ++n) {
                const int col = col0 + wc * 64 + n * 16 + (lane >> 4) * 4;
                const u32x2 b = *(const u32x2*)(gb + (size_t)row * 1024 + col);
                const f32x4 y = acc[m][n]; const u32x2 q = *(const u32x2*)(gated + (size_t)row * 1024 + col);
                const float o0 = bf_lo(q[0]) + bf_lo(b[0]) * y[0], o1 = bf_hi(q[0]) + bf_hi(b[0]) * y[1];
                const float o2 = bf_lo(q[1]) + bf_lo(b[1]) * y[2], o3 = bf_hi(q[1]) + bf_hi(b[1]) * y[3];
                *(u32x2*)(gated + (size_t)row * 1024 + col) = (u32x2){pk_bf16(o0, o1), pk_bf16(o2, o3)};
            }
        }
    }
}
__device__ __forceinline__ void epi_store_ss(const f32x4 (&acc)[4][4], bf16_t* out, int ldo, int orow0, int col0, float* ssp, int ssrow0, int wr, int wc, int lane) {
#pragma unroll
    for (int m = 0; m < 4; ++m) {
        const int rl = wr * 64 + m * 16 + (lane & 15);
        float s = 0.f;
#pragma unroll
        for (int n = 0; n < 4; ++n) {
            const int col = col0 + wc * 64 + n * 16 + (lane >> 4) * 4;
            const f32x4 v = acc[m][n];
            s += v[0] * v[0] + v[1] * v[1] + v[2] * v[2] + v[3] * v[3];
            *(u32x2*)(out + (size_t)(orow0 + rl) * ldo + col) = (u32x2){pk_bf16(v[0], v[1]), pk_bf16(v[2], v[3])};
        }
#if 1
        s += __shfl_xor(s, 16); s += __shfl_xor(s, 32);
        if (lane < 16) ssp[(size_t)((col0 >> 7) * 2 + wc) * M + ssrow0 + rl] = s;
#endif
    }
}
__device__ __forceinline__ void phase3b(const Params& p, LAS char* lds) {
    unsigned char* ws = p.ws;
    const int lane = threadIdx.x & 63, w = wave_id(), wr = w >> 1, wc = w & 1;
    const bf16_t* gated = (const bf16_t*)(ws + WS_GATED); bf16_t* mixed = (bf16_t*)(ws + WS_MIXED);
    for (int it = 0;; ++it) {
        int tm, tn; const int st = tile_at(it, 129, 8, tm, tn); if (st == 0) break; if (st == 2) continue;
        const int row0 = tm * 128, col0 = tn * 128;
        f32x4 acc[4][4]; zero_acc(acc);
        gemm_main<true>(lds, gated + (size_t)row0 * 1024, 1024, (const bf16_t*)(ws + WS_BTOUT) + (size_t)col0 * 1024, 1024, 16, acc);
        epi_store_ss(acc, mixed, 1024, row0, col0, (float*)(ws + WS_SSP2), row0, wr, wc, lane);
    }
}
__device__ __forceinline__ void phase3c(const Params& p) {
    unsigned char* ws = p.ws;
    const int lane = threadIdx.x & 63, w = wave_id();
    const bf16_t* mixed = (const bf16_t*)(ws + WS_MIXED); bf16_t* hb = (bf16_t*)(ws + WS_A);
    const float* ssp2 = (const float*)(ws + WS_SSP2); float* r2 = (float*)(ws + WS_R2);
    const float* g1 = p.gains + D;
    for (int r_ = blockIdx.x * 32 + w; r_ < M; r_ += (r_ & 31) < 28 ? 4 : gridDim.x * 32 - 28) {
        const int r = r_;
        if (r >= MV) continue;
        const float* src = r < MX ? p.x + (size_t)r * D : p.meta + (size_t)((r - MX) & 15) * D;
        float sq = lane < 16 ? ssp2[(size_t)lane * M + r] : 0.f;
        sq = wave_sum(sq);
        const float a = 1.0f / sqrtf(sq * (1.0f / D) + EPS);
        float ss = 0.f;
#pragma unroll
        for (int i = 0; i < 4; ++i) {
            const int col = lane * 4 + 256 * i;
            const f32x4 v = *(const f32x4*)(src + col), g = *(const f32x4*)(g1 + col);
            const u32x2 mx = *(const u32x2*)(mixed + (size_t)r * D + col);
            f32x4 hh;
            hh[0] = v[0] + bf_lo(mx[0]) * a * g[0]; hh[1] = v[1] + bf_hi(mx[0]) * a * g[1];
            hh[2] = v[2] + bf_lo(mx[1]) * a * g[2]; hh[3] = v[3] + bf_hi(mx[1]) * a * g[3];
            ss += hh[0] * hh[0] + hh[1] * hh[1] + hh[2] * hh[2] + hh[3] * hh[3];
            *(u32x2*)(hb + (size_t)r * D + col) = (u32x2){pk_bf16(hh[0], hh[1]), pk_bf16(hh[2], hh[3])};
            if (r < MX) *(f32x4*)(p.out + (size_t)r * D + col) = hh;
        }
        ss = wave_sum(ss);
        if (lane == 0) r2[r] = 1.0f / sqrtf(ss * (1.0f / D) + EPS);
    }
}
constexpr int UST = 272;
__device__ __forceinline__ f32x4 unpack4(const u32x2 u) { return (f32x4){bf_lo(u[0]), bf_hi(u[0]), bf_lo(u[1]), bf_hi(u[1])}; }
struct ConvW { f32x4 w0g, w1g, w2g, bg, w0v, w1v, w2v, bv; };
__device__ __forceinline__ ConvW load_convw(const Params& p, int c) {
    ConvW q;
    q.w0g = *(const f32x4*)(p.conv_w + c); q.w1g = *(const f32x4*)(p.conv_w + NUP + c); q.w2g = *(const f32x4*)(p.conv_w + 2 * NUP + c); q.bg = *(const f32x4*)(p.conv_b + c);
    q.w0v = *(const f32x4*)(p.conv_w + DFF + c); q.w1v = *(const f32x4*)(p.conv_w + NUP + DFF + c); q.w2v = *(const f32x4*)(p.conv_w + 2 * NUP + DFF + c); q.bv = *(const f32x4*)(p.conv_b + DFF + c);
    return q;
}
__device__ __forceinline__ u32x2 conv_gelu4(const ConvW& q, const f32x4 g2, const f32x4 g1, const f32x4 g0, const f32x4 v2, const f32x4 v1, const f32x4 v0) {
    float o[4];
#pragma unroll
    for (int e = 0; e < 4; ++e) {
        const float ug = q.bg[e] + q.w0g[e] * g2[e] + q.w1g[e] * g1[e] + q.w2g[e] * g0[e];
        const float uv = q.bv[e] + q.w0v[e] * v2[e] + q.w1v[e] * v1[e] + q.w2v[e] * v0[e];
        const float t = 0.7978845608028654f * (ug + 0.044715f * ug * ug * ug);
        o[e] = ug * rcp(1.0f + ex2(-2.0f * LOG2E * t)) * uv;
    }
    return (u32x2){pk_bf16(o[0], o[1]), pk_bf16(o[2], o[3])};
}
__device__ __forceinline__ void phase4(const Params& p, LAS char* lds) {
    unsigned char* ws = p.ws;
    const int tid = threadIdx.x, lane = tid & 63, w = wave_id(), wr = w >> 1, wc = w & 1;
    const bf16_t* hb = (const bf16_t*)(ws + WS_A); const bf16_t* Bt = (const bf16_t*)(ws + WS_BTUP);
    const float* r2 = (const float*)(ws + WS_R2);
    bf16_t* act = (bf16_t*)(ws + WS_ACT); bf16_t* hal = (bf16_t*)(ws + WS_HAL);
    for (int it = 0;; ++it) {
        int tm, tn; int st = tile_at(it, 128, 44, tm, tn);
        if (st == 0) { if (it < (1 << 20) && (int)blockIdx.x < 44) { tm = 128; tn = blockIdx.x; it = 1 << 20; st = 1; } else break; }
        if (st == 2) continue;
        const bool mt = tm == 128; const int row0 = mt ? MX : tm * 128, col0 = tn * 128;
        f32x4 acc[4][4]; zero_acc(acc);
        gemm_main<true>(lds, hb + (size_t)row0 * D, D, Bt + (size_t)col0 * D, D, 16, acc);
#pragma unroll
        for (int m = 0; m < 4; ++m) {
            const int rl = wr * 64 + m * 16 + (lane & 15); const float rs = r2[row0 + rl];
#pragma unroll
            for (int n = 0; n < 4; ++n) {
                const int cl = wc * 64 + n * 16 + (lane >> 4) * 4; const f32x4 v = acc[m][n] * rs;
                *(LAS u32x2*)(lds + rl * UST + cl * 2) = (u32x2){pk_bf16(v[0], v[1]), pk_bf16(v[2], v[3])};
            }
        }
        __syncthreads();
        if (!mt) {
            const int cg = tid & 15, rb = tid >> 4, c = tn * 64 + cg * 4;
            const ConvW q = load_convw(p, c);
            const int hr = rb == 0 ? 0 : rb * 8 - 2;
            f32x4 g2 = unpack4(*(const LAS u32x2*)(lds + hr * UST + cg * 8)), v2 = unpack4(*(const LAS u32x2*)(lds + hr * UST + 128 + cg * 8));
            f32x4 g1 = unpack4(*(const LAS u32x2*)(lds + (hr + 1) * UST + cg * 8)), v1 = unpack4(*(const LAS u32x2*)(lds + (hr + 1) * UST + 128 + cg * 8));
            for (int r = hr + 2; r < rb * 8 + 8; ++r) {
                const f32x4 g0 = unpack4(*(const LAS u32x2*)(lds + r * UST + cg * 8)), v0 = unpack4(*(const LAS u32x2*)(lds + r * UST + 128 + cg * 8));
                *(u32x2*)(act + (size_t)(row0 + r) * DFF + c) = conv_gelu4(q, g2, g1, g0, v2, v1, v0);
                g2 = g1; g1 = g0; v2 = v1; v1 = v0;
            }
            if (tid < 64) { const int qq = tid >> 4, ch = tid & 15, rl = qq < 2 ? qq : 124 + qq;
                *(u32x4*)(hal + ((size_t)tm * 4 + qq) * NUP + col0 + ch * 8) = *(const LAS u32x4*)(lds + rl * UST + ch * 16); }
        } else {
            if (tid < 64) { const int qq = tid >> 4, ch = tid & 15, rl = (qq >> 1) * 16 + 14 + (qq & 1);
                *(u32x4*)(hal + ((size_t)(128 + (qq >> 1)) * 4 + 2 + (qq & 1)) * NUP + col0 + ch * 8) = *(const LAS u32x4*)(lds + rl * UST + ch * 16); }
        }
        __syncthreads();
    }
}
__device__ __forceinline__ void phase_fix(const Params& p) {
    unsigned char* ws = p.ws;
    const bf16_t* hal = (const bf16_t*)(ws + WS_HAL); bf16_t* act = (bf16_t*)(ws + WS_ACT);
    constexpr int NCG = DFF / 4;
    for (int it = blockIdx.x * NTHREADS + threadIdx.x; it < 128 * NCG; it += gridDim.x * NTHREADS) {
        const int tmg = it / NCG, c = (it % NCG) * 4, colg = (c >> 6) * 128 + (c & 63), colv = colg + 64;
        const bf16_t* own = hal + (size_t)tmg * 4 * NUP;
        const bf16_t* prv = hal + (size_t)((tmg & 63) ? tmg - 1 : 128 + (tmg >> 6)) * 4 * NUP;
        const ConvW q = load_convw(p, c);
        const f32x4 pg2 = unpack4(*(const u32x2*)(prv + 2 * NUP + colg)), pv2 = unpack4(*(const u32x2*)(prv + 2 * NUP + colv));
        const f32x4 pg3 = unpack4(*(const u32x2*)(prv + 3 * NUP + colg)), pv3 = unpack4(*(const u32x2*)(prv + 3 * NUP + colv));
        const f32x4 og0 = unpack4(*(const u32x2*)(own + colg)), ov0 = unpack4(*(const u32x2*)(own + colv));
        const f32x4 og1 = unpack4(*(const u32x2*)(own + NUP + colg)), ov1 = unpack4(*(const u32x2*)(own + NUP + colv));
        *(u32x2*)(act + (size_t)(tmg * 128) * DFF + c) = conv_gelu4(q, pg2, pg3, og0, pv2, pv3, ov0);
        *(u32x2*)(act + (size_t)(tmg * 128 + 1) * DFF + c) = conv_gelu4(q, pg3, og0, og1, pv3, ov0, ov1);
    }
}
__device__ __forceinline__ void phase6(const Params& p, LAS char* lds) {
    unsigned char* ws = p.ws;
    const int lane = threadIdx.x & 63, w = wave_id(), wr = w >> 1, wc = w & 1;
    const bf16_t* act = (const bf16_t*)(ws + WS_ACT); bf16_t* ffn = (bf16_t*)(ws + WS_FFN);
    for (int it = 0;; ++it) {
        int tm, tn; const int st = tile_at(it, 128, 8, tm, tn); if (st == 0) break; if (st == 2) continue;
        const int col0 = tn * 128;
        f32x4 acc[4][4]; zero_acc(acc);
        gemm_main<true>(lds, act + (size_t)(tm * 128) * DFF, DFF, (const bf16_t*)(ws + WS_BTDN) + (size_t)col0 * DFF, DFF, 44, acc);
        epi_store_ss(acc, ffn, 1024, tm * 128, col0, (float*)(ws + WS_SSP4), tm * 128, wr, wc, lane);
    }
}
__device__ __forceinline__ void phase7(const Params& p) {
    unsigned char* ws = p.ws;
    const bf16_t* ffn = (const bf16_t*)(ws + WS_FFN); const float* ssp4 = (const float*)(ws + WS_SSP4); const float* g3 = p.gains + 3 * D;
    for (int it = blockIdx.x * NTHREADS + threadIdx.x; it < MX * 256; it += gridDim.x * NTHREADS) {
        const int row = it >> 8, col = (it & 255) * 4;
        float sq = 0.f;
#pragma unroll
        for (int sl = 0; sl < 16; ++sl) sq += ssp4[(size_t)sl * M + row];
        const float a = 1.0f / sqrtf(sq * (1.0f / D) + EPS);
        const f32x4 hh = *(const f32x4*)(p.out + (size_t)row * D + col), g = *(const f32x4*)(g3 + col);
        const u32x2 f = *(const u32x2*)(ffn + (size_t)row * D + col);
        f32x4 o;
        o[0] = hh[0] + bf_lo(f[0]) * a * g[0]; o[1] = hh[1] + bf_hi(f[0]) * a * g[1];
        o[2] = hh[2] + bf_lo(f[1]) * a * g[2]; o[3] = hh[3] + bf_hi(f[1]) * a * g[3];
        *(f32x4*)(p.out + (size_t)row * D + col) = o;
    }
}


#ifndef DUMP
#define DUMP 0
#endif
__device__ __forceinline__ void phase_dump(const Params& p) {
    unsigned char* ws = p.ws;
    const bf16_t* s0; const bf16_t* s1; int ld;
    if (DUMP == 1) { s0 = (const bf16_t*)(ws + WS_B); s1 = s0 + 512; ld = 1024; }
    else if (DUMP == 2) { s0 = (const bf16_t*)(ws + WS_QF); s1 = (const bf16_t*)(ws + WS_KF); ld = 512; }
    else if (DUMP == 3) { s0 = (const bf16_t*)(ws + WS_A); s1 = s0 + (size_t)M * 512; ld = 512; }
    else if (DUMP == 4) { s0 = (const bf16_t*)(ws + WS_GATED); s1 = s0 + 512; ld = 1024; }
    else if (DUMP == 8) { s0 = (const bf16_t*)(ws + WS_A); s1 = s0 + 512; ld = 1024; }
    else if (DUMP == 9) { s0 = (const bf16_t*)(ws + WS_ACT) + 1024; s1 = (const bf16_t*)(ws + WS_ACT) + 2304 - 512 + 512; ld = DFF; }
    else if (DUMP == 10) { s0 = (const bf16_t*)(ws + WS_FFN); s1 = s0 + 512; ld = 1024; }
    else if (DUMP == 6) { s0 = (const bf16_t*)(ws + WS_QS); s1 = (const bf16_t*)(ws + WS_KS); ld = 512; }
    else { s0 = (const bf16_t*)(ws + WS_MIXED); s1 = s0 + 512; ld = 1024; }
    for (int it = blockIdx.x * NTHREADS + threadIdx.x; it < MX * 1024; it += gridDim.x * NTHREADS) {
        const int row = it >> 10, col = it & 1023;
        if (DUMP >= 9 && row >= 8192) { p.out[it] = 0.f; continue; }
        const bf16_t v = col < 512 ? s0[(size_t)row * ld + col] : s1[(size_t)row * ld + col - 512];
        p.out[it] = __uint_as_float((unsigned)v << 16);
    }
}

__device__ __forceinline__ void l2_scrub(const Params& p) {
    const f32x4* src = (const f32x4*)p.x + (size_t)(blockIdx.x & 511) * 8192;
    f32x4 a = (f32x4){0.f, 0.f, 0.f, 0.f};
    for (int i = threadIdx.x; i < 8192; i += NTHREADS) a += src[i];
    if (a[0] + a[1] + a[2] + a[3] == 1.2345e-30f) ((float*)(p.ws + WS_CTL))[32 + (threadIdx.x & 7)] = a[0];
}

__device__ __forceinline__ void my_grid_sync(const Params& p, unsigned& target) {
    unsigned* bar = (unsigned*)(p.ws + WS_CTL) + 16;
    asm volatile("s_waitcnt vmcnt(0)" ::: "memory");
    __syncthreads();
    target += gridDim.x;
    if (threadIdx.x == 0) {
        __builtin_amdgcn_fence(__ATOMIC_RELEASE, "agent");
        asm volatile("s_waitcnt vmcnt(0)" ::: "memory");
        __hip_atomic_fetch_add(bar, 1u, __ATOMIC_RELAXED, __HIP_MEMORY_SCOPE_AGENT);
        while (__hip_atomic_load(bar, __ATOMIC_RELAXED, __HIP_MEMORY_SCOPE_AGENT) < target) __builtin_amdgcn_s_sleep(2);
        __builtin_amdgcn_fence(__ATOMIC_ACQUIRE, "agent");
        asm volatile("s_waitcnt vmcnt(0)" ::: "memory");
    }
    __syncthreads();
}
__global__ void __launch_bounds__(NTHREADS, 2) fwd_kernel(Params p) {
    extern __shared__ __attribute__((aligned(16))) unsigned char lds_raw[];
    LAS char* lds = (LAS char*)lds_raw;
    cg::grid_group grid = cg::this_grid();
#define IN(k) (p.ph_lo <= (k) && (k) < p.ph_hi)
#define SEAM(k) do { if (IN(k) && IN((k) + 1)) { if (p.ph_hi > 1000) grid.sync(); my_grid_sync(p, bar_target); } } while (0)
    unsigned bar_target = 0u;
    if (IN(0)) phase0(p, lds);
    SEAM(0);
    if (IN(1)) phase1(p, lds);
    SEAM(1);
    if (IN(2)) phase2(p, lds);
    SEAM(2);
    if (IN(3)) phase3a(p, lds);
    SEAM(3);
    if (IN(4)) phase3b(p, lds);
    SEAM(4);
    if (IN(5)) phase3c(p);
    SEAM(5);
    if (IN(6)) phase4(p, lds);
    SEAM(6);
    if (IN(7)) phase_fix(p);
    SEAM(7);
    if (IN(8)) phase6(p, lds);
    SEAM(8);
    if (IN(9)) phase7(p);
#undef IN
#undef SEAM
}


__global__ void ab_save(const unsigned char* ws, float* out) {
    const u32x4* src = (const u32x4*)(ws + AB_SRC); u32x4* dst = (u32x4*)((unsigned char*)out + (size_t)32 * MiB);
    for (size_t i = blockIdx.x * (size_t)blockDim.x + threadIdx.x; i < (size_t)AB_BYTES / 16; i += (size_t)gridDim.x * blockDim.x) dst[i] = src[i];
}
__global__ void ab_diff(const unsigned char* ws, float* out) {
    const bf16_t* src = (const bf16_t*)(ws + AB_SRC); const bf16_t* sav = (const bf16_t*)((unsigned char*)out + (size_t)32 * MiB);
    for (size_t i = blockIdx.x * (size_t)blockDim.x + threadIdx.x; i < (size_t)8192 * 1024; i += (size_t)gridDim.x * blockDim.x) {
        if (i >= (size_t)AB_BYTES / 2) { out[i] = 0.f; continue; }
        out[i] = src[i] != sav[i] ? 1000.0f : 0.f;
    }
}
__global__ void ab_zero(float* out) {
    for (size_t i = blockIdx.x * (size_t)blockDim.x + threadIdx.x; i < (size_t)8192 * 1024; i += (size_t)gridDim.x * blockDim.x) out[(size_t)8192 * 1024 + i] = 0.f;
}
extern "C" void kernel_launch(void* const* d_in, const int* in_sizes, int n_in, void* d_out, int out_size, void* d_ws, size_t ws_size, hipStream_t stream) {
    static int grid_blocks = 0;
    if (grid_blocks == 0) {
        if (n_in != 12 || ws_size < WS_END) { fprintf(stderr, "kernel_launch: unexpected n_in %d or ws_size %zu (need %zu)\n", n_in, ws_size, (size_t)WS_END); grid_blocks = -1; return; }
        int dev = 0, cus = 0, per_cu = 0;
        (void)hipGetDevice(&dev);
        (void)hipDeviceGetAttribute(&cus, hipDeviceAttributeMultiprocessorCount, dev);
        (void)hipFuncSetAttribute((const void*)fwd_kernel, hipFuncAttributeMaxDynamicSharedMemorySize, LDS_BYTES);
        (void)hipOccupancyMaxActiveBlocksPerMultiprocessor(&per_cu, (const void*)fwd_kernel, NTHREADS, LDS_BYTES);
        if (per_cu < 1) per_cu = 1;
        if (per_cu > 2) per_cu = 2;
        grid_blocks = cus * per_cu;
        (void)hipGetLastError();
    }
    if (grid_blocks < 0) return;
    Params p{};
    p.x = (const float*)d_in[0]; p.meta = (const float*)d_in[1]; p.gains = (const float*)d_in[2]; p.w_in = (const float*)d_in[3];
    p.b_forget = (const float*)d_in[4]; p.w_o_fox = (const float*)d_in[5]; p.w_o_sb = (const float*)d_in[6]; p.w_out = (const float*)d_in[7];
    p.w_up = (const float*)d_in[8]; p.conv_w = (const float*)d_in[9]; p.conv_b = (const float*)d_in[10]; p.w_down = (const float*)d_in[11];
    p.out = (float*)d_out; p.ws = (unsigned char*)d_ws;
#if SINGLE_LAUNCH
    (void)hipMemsetAsync((unsigned char*)d_ws + WS_CTL, 0, 256, stream);
    p.ph_lo = 0; p.ph_hi = NPHASE;
    void* args[] = {&p};
    hipError_t e = hipLaunchCooperativeKernel((const void*)fwd_kernel, dim3(grid_blocks), dim3(NTHREADS), args, LDS_BYTES, stream);
    if (e != hipSuccess) fprintf(stderr, "cooperative launch failed: %s (grid %d)\n", hipGetErrorString(e), grid_blocks);
#else
#ifndef STOP_AT
#define STOP_AT NPHASE
#endif
    for (int k = 0; k < STOP_AT; ++k) {
        p.ph_lo = k; p.ph_hi = k + 1;
        hipLaunchKernelGGL(fwd_kernel, dim3(grid_blocks), dim3(NTHREADS), LDS_BYTES, stream, p);
    }
#if ABTEST
    ab_save<<<1024, 256, 0, stream>>>(p.ws, p.out);
    for (int k = AB_FROM; k < STOP_AT; ++k) {
        p.ph_lo = k; p.ph_hi = k + 1;
        hipLaunchKernelGGL(fwd_kernel, dim3(grid_blocks), dim3(NTHREADS), LDS_BYTES, stream, p);
    }
    ab_diff<<<1024, 256, 0, stream>>>(p.ws, p.out);
    ab_zero<<<1024, 256, 0, stream>>>(p.out);
#endif

#endif
}
```

```cpp
#include <hip/hip_runtime.h>
#include <hip/hip_cooperative_groups.h>
#include <cstdio>
#include <cstdint>
namespace cg = cooperative_groups;

#define DUMP 0
#define ABTEST 0
#define AB_FROM 0
#define AB_SRC WS_SSP2
#define AB_BYTES (2 * MiB)
#ifndef SINGLE_LAUNCH
#define SINGLE_LAUNCH 1
#endif

#define LAS __attribute__((address_space(3)))
typedef unsigned short bf16_t;
typedef short bf16x8 __attribute__((ext_vector_type(8)));
typedef float f32x4 __attribute__((ext_vector_type(4)));
typedef float f32x16 __attribute__((ext_vector_type(16)));
typedef unsigned u32x4 __attribute__((ext_vector_type(4)));
typedef unsigned u32x2 __attribute__((ext_vector_type(2)));

constexpr int D = 1024, SEQ = 8192, NMETA = 16, NB = 2;
constexpr int MX = NB * SEQ;
constexpr int MV = MX + NB * NMETA;
constexpr int M = 16512;
constexpr int LPK = 8256;
constexpr int PROJW = 5128, NPROJ = 5120, DFF = 2816, NUP = 5632;
constexpr float EPS = 1e-6f;
constexpr float LOG2E = 1.4426950408889634f, LN2 = 0.6931471805599453f;
constexpr int NTHREADS = 256;
constexpr int LDS_BYTES = 65536 + 16;
constexpr int NPHASE = 10;

constexpr size_t MiB = 1u << 20;
constexpr size_t WS_CTL = 0;
constexpr size_t WS_R1 = 4096, WS_R2 = WS_R1 + 69632, WS_SS2 = WS_R2 + 69632, WS_SS4 = WS_SS2 + 69632;
constexpr size_t WS_LOGF = WS_SS4 + 69632, WS_CK = WS_LOGF + 528384, WS_UPMETA = WS_CK + 528384;
constexpr size_t WS_BTIN = 2 * MiB, WS_BTOF = WS_BTIN + 10 * MiB, WS_BTOS = WS_BTOF + 1 * MiB, WS_BTOUT = WS_BTOS + 1 * MiB,
                 WS_BTUP = WS_BTOUT + 2 * MiB, WS_BTDN = WS_BTUP + 11 * MiB;
constexpr size_t SZ_M1024 = (size_t)M * 1024 * 2, SZ_M512 = (size_t)M * 512 * 2;
constexpr size_t WS_A = 33 * MiB;
constexpr size_t WS_B = WS_A + SZ_M1024;
constexpr size_t WS_C = WS_B + 2 * SZ_M1024;
constexpr size_t WS_QF = WS_C, WS_KF = WS_QF + SZ_M512, WS_QS = WS_KF + SZ_M512, WS_KS = WS_QS + SZ_M512, WS_VFT = WS_KS + SZ_M512, WS_VST = WS_VFT + SZ_M512;
constexpr size_t WS_GATED = WS_C, WS_MIXED = WS_B + SZ_M1024;
constexpr size_t WS_ACT = WS_B;
constexpr size_t WS_FFN = WS_ACT + 132 * MiB;
constexpr size_t WS_SSP2 = 230 * MiB, WS_SSP4 = 232 * MiB;
constexpr size_t WS_HAL = 234 * MiB;
constexpr size_t WS_XBAR = 240 * MiB;
constexpr size_t WS_END = 241 * MiB;

struct Params {
    const float *x, *meta, *gains, *w_in, *b_forget, *w_o_fox, *w_o_sb, *w_out, *w_up, *conv_w, *conv_b, *w_down;
    float* out; unsigned char* ws; int ph_lo, ph_hi;
};

typedef __bf16 bf16x2_t __attribute__((ext_vector_type(2)));
__device__ __forceinline__ unsigned pk_bf16(float lo, float hi) { bf16x2_t v = {(__bf16)lo, (__bf16)hi}; return __builtin_bit_cast(unsigned, v); }
__device__ __forceinline__ float bf_lo(unsigned u) { return __uint_as_float(u << 16); }
__device__ __forceinline__ float bf_hi(unsigned u) { return __uint_as_float(u & 0xffff0000u); }
__device__ __forceinline__ float ex2(float x) { return __builtin_amdgcn_exp2f(x); }
__device__ __forceinline__ float lg2(float x) { return __builtin_amdgcn_logf(x); }
__device__ __forceinline__ float rcp(float x) { return __builtin_amdgcn_rcpf(x); }
__device__ __forceinline__ float sigmoidf_(float v) { return rcp(1.0f + ex2(-v * LOG2E)); }
__device__ __forceinline__ float wave_sum(float v) {
#pragma unroll
    for (int o = 32; o > 0; o >>= 1) v += __shfl_xor(v, o);
    return v;
}
__device__ __forceinline__ int wave_id() { return __builtin_amdgcn_readfirstlane((int)(threadIdx.x >> 6)); }

__device__ __forceinline__ void transpose_tile(LAS char* lds, const float* src, int ldsrc, int srccol, int k0, const float* gain, bf16_t* dst, int K, int n0) {
    LAS bf16_t* T = (LAS bf16_t*)lds;
    const int tid = threadIdx.x, r = tid >> 4, c4 = tid & 15;
#pragma unroll
    for (int p = 0; p < 4; ++p) {
        const int k = r + 16 * p;
        f32x4 v = *(const f32x4*)(src + (size_t)(k0 + k) * ldsrc + srccol + c4 * 4);
        const float g = gain ? gain[k0 + k] : 1.0f;
        const unsigned a = pk_bf16(v[0] * g, v[1] * g), b = pk_bf16(v[2] * g, v[3] * g);
        T[(c4 * 4 + 0) * 72 + k] = (bf16_t)(a & 0xffff); T[(c4 * 4 + 1) * 72 + k] = (bf16_t)(a >> 16);
        T[(c4 * 4 + 2) * 72 + k] = (bf16_t)(b & 0xffff); T[(c4 * 4 + 3) * 72 + k] = (bf16_t)(b >> 16);
    }
    __syncthreads();
    const int n = tid >> 2, kq = tid & 3;
    const u32x4 lo = *(LAS u32x4*)(T + n * 72 + kq * 16), hi = *(LAS u32x4*)(T + n * 72 + kq * 16 + 8);
    bf16_t* d = dst + (size_t)(n0 + n) * K + k0 + kq * 16;
    *(u32x4*)d = lo; *(u32x4*)(d + 8) = hi;
    __syncthreads();
}

__device__ __forceinline__ void phase0(const Params& p, LAS char* lds) {
    unsigned char* ws = p.ws;
    const int tid = threadIdx.x, lane = tid & 63, w = wave_id();
    LAS float* wfT = (LAS float*)lds;
    const float* g0 = p.gains;
    for (int idx = tid; idx < 8192; idx += NTHREADS) { const int h = idx & 7, k = idx >> 3; wfT[h * 1024 + k] = p.w_in[(size_t)k * PROJW + 1536 + h] * g0[k]; }
    __syncthreads();
    bf16_t* xb = (bf16_t*)(ws + WS_A);
    float* r1 = (float*)(ws + WS_R1);
    float* logf_ = (float*)(ws + WS_LOGF);
    for (int r_ = blockIdx.x * 32 + w; r_ < M; r_ += (r_ & 31) < 28 ? 4 : gridDim.x * 32 - 28) {
        const int r = r_;
        if (r >= MV) {
#pragma unroll
            for (int i = 0; i < 4; ++i) *(u32x2*)(xb + (size_t)r * D + lane * 4 + 256 * i) = (u32x2){0u, 0u};
            if (lane == 0) r1[r] = 0.f;
            continue;
        }
        const float* src = r < MX ? p.x + (size_t)r * D : p.meta + (size_t)((r - MX) & 15) * D;
        f32x4 v[4]; float ss = 0.f;
#pragma unroll
        for (int i = 0; i < 4; ++i) { v[i] = *(const f32x4*)(src + lane * 4 + 256 * i); ss += v[i][0] * v[i][0] + v[i][1] * v[i][1] + v[i][2] * v[i][2] + v[i][3] * v[i][3]; }
#pragma unroll
        for (int i = 0; i < 4; ++i) *(u32x2*)(xb + (size_t)r * D + lane * 4 + 256 * i) = (u32x2){pk_bf16(v[i][0], v[i][1]), pk_bf16(v[i][2], v[i][3])};
        ss = wave_sum(ss);
        const float rs = 1.0f / sqrtf(ss * (1.0f / D) + EPS);
        if (lane == 0) r1[r] = rs;
        float mine = 0.f;
#pragma unroll
        for (int h = 0; h < 8; ++h) {
            float a = 0.f;
#pragma unroll
            for (int i = 0; i < 4; ++i) { const f32x4 wv = *(LAS f32x4*)(wfT + h * 1024 + lane * 4 + 256 * i); a += v[i][0] * wv[0] + v[i][1] * wv[1] + v[i][2] * wv[2] + v[i][3] * wv[3]; }
            a = wave_sum(a);
            if (lane == h) mine = a;
        }
        if (lane < 8) {
            const float f = mine * rs + p.b_forget[lane];
            const float lf = fminf(f, 0.f) - log1pf(expf(-fabsf(f)));
            int b, kidx; if (r < MX) { b = r >> 13; kidx = r & 8191; } else { const int j = r - MX; b = j >> 4; kidx = 8192 + (j & 15); }
            logf_[(size_t)(b * 8 + lane) * LPK + kidx] = lf;
        }
    }
    __syncthreads();
    LAS char* tl = lds + 32768;
    const float* g2 = p.gains + 2 * D;
    constexpr int T_IN = 16 * 80, T_OF = 8 * 16, T_OS = 8 * 16, T_OUT = 16 * 16, T_UP = 16 * 88, T_DN = 44 * 16;
    constexpr int T_ALL = T_IN + T_OF + T_OS + T_OUT + T_UP + T_DN;
    for (int t = blockIdx.x; t < T_ALL; t += gridDim.x) {
        int u = t;
        if (u < T_IN) { const int nt = u % 80, kt = u / 80; const int sc = nt * 64 + (nt * 64 >= 1536 ? 8 : 0); transpose_tile(tl, p.w_in, PROJW, sc, kt * 64, g0, (bf16_t*)(ws + WS_BTIN), 1024, nt * 64); continue; }
        u -= T_IN;
        if (u < T_OF) { const int nt = u % 16, kt = u / 16; transpose_tile(tl, p.w_o_fox, 1024, nt * 64, kt * 64, nullptr, (bf16_t*)(ws + WS_BTOF), 512, nt * 64); continue; }
        u -= T_OF;
        if (u < T_OS) { const int nt = u % 16, kt = u / 16; transpose_tile(tl, p.w_o_sb, 1024, nt * 64, kt * 64, nullptr, (bf16_t*)(ws + WS_BTOS), 512, nt * 64); continue; }
        u -= T_OS;
        if (u < T_OUT) { const int nt = u % 16, kt = u / 16; transpose_tile(tl, p.w_out, 1024, nt * 64, kt * 64, nullptr, (bf16_t*)(ws + WS_BTOUT), 1024, nt * 64); continue; }
        u -= T_OUT;
        if (u < T_UP) { const int nt = u % 88, kt = u / 88; transpose_tile(tl, p.w_up, NUP, (nt & 1) * DFF + (nt >> 1) * 64, kt * 64, g2, (bf16_t*)(ws + WS_BTUP), 1024, nt * 64); continue; }
        u -= T_UP;
        { const int nt = u % 16, kt = u / 16; transpose_tile(tl, p.w_down, 1024, nt * 64, kt * 64, nullptr, (bf16_t*)(ws + WS_BTDN), DFF, nt * 64); }
    }
}

template <bool SWAP>
__device__ __forceinline__ void gemm_main(LAS char* lds, const bf16_t* Ag, int lda, const bf16_t* Bg, int ldb, int nk, f32x4 (&acc)[4][4]) {
    const int tid = threadIdx.x, lane = tid & 63, w = wave_id(), wr = w >> 1, wc = w & 1;
    const int row_0 = w * 8 + (lane >> 3), c_0 = (lane & 7) ^ ((row_0 >> 1) & 7);
    const bf16_t* pa0 = Ag + (size_t)row_0 * lda + c_0 * 8; const bf16_t* pb0 = Bg + (size_t)row_0 * ldb + c_0 * 8;
    const size_t sa = (size_t)32 * lda, sb_ = (size_t)32 * ldb;
    const int swz = (lane >> 1) & 7;
    int aoff[2], boff[2];
#pragma unroll
    for (int kh = 0; kh < 2; ++kh) {
        aoff[kh] = (wr * 64 + (lane & 15)) * 128 + (((kh * 4 + (lane >> 4)) ^ swz) << 4);
        boff[kh] = 16384 + (wc * 64 + (lane & 15)) * 128 + (((kh * 4 + (lane >> 4)) ^ swz) << 4);
    }
#define GM_STAGE(s, kt) do { _Pragma("unroll") for (int i_ = 0; i_ < 4; ++i_) { \
        __builtin_amdgcn_global_load_lds((const unsigned*)(pa0 + i_ * sa + (kt) * 64), (LAS unsigned*)(lds + (s) * 32768 + (i_ * 4 + w) * 1024), 16, 0, 0); \
        __builtin_amdgcn_global_load_lds((const unsigned*)(pb0 + i_ * sb_ + (kt) * 64), (LAS unsigned*)(lds + (s) * 32768 + 16384 + (i_ * 4 + w) * 1024), 16, 0, 0); } } while (0)
    GM_STAGE(0, 0);
    for (int kt = 0; kt < nk; ++kt) {
        asm volatile("s_waitcnt vmcnt(0)" ::: "memory");
        __syncthreads();
        const int s = kt & 1;
        if (kt + 1 < nk) GM_STAGE(s ^ 1, kt + 1);
        bf16x8 af[4][2], bf[4][2];
#pragma unroll
        for (int kh = 0; kh < 2; ++kh) {
#pragma unroll
            for (int m = 0; m < 4; ++m) af[m][kh] = *(LAS bf16x8*)(lds + s * 32768 + aoff[kh] + m * 2048);
#pragma unroll
            for (int n = 0; n < 4; ++n) bf[n][kh] = *(LAS bf16x8*)(lds + s * 32768 + boff[kh] + n * 2048);
        }
        __builtin_amdgcn_s_setprio(1);
#pragma unroll
        for (int kh = 0; kh < 2; ++kh)
#pragma unroll
            for (int m = 0; m < 4; ++m)
#pragma unroll
                for (int n = 0; n < 4; ++n)
                    acc[m][n] = SWAP ? __builtin_amdgcn_mfma_f32_16x16x32_bf16(bf[n][kh], af[m][kh], acc[m][n], 0, 0, 0)
                                     : __builtin_amdgcn_mfma_f32_16x16x32_bf16(af[m][kh], bf[n][kh], acc[m][n], 0, 0, 0);
        __builtin_amdgcn_s_setprio(0);
    }
    __syncthreads();
#undef GM_STAGE
}
__device__ __forceinline__ void zero_acc(f32x4 (&acc)[4][4]) {
#pragma unroll
    for (int m = 0; m < 4; ++m)
#pragma unroll
        for (int n = 0; n < 4; ++n) acc[m][n] = (f32x4){0.f, 0.f, 0.f, 0.f};
}


__device__ __forceinline__ int tile_at(int it, int ntm, int ntn, int& tm, int& tn) {
    const int G = gridDim.x;
    if (G % 256 != 0) { const int t = it * G + blockIdx.x; if (t >= ntm * ntn) return 0; tm = t / ntn; tn = t % ntn; return 1; }
    const int xcd = blockIdx.x & 7, j = blockIdx.x >> 3, ppx = G >> 8;
    const int pcols = (ntn + 3) >> 2, prows = (ntm + 7) >> 3;
    const int patch = (it * ppx + (j >> 5)) * 8 + xcd;
    if (patch >= prows * pcols) return 0;
    const int wi = j & 31;
    tm = (patch / pcols) * 8 + (wi >> 2); tn = (patch % pcols) * 4 + (wi & 3);
    return (tm < ntm && tn < ntn) ? 1 : 2;
}
__device__ __forceinline__ void cumsum_block(const Params& p, LAS char* lds, int bh) {
    const float* lf = (const float*)(p.ws + WS_LOGF) + (size_t)bh * LPK; float* ck = (float*)(p.ws + WS_CK) + (size_t)bh * LPK;
    LAS float* sums = (LAS float*)lds;
    const int tid = threadIdx.x; constexpr int PER = 33, L = SEQ + NMETA;
    float loc = 0.f;
    for (int e = 0; e < PER; ++e) { const int t = tid * PER + e; if (t < L) loc += lf[t < 16 ? 8192 + t : t - 16]; }
    sums[tid] = loc;
    __syncthreads();
    float run = 0.f;
    for (int i = 0; i < tid; ++i) run += sums[i];
    for (int e = 0; e < PER; ++e) { const int t = tid * PER + e; if (t < L) { const int kx = t < 16 ? 8192 + t : t - 16; run += lf[kx]; ck[kx] = run * LOG2E; } }
    __syncthreads();
}

__device__ __forceinline__ void phase1(const Params& p, LAS char* lds) {
    unsigned char* ws = p.ws;
    if (blockIdx.x < 16) cumsum_block(p, lds, blockIdx.x);
    const int lane = threadIdx.x & 63, w = wave_id(), wr = w >> 1, wc = w & 1;
    const bf16_t* xb = (const bf16_t*)(ws + WS_A); const bf16_t* Bt = (const bf16_t*)(ws + WS_BTIN);
    const float* r1 = (const float*)(ws + WS_R1);
    constexpr int NTN = 40, NTM = 129;
    for (int it = 0;; ++it) {
        int tm, tn; const int st = tile_at(it, NTM, NTN, tm, tn); if (st == 0) break; if (st == 2) continue;
        const int row0 = tm * 128, col0 = tn * 128;
        const bool vtile = (tn >= 8 && tn < 12) || (tn >= 20 && tn < 24);
        f32x4 acc[4][4]; zero_acc(acc);
        if (vtile) {
            gemm_main<false>(lds, xb + (size_t)row0 * D, D, Bt + (size_t)col0 * D, D, 16, acc);
            bf16_t* vT = (bf16_t*)(ws + (tn < 12 ? WS_VFT : WS_VST)); const int cb = tn < 12 ? 1024 : 2560;
            const int g = lane >> 4, gp = ((g & 1) << 1) | (g >> 1);
#pragma unroll
            for (int m = 0; m < 4; ++m) {
                const int rb = row0 + wr * 64 + m * 16; int b, kb16;
                if (rb < MX) { b = rb >> 13; kb16 = rb & 8191; } else { const int j = rb - MX; if (j >= 32) continue; b = j >> 4; kb16 = 8192; }
                const f32x4 rs = *(const f32x4*)(r1 + rb + g * 4);
#pragma unroll
                for (int n = 0; n < 4; ++n) {
                    const int dc = col0 + wc * 64 + n * 16 + (lane & 15) - cb, h = dc >> 6, d = dc & 63;
                    const f32x4 v = acc[m][n] * rs;
                    *(u32x2*)(vT + ((size_t)(b * 8 + h) * 64 + d) * LPK + kb16 + gp * 4) = (u32x2){pk_bf16(v[0], v[1]), pk_bf16(v[2], v[3])};
                }
            }
        } else {
            gemm_main<true>(lds, xb + (size_t)row0 * D, D, Bt + (size_t)col0 * D, D, 16, acc);
            bf16_t* dst; int ld, cb; float sc = 1.f; bool sg = false;
            if (tn < 4) { dst = (bf16_t*)(ws + WS_QF); ld = 512; cb = 0; sc = 0.125f * LOG2E; }
            else if (tn < 8) { dst = (bf16_t*)(ws + WS_KF); ld = 512; cb = 512; }
            else if (tn < 16) { dst = (bf16_t*)(ws + WS_QS); ld = 512; cb = 1536; sc = 0.125f; }
            else if (tn < 20) { dst = (bf16_t*)(ws + WS_KS); ld = 512; cb = 2048; }
            else if (tn < 32) { dst = (bf16_t*)(ws + WS_B); ld = 1024; cb = 3072; sg = true; }
            else { dst = (bf16_t*)(ws + WS_B + SZ_M1024); ld = 1024; cb = 4096; sg = true; }
            const bool kfox = tn >= 4 && tn < 8;
            float wmax = 0.f;
#pragma unroll
            for (int m = 0; m < 4; ++m) {
                const int row = row0 + wr * 64 + m * 16 + (lane & 15); const float rs = r1[row] * sc;
                float s2 = 0.f;
#pragma unroll
                for (int n = 0; n < 4; ++n) {
                    const int col = col0 + wc * 64 + n * 16 + (lane >> 4) * 4 - cb;
                    f32x4 v = acc[m][n] * rs;
                    if (sg) { v[0] = sigmoidf_(v[0]); v[1] = sigmoidf_(v[1]); v[2] = sigmoidf_(v[2]); v[3] = sigmoidf_(v[3]); }
                    s2 += v[0] * v[0] + v[1] * v[1] + v[2] * v[2] + v[3] * v[3];
                    *(u32x2*)(dst + (size_t)row * ld + col) = (u32x2){pk_bf16(v[0], v[1]), pk_bf16(v[2], v[3])};
                }
                if (kfox) { s2 += __shfl_xor(s2, 16); s2 += __shfl_xor(s2, 32); wmax = fmaxf(wmax, s2); }
            }
            if (kfox) {
#pragma unroll
                for (int o = 1; o < 16; o <<= 1) wmax = fmaxf(wmax, __shfl_xor(wmax, o));
                if (lane == 0) {
                    unsigned* km = (unsigned*)(ws + WS_CTL) + 32; const int head = (tn - 4) * 2 + wc; const unsigned bits = __float_as_uint(wmax);
                    if (row0 < MX) atomicMax(km + (row0 >> 13) * 8 + head, bits);
                    else { atomicMax(km + head, bits); atomicMax(km + 8 + head, bits); }
                }
            }
        }
    }
}

constexpr int AT_STAGE = 16640;
template <int TYPE>
__device__ __forceinline__ void attn_unit(LAS char* lds, const Params& p, int b, int h, int qb) {
    unsigned char* ws = p.ws;
    const int tid = threadIdx.x, lane = tid & 63, w = wave_id(), ql = lane & 31, hi = lane >> 5;
    const bf16_t* Q = (const bf16_t*)(ws + (TYPE == 0 ? WS_QF : WS_QS));
    const bf16_t* Kp = (const bf16_t*)(ws + (TYPE == 0 ? WS_KF : WS_KS));
    const bf16_t* VT = (const bf16_t*)(ws + (TYPE == 0 ? WS_VFT : WS_VST)) + (size_t)(b * 8 + h) * 64 * LPK;
    const float* cK = (const float*)(ws + WS_CK) + (size_t)(b * 8 + h) * LPK;
    bf16_t* Oo = (bf16_t*)(ws + WS_A + (TYPE == 0 ? 0 : SZ_M512));
    const bool meta_unit = qb < 0;
    const int qrow0 = meta_unit ? MX + 16 * b : b * SEQ + qb * 128;
    const int nt = meta_unit ? 1 : 2 * qb + 3;
    int qrow = qrow0 + 32 * w + ql; if (qrow > M - 1) qrow = M - 1;
    bf16x8 qf[4];
#pragma unroll
    for (int ds = 0; ds < 4; ++ds) qf[ds] = *(const bf16x8*)(Q + (size_t)qrow * 512 + h * 64 + ds * 16 + hi * 8);
    f32x16 O0, O1;
#pragma unroll
    for (int i = 0; i < 16; ++i) { O0[i] = 0.f; O1[i] = 0.f; }
    float m_run = -INFINITY, lsum = 0.f, R = 0.f;
    float qbound = 0.f;
    if (TYPE == 0) {
        float q2 = 0.f;
#pragma unroll
        for (int ds = 0; ds < 4; ++ds)
#pragma unroll
            for (int e = 0; e < 8; ++e) { const float x = __uint_as_float((unsigned)(unsigned short)qf[ds][e] << 16); q2 += x * x; }
        q2 += __shfl_xor(q2, 32);
        const unsigned kb = __hip_atomic_load((unsigned*)(ws + WS_CTL) + 32 + b * 8 + h, __ATOMIC_RELAXED, __HIP_MEMORY_SCOPE_AGENT);
        qbound = sqrtf(q2) * sqrtf(__uint_as_float(kb)) * 1.02f + 1.0f;
    }
    u32x4 kreg[2], vreg[2]; float creg = 0.f;
    const int srow = tid >> 3, spos = tid & 7;
    const int swz_st = (spos ^ ((srow >> 1) & 7)) << 4;
    const int swz = (lane >> 1) & 7;
    LAS unsigned* flags = (LAS unsigned*)(lds + 2 * AT_STAGE);
#define AT_LOAD(j) do { int krow0_, kidx0_; if (!meta_unit && (j) < nt - 1) { const int kt_ = nt - 2 - (j); krow0_ = b * SEQ + 64 * kt_; kidx0_ = 64 * kt_; } else { krow0_ = MX + 16 * b; kidx0_ = 8192; } \
        _Pragma("unroll") for (int i_ = 0; i_ < 2; ++i_) { \
            kreg[i_] = *(const u32x4*)(Kp + (size_t)(krow0_ + srow + 32 * i_) * 512 + h * 64 + spos * 8); \
            vreg[i_] = *(const u32x4*)(VT + (size_t)(srow + 32 * i_) * LPK + kidx0_ + spos * 8); } \
        if (TYPE == 0 && tid < 64) creg = cK[kidx0_ + tid]; } while (0)
#define AT_WRITE(s) do { _Pragma("unroll") for (int i_ = 0; i_ < 2; ++i_) { \
            *(LAS u32x4*)(lds + (s) * AT_STAGE + (srow + 32 * i_) * 128 + swz_st) = kreg[i_]; \
            *(LAS u32x4*)(lds + (s) * AT_STAGE + 8192 + (srow + 32 * i_) * 128 + swz_st) = vreg[i_]; } \
        if (TYPE == 0 && tid < 64) *(LAS float*)(lds + (s) * AT_STAGE + 16384 + tid * 4) = creg; } while (0)
    AT_LOAD(0); AT_WRITE(0);
    __syncthreads();
    for (int j = 0; j < nt; ++j) {
        const bool more = j + 1 < nt;
        if (more) AT_LOAD(j + 1);
        int klim, d0;
        if (meta_unit) { klim = 16; d0 = 0; }
        else if (j == nt - 1) { klim = 16; d0 = 1 << 20; }
        else { klim = 64; d0 = 128 * qb - 64 * (nt - 2 - j); if (d0 >= 64) d0 = 1 << 20; }
        const int limw = 32 * w + d0 - TYPE;
        bool wdone = false;
        if (TYPE == 0) {
            const float clast = *(const LAS float*)(lds + (j & 1) * AT_STAGE + 16384 + (klim - 1) * 4);
            wdone = __all((qbound - clast - m_run) < -126.0f) != 0;
        }
        if (limw + 31 >= 0 && !(TYPE == 0 && wdone)) {
            const LAS char* sb = lds + (j & 1) * AT_STAGE;
            int kmax = limw + ql; if (kmax > klim - 1) kmax = klim - 1;
            const bool needmask = (klim < 64) || (limw < 63);
            f32x16 S0, S1;
#pragma unroll
            for (int i = 0; i < 16; ++i) { S0[i] = 0.f; S1[i] = 0.f; }
#pragma unroll
            for (int ds = 0; ds < 4; ++ds) {
                const bf16x8 k0 = *(const LAS bf16x8*)(sb + ql * 128 + (((2 * ds + hi) ^ swz) << 4));
                const bf16x8 k1 = *(const LAS bf16x8*)(sb + (32 + ql) * 128 + (((2 * ds + hi) ^ swz) << 4));
                S0 = __builtin_amdgcn_mfma_f32_32x32x16_bf16(k0, qf[ds], S0, 0, 0, 0);
                S1 = __builtin_amdgcn_mfma_f32_32x32x16_bf16(k1, qf[ds], S1, 0, 0, 0);
            }
            if (TYPE == 0) {
#pragma unroll
                for (int g = 0; g < 4; ++g) {
                    const f32x4 c0 = *(const LAS f32x4*)(sb + 16384 + (8 * g + 4 * hi) * 4), c1 = *(const LAS f32x4*)(sb + 16384 + (32 + 8 * g + 4 * hi) * 4);
#pragma unroll
                    for (int i = 0; i < 4; ++i) { S0[4 * g + i] -= c0[i]; S1[4 * g + i] -= c1[i]; }
                }
                if (needmask) {
#pragma unroll
                    for (int r = 0; r < 16; ++r) { const int kl = (r & 3) + 8 * (r >> 2) + 4 * hi; if (kl > kmax) S0[r] = -INFINITY; if (kl + 32 > kmax) S1[r] = -INFINITY; }
                }
                float mx = -INFINITY;
#pragma unroll
                for (int r = 0; r < 16; ++r) mx = fmaxf(mx, fmaxf(S0[r], S1[r]));
                mx = fmaxf(mx, __shfl_xor(mx, 32));
                const float m_new = fmaxf(m_run, mx), alpha = ex2(m_run - m_new);
                m_run = m_new;
                float ps = 0.f;
#pragma unroll
                for (int r = 0; r < 16; ++r) { S0[r] = ex2(S0[r] - m_new); S1[r] = ex2(S1[r] - m_new); ps += S0[r] + S1[r]; }
                lsum = lsum * alpha + ps;
#pragma unroll
                for (int r = 0; r < 16; ++r) { O0[r] *= alpha; O1[r] *= alpha; }
            } else {
                float G0[4], G1[4];
                f32x16 L0, L1;
#pragma unroll
                for (int r = 0; r < 16; ++r) {
                    const int kl = (r & 3) + 8 * (r >> 2) + 4 * hi;
                    const float z0 = S0[r], z1 = S1[r];
                    const float sp0 = fmaxf(z0, 0.f) + lg2(1.0f + ex2(-fabsf(z0) * LOG2E)) * LN2;
                    const float sp1 = fmaxf(z1, 0.f) + lg2(1.0f + ex2(-fabsf(z1) * LOG2E)) * LN2;
                    L0[r] = (!needmask || kl <= kmax) ? -sp0 : 0.f;
                    L1[r] = (!needmask || kl + 32 <= kmax) ? -sp1 : 0.f;
                }
#pragma unroll
                for (int g = 0; g < 4; ++g) {
                    L0[4 * g + 2] += L0[4 * g + 3]; L0[4 * g + 1] += L0[4 * g + 2]; L0[4 * g] += L0[4 * g + 1]; G0[g] = L0[4 * g];
                    L1[4 * g + 2] += L1[4 * g + 3]; L1[4 * g + 1] += L1[4 * g + 2]; L1[4 * g] += L1[4 * g + 1]; G1[g] = L1[4 * g];
                }
                float run = R;
#pragma unroll
                for (int g = 3; g >= 0; --g) {
                    const float gp = __shfl_xor(G1[g], 32);
                    const float off = hi ? run : run + gp;
#pragma unroll
                    for (int i = 0; i < 4; ++i) { const int r = 4 * g + i; const int kl = 32 + i + 8 * g + 4 * hi;
                        const float a = ex2((S1[r] + L1[r] + off) * LOG2E); S1[r] = (!needmask || kl <= kmax) ? a : 0.f; }
                    run += G1[g] + gp;
                }
#pragma unroll
                for (int g = 3; g >= 0; --g) {
                    const float gp = __shfl_xor(G0[g], 32);
                    const float off = hi ? run : run + gp;
#pragma unroll
                    for (int i = 0; i < 4; ++i) { const int r = 4 * g + i; const int kl = i + 8 * g + 4 * hi;
                        const float a = ex2((S0[r] + L0[r] + off) * LOG2E); S0[r] = (!needmask || kl <= kmax) ? a : 0.f; }
                    run += G0[g] + gp;
                }
                R = run;
                wdone = __all(R < -120.0f) != 0;
            }
#pragma unroll
            for (int ks = 0; ks < 4; ++ks) {
                bf16x8 pf; u32x4 pu;
                if (ks < 2) { pu = (u32x4){pk_bf16(S0[8 * ks + 0], S0[8 * ks + 1]), pk_bf16(S0[8 * ks + 2], S0[8 * ks + 3]), pk_bf16(S0[8 * ks + 4], S0[8 * ks + 5]), pk_bf16(S0[8 * ks + 6], S0[8 * ks + 7])}; }
                else { const int k2 = ks - 2; pu = (u32x4){pk_bf16(S1[8 * k2 + 0], S1[8 * k2 + 1]), pk_bf16(S1[8 * k2 + 2], S1[8 * k2 + 3]), pk_bf16(S1[8 * k2 + 4], S1[8 * k2 + 5]), pk_bf16(S1[8 * k2 + 6], S1[8 * k2 + 7])}; }
                pf = __builtin_bit_cast(bf16x8, pu);
                const bf16x8 v0 = *(const LAS bf16x8*)(sb + 8192 + ql * 128 + (((2 * ks + hi) ^ swz) << 4));
                const bf16x8 v1 = *(const LAS bf16x8*)(sb + 8192 + (32 + ql) * 128 + (((2 * ks + hi) ^ swz) << 4));
                O0 = __builtin_amdgcn_mfma_f32_32x32x16_bf16(v0, pf, O0, 0, 0, 0);
                O1 = __builtin_amdgcn_mfma_f32_32x32x16_bf16(v1, pf, O1, 0, 0, 0);
            }
        }
        if (more) AT_WRITE((j + 1) & 1);
        if (lane == 0) flags[(j & 1) * 4 + w] = wdone ? 1u : 0u;
        __syncthreads();
        { const LAS unsigned* fl = flags + (j & 1) * 4; const unsigned f = fl[0] & fl[1] & fl[2] & fl[3]; if (f) break; }
    }
    float inv = 1.0f;
    if (TYPE == 0) { const float l = lsum + __shfl_xor(lsum, 32); inv = 1.0f / l; }
    const bool qvalid = meta_unit ? (w == 0 && ql < 16) : true;
    if (qvalid) {
        bf16_t* op = Oo + (size_t)qrow * 512 + h * 64 + 4 * hi;
#pragma unroll
        for (int g = 0; g < 4; ++g) {
            *(u32x2*)(op + 8 * g) = (u32x2){pk_bf16(O0[4 * g] * inv, O0[4 * g + 1] * inv), pk_bf16(O0[4 * g + 2] * inv, O0[4 * g + 3] * inv)};
            *(u32x2*)(op + 32 + 8 * g) = (u32x2){pk_bf16(O1[4 * g] * inv, O1[4 * g + 1] * inv), pk_bf16(O1[4 * g + 2] * inv, O1[4 * g + 3] * inv)};
        }
    }
    __syncthreads();
#undef AT_LOAD
#undef AT_WRITE
}

__device__ __forceinline__ void phase2(const Params& p, LAS char* lds) {
    unsigned* ctr = (unsigned*)(p.ws + WS_CTL);
    LAS unsigned* shu = (LAS unsigned*)(lds + 2 * AT_STAGE + 64);
    constexpr int NU = 2048 + 32;
    const int G = gridDim.x;
    for (int it = blockIdx.x; it < NU; it += G) {
        int u = it;
        if (it < 1024 && (1024 % (2 * G)) == 0) { const int rnd = it / G, pos = it - rnd * G; u = (rnd & 1) ? ((rnd + 1) * G - 1 - pos) : it; }
        if (u < 1024) attn_unit<0>(lds, p, (u & 15) >> 3, u & 7, 63 - (u >> 4));
        else if (u < 2048) { const int v = u - 1024; attn_unit<1>(lds, p, (v & 15) >> 3, v & 7, 63 - (v >> 4)); }
        else if (u < 2064) { const int v = u - 2048; attn_unit<0>(lds, p, v >> 3, v & 7, -1); }
        else { const int v = u - 2064; attn_unit<1>(lds, p, v >> 3, v & 7, -1); }
    }
}

__device__ __forceinline__ void phase3a(const Params& p, LAS char* lds) {
    unsigned char* ws = p.ws;
    const int lane = threadIdx.x & 63, w = wave_id(), wr = w >> 1, wc = w & 1;
    const bf16_t* oa = (const bf16_t*)(ws + WS_A); const bf16_t* ob = oa + (size_t)M * 512;
    const bf16_t* ga = (const bf16_t*)(ws + WS_B); const bf16_t* gb = ga + (size_t)M * 1024;
    bf16_t* gated = (bf16_t*)(ws + WS_GATED);
    for (int it = 0;; ++it) {
        int tm, tn; const int st = tile_at(it, 129, 8, tm, tn); if (st == 0) break; if (st == 2) continue;
        const int row0 = tm * 128, col0 = tn * 128;
        f32x4 acc[4][4]; zero_acc(acc);
        gemm_main<true>(lds, oa + (size_t)row0 * 512, 512, (const bf16_t*)(ws + WS_BTOF) + (size_t)col0 * 512, 512, 8, acc);
#pragma unroll
        for (int m = 0; m < 4; ++m) {
            const int row = row0 + wr * 64 + m * 16 + (lane & 15);
#pragma unroll
            for (int n = 0; n < 4; ++n) {
                const int col = col0 + wc * 64 + n * 16 + (lane >> 4) * 4;
                const u32x2 a = *(const u32x2*)(ga + (size_t)row * 1024 + col);
                const f32x4 x = acc[m][n];
                *(u32x2*)(gated + (size_t)row * 1024 + col) = (u32x2){pk_bf16(bf_lo(a[0]) * x[0], bf_hi(a[0]) * x[1]), pk_bf16(bf_lo(a[1]) * x[2], bf_hi(a[1]) * x[3])};
            }
        }
        zero_acc(acc);
        gemm_main<true>(lds, ob + (size_t)row0 * 512, 512, (const bf16_t*)(ws + WS_BTOS) + (size_t)col0 * 512, 512, 8, acc);
#pragma unroll
        for (int m = 0; m < 4; ++m) {
            const int row = row0 + wr * 64 + m * 16 + (lane & 15);
#pragma unroll
            for (int n = 0; n < 4; ++n) {
                const int col = col0 + wc * 64 + n * 16 + (lane >> 4) * 4;
                const u32x2 b = *(const u32x2*)(gb + (size_t)row * 1024 + col);
                const f32x4 y = acc[m][n]; const u32x2 q = *(const u32x2*)(gated + (size_t)row * 1024 + col);
                const float o0 = bf_lo(q[0]) + bf_lo(b[0]) * y[0], o1 = bf_hi(q[0]) + bf_hi(b[0]) * y[1];
                const float o2 = bf_lo(q[1]) + bf_lo(b[1]) * y[2], o3 = bf_hi(q[1]) + bf_hi(b[1]) * y[3];
                *(u32x2*)(gated + (size_t)row * 1024 + col) = (u32x2){pk_bf16(o0, o1), pk_bf16(o2, o3)};
            }
        }
    }
}
__device__ __forceinline__ void epi_store_ss(const f32x4 (&acc)[4][4], bf16_t* out, int ldo, int orow0, int col0, float* ssp, int ssrow0, int wr, int wc, int lane) {
#pragma unroll
    for (int m = 0; m < 4; ++m) {
        const int rl = wr * 64 + m * 16 + (lane & 15);
        float s = 0.f;
#pragma unroll
        for (int n = 0; n < 4; ++n) {
            const int col = col0 + wc * 64 + n * 16 + (lane >> 4) * 4;
            const f32x4 v = acc[m][n];
            s += v[0] * v[0] + v[1] * v[1] + v[2] * v[2] + v[3] * v[3];
            *(u32x2*)(out + (size_t)(orow0 + rl) * ldo + col) = (u32x2){pk_bf16(v[0], v[1]), pk_bf16(v[2], v[3])};
        }
#if 1
        s += __shfl_xor(s, 16); s += __shfl_xor(s, 32);
        if (lane < 16) ssp[(size_t)((col0 >> 7) * 2 + wc) * M + ssrow0 + rl] = s;
#endif
    }
}
__device__ __forceinline__ void phase3b(const Params& p, LAS char* lds) {
    unsigned char* ws = p.ws;
    const int lane = threadIdx.x & 63, w = wave_id(), wr = w >> 1, wc = w & 1;
    const bf16_t* gated = (const bf16_t*)(ws + WS_GATED); bf16_t* mixed = (bf16_t*)(ws + WS_MIXED);
    for (int it = 0;; ++it) {
        int tm, tn; const int st = tile_at(it, 129, 8, tm, tn); if (st == 0) break; if (st == 2) continue;
        const int row0 = tm * 128, col0 = tn * 128;
        f32x4 acc[4][4]; zero_acc(acc);
        gemm_main<true>(lds, gated + (size_t)row0 * 1024, 1024, (const bf16_t*)(ws + WS_BTOUT) + (size_t)col0 * 1024, 1024, 16, acc);
        epi_store_ss(acc, mixed, 1024, row0, col0, (float*)(ws + WS_SSP2), row0, wr, wc, lane);
    }
}
__device__ __forceinline__ void phase3c(const Params& p) {
    unsigned char* ws = p.ws;
    const int lane = threadIdx.x & 63, w = wave_id();
    const bf16_t* mixed = (const bf16_t*)(ws + WS_MIXED); bf16_t* hb = (bf16_t*)(ws + WS_A);
    const float* ssp2 = (const float*)(ws + WS_SSP2); float* r2 = (float*)(ws + WS_R2);
    const float* g1 = p.gains + D;
    for (int r_ = blockIdx.x * 32 + w; r_ < M; r_ += (r_ & 31) < 28 ? 4 : gridDim.x * 32 - 28) {
        const int r = r_;
        if (r >= MV) continue;
        const float* src = r < MX ? p.x + (size_t)r * D : p.meta + (size_t)((r - MX) & 15) * D;
        float sq = lane < 16 ? ssp2[(size_t)lane * M + r] : 0.f;
        sq = wave_sum(sq);
        const float a = 1.0f / sqrtf(sq * (1.0f / D) + EPS);
        float ss = 0.f;
#pragma unroll
        for (int i = 0; i < 4; ++i) {
            const int col = lane * 4 + 256 * i;
            const f32x4 v = *(const f32x4*)(src + col), g = *(const f32x4*)(g1 + col);
            const u32x2 mx = *(const u32x2*)(mixed + (size_t)r * D + col);
            f32x4 hh;
            hh[0] = v[0] + bf_lo(mx[0]) * a * g[0]; hh[1] = v[1] + bf_hi(mx[0]) * a * g[1];
            hh[2] = v[2] + bf_lo(mx[1]) * a * g[2]; hh[3] = v[3] + bf_hi(mx[1]) * a * g[3];
            ss += hh[0] * hh[0] + hh[1] * hh[1] + hh[2] * hh[2] + hh[3] * hh[3];
            *(u32x2*)(hb + (size_t)r * D + col) = (u32x2){pk_bf16(hh[0], hh[1]), pk_bf16(hh[2], hh[3])};
            if (r < MX) *(f32x4*)(p.out + (size_t)r * D + col) = hh;
        }
        ss = wave_sum(ss);
        if (lane == 0) r2[r] = 1.0f / sqrtf(ss * (1.0f / D) + EPS);
    }
}
constexpr int UST = 272;
__device__ __forceinline__ f32x4 unpack4(const u32x2 u) { return (f32x4){bf_lo(u[0]), bf_hi(u[0]), bf_lo(u[1]), bf_hi(u[1])}; }
struct ConvW { f32x4 w0g, w1g, w2g, bg, w0v, w1v, w2v, bv; };
__device__ __forceinline__ ConvW load_convw(const Params& p, int c) {
    ConvW q;
    q.w0g = *(const f32x4*)(p.conv_w + c); q.w1g = *(const f32x4*)(p.conv_w + NUP + c); q.w2g = *(const f32x4*)(p.conv_w + 2 * NUP + c); q.bg = *(const f32x4*)(p.conv_b + c);
    q.w0v = *(const f32x4*)(p.conv_w + DFF + c); q.w1v = *(const f32x4*)(p.conv_w + NUP + DFF + c); q.w2v = *(const f32x4*)(p.conv_w + 2 * NUP + DFF + c); q.bv = *(const f32x4*)(p.conv_b + DFF + c);
    return q;
}
__device__ __forceinline__ u32x2 conv_gelu4(const ConvW& q, const f32x4 g2, const f32x4 g1, const f32x4 g0, const f32x4 v2, const f32x4 v1, const f32x4 v0) {
    float o[4];
#pragma unroll
    for (int e = 0; e < 4; ++e) {
        const float ug = q.bg[e] + q.w0g[e] * g2[e] + q.w1g[e] * g1[e] + q.w2g[e] * g0[e];
        const float uv = q.bv[e] + q.w0v[e] * v2[e] + q.w1v[e] * v1[e] + q.w2v[e] * v0[e];
        const float t = 0.7978845608028654f * (ug + 0.044715f * ug * ug * ug);
        o[e] = ug * rcp(1.0f + ex2(-2.0f * LOG2E * t)) * uv;
    }
    return (u32x2){pk_bf16(o[0], o[1]), pk_bf16(o[2], o[3])};
}
__device__ __forceinline__ void phase4(const Params& p, LAS char* lds) {
    unsigned char* ws = p.ws;
    const int tid = threadIdx.x, lane = tid & 63, w = wave_id(), wr = w >> 1, wc = w & 1;
    const bf16_t* hb = (const bf16_t*)(ws + WS_A); const bf16_t* Bt = (const bf16_t*)(ws + WS_BTUP);
    const float* r2 = (const float*)(ws + WS_R2);
    bf16_t* act = (bf16_t*)(ws + WS_ACT); bf16_t* hal = (bf16_t*)(ws + WS_HAL);
    for (int it = 0;; ++it) {
        int tm, tn; int st = tile_at(it, 128, 44, tm, tn);
        if (st == 0) { if (it < (1 << 20) && (int)blockIdx.x < 44) { tm = 128; tn = blockIdx.x; it = 1 << 20; st = 1; } else break; }
        if (st == 2) continue;
        const bool mt = tm == 128; const int row0 = mt ? MX : tm * 128, col0 = tn * 128;
        f32x4 acc[4][4]; zero_acc(acc);
        gemm_main<true>(lds, hb + (size_t)row0 * D, D, Bt + (size_t)col0 * D, D, 16, acc);
#pragma unroll
        for (int m = 0; m < 4; ++m) {
            const int rl = wr * 64 + m * 16 + (lane & 15); const float rs = r2[row0 + rl];
#pragma unroll
            for (int n = 0; n < 4; ++n) {
                const int cl = wc * 64 + n * 16 + (lane >> 4) * 4; const f32x4 v = acc[m][n] * rs;
                *(LAS u32x2*)(lds + rl * UST + cl * 2) = (u32x2){pk_bf16(v[0], v[1]), pk_bf16(v[2], v[3])};
            }
        }
        __syncthreads();
        if (!mt) {
            const int cg = tid & 15, rb = tid >> 4, c = tn * 64 + cg * 4;
            const ConvW q = load_convw(p, c);
            const int hr = rb == 0 ? 0 : rb * 8 - 2;
            f32x4 g2 = unpack4(*(const LAS u32x2*)(lds + hr * UST + cg * 8)), v2 = unpack4(*(const LAS u32x2*)(lds + hr * UST + 128 + cg * 8));
            f32x4 g1 = unpack4(*(const LAS u32x2*)(lds + (hr + 1) * UST + cg * 8)), v1 = unpack4(*(const LAS u32x2*)(lds + (hr + 1) * UST + 128 + cg * 8));
            for (int r = hr + 2; r < rb * 8 + 8; ++r) {
                const f32x4 g0 = unpack4(*(const LAS u32x2*)(lds + r * UST + cg * 8)), v0 = unpack4(*(const LAS u32x2*)(lds + r * UST + 128 + cg * 8));
                *(u32x2*)(act + (size_t)(row0 + r) * DFF + c) = conv_gelu4(q, g2, g1, g0, v2, v1, v0);
                g2 = g1; g1 = g0; v2 = v1; v1 = v0;
            }
            if (tid < 64) { const int qq = tid >> 4, ch = tid & 15, rl = qq < 2 ? qq : 124 + qq;
                *(u32x4*)(hal + ((size_t)tm * 4 + qq) * NUP + col0 + ch * 8) = *(const LAS u32x4*)(lds + rl * UST + ch * 16); }
        } else {
            if (tid < 64) { const int qq = tid >> 4, ch = tid & 15, rl = (qq >> 1) * 16 + 14 + (qq & 1);
                *(u32x4*)(hal + ((size_t)(128 + (qq >> 1)) * 4 + 2 + (qq & 1)) * NUP + col0 + ch * 8) = *(const LAS u32x4*)(lds + rl * UST + ch * 16); }
        }
        __syncthreads();
    }
}
__device__ __forceinline__ void phase_fix(const Params& p) {
    unsigned char* ws = p.ws;
    const bf16_t* hal = (const bf16_t*)(ws + WS_HAL); bf16_t* act = (bf16_t*)(ws + WS_ACT);
    constexpr int NCG = DFF / 4;
    for (int it = blockIdx.x * NTHREADS + threadIdx.x; it < 128 * NCG; it += gridDim.x * NTHREADS) {
        const int tmg = it / NCG, c = (it % NCG) * 4, colg = (c >> 6) * 128 + (c & 63), colv = colg + 64;
        const bf16_t* own = hal + (size_t)tmg * 4 * NUP;
        const bf16_t* prv = hal + (size_t)((tmg & 63) ? tmg - 1 : 128 + (tmg >> 6)) * 4 * NUP;
        const ConvW q = load_convw(p, c);
        const f32x4 pg2 = unpack4(*(const u32x2*)(prv + 2 * NUP + colg)), pv2 = unpack4(*(const u32x2*)(prv + 2 * NUP + colv));
        const f32x4 pg3 = unpack4(*(const u32x2*)(prv + 3 * NUP + colg)), pv3 = unpack4(*(const u32x2*)(prv + 3 * NUP + colv));
        const f32x4 og0 = unpack4(*(const u32x2*)(own + colg)), ov0 = unpack4(*(const u32x2*)(own + colv));
        const f32x4 og1 = unpack4(*(const u32x2*)(own + NUP + colg)), ov1 = unpack4(*(const u32x2*)(own + NUP + colv));
        *(u32x2*)(act + (size_t)(tmg * 128) * DFF + c) = conv_gelu4(q, pg2, pg3, og0, pv2, pv3, ov0);
        *(u32x2*)(act + (size_t)(tmg * 128 + 1) * DFF + c) = conv_gelu4(q, pg3, og0, og1, pv3, ov0, ov1);
    }
}
__device__ __forceinline__ void phase6(const Params& p, LAS char* lds) {
    unsigned char* ws = p.ws;
    const int lane = threadIdx.x & 63, w = wave_id(), wr = w >> 1, wc = w & 1;
    const bf16_t* act = (const bf16_t*)(ws + WS_ACT); bf16_t* ffn = (bf16_t*)(ws + WS_FFN);
    for (int it = 0;; ++it) {
        int tm, tn; const int st = tile_at(it, 128, 8, tm, tn); if (st == 0) break; if (st == 2) continue;
        const int col0 = tn * 128;
        f32x4 acc[4][4]; zero_acc(acc);
        gemm_main<true>(lds, act + (size_t)(tm * 128) * DFF, DFF, (const bf16_t*)(ws + WS_BTDN) + (size_t)col0 * DFF, DFF, 44, acc);
        epi_store_ss(acc, ffn, 1024, tm * 128, col0, (float*)(ws + WS_SSP4), tm * 128, wr, wc, lane);
    }
}
__device__ __forceinline__ void phase7(const Params& p) {
    unsigned char* ws = p.ws;
    const bf16_t* ffn = (const bf16_t*)(ws + WS_FFN); const float* ssp4 = (const float*)(ws + WS_SSP4); const float* g3 = p.gains + 3 * D;
    for (int it = blockIdx.x * NTHREADS + threadIdx.x; it < MX * 256; it += gridDim.x * NTHREADS) {
        const int row = it >> 8, col = (it & 255) * 4;
        float sq = 0.f;
#pragma unroll
        for (int sl = 0; sl < 16; ++sl) sq += ssp4[(size_t)sl * M + row];
        const float a = 1.0f / sqrtf(sq * (1.0f / D) + EPS);
        const f32x4 hh = *(const f32x4*)(p.out + (size_t)row * D + col), g = *(const f32x4*)(g3 + col);
        const u32x2 f = *(const u32x2*)(ffn + (size_t)row * D + col);
        f32x4 o;
        o[0] = hh[0] + bf_lo(f[0]) * a * g[0]; o[1] = hh[1] + bf_hi(f[0]) * a * g[1];
        o[2] = hh[2] + bf_lo(f[1]) * a * g[2]; o[3] = hh[3] + bf_hi(f[1]) * a * g[3];
        *(f32x4*)(p.out + (size_t)row * D + col) = o;
    }
}


#ifndef DUMP
#define DUMP 0
#endif
__device__ __forceinline__ void phase_dump(const Params& p) {
    unsigned char* ws = p.ws;
    const bf16_t* s0; const bf16_t* s1; int ld;
    if (DUMP == 1) { s0 = (const bf16_t*)(ws + WS_B); s1 = s0 + 512; ld = 1024; }
    else if (DUMP == 2) { s0 = (const bf16_t*)(ws + WS_QF); s1 = (const bf16_t*)(ws + WS_KF); ld = 512; }
    else if (DUMP == 3) { s0 = (const bf16_t*)(ws + WS_A); s1 = s0 + (size_t)M * 512; ld = 512; }
    else if (DUMP == 4) { s0 = (const bf16_t*)(ws + WS_GATED); s1 = s0 + 512; ld = 1024; }
    else if (DUMP == 8) { s0 = (const bf16_t*)(ws + WS_A); s1 = s0 + 512; ld = 1024; }
    else if (DUMP == 9) { s0 = (const bf16_t*)(ws + WS_ACT) + 1024; s1 = (const bf16_t*)(ws + WS_ACT) + 2304 - 512 + 512; ld = DFF; }
    else if (DUMP == 10) { s0 = (const bf16_t*)(ws + WS_FFN); s1 = s0 + 512; ld = 1024; }
    else if (DUMP == 6) { s0 = (const bf16_t*)(ws + WS_QS); s1 = (const bf16_t*)(ws + WS_KS); ld = 512; }
    else { s0 = (const bf16_t*)(ws + WS_MIXED); s1 = s0 + 512; ld = 1024; }
    for (int it = blockIdx.x * NTHREADS + threadIdx.x; it < MX * 1024; it += gridDim.x * NTHREADS) {
        const int row = it >> 10, col = it & 1023;
        if (DUMP >= 9 && row >= 8192) { p.out[it] = 0.f; continue; }
        const bf16_t v = col < 512 ? s0[(size_t)row * ld + col] : s1[(size_t)row * ld + col - 512];
        p.out[it] = __uint_as_float((unsigned)v << 16);
    }
}

__device__ __forceinline__ void l2_scrub(const Params& p) {
    const f32x4* src = (const f32x4*)p.x + (size_t)(blockIdx.x & 511) * 8192;
    f32x4 a = (f32x4){0.f, 0.f, 0.f, 0.f};
    for (int i = threadIdx.x; i < 8192; i += NTHREADS) a += src[i];
    if (a[0] + a[1] + a[2] + a[3] == 1.2345e-30f) ((float*)(p.ws + WS_CTL))[32 + (threadIdx.x & 7)] = a[0];
}


#define XB_TMO      128
#define XB_XCNT(j)  (256  + 64 * (j))
#define XB_XSUB(j)  (1280 + 64 * (j))
#define XB_XGEN(j)  (2304 + 64 * (j))
#define XB_TOP      3328
#define XB_TOPGEN   3392
#define XCD_BAR_WORDS 3456
#define XB_SPIN_CAP (1u << 18)
__device__ __forceinline__ unsigned xb_ld(unsigned* p)              { return __hip_atomic_load(p, __ATOMIC_RELAXED, __HIP_MEMORY_SCOPE_AGENT); }
__device__ __forceinline__ unsigned xb_add(unsigned* p, unsigned v) { return __hip_atomic_fetch_add(p, v, __ATOMIC_RELAXED, __HIP_MEMORY_SCOPE_AGENT); }
__device__ __forceinline__ unsigned xb_xcc_id() { return (unsigned)__builtin_amdgcn_s_getreg((3 << 11) | 20) & 0xFu; }
#define XB_SPIN(cond, bar) do { unsigned _sp = 0; while (cond) { __builtin_amdgcn_s_sleep(1); \
    if ((++_sp & 255u) == 0u) { if (xb_ld(&(bar)[XB_TMO])) break; if (_sp > XB_SPIN_CAP) { atomicAdd(&(bar)[XB_TMO], 1u); break; } } } } while (0)
struct XcdBarrier { unsigned* bar; unsigned x; volatile LAS unsigned* st; };
__device__ __forceinline__ XcdBarrier xcd_barrier_post(unsigned* bar, volatile LAS unsigned* st) {
    XcdBarrier b; b.bar = bar; b.x = xb_xcc_id(); b.st = st;
    if (threadIdx.x == 0) (void)xb_add(&bar[XB_XCNT(b.x)], 1u);
    return b;
}
__device__ __forceinline__ void xcd_barrier_complete(unsigned* bar, unsigned x, unsigned& nloc, unsigned& nx) {
    const unsigned G = gridDim.x * gridDim.y * gridDim.z;
    unsigned sum, cnt, mine, sp = 0u;
    for (;;) {
        sum = 0u; cnt = 0u; mine = 0u;
#pragma unroll
        for (unsigned j = 0; j < 16; ++j) { const unsigned c = xb_ld(&bar[XB_XCNT(j)]); sum += c; cnt += (c > 0u) ? 1u : 0u; mine = (j == x) ? c : mine; }
        if (sum == G) break;
        __builtin_amdgcn_s_sleep(1);
        if ((++sp & 255u) == 0u) { if (xb_ld(&bar[XB_TMO])) break; if (sp > XB_SPIN_CAP) { atomicAdd(&bar[XB_TMO], 1u); break; } }
    }
    nloc = mine > 0u ? mine : 1u; nx = cnt > 0u ? cnt : 1u;
}
__device__ __forceinline__ void xcd_barrier(const XcdBarrier& b) {
    asm volatile("s_waitcnt vmcnt(0)" ::: "memory");
    __syncthreads();
    if (threadIdx.x == 0) {
        unsigned* bar = b.bar;
        __builtin_amdgcn_s_waitcnt(0);
        unsigned nloc = b.st[0], nx = b.st[1];
        if (nloc == 0u) { xcd_barrier_complete(bar, b.x, nloc, nx); b.st[0] = nloc; b.st[1] = nx; }
        const unsigned old = xb_add(&bar[XB_XSUB(b.x)], 1u);
        const unsigned gen = old / nloc;
        if (old + 1u == (gen + 1u) * nloc) {
            __builtin_amdgcn_fence(__ATOMIC_RELEASE, "agent");
            asm volatile("s_waitcnt vmcnt(0)" ::: "memory");
            const unsigned og = xb_add(&bar[XB_TOP], 1u);
            const unsigned tg = og / nx;
            if (og + 1u == (tg + 1u) * nx) xb_add(&bar[XB_TOPGEN], 1u);
            else XB_SPIN(xb_ld(&bar[XB_TOPGEN]) == tg, bar);
            __builtin_amdgcn_fence(__ATOMIC_ACQUIRE, "agent");
            xb_add(&bar[XB_XGEN(b.x)], 1u);
            asm volatile("s_waitcnt vmcnt(0)" ::: "memory");
        } else {
            XB_SPIN(xb_ld(&bar[XB_XGEN(b.x)]) == gen, bar);
            __builtin_amdgcn_fence(__ATOMIC_ACQUIRE, "agent");
            asm volatile("s_waitcnt vmcnt(0)" ::: "memory");
        }
    }
    __syncthreads();
}

__device__ __forceinline__ void my_grid_sync(const Params& p, unsigned& target) {
    unsigned* bar = (unsigned*)(p.ws + WS_CTL) + 16;
    asm volatile("s_waitcnt vmcnt(0)" ::: "memory");
    __syncthreads();
    target += gridDim.x;
    if (threadIdx.x == 0) {
        __builtin_amdgcn_fence(__ATOMIC_RELEASE, "agent");
        asm volatile("s_waitcnt vmcnt(0)" ::: "memory");
        __hip_atomic_fetch_add(bar, 1u, __ATOMIC_RELAXED, __HIP_MEMORY_SCOPE_AGENT);
        while (__hip_atomic_load(bar, __ATOMIC_RELAXED, __HIP_MEMORY_SCOPE_AGENT) < target) __builtin_amdgcn_s_sleep(2);
        __builtin_amdgcn_fence(__ATOMIC_ACQUIRE, "agent");
        asm volatile("s_waitcnt vmcnt(0)" ::: "memory");
    }
    __syncthreads();
}
__global__ void __launch_bounds__(NTHREADS, 2) fwd_kernel(Params p) {
    extern __shared__ __attribute__((aligned(16))) unsigned char lds_raw[];
    LAS char* lds = (LAS char*)lds_raw;
    cg::grid_group grid = cg::this_grid();
#define IN(k) (p.ph_lo <= (k) && (k) < p.ph_hi)
#define SEAM(k) do { if (IN(k) && IN((k) + 1)) { if (p.ph_hi > 1000) grid.sync(); xcd_barrier(xbar); } } while (0)
    volatile LAS unsigned* xst = (volatile LAS unsigned*)(lds + 65536);
    if (threadIdx.x < 4) xst[threadIdx.x] = 0u;
    __syncthreads();
    const XcdBarrier xbar = xcd_barrier_post((unsigned*)(p.ws + WS_XBAR), xst);
    if (IN(0)) phase0(p, lds);
    SEAM(0);
    if (IN(1)) phase1(p, lds);
    SEAM(1);
    if (IN(2)) phase2(p, lds);
    SEAM(2);
    if (IN(3)) phase3a(p, lds);
    SEAM(3);
    if (IN(4)) phase3b(p, lds);
    SEAM(4);
    if (IN(5)) phase3c(p);
    SEAM(5);
    if (IN(6)) phase4(p, lds);
    SEAM(6);
    if (IN(7)) phase_fix(p);
    SEAM(7);
    if (IN(8)) phase6(p, lds);
    SEAM(8);
    if (IN(9)) phase7(p);
#undef IN
#undef SEAM
}


__global__ void ab_save(const unsigned char* ws, float* out) {
    const u32x4* src = (const u32x4*)(ws + AB_SRC); u32x4* dst = (u32x4*)((unsigned char*)out + (size_t)32 * MiB);
    for (size_t i = blockIdx.x * (size_t)blockDim.x + threadIdx.x; i < (size_t)AB_BYTES / 16; i += (size_t)gridDim.x * blockDim.x) dst[i] = src[i];
}
__global__ void ab_diff(const unsigned char* ws, float* out) {
    const bf16_t* src = (const bf16_t*)(ws + AB_SRC); const bf16_t* sav = (const bf16_t*)((unsigned char*)out + (size_t)32 * MiB);
    for (size_t i = blockIdx.x * (size_t)blockDim.x + threadIdx.x; i < (size_t)8192 * 1024; i += (size_t)gridDim.x * blockDim.x) {
        if (i >= (size_t)AB_BYTES / 2) { out[i] = 0.f; continue; }
        out[i] = src[i] != sav[i] ? 1000.0f : 0.f;
    }
}
__global__ void ab_zero(float* out) {
    for (size_t i = blockIdx.x * (size_t)blockDim.x + threadIdx.x; i < (size_t)8192 * 1024; i += (size_t)gridDim.x * blockDim.x) out[(size_t)8192 * 1024 + i] = 0.f;
}
extern "C" void kernel_launch(void* const* d_in, const int* in_sizes, int n_in, void* d_out, int out_size, void* d_ws, size_t ws_size, hipStream_t stream) {
    static int grid_blocks = 0;
    if (grid_blocks == 0) {
        if (n_in != 12 || ws_size < WS_END) { fprintf(stderr, "kernel_launch: unexpected n_in %d or ws_size %zu (need %zu)\n", n_in, ws_size, (size_t)WS_END); grid_blocks = -1; return; }
        int dev = 0, cus = 0, per_cu = 0;
        (void)hipGetDevice(&dev);
        (void)hipDeviceGetAttribute(&cus, hipDeviceAttributeMultiprocessorCount, dev);
        (void)hipFuncSetAttribute((const void*)fwd_kernel, hipFuncAttributeMaxDynamicSharedMemorySize, LDS_BYTES);
        (void)hipOccupancyMaxActiveBlocksPerMultiprocessor(&per_cu, (const void*)fwd_kernel, NTHREADS, LDS_BYTES);
        if (per_cu < 1) per_cu = 1;
        if (per_cu > 2) per_cu = 2;
        grid_blocks = cus * per_cu;
        (void)hipGetLastError();
    }
    if (grid_blocks < 0) return;
    Params p{};
    p.x = (const float*)d_in[0]; p.meta = (const float*)d_in[1]; p.gains = (const float*)d_in[2]; p.w_in = (const float*)d_in[3];
    p.b_forget = (const float*)d_in[4]; p.w_o_fox = (const float*)d_in[5]; p.w_o_sb = (const float*)d_in[6]; p.w_out = (const float*)d_in[7];
    p.w_up = (const float*)d_in[8]; p.conv_w = (const float*)d_in[9]; p.conv_b = (const float*)d_in[10]; p.w_down = (const float*)d_in[11];
    p.out = (float*)d_out; p.ws = (unsigned char*)d_ws;
#if SINGLE_LAUNCH
    (void)hipMemsetAsync((unsigned char*)d_ws + WS_CTL, 0, 256, stream);
    (void)hipMemsetAsync((unsigned char*)d_ws + WS_XBAR, 0, XCD_BAR_WORDS * 4, stream);
    p.ph_lo = 0; p.ph_hi = NPHASE;
    void* args[] = {&p};
    hipError_t e = hipLaunchCooperativeKernel((const void*)fwd_kernel, dim3(grid_blocks), dim3(NTHREADS), args, LDS_BYTES, stream);
    if (e != hipSuccess) fprintf(stderr, "cooperative launch failed: %s (grid %d)\n", hipGetErrorString(e), grid_blocks);
#else
#ifndef STOP_AT
#define STOP_AT NPHASE
#endif
    for (int k = 0; k < STOP_AT; ++k) {
        p.ph_lo = k; p.ph_hi = k + 1;
        hipLaunchKernelGGL(fwd_kernel, dim3(grid_blocks), dim3(NTHREADS), LDS_BYTES, stream, p);
    }
#if ABTEST
    ab_save<<<1024, 256, 0, stream>>>(p.ws, p.out);
    for (int k = AB_FROM; k < STOP_AT; ++k) {
        p.ph_lo = k; p.ph_hi = k + 1;
        hipLaunchKernelGGL(fwd_kernel, dim3(grid_blocks), dim3(NTHREADS), LDS_BYTES, stream, p);
    }
    ab_diff<<<1024, 256, 0, stream>>>(p.ws, p.out);
    ab_zero<<<1024, 256, 0, stream>>>(p.out);
#endif

#endif
}
```

```cpp
#include <hip/hip_runtime.h>
#include <hip/hip_cooperative_groups.h>
#include <cstdio>
#include <cstdint>
namespace cg = cooperative_groups;

#define DUMP 0
#define ABTEST 0
#define AB_FROM 0
#define AB_SRC WS_SSP2
#define AB_BYTES (2 * MiB)
#ifndef SINGLE_LAUNCH
#define SINGLE_LAUNCH 1
#endif

#define LAS __attribute__((address_space(3)))
typedef unsigned short bf16_t;
typedef short bf16x8 __attribute__((ext_vector_type(8)));
typedef float f32x4 __attribute__((ext_vector_type(4)));
typedef float f32x16 __attribute__((ext_vector_type(16)));
typedef unsigned u32x4 __attribute__((ext_vector_type(4)));
typedef unsigned u32x2 __attribute__((ext_vector_type(2)));

constexpr int D = 1024, SEQ = 8192, NMETA = 16, NB = 2;
constexpr int MX = NB * SEQ;
constexpr int MV = MX + NB * NMETA;
constexpr int M = 16512;
constexpr int LPK = 8256;
constexpr int PROJW = 5128, NPROJ = 5120, DFF = 2816, NUP = 5632;
constexpr float EPS = 1e-6f;
constexpr float LOG2E = 1.4426950408889634f, LN2 = 0.6931471805599453f;
constexpr int NTHREADS = 256;
constexpr int LDS_BYTES = 65536 + 16;
constexpr int NPHASE = 10;

constexpr size_t MiB = 1u << 20;
constexpr size_t WS_CTL = 0;
constexpr size_t WS_R1 = 4096, WS_R2 = WS_R1 + 69632, WS_SS2 = WS_R2 + 69632, WS_SS4 = WS_SS2 + 69632;
constexpr size_t WS_LOGF = WS_SS4 + 69632, WS_CK = WS_LOGF + 528384, WS_UPMETA = WS_CK + 528384;
constexpr size_t WS_BTIN = 2 * MiB, WS_BTOF = WS_BTIN + 10 * MiB, WS_BTOS = WS_BTOF + 1 * MiB, WS_BTOUT = WS_BTOS + 1 * MiB,
                 WS_BTUP = WS_BTOUT + 2 * MiB, WS_BTDN = WS_BTUP + 11 * MiB;
constexpr size_t SZ_M1024 = (size_t)M * 1024 * 2, SZ_M512 = (size_t)M * 512 * 2;
constexpr size_t WS_A = 33 * MiB;
constexpr size_t WS_B = WS_A + SZ_M1024;
constexpr size_t WS_C = WS_B + 2 * SZ_M1024;
constexpr size_t WS_QF = WS_C, WS_KF = WS_QF + SZ_M512, WS_QS = WS_KF + SZ_M512, WS_KS = WS_QS + SZ_M512, WS_VFT = WS_KS + SZ_M512, WS_VST = WS_VFT + SZ_M512;
constexpr size_t WS_GATED = WS_C, WS_MIXED = WS_B + SZ_M1024;
constexpr size_t WS_ACT = WS_B;
constexpr size_t WS_FFN = WS_ACT + 132 * MiB;
constexpr size_t WS_SSP2 = 230 * MiB, WS_SSP4 = 232 * MiB;
constexpr size_t WS_HAL = 234 * MiB;
constexpr size_t WS_XBAR = 240 * MiB;
constexpr size_t WS_END = 241 * MiB;

struct Params {
    const float *x, *meta, *gains, *w_in, *b_forget, *w_o_fox, *w_o_sb, *w_out, *w_up, *conv_w, *conv_b, *w_down;
    float* out; unsigned char* ws; int ph_lo, ph_hi;
};

typedef __bf16 bf16x2_t __attribute__((ext_vector_type(2)));
__device__ __forceinline__ unsigned pk_bf16(float lo, float hi) { bf16x2_t v = {(__bf16)lo, (__bf16)hi}; return __builtin_bit_cast(unsigned, v); }
__device__ __forceinline__ float bf_lo(unsigned u) { return __uint_as_float(u << 16); }
__device__ __forceinline__ float bf_hi(unsigned u) { return __uint_as_float(u & 0xffff0000u); }
__device__ __forceinline__ float ex2(float x) { return __builtin_amdgcn_exp2f(x); }
__device__ __forceinline__ float lg2(float x) { return __builtin_amdgcn_logf(x); }
__device__ __forceinline__ float rcp(float x) { return __builtin_amdgcn_rcpf(x); }
__device__ __forceinline__ float sigmoidf_(float v) { return rcp(1.0f + ex2(-v * LOG2E)); }
__device__ __forceinline__ float wave_sum(float v) {
#pragma unroll
    for (int o = 32; o > 0; o >>= 1) v += __shfl_xor(v, o);
    return v;
}
__device__ __forceinline__ int wave_id() { return __builtin_amdgcn_readfirstlane((int)(threadIdx.x >> 6)); }

__device__ __forceinline__ void transpose_tile(LAS char* lds, const float* src, int ldsrc, int srccol, int k0, const float* gain, bf16_t* dst, int K, int n0) {
    LAS bf16_t* T = (LAS bf16_t*)lds;
    const int tid = threadIdx.x, r = tid >> 4, c4 = tid & 15;
#pragma unroll
    for (int p = 0; p < 4; ++p) {
        const int k = r + 16 * p;
        f32x4 v = *(const f32x4*)(src + (size_t)(k0 + k) * ldsrc + srccol + c4 * 4);
        const float g = gain ? gain[k0 + k] : 1.0f;
        const unsigned a = pk_bf16(v[0] * g, v[1] * g), b = pk_bf16(v[2] * g, v[3] * g);
        T[(c4 * 4 + 0) * 72 + k] = (bf16_t)(a & 0xffff); T[(c4 * 4 + 1) * 72 + k] = (bf16_t)(a >> 16);
        T[(c4 * 4 + 2) * 72 + k] = (bf16_t)(b & 0xffff); T[(c4 * 4 + 3) * 72 + k] = (bf16_t)(b >> 16);
    }
    __syncthreads();
    const int n = tid >> 2, kq = tid & 3;
    const u32x4 lo = *(LAS u32x4*)(T + n * 72 + kq * 16), hi = *(LAS u32x4*)(T + n * 72 + kq * 16 + 8);
    bf16_t* d = dst + (size_t)(n0 + n) * K + k0 + kq * 16;
    *(u32x4*)d = lo; *(u32x4*)(d + 8) = hi;
    __syncthreads();
}

__device__ __forceinline__ void phase0(const Params& p, LAS char* lds) {
    unsigned char* ws = p.ws;
    const int tid = threadIdx.x, lane = tid & 63, w = wave_id();
    LAS float* wfT = (LAS float*)lds;
    const float* g0 = p.gains;
    for (int idx = tid; idx < 8192; idx += NTHREADS) { const int h = idx & 7, k = idx >> 3; wfT[h * 1024 + k] = p.w_in[(size_t)k * PROJW + 1536 + h] * g0[k]; }
    __syncthreads();
    bf16_t* xb = (bf16_t*)(ws + WS_A);
    float* r1 = (float*)(ws + WS_R1);
    float* logf_ = (float*)(ws + WS_LOGF);
    for (int r_ = blockIdx.x * 32 + w; r_ < M; r_ += (r_ & 31) < 28 ? 4 : gridDim.x * 32 - 28) {
        const int r = r_;
        if (r >= MV) {
#pragma unroll
            for (int i = 0; i < 4; ++i) *(u32x2*)(xb + (size_t)r * D + lane * 4 + 256 * i) = (u32x2){0u, 0u};
            if (lane == 0) r1[r] = 0.f;
            continue;
        }
        const float* src = r < MX ? p.x + (size_t)r * D : p.meta + (size_t)((r - MX) & 15) * D;
        f32x4 v[4]; float ss = 0.f;
#pragma unroll
        for (int i = 0; i < 4; ++i) { v[i] = *(const f32x4*)(src + lane * 4 + 256 * i); ss += v[i][0] * v[i][0] + v[i][1] * v[i][1] + v[i][2] * v[i][2] + v[i][3] * v[i][3]; }
#pragma unroll
        for (int i = 0; i < 4; ++i) *(u32x2*)(xb + (size_t)r * D + lane * 4 + 256 * i) = (u32x2){pk_bf16(v[i][0], v[i][1]), pk_bf16(v[i][2], v[i][3])};
        ss = wave_sum(ss);
        const float rs = 1.0f / sqrtf(ss * (1.0f / D) + EPS);
        if (lane == 0) r1[r] = rs;
        float mine = 0.f;
#pragma unroll
        for (int h = 0; h < 8; ++h) {
            float a = 0.f;
#pragma unroll
            for (int i = 0; i < 4; ++i) { const f32x4 wv = *(LAS f32x4*)(wfT + h * 1024 + lane * 4 + 256 * i); a += v[i][0] * wv[0] + v[i][1] * wv[1] + v[i][2] * wv[2] + v[i][3] * wv[3]; }
            a = wave_sum(a);
            if (lane == h) mine = a;
        }
        if (lane < 8) {
            const float f = mine * rs + p.b_forget[lane];
            const float lf = fminf(f, 0.f) - log1pf(expf(-fabsf(f)));
            int b, kidx; if (r < MX) { b = r >> 13; kidx = r & 8191; } else { const int j = r - MX; b = j >> 4; kidx = 8192 + (j & 15); }
            logf_[(size_t)(b * 8 + lane) * LPK + kidx] = lf;
        }
    }
    __syncthreads();
    LAS char* tl = lds + 32768;
    const float* g2 = p.gains + 2 * D;
    constexpr int T_IN = 16 * 80, T_OF = 8 * 16, T_OS = 8 * 16, T_OUT = 16 * 16, T_UP = 16 * 88, T_DN = 44 * 16;
    constexpr int T_ALL = T_IN + T_OF + T_OS + T_OUT + T_UP + T_DN;
    for (int t = blockIdx.x; t < T_ALL; t += gridDim.x) {
        int u = t;
        if (u < T_IN) { const int nt = u % 80, kt = u / 80; const int sc = nt * 64 + (nt * 64 >= 1536 ? 8 : 0); transpose_tile(tl, p.w_in, PROJW, sc, kt * 64, g0, (bf16_t*)(ws + WS_BTIN), 1024, nt * 64); continue; }
        u -= T_IN;
        if (u < T_OF) { const int nt = u % 16, kt = u / 16; transpose_tile(tl, p.w_o_fox, 1024, nt * 64, kt * 64, nullptr, (bf16_t*)(ws + WS_BTOF), 512, nt * 64); continue; }
        u -= T_OF;
        if (u < T_OS) { const int nt = u % 16, kt = u / 16; transpose_tile(tl, p.w_o_sb, 1024, nt * 64, kt * 64, nullptr, (bf16_t*)(ws + WS_BTOS), 512, nt * 64); continue; }
        u -= T_OS;
        if (u < T_OUT) { const int nt = u % 16, kt = u / 16; transpose_tile(tl, p.w_out, 1024, nt * 64, kt * 64, nullptr, (bf16_t*)(ws + WS_BTOUT), 1024, nt * 64); continue; }
        u -= T_OUT;
        if (u < T_UP) { const int nt = u % 88, kt = u / 88; transpose_tile(tl, p.w_up, NUP, (nt & 1) * DFF + (nt >> 1) * 64, kt * 64, g2, (bf16_t*)(ws + WS_BTUP), 1024, nt * 64); continue; }
        u -= T_UP;
        { const int nt = u % 16, kt = u / 16; transpose_tile(tl, p.w_down, 1024, nt * 64, kt * 64, nullptr, (bf16_t*)(ws + WS_BTDN), DFF, nt * 64); }
    }
}

template <bool SWAP>
__device__ __forceinline__ void gemm_main(LAS char* lds, const bf16_t* Ag, int lda, const bf16_t* Bg, int ldb, int nk, f32x4 (&acc)[4][4], int mlim = 4) {
    const int tid = threadIdx.x, lane = tid & 63, w = wave_id(), wr = w >> 1, wc = w & 1;
    const int row_0 = w * 8 + (lane >> 3), c_0 = (lane & 7) ^ ((row_0 >> 1) & 7);
    const bf16_t* pa0 = Ag + (size_t)row_0 * lda + c_0 * 8; const bf16_t* pb0 = Bg + (size_t)row_0 * ldb + c_0 * 8;
    const size_t sa = (size_t)32 * lda, sb_ = (size_t)32 * ldb;
    const int swz = (lane >> 1) & 7;
    int aoff[2], boff[2];
#pragma unroll
    for (int kh = 0; kh < 2; ++kh) {
        aoff[kh] = (wr * 64 + (lane & 15)) * 128 + (((kh * 4 + (lane >> 4)) ^ swz) << 4);
        boff[kh] = 16384 + (wc * 64 + (lane & 15)) * 128 + (((kh * 4 + (lane >> 4)) ^ swz) << 4);
    }
#define GM_STAGE(s, kt) do { _Pragma("unroll") for (int i_ = 0; i_ < 4; ++i_) { \
        __builtin_amdgcn_global_load_lds((const unsigned*)(pa0 + i_ * sa + (kt) * 64), (LAS unsigned*)(lds + (s) * 32768 + (i_ * 4 + w) * 1024), 16, 0, 0); \
        __builtin_amdgcn_global_load_lds((const unsigned*)(pb0 + i_ * sb_ + (kt) * 64), (LAS unsigned*)(lds + (s) * 32768 + 16384 + (i_ * 4 + w) * 1024), 16, 0, 0); } } while (0)
    GM_STAGE(0, 0);
    for (int kt = 0; kt < nk; ++kt) {
        asm volatile("s_waitcnt vmcnt(0)" ::: "memory");
        __syncthreads();
        const int s = kt & 1;
        if (kt + 1 < nk) GM_STAGE(s ^ 1, kt + 1);
        bf16x8 af[4][2], bf[4][2];
#pragma unroll
        for (int kh = 0; kh < 2; ++kh) {
#pragma unroll
            for (int m = 0; m < 4; ++m) if (m < mlim) af[m][kh] = *(LAS bf16x8*)(lds + s * 32768 + aoff[kh] + m * 2048);
#pragma unroll
            for (int n = 0; n < 4; ++n) bf[n][kh] = *(LAS bf16x8*)(lds + s * 32768 + boff[kh] + n * 2048);
        }
        __builtin_amdgcn_s_setprio(1);
#pragma unroll
        for (int kh = 0; kh < 2; ++kh)
#pragma unroll
            for (int m = 0; m < 4; ++m) if (m < mlim) {
#pragma unroll
                for (int n = 0; n < 4; ++n)
                    acc[m][n] = SWAP ? __builtin_amdgcn_mfma_f32_16x16x32_bf16(bf[n][kh], af[m][kh], acc[m][n], 0, 0, 0)
                                     : __builtin_amdgcn_mfma_f32_16x16x32_bf16(af[m][kh], bf[n][kh], acc[m][n], 0, 0, 0);
            }
        __builtin_amdgcn_s_setprio(0);
    }
    __syncthreads();
#undef GM_STAGE
}
__device__ __forceinline__ void zero_acc(f32x4 (&acc)[4][4]) {
#pragma unroll
    for (int m = 0; m < 4; ++m)
#pragma unroll
        for (int n = 0; n < 4; ++n) acc[m][n] = (f32x4){0.f, 0.f, 0.f, 0.f};
}


__device__ __forceinline__ int tile_at(int it, int ntm, int ntn, int& tm, int& tn) {
    const int G = gridDim.x;
    if (G % 256 != 0) { const int t = it * G + blockIdx.x; if (t >= ntm * ntn) return 0; tm = t / ntn; tn = t % ntn; return 1; }
    const int xcd = blockIdx.x & 7, j = blockIdx.x >> 3, ppx = G >> 8;
    const int pcols = (ntn + 3) >> 2, prows = (ntm + 7) >> 3;
    const int patch = (it * ppx + (j >> 5)) * 8 + xcd;
    if (patch >= prows * pcols) return 0;
    const int wi = j & 31;
    tm = (patch / pcols) * 8 + (wi >> 2); tn = (patch % pcols) * 4 + (wi & 3);
    return (tm < ntm && tn < ntn) ? 1 : 2;
}
__device__ __forceinline__ void cumsum_block(const Params& p, LAS char* lds, int bh) {
    const float* lf = (const float*)(p.ws + WS_LOGF) + (size_t)bh * LPK; float* ck = (float*)(p.ws + WS_CK) + (size_t)bh * LPK;
    LAS float* sums = (LAS float*)lds;
    const int tid = threadIdx.x; constexpr int PER = 33, L = SEQ + NMETA;
    float loc = 0.f;
    for (int e = 0; e < PER; ++e) { const int t = tid * PER + e; if (t < L) loc += lf[t < 16 ? 8192 + t : t - 16]; }
    sums[tid] = loc;
    __syncthreads();
    float run = 0.f;
    for (int i = 0; i < tid; ++i) run += sums[i];
    for (int e = 0; e < PER; ++e) { const int t = tid * PER + e; if (t < L) { const int kx = t < 16 ? 8192 + t : t - 16; run += lf[kx]; ck[kx] = run * LOG2E; } }
    __syncthreads();
}

__device__ __forceinline__ void phase1(const Params& p, LAS char* lds) {
    unsigned char* ws = p.ws;
    if (blockIdx.x < 16) cumsum_block(p, lds, blockIdx.x);
    const int lane = threadIdx.x & 63, w = wave_id(), wr = w >> 1, wc = w & 1;
    const bf16_t* xb = (const bf16_t*)(ws + WS_A); const bf16_t* Bt = (const bf16_t*)(ws + WS_BTIN);
    const float* r1 = (const float*)(ws + WS_R1);
    constexpr int NTN = 40, NTM = 129;
    for (int it = 0;; ++it) {
        int tm, tn; int st = tile_at(it, NTM - 1, NTN, tm, tn);
        if (st == 0) { if (it < (1 << 20) && (int)blockIdx.x < NTN) { tm = NTM - 1; tn = blockIdx.x; it = 1 << 20; st = 1; } else break; }
        if (st == 2) continue;
        const int row0 = tm * 128, col0 = tn * 128; const int mlim = tm == NTM - 1 ? (wr == 0 ? 2 : 0) : 4;
        const bool vtile = (tn >= 8 && tn < 12) || (tn >= 20 && tn < 24);
        f32x4 acc[4][4]; zero_acc(acc);
        if (vtile) {
            gemm_main<false>(lds, xb + (size_t)row0 * D, D, Bt + (size_t)col0 * D, D, 16, acc, mlim);
            bf16_t* vT = (bf16_t*)(ws + (tn < 12 ? WS_VFT : WS_VST)); const int cb = tn < 12 ? 1024 : 2560;
            const int g = lane >> 4, gp = ((g & 1) << 1) | (g >> 1);
#pragma unroll
            for (int m = 0; m < 4; ++m) {
                const int rb = row0 + wr * 64 + m * 16; int b, kb16;
                if (rb < MX) { b = rb >> 13; kb16 = rb & 8191; } else { const int j = rb - MX; if (j >= 32) continue; b = j >> 4; kb16 = 8192; }
                const f32x4 rs = *(const f32x4*)(r1 + rb + g * 4);
#pragma unroll
                for (int n = 0; n < 4; ++n) {
                    const int dc = col0 + wc * 64 + n * 16 + (lane & 15) - cb, h = dc >> 6, d = dc & 63;
                    const f32x4 v = acc[m][n] * rs;
                    *(u32x2*)(vT + ((size_t)(b * 8 + h) * 64 + d) * LPK + kb16 + gp * 4) = (u32x2){pk_bf16(v[0], v[1]), pk_bf16(v[2], v[3])};
                }
            }
        } else {
            gemm_main<true>(lds, xb + (size_t)row0 * D, D, Bt + (size_t)col0 * D, D, 16, acc, mlim);
            bf16_t* dst; int ld, cb; float sc = 1.f; bool sg = false;
            if (tn < 4) { dst = (bf16_t*)(ws + WS_QF); ld = 512; cb = 0; sc = 0.125f * LOG2E; }
            else if (tn < 8) { dst = (bf16_t*)(ws + WS_KF); ld = 512; cb = 512; }
            else if (tn < 16) { dst = (bf16_t*)(ws + WS_QS); ld = 512; cb = 1536; sc = 0.125f; }
            else if (tn < 20) { dst = (bf16_t*)(ws + WS_KS); ld = 512; cb = 2048; }
            else if (tn < 32) { dst = (bf16_t*)(ws + WS_B); ld = 1024; cb = 3072; sg = true; }
            else { dst = (bf16_t*)(ws + WS_B + SZ_M1024); ld = 1024; cb = 4096; sg = true; }
            const bool kfox = tn >= 4 && tn < 8;
            float wmax = 0.f;
#pragma unroll
            for (int m = 0; m < 4; ++m) {
                const int row = row0 + wr * 64 + m * 16 + (lane & 15); const float rs = r1[row] * sc;
                float s2 = 0.f;
#pragma unroll
                for (int n = 0; n < 4; ++n) {
                    const int col = col0 + wc * 64 + n * 16 + (lane >> 4) * 4 - cb;
                    f32x4 v = acc[m][n] * rs;
                    if (sg) { v[0] = sigmoidf_(v[0]); v[1] = sigmoidf_(v[1]); v[2] = sigmoidf_(v[2]); v[3] = sigmoidf_(v[3]); }
                    s2 += v[0] * v[0] + v[1] * v[1] + v[2] * v[2] + v[3] * v[3];
                    *(u32x2*)(dst + (size_t)row * ld + col) = (u32x2){pk_bf16(v[0], v[1]), pk_bf16(v[2], v[3])};
                }
                if (kfox) { s2 += __shfl_xor(s2, 16); s2 += __shfl_xor(s2, 32); wmax = fmaxf(wmax, s2); }
            }
            if (kfox) {
#pragma unroll
                for (int o = 1; o < 16; o <<= 1) wmax = fmaxf(wmax, __shfl_xor(wmax, o));
                if (lane == 0) {
                    unsigned* km = (unsigned*)(ws + WS_CTL) + 32; const int head = (tn - 4) * 2 + wc; const unsigned bits = __float_as_uint(wmax);
                    if (row0 < MX) atomicMax(km + (row0 >> 13) * 8 + head, bits);
                    else { atomicMax(km + head, bits); atomicMax(km + 8 + head, bits); }
                }
            }
        }
    }
}

constexpr int AT_STAGE = 16640;
template <int TYPE>
__device__ __forceinline__ void attn_unit(LAS char* lds, const Params& p, int b, int h, int qb) {
    unsigned char* ws = p.ws;
    const int tid = threadIdx.x, lane = tid & 63, w = wave_id(), ql = lane & 31, hi = lane >> 5;
    const bf16_t* Q = (const bf16_t*)(ws + (TYPE == 0 ? WS_QF : WS_QS));
    const bf16_t* Kp = (const bf16_t*)(ws + (TYPE == 0 ? WS_KF : WS_KS));
    const bf16_t* VT = (const bf16_t*)(ws + (TYPE == 0 ? WS_VFT : WS_VST)) + (size_t)(b * 8 + h) * 64 * LPK;
    const float* cK = (const float*)(ws + WS_CK) + (size_t)(b * 8 + h) * LPK;
    bf16_t* Oo = (bf16_t*)(ws + WS_A + (TYPE == 0 ? 0 : SZ_M512));
    const bool meta_unit = qb < 0;
    const int qrow0 = meta_unit ? MX + 16 * b : b * SEQ + qb * 128;
    const int nt = meta_unit ? 1 : 2 * qb + 3;
    int qrow = qrow0 + 32 * w + ql; if (qrow > M - 1) qrow = M - 1;
    bf16x8 qf[4];
#pragma unroll
    for (int ds = 0; ds < 4; ++ds) qf[ds] = *(const bf16x8*)(Q + (size_t)qrow * 512 + h * 64 + ds * 16 + hi * 8);
    f32x16 O0, O1;
#pragma unroll
    for (int i = 0; i < 16; ++i) { O0[i] = 0.f; O1[i] = 0.f; }
    float m_run = -INFINITY, lsum = 0.f, R = 0.f;
    float qbound = 0.f;
    if (TYPE == 0) {
        float q2 = 0.f;
#pragma unroll
        for (int ds = 0; ds < 4; ++ds)
#pragma unroll
            for (int e = 0; e < 8; ++e) { const float x = __uint_as_float((unsigned)(unsigned short)qf[ds][e] << 16); q2 += x * x; }
        q2 += __shfl_xor(q2, 32);
        const unsigned kb = __hip_atomic_load((unsigned*)(ws + WS_CTL) + 32 + b * 8 + h, __ATOMIC_RELAXED, __HIP_MEMORY_SCOPE_AGENT);
        qbound = sqrtf(q2) * sqrtf(__uint_as_float(kb)) * 1.02f + 1.0f;
    }
    u32x4 kreg[2], vreg[2]; float creg = 0.f;
    const int srow = tid >> 3, spos = tid & 7;
    const int swz_st = (spos ^ ((srow >> 1) & 7)) << 4;
    const int swz = (lane >> 1) & 7;
    LAS unsigned* flags = (LAS unsigned*)(lds + 2 * AT_STAGE);
#define AT_LOAD(j) do { int krow0_, kidx0_; if (!meta_unit && (j) < nt - 1) { const int kt_ = nt - 2 - (j); krow0_ = b * SEQ + 64 * kt_; kidx0_ = 64 * kt_; } else { krow0_ = MX + 16 * b; kidx0_ = 8192; } \
        _Pragma("unroll") for (int i_ = 0; i_ < 2; ++i_) { \
            kreg[i_] = *(const u32x4*)(Kp + (size_t)(krow0_ + srow + 32 * i_) * 512 + h * 64 + spos * 8); \
            vreg[i_] = *(const u32x4*)(VT + (size_t)(srow + 32 * i_) * LPK + kidx0_ + spos * 8); } \
        if (TYPE == 0 && tid < 64) creg = cK[kidx0_ + tid]; } while (0)
#define AT_WRITE(s) do { _Pragma("unroll") for (int i_ = 0; i_ < 2; ++i_) { \
            *(LAS u32x4*)(lds + (s) * AT_STAGE + (srow + 32 * i_) * 128 + swz_st) = kreg[i_]; \
            *(LAS u32x4*)(lds + (s) * AT_STAGE + 8192 + (srow + 32 * i_) * 128 + swz_st) = vreg[i_]; } \
        if (TYPE == 0 && tid < 64) *(LAS float*)(lds + (s) * AT_STAGE + 16384 + tid * 4) = creg; } while (0)
    AT_LOAD(0); AT_WRITE(0);
    __syncthreads();
    for (int j = 0; j < nt; ++j) {
        const bool more = j + 1 < nt;
        if (more) AT_LOAD(j + 1);
        int klim, d0;
        if (meta_unit) { klim = 16; d0 = 0; }
        else if (j == nt - 1) { klim = 16; d0 = 1 << 20; }
        else { klim = 64; d0 = 128 * qb - 64 * (nt - 2 - j); if (d0 >= 64) d0 = 1 << 20; }
        const int limw = 32 * w + d0 - TYPE;
        bool wdone = false;
        if (TYPE == 0) {
            const float clast = *(const LAS float*)(lds + (j & 1) * AT_STAGE + 16384 + (klim - 1) * 4);
            wdone = __all((qbound - clast - m_run) < -126.0f) != 0;
        }
        if (limw + 31 >= 0 && !(TYPE == 0 && wdone)) {
            const LAS char* sb = lds + (j & 1) * AT_STAGE;
            int kmax = limw + ql; if (kmax > klim - 1) kmax = klim - 1;
            const bool needmask = (klim < 64) || (limw < 63);
            f32x16 S0, S1;
#pragma unroll
            for (int i = 0; i < 16; ++i) { S0[i] = 0.f; S1[i] = 0.f; }
#pragma unroll
            for (int ds = 0; ds < 4; ++ds) {
                const bf16x8 k0 = *(const LAS bf16x8*)(sb + ql * 128 + (((2 * ds + hi) ^ swz) << 4));
                const bf16x8 k1 = *(const LAS bf16x8*)(sb + (32 + ql) * 128 + (((2 * ds + hi) ^ swz) << 4));
                S0 = __builtin_amdgcn_mfma_f32_32x32x16_bf16(k0, qf[ds], S0, 0, 0, 0);
                S1 = __builtin_amdgcn_mfma_f32_32x32x16_bf16(k1, qf[ds], S1, 0, 0, 0);
            }
            if (TYPE == 0) {
#pragma unroll
                for (int g = 0; g < 4; ++g) {
                    const f32x4 c0 = *(const LAS f32x4*)(sb + 16384 + (8 * g + 4 * hi) * 4), c1 = *(const LAS f32x4*)(sb + 16384 + (32 + 8 * g + 4 * hi) * 4);
#pragma unroll
                    for (int i = 0; i < 4; ++i) { S0[4 * g + i] -= c0[i]; S1[4 * g + i] -= c1[i]; }
                }
                if (needmask) {
#pragma unroll
                    for (int r = 0; r < 16; ++r) { const int kl = (r & 3) + 8 * (r >> 2) + 4 * hi; if (kl > kmax) S0[r] = -INFINITY; if (kl + 32 > kmax) S1[r] = -INFINITY; }
                }
                float mx = -INFINITY;
#pragma unroll
                for (int r = 0; r < 16; ++r) mx = fmaxf(mx, fmaxf(S0[r], S1[r]));
                mx = fmaxf(mx, __shfl_xor(mx, 32));
                const float m_new = fmaxf(m_run, mx), alpha = ex2(m_run - m_new);
                m_run = m_new;
                float ps = 0.f;
#pragma unroll
                for (int r = 0; r < 16; ++r) { S0[r] = ex2(S0[r] - m_new); S1[r] = ex2(S1[r] - m_new); ps += S0[r] + S1[r]; }
                lsum = lsum * alpha + ps;
#pragma unroll
                for (int r = 0; r < 16; ++r) { O0[r] *= alpha; O1[r] *= alpha; }
            } else {
                float G0[4], G1[4];
                f32x16 L0, L1;
#pragma unroll
                for (int r = 0; r < 16; ++r) {
                    const int kl = (r & 3) + 8 * (r >> 2) + 4 * hi;
                    const float z0 = S0[r], z1 = S1[r];
                    const float sp0 = fmaxf(z0, 0.f) + lg2(1.0f + ex2(-fabsf(z0) * LOG2E)) * LN2;
                    const float sp1 = fmaxf(z1, 0.f) + lg2(1.0f + ex2(-fabsf(z1) * LOG2E)) * LN2;
                    L0[r] = (!needmask || kl <= kmax) ? -sp0 : 0.f;
                    L1[r] = (!needmask || kl + 32 <= kmax) ? -sp1 : 0.f;
                }
#pragma unroll
                for (int g = 0; g < 4; ++g) {
                    L0[4 * g + 2] += L0[4 * g + 3]; L0[4 * g + 1] += L0[4 * g + 2]; L0[4 * g] += L0[4 * g + 1]; G0[g] = L0[4 * g];
                    L1[4 * g + 2] += L1[4 * g + 3]; L1[4 * g + 1] += L1[4 * g + 2]; L1[4 * g] += L1[4 * g + 1]; G1[g] = L1[4 * g];
                }
                float run = R;
#pragma unroll
                for (int g = 3; g >= 0; --g) {
                    const float gp = __shfl_xor(G1[g], 32);
                    const float off = hi ? run : run + gp;
#pragma unroll
                    for (int i = 0; i < 4; ++i) { const int r = 4 * g + i; const int kl = 32 + i + 8 * g + 4 * hi;
                        const float a = ex2((S1[r] + L1[r] + off) * LOG2E); S1[r] = (!needmask || kl <= kmax) ? a : 0.f; }
                    run += G1[g] + gp;
                }
#pragma unroll
                for (int g = 3; g >= 0; --g) {
                    const float gp = __shfl_xor(G0[g], 32);
                    const float off = hi ? run : run + gp;
#pragma unroll
                    for (int i = 0; i < 4; ++i) { const int r = 4 * g + i; const int kl = i + 8 * g + 4 * hi;
                        const float a = ex2((S0[r] + L0[r] + off) * LOG2E); S0[r] = (!needmask || kl <= kmax) ? a : 0.f; }
                    run += G0[g] + gp;
                }
                R = run;
                wdone = __all(R < -120.0f) != 0;
            }
#pragma unroll
            for (int ks = 0; ks < 4; ++ks) {
                bf16x8 pf; u32x4 pu;
                if (ks < 2) { pu = (u32x4){pk_bf16(S0[8 * ks + 0], S0[8 * ks + 1]), pk_bf16(S0[8 * ks + 2], S0[8 * ks + 3]), pk_bf16(S0[8 * ks + 4], S0[8 * ks + 5]), pk_bf16(S0[8 * ks + 6], S0[8 * ks + 7])}; }
                else { const int k2 = ks - 2; pu = (u32x4){pk_bf16(S1[8 * k2 + 0], S1[8 * k2 + 1]), pk_bf16(S1[8 * k2 + 2], S1[8 * k2 + 3]), pk_bf16(S1[8 * k2 + 4], S1[8 * k2 + 5]), pk_bf16(S1[8 * k2 + 6], S1[8 * k2 + 7])}; }
                pf = __builtin_bit_cast(bf16x8, pu);
                const bf16x8 v0 = *(const LAS bf16x8*)(sb + 8192 + ql * 128 + (((2 * ks + hi) ^ swz) << 4));
                const bf16x8 v1 = *(const LAS bf16x8*)(sb + 8192 + (32 + ql) * 128 + (((2 * ks + hi) ^ swz) << 4));
                O0 = __builtin_amdgcn_mfma_f32_32x32x16_bf16(v0, pf, O0, 0, 0, 0);
                O1 = __builtin_amdgcn_mfma_f32_32x32x16_bf16(v1, pf, O1, 0, 0, 0);
            }
        }
        if (more) AT_WRITE((j + 1) & 1);
        if (lane == 0) flags[(j & 1) * 4 + w] = wdone ? 1u : 0u;
        __syncthreads();
        { const LAS unsigned* fl = flags + (j & 1) * 4; const unsigned f = fl[0] & fl[1] & fl[2] & fl[3]; if (f) break; }
    }
    float inv = 1.0f;
    if (TYPE == 0) { const float l = lsum + __shfl_xor(lsum, 32); inv = 1.0f / l; }
    const bool qvalid = meta_unit ? (w == 0 && ql < 16) : true;
    if (qvalid) {
        bf16_t* op = Oo + (size_t)qrow * 512 + h * 64 + 4 * hi;
#pragma unroll
        for (int g = 0; g < 4; ++g) {
            *(u32x2*)(op + 8 * g) = (u32x2){pk_bf16(O0[4 * g] * inv, O0[4 * g + 1] * inv), pk_bf16(O0[4 * g + 2] * inv, O0[4 * g + 3] * inv)};
            *(u32x2*)(op + 32 + 8 * g) = (u32x2){pk_bf16(O1[4 * g] * inv, O1[4 * g + 1] * inv), pk_bf16(O1[4 * g + 2] * inv, O1[4 * g + 3] * inv)};
        }
    }
    __syncthreads();
#undef AT_LOAD
#undef AT_WRITE
}

__device__ __forceinline__ void phase2(const Params& p, LAS char* lds) {
    unsigned* ctr = (unsigned*)(p.ws + WS_CTL);
    LAS unsigned* shu = (LAS unsigned*)(lds + 2 * AT_STAGE + 64);
    constexpr int NU = 2048 + 32;
    for (;;) {
        if (threadIdx.x == 0) shu[0] = __hip_atomic_fetch_add(ctr, 1u, __ATOMIC_RELAXED, __HIP_MEMORY_SCOPE_AGENT);
        __syncthreads();
        const int u = (int)shu[0];
        __syncthreads();
        if (u >= NU) break;
        if (u < 1024) attn_unit<0>(lds, p, (u & 15) >> 3, u & 7, 63 - (u >> 4));
        else if (u < 2048) { const int v = u - 1024; attn_unit<1>(lds, p, (v & 15) >> 3, v & 7, 63 - (v >> 4)); }
        else if (u < 2064) { const int v = u - 2048; attn_unit<0>(lds, p, v >> 3, v & 7, -1); }
        else { const int v = u - 2064; attn_unit<1>(lds, p, v >> 3, v & 7, -1); }
    }
}

__device__ __forceinline__ void phase3a(const Params& p, LAS char* lds) {
    unsigned char* ws = p.ws;
    const int lane = threadIdx.x & 63, w = wave_id(), wr = w >> 1, wc = w & 1;
    const bf16_t* oa = (const bf16_t*)(ws + WS_A); const bf16_t* ob = oa + (size_t)M * 512;
    const bf16_t* ga = (const bf16_t*)(ws + WS_B); const bf16_t* gb = ga + (size_t)M * 1024;
    bf16_t* gated = (bf16_t*)(ws + WS_GATED);
    for (int it = 0;; ++it) {
        int tm, tn; int st = tile_at(it, 128, 8, tm, tn);
        if (st == 0) { if (it < (1 << 20) && (int)blockIdx.x < 8) { tm = 128; tn = blockIdx.x; it = 1 << 20; st = 1; } else break; }
        if (st == 2) continue;
        const int row0 = tm * 128, col0 = tn * 128; const int mlim = tm == 128 ? (wr == 0 ? 2 : 0) : 4;
        f32x4 acc[4][4]; zero_acc(acc);
        gemm_main<true>(lds, oa + (size_t)row0 * 512, 512, (const bf16_t*)(ws + WS_BTOF) + (size_t)col0 * 512, 512, 8, acc, mlim);
#pragma unroll
        for (int m = 0; m < 4; ++m) {
            const int row = row0 + wr * 64 + m * 16 + (lane & 15);
#pragma unroll
            for (int n = 0; n < 4; ++n) {
                const int col = col0 + wc * 64 + n * 16 + (lane >> 4) * 4;
                const u32x2 a = *(const u32x2*)(ga + (size_t)row * 1024 + col);
                const f32x4 x = acc[m][n];
                *(u32x2*)(gated + (size_t)row * 1024 + col) = (u32x2){pk_bf16(bf_lo(a[0]) * x[0], bf_hi(a[0]) * x[1]), pk_bf16(bf_lo(a[1]) * x[2], bf_hi(a[1]) * x[3])};
            }
        }
        zero_acc(acc);
        gemm_main<true>(lds, ob + (size_t)row0 * 512, 512, (const bf16_t*)(ws + WS_BTOS) + (size_t)col0 * 512, 512, 8, acc, mlim);
#pragma unroll
        for (int m = 0; m < 4; ++m) {
            const int row = row0 + wr * 64 + m * 16 + (lane & 15);
#pragma unroll
            for (int n = 0; n < 4; ++n) {
                const int col = col0 + wc * 64 + n * 16 + (lane >> 4) * 4;
                const u32x2 b = *(const u32x2*)(gb + (size_t)row * 1024 + col);
                const f32x4 y = acc[m][n]; const u32x2 q = *(const u32x2*)(gated + (size_t)row * 1024 + col);
                const float o0 = bf_lo(q[0]) + bf_lo(b[0]) * y[0], o1 = bf_hi(q[0]) + bf_hi(b[0]) * y[1];
                const float o2 = bf_lo(q[1]) + bf_lo(b[1]) * y[2], o3 = bf_hi(q[1]) + bf_hi(b[1]) * y[3];
                *(u32x2*)(gated + (size_t)row * 1024 + col) = (u32x2){pk_bf16(o0, o1), pk_bf16(o2, o3)};
            }
        }
    }
}
__device__ __forceinline__ void epi_store_ss(const f32x4 (&acc)[4][4], bf16_t* out, int ldo, int orow0, int col0, float* ssp, int ssrow0, int wr, int wc, int lane) {
#pragma unroll
    for (int m = 0; m < 4; ++m) {
        const int rl = wr * 64 + m * 16 + (lane & 15);
        float s = 0.f;
#pragma unroll
        for (int n = 0; n < 4; ++n) {
            const int col = col0 + wc * 64 + n * 16 + (lane >> 4) * 4;
            const f32x4 v = acc[m][n];
            s += v[0] * v[0] + v[1] * v[1] + v[2] * v[2] + v[3] * v[3];
            *(u32x2*)(out + (size_t)(orow0 + rl) * ldo + col) = (u32x2){pk_bf16(v[0], v[1]), pk_bf16(v[2], v[3])};
        }
#if 1
        s += __shfl_xor(s, 16); s += __shfl_xor(s, 32);
        if (lane < 16) ssp[(size_t)((col0 >> 7) * 2 + wc) * M + ssrow0 + rl] = s;
#endif
    }
}
__device__ __forceinline__ void phase3b(const Params& p, LAS char* lds) {
    unsigned char* ws = p.ws;
    const int lane = threadIdx.x & 63, w = wave_id(), wr = w >> 1, wc = w & 1;
    const bf16_t* gated = (const bf16_t*)(ws + WS_GATED); bf16_t* mixed = (bf16_t*)(ws + WS_MIXED);
    for (int it = 0;; ++it) {
        int tm, tn; int st = tile_at(it, 128, 8, tm, tn);
        if (st == 0) { if (it < (1 << 20) && (int)blockIdx.x < 8) { tm = 128; tn = blockIdx.x; it = 1 << 20; st = 1; } else break; }
        if (st == 2) continue;
        const int row0 = tm * 128, col0 = tn * 128; const int mlim = tm == 128 ? (wr == 0 ? 2 : 0) : 4;
        f32x4 acc[4][4]; zero_acc(acc);
        gemm_main<true>(lds, gated + (size_t)row0 * 1024, 1024, (const bf16_t*)(ws + WS_BTOUT) + (size_t)col0 * 1024, 1024, 16, acc, mlim);
        epi_store_ss(acc, mixed, 1024, row0, col0, (float*)(ws + WS_SSP2), row0, wr, wc, lane);
    }
}
__device__ __forceinline__ void phase3c(const Params& p) {
    unsigned char* ws = p.ws;
    const int lane = threadIdx.x & 63, w = wave_id();
    const bf16_t* mixed = (const bf16_t*)(ws + WS_MIXED); bf16_t* hb = (bf16_t*)(ws + WS_A);
    const float* ssp2 = (const float*)(ws + WS_SSP2); float* r2 = (float*)(ws + WS_R2);
    const float* g1 = p.gains + D;
    for (int r_ = blockIdx.x * 32 + w; r_ < M; r_ += (r_ & 31) < 28 ? 4 : gridDim.x * 32 - 28) {
        const int r = r_;
        if (r >= MV) continue;
        const float* src = r < MX ? p.x + (size_t)r * D : p.meta + (size_t)((r - MX) & 15) * D;
        float sq = lane < 16 ? ssp2[(size_t)lane * M + r] : 0.f;
        sq = wave_sum(sq);
        const float a = 1.0f / sqrtf(sq * (1.0f / D) + EPS);
        float ss = 0.f;
#pragma unroll
        for (int i = 0; i < 4; ++i) {
            const int col = lane * 4 + 256 * i;
            const f32x4 v = *(const f32x4*)(src + col), g = *(const f32x4*)(g1 + col);
            const u32x2 mx = *(const u32x2*)(mixed + (size_t)r * D + col);
            f32x4 hh;
            hh[0] = v[0] + bf_lo(mx[0]) * a * g[0]; hh[1] = v[1] + bf_hi(mx[0]) * a * g[1];
            hh[2] = v[2] + bf_lo(mx[1]) * a * g[2]; hh[3] = v[3] + bf_hi(mx[1]) * a * g[3];
            ss += hh[0] * hh[0] + hh[1] * hh[1] + hh[2] * hh[2] + hh[3] * hh[3];
            *(u32x2*)(hb + (size_t)r * D + col) = (u32x2){pk_bf16(hh[0], hh[1]), pk_bf16(hh[2], hh[3])};
            if (r < MX) *(f32x4*)(p.out + (size_t)r * D + col) = hh;
        }
        ss = wave_sum(ss);
        if (lane == 0) r2[r] = 1.0f / sqrtf(ss * (1.0f / D) + EPS);
    }
}
constexpr int UST = 272;
__device__ __forceinline__ f32x4 unpack4(const u32x2 u) { return (f32x4){bf_lo(u[0]), bf_hi(u[0]), bf_lo(u[1]), bf_hi(u[1])}; }
struct ConvW { f32x4 w0g, w1g, w2g, bg, w0v, w1v, w2v, bv; };
__device__ __forceinline__ ConvW load_convw(const Params& p, int c) {
    ConvW q;
    q.w0g = *(const f32x4*)(p.conv_w + c); q.w1g = *(const f32x4*)(p.conv_w + NUP + c); q.w2g = *(const f32x4*)(p.conv_w + 2 * NUP + c); q.bg = *(const f32x4*)(p.conv_b + c);
    q.w0v = *(const f32x4*)(p.conv_w + DFF + c); q.w1v = *(const f32x4*)(p.conv_w + NUP + DFF + c); q.w2v = *(const f32x4*)(p.conv_w + 2 * NUP + DFF + c); q.bv = *(const f32x4*)(p.conv_b + DFF + c);
    return q;
}
__device__ __forceinline__ u32x2 conv_gelu4(const ConvW& q, const f32x4 g2, const f32x4 g1, const f32x4 g0, const f32x4 v2, const f32x4 v1, const f32x4 v0) {
    float o[4];
#pragma unroll
    for (int e = 0; e < 4; ++e) {
        const float ug = q.bg[e] + q.w0g[e] * g2[e] + q.w1g[e] * g1[e] + q.w2g[e] * g0[e];
        const float uv = q.bv[e] + q.w0v[e] * v2[e] + q.w1v[e] * v1[e] + q.w2v[e] * v0[e];
        const float t = 0.7978845608028654f * (ug + 0.044715f * ug * ug * ug);
        o[e] = ug * rcp(1.0f + ex2(-2.0f * LOG2E * t)) * uv;
    }
    return (u32x2){pk_bf16(o[0], o[1]), pk_bf16(o[2], o[3])};
}
__device__ __forceinline__ void phase4(const Params& p, LAS char* lds) {
    unsigned char* ws = p.ws;
    const int tid = threadIdx.x, lane = tid & 63, w = wave_id(), wr = w >> 1, wc = w & 1;
    const bf16_t* hb = (const bf16_t*)(ws + WS_A); const bf16_t* Bt = (const bf16_t*)(ws + WS_BTUP);
    const float* r2 = (const float*)(ws + WS_R2);
    bf16_t* act = (bf16_t*)(ws + WS_ACT); bf16_t* hal = (bf16_t*)(ws + WS_HAL);
    for (int it = 0;; ++it) {
        int tm, tn; int st = tile_at(it, 128, 44, tm, tn);
        if (st == 0) { if (it < (1 << 20) && (int)blockIdx.x < 44) { tm = 128; tn = blockIdx.x; it = 1 << 20; st = 1; } else break; }
        if (st == 2) continue;
        const bool mt = tm == 128; const int row0 = mt ? MX : tm * 128, col0 = tn * 128;
        f32x4 acc[4][4]; zero_acc(acc);
        gemm_main<true>(lds, hb + (size_t)row0 * D, D, Bt + (size_t)col0 * D, D, 16, acc, mt ? (wr == 0 ? 2 : 0) : 4);
#pragma unroll
        for (int m = 0; m < 4; ++m) {
            const int rl = wr * 64 + m * 16 + (lane & 15); const float rs = r2[row0 + rl];
#pragma unroll
            for (int n = 0; n < 4; ++n) {
                const int cl = wc * 64 + n * 16 + (lane >> 4) * 4; const f32x4 v = acc[m][n] * rs;
                *(LAS u32x2*)(lds + rl * UST + cl * 2) = (u32x2){pk_bf16(v[0], v[1]), pk_bf16(v[2], v[3])};
            }
        }
        __syncthreads();
        if (!mt) {
            const int cg = tid & 15, rb = tid >> 4, c = tn * 64 + cg * 4;
            const ConvW q = load_convw(p, c);
            const int hr = rb == 0 ? 0 : rb * 8 - 2;
            f32x4 g2 = unpack4(*(const LAS u32x2*)(lds + hr * UST + cg * 8)), v2 = unpack4(*(const LAS u32x2*)(lds + hr * UST + 128 + cg * 8));
            f32x4 g1 = unpack4(*(const LAS u32x2*)(lds + (hr + 1) * UST + cg * 8)), v1 = unpack4(*(const LAS u32x2*)(lds + (hr + 1) * UST + 128 + cg * 8));
            for (int r = hr + 2; r < rb * 8 + 8; ++r) {
                const f32x4 g0 = unpack4(*(const LAS u32x2*)(lds + r * UST + cg * 8)), v0 = unpack4(*(const LAS u32x2*)(lds + r * UST + 128 + cg * 8));
                *(u32x2*)(act + (size_t)(row0 + r) * DFF + c) = conv_gelu4(q, g2, g1, g0, v2, v1, v0);
                g2 = g1; g1 = g0; v2 = v1; v1 = v0;
            }
            if (tid < 64) { const int qq = tid >> 4, ch = tid & 15, rl = qq < 2 ? qq : 124 + qq;
                *(u32x4*)(hal + ((size_t)tm * 4 + qq) * NUP + col0 + ch * 8) = *(const LAS u32x4*)(lds + rl * UST + ch * 16); }
        } else {
            if (tid < 64) { const int qq = tid >> 4, ch = tid & 15, rl = (qq >> 1) * 16 + 14 + (qq & 1);
                *(u32x4*)(hal + ((size_t)(128 + (qq >> 1)) * 4 + 2 + (qq & 1)) * NUP + col0 + ch * 8) = *(const LAS u32x4*)(lds + rl * UST + ch * 16); }
        }
        __syncthreads();
    }
}
__device__ __forceinline__ void phase_fix(const Params& p) {
    unsigned char* ws = p.ws;
    const bf16_t* hal = (const bf16_t*)(ws + WS_HAL); bf16_t* act = (bf16_t*)(ws + WS_ACT);
    constexpr int NCG = DFF / 4;
    for (int it = blockIdx.x * NTHREADS + threadIdx.x; it < 128 * NCG; it += gridDim.x * NTHREADS) {
        const int tmg = it / NCG, c = (it % NCG) * 4, colg = (c >> 6) * 128 + (c & 63), colv = colg + 64;
        const bf16_t* own = hal + (size_t)tmg * 4 * NUP;
        const bf16_t* prv = hal + (size_t)((tmg & 63) ? tmg - 1 : 128 + (tmg >> 6)) * 4 * NUP;
        const ConvW q = load_convw(p, c);
        const f32x4 pg2 = unpack4(*(const u32x2*)(prv + 2 * NUP + colg)), pv2 = unpack4(*(const u32x2*)(prv + 2 * NUP + colv));
        const f32x4 pg3 = unpack4(*(const u32x2*)(prv + 3 * NUP + colg)), pv3 = unpack4(*(const u32x2*)(prv + 3 * NUP + colv));
        const f32x4 og0 = unpack4(*(const u32x2*)(own + colg)), ov0 = unpack4(*(const u32x2*)(own + colv));
        const f32x4 og1 = unpack4(*(const u32x2*)(own + NUP + colg)), ov1 = unpack4(*(const u32x2*)(own + NUP + colv));
        *(u32x2*)(act + (size_t)(tmg * 128) * DFF + c) = conv_gelu4(q, pg2, pg3, og0, pv2, pv3, ov0);
        *(u32x2*)(act + (size_t)(tmg * 128 + 1) * DFF + c) = conv_gelu4(q, pg3, og0, og1, pv3, ov0, ov1);
    }
}
__device__ __forceinline__ void phase6(const Params& p, LAS char* lds) {
    unsigned char* ws = p.ws;
    const int lane = threadIdx.x & 63, w = wave_id(), wr = w >> 1, wc = w & 1;
    const bf16_t* act = (const bf16_t*)(ws + WS_ACT); bf16_t* ffn = (bf16_t*)(ws + WS_FFN);
    for (int it = 0;; ++it) {
        int tm, tn; const int st = tile_at(it, 128, 8, tm, tn); if (st == 0) break; if (st == 2) continue;
        const int col0 = tn * 128;
        f32x4 acc[4][4]; zero_acc(acc);
        gemm_main<true>(lds, act + (size_t)(tm * 128) * DFF, DFF, (const bf16_t*)(ws + WS_BTDN) + (size_t)col0 * DFF, DFF, 44, acc);
        epi_store_ss(acc, ffn, 1024, tm * 128, col0, (float*)(ws + WS_SSP4), tm * 128, wr, wc, lane);
    }
}
__device__ __forceinline__ void phase7(const Params& p) {
    unsigned char* ws = p.ws;
    const bf16_t* ffn = (const bf16_t*)(ws + WS_FFN); const float* ssp4 = (const float*)(ws + WS_SSP4); const float* g3 = p.gains + 3 * D;
    for (int it = blockIdx.x * NTHREADS + threadIdx.x; it < MX * 256; it += gridDim.x * NTHREADS) {
        const int row = it >> 8, col = (it & 255) * 4;
        float sq = 0.f;
#pragma unroll
        for (int sl = 0; sl < 16; ++sl) sq += ssp4[(size_t)sl * M + row];
        const float a = 1.0f / sqrtf(sq * (1.0f / D) + EPS);
        const f32x4 hh = *(const f32x4*)(p.out + (size_t)row * D + col), g = *(const f32x4*)(g3 + col);
        const u32x2 f = *(const u32x2*)(ffn + (size_t)row * D + col);
        f32x4 o;
        o[0] = hh[0] + bf_lo(f[0]) * a * g[0]; o[1] = hh[1] + bf_hi(f[0]) * a * g[1];
        o[2] = hh[2] + bf_lo(f[1]) * a * g[2]; o[3] = hh[3] + bf_hi(f[1]) * a * g[3];
        *(f32x4*)(p.out + (size_t)row * D + col) = o;
    }
}


#ifndef DUMP
#define DUMP 0
#endif
__device__ __forceinline__ void phase_dump(const Params& p) {
    unsigned char* ws = p.ws;
    const bf16_t* s0; const bf16_t* s1; int ld;
    if (DUMP == 1) { s0 = (const bf16_t*)(ws + WS_B); s1 = s0 + 512; ld = 1024; }
    else if (DUMP == 2) { s0 = (const bf16_t*)(ws + WS_QF); s1 = (const bf16_t*)(ws + WS_KF); ld = 512; }
    else if (DUMP == 3) { s0 = (const bf16_t*)(ws + WS_A); s1 = s0 + (size_t)M * 512; ld = 512; }
    else if (DUMP == 4) { s0 = (const bf16_t*)(ws + WS_GATED); s1 = s0 + 512; ld = 1024; }
    else if (DUMP == 8) { s0 = (const bf16_t*)(ws + WS_A); s1 = s0 + 512; ld = 1024; }
    else if (DUMP == 9) { s0 = (const bf16_t*)(ws + WS_ACT) + 1024; s1 = (const bf16_t*)(ws + WS_ACT) + 2304 - 512 + 512; ld = DFF; }
    else if (DUMP == 10) { s0 = (const bf16_t*)(ws + WS_FFN); s1 = s0 + 512; ld = 1024; }
    else if (DUMP == 6) { s0 = (const bf16_t*)(ws + WS_QS); s1 = (const bf16_t*)(ws + WS_KS); ld = 512; }
    else { s0 = (const bf16_t*)(ws + WS_MIXED); s1 = s0 + 512; ld = 1024; }
    for (int it = blockIdx.x * NTHREADS + threadIdx.x; it < MX * 1024; it += gridDim.x * NTHREADS) {
        const int row = it >> 10, col = it & 1023;
        if (DUMP >= 9 && row >= 8192) { p.out[it] = 0.f; continue; }
        const bf16_t v = col < 512 ? s0[(size_t)row * ld + col] : s1[(size_t)row * ld + col - 512];
        p.out[it] = __uint_as_float((unsigned)v << 16);
    }
}

__device__ __forceinline__ void l2_scrub(const Params& p) {
    const f32x4* src = (const f32x4*)p.x + (size_t)(blockIdx.x & 511) * 8192;
    f32x4 a = (f32x4){0.f, 0.f, 0.f, 0.f};
    for (int i = threadIdx.x; i < 8192; i += NTHREADS) a += src[i];
    if (a[0] + a[1] + a[2] + a[3] == 1.2345e-30f) ((float*)(p.ws + WS_CTL))[32 + (threadIdx.x & 7)] = a[0];
}


#define XB_TMO      128
#define XB_XCNT(j)  (256  + 64 * (j))
#define XB_XSUB(j)  (1280 + 64 * (j))
#define XB_XGEN(j)  (2304 + 64 * (j))
#define XB_TOP      3328
#define XB_TOPGEN   3392
#define XCD_BAR_WORDS 3456
#define XB_SPIN_CAP (1u << 18)
__device__ __forceinline__ unsigned xb_ld(unsigned* p)              { return __hip_atomic_load(p, __ATOMIC_RELAXED, __HIP_MEMORY_SCOPE_AGENT); }
__device__ __forceinline__ unsigned xb_add(unsigned* p, unsigned v) { return __hip_atomic_fetch_add(p, v, __ATOMIC_RELAXED, __HIP_MEMORY_SCOPE_AGENT); }
__device__ __forceinline__ unsigned xb_xcc_id() { return (unsigned)__builtin_amdgcn_s_getreg((3 << 11) | 20) & 0xFu; }
#define XB_SPIN(cond, bar) do { unsigned _sp = 0; while (cond) { __builtin_amdgcn_s_sleep(1); \
    if ((++_sp & 255u) == 0u) { if (xb_ld(&(bar)[XB_TMO])) break; if (_sp > XB_SPIN_CAP) { atomicAdd(&(bar)[XB_TMO], 1u); break; } } } } while (0)
struct XcdBarrier { unsigned* bar; unsigned x; volatile LAS unsigned* st; };
__device__ __forceinline__ XcdBarrier xcd_barrier_post(unsigned* bar, volatile LAS unsigned* st) {
    XcdBarrier b; b.bar = bar; b.x = xb_xcc_id(); b.st = st;
    if (threadIdx.x == 0) (void)xb_add(&bar[XB_XCNT(b.x)], 1u);
    return b;
}
__device__ __forceinline__ void xcd_barrier_complete(unsigned* bar, unsigned x, unsigned& nloc, unsigned& nx) {
    const unsigned G = gridDim.x * gridDim.y * gridDim.z;
    unsigned sum, cnt, mine, sp = 0u;
    for (;;) {
        sum = 0u; cnt = 0u; mine = 0u;
#pragma unroll
        for (unsigned j = 0; j < 16; ++j) { const unsigned c = xb_ld(&bar[XB_XCNT(j)]); sum += c; cnt += (c > 0u) ? 1u : 0u; mine = (j == x) ? c : mine; }
        if (sum == G) break;
        __builtin_amdgcn_s_sleep(1);
        if ((++sp & 255u) == 0u) { if (xb_ld(&bar[XB_TMO])) break; if (sp > XB_SPIN_CAP) { atomicAdd(&bar[XB_TMO], 1u); break; } }
    }
    nloc = mine > 0u ? mine : 1u; nx = cnt > 0u ? cnt : 1u;
}
__device__ __forceinline__ void xcd_barrier(const XcdBarrier& b) {
    asm volatile("s_waitcnt vmcnt(0)" ::: "memory");
    __syncthreads();
    if (threadIdx.x == 0) {
        unsigned* bar = b.bar;
        __builtin_amdgcn_s_waitcnt(0);
        unsigned nloc = b.st[0], nx = b.st[1];
        if (nloc == 0u) { xcd_barrier_complete(bar, b.x, nloc, nx); b.st[0] = nloc; b.st[1] = nx; }
        const unsigned old = xb_add(&bar[XB_XSUB(b.x)], 1u);
        const unsigned gen = old / nloc;
        if (old + 1u == (gen + 1u) * nloc) {
            __builtin_amdgcn_fence(__ATOMIC_RELEASE, "agent");
            asm volatile("s_waitcnt vmcnt(0)" ::: "memory");
            const unsigned og = xb_add(&bar[XB_TOP], 1u);
            const unsigned tg = og / nx;
            if (og + 1u == (tg + 1u) * nx) xb_add(&bar[XB_TOPGEN], 1u);
            else XB_SPIN(xb_ld(&bar[XB_TOPGEN]) == tg, bar);
            __builtin_amdgcn_fence(__ATOMIC_ACQUIRE, "agent");
            xb_add(&bar[XB_XGEN(b.x)], 1u);
            asm volatile("s_waitcnt vmcnt(0)" ::: "memory");
        } else {
            XB_SPIN(xb_ld(&bar[XB_XGEN(b.x)]) == gen, bar);
            __builtin_amdgcn_fence(__ATOMIC_ACQUIRE, "agent");
            asm volatile("s_waitcnt vmcnt(0)" ::: "memory");
        }
    }
    __syncthreads();
}

__device__ __forceinline__ void my_grid_sync(const Params& p, unsigned& target) {
    unsigned* bar = (unsigned*)(p.ws + WS_CTL) + 16;
    asm volatile("s_waitcnt vmcnt(0)" ::: "memory");
    __syncthreads();
    target += gridDim.x;
    if (threadIdx.x == 0) {
        __builtin_amdgcn_fence(__ATOMIC_RELEASE, "agent");
        asm volatile("s_waitcnt vmcnt(0)" ::: "memory");
        __hip_atomic_fetch_add(bar, 1u, __ATOMIC_RELAXED, __HIP_MEMORY_SCOPE_AGENT);
        while (__hip_atomic_load(bar, __ATOMIC_RELAXED, __HIP_MEMORY_SCOPE_AGENT) < target) __builtin_amdgcn_s_sleep(2);
        __builtin_amdgcn_fence(__ATOMIC_ACQUIRE, "agent");
        asm volatile("s_waitcnt vmcnt(0)" ::: "memory");
    }
    __syncthreads();
}
__global__ void __launch_bounds__(NTHREADS, 2) fwd_kernel(Params p) {
    extern __shared__ __attribute__((aligned(16))) unsigned char lds_raw[];
    LAS char* lds = (LAS char*)lds_raw;
    cg::grid_group grid = cg::this_grid();
#define IN(k) (p.ph_lo <= (k) && (k) < p.ph_hi)
#define SEAM(k) do { if (IN(k) && IN((k) + 1)) { if (p.ph_hi > 1000) grid.sync(); xcd_barrier(xbar); } } while (0)
    volatile LAS unsigned* xst = (volatile LAS unsigned*)(lds + 65536);
    if (threadIdx.x < 4) xst[threadIdx.x] = 0u;
    __syncthreads();
    const XcdBarrier xbar = xcd_barrier_post((unsigned*)(p.ws + WS_XBAR), xst);
    if (IN(0)) phase0(p, lds);
    SEAM(0);
    if (IN(1)) phase1(p, lds);
    SEAM(1);
    if (IN(2)) phase2(p, lds);
    SEAM(2);
    if (IN(3)) phase3a(p, lds);
    SEAM(3);
    if (IN(4)) phase3b(p, lds);
    SEAM(4);
    if (IN(5)) phase3c(p);
    SEAM(5);
    if (IN(6)) phase4(p, lds);
    SEAM(6);
    if (IN(7)) phase_fix(p);
    SEAM(7);
    if (IN(8)) phase6(p, lds);
    SEAM(8);
    if (IN(9)) phase7(p);
#undef IN
#undef SEAM
}


__global__ void ab_save(const unsigned char* ws, float* out) {
    const u32x4* src = (const u32x4*)(ws + AB_SRC); u32x4* dst = (u32x4*)((unsigned char*)out + (size_t)32 * MiB);
    for (size_t i = blockIdx.x * (size_t)blockDim.x + threadIdx.x; i < (size_t)AB_BYTES / 16; i += (size_t)gridDim.x * blockDim.x) dst[i] = src[i];
}
__global__ void ab_diff(const unsigned char* ws, float* out) {
    const bf16_t* src = (const bf16_t*)(ws + AB_SRC); const bf16_t* sav = (const bf16_t*)((unsigned char*)out + (size_t)32 * MiB);
    for (size_t i = blockIdx.x * (size_t)blockDim.x + threadIdx.x; i < (size_t)8192 * 1024; i += (size_t)gridDim.x * blockDim.x) {
        if (i >= (size_t)AB_BYTES / 2) { out[i] = 0.f; continue; }
        out[i] = src[i] != sav[i] ? 1000.0f : 0.f;
    }
}
__global__ void ab_zero(float* out) {
    for (size_t i = blockIdx.x * (size_t)blockDim.x + threadIdx.x; i < (size_t)8192 * 1024; i += (size_t)gridDim.x * blockDim.x) out[(size_t)8192 * 1024 + i] = 0.f;
}
extern "C" void kernel_launch(void* const* d_in, const int* in_sizes, int n_in, void* d_out, int out_size, void* d_ws, size_t ws_size, hipStream_t stream) {
    static int grid_blocks = 0;
    if (grid_blocks == 0) {
        if (n_in != 12 || ws_size < WS_END) { fprintf(stderr, "kernel_launch: unexpected n_in %d or ws_size %zu (need %zu)\n", n_in, ws_size, (size_t)WS_END); grid_blocks = -1; return; }
        int dev = 0, cus = 0, per_cu = 0;
        (void)hipGetDevice(&dev);
        (void)hipDeviceGetAttribute(&cus, hipDeviceAttributeMultiprocessorCount, dev);
        (void)hipFuncSetAttribute((const void*)fwd_kernel, hipFuncAttributeMaxDynamicSharedMemorySize, LDS_BYTES);
        (void)hipOccupancyMaxActiveBlocksPerMultiprocessor(&per_cu, (const void*)fwd_kernel, NTHREADS, LDS_BYTES);
        if (per_cu < 1) per_cu = 1;
        if (per_cu > 2) per_cu = 2;
        grid_blocks = cus * per_cu;
        (void)hipGetLastError();
    }
    if (grid_blocks < 0) return;
    Params p{};
    p.x = (const float*)d_in[0]; p.meta = (const float*)d_in[1]; p.gains = (const float*)d_in[2]; p.w_in = (const float*)d_in[3];
    p.b_forget = (const float*)d_in[4]; p.w_o_fox = (const float*)d_in[5]; p.w_o_sb = (const float*)d_in[6]; p.w_out = (const float*)d_in[7];
    p.w_up = (const float*)d_in[8]; p.conv_w = (const float*)d_in[9]; p.conv_b = (const float*)d_in[10]; p.w_down = (const float*)d_in[11];
    p.out = (float*)d_out; p.ws = (unsigned char*)d_ws;
#if SINGLE_LAUNCH
    (void)hipMemsetAsync((unsigned char*)d_ws + WS_CTL, 0, 256, stream);
    (void)hipMemsetAsync((unsigned char*)d_ws + WS_XBAR, 0, XCD_BAR_WORDS * 4, stream);
    p.ph_lo = 0; p.ph_hi = NPHASE;
    void* args[] = {&p};
    hipError_t e = hipLaunchCooperativeKernel((const void*)fwd_kernel, dim3(grid_blocks), dim3(NTHREADS), args, LDS_BYTES, stream);
    if (e != hipSuccess) fprintf(stderr, "cooperative launch failed: %s (grid %d)\n", hipGetErrorString(e), grid_blocks);
#else
#ifndef STOP_AT
#define STOP_AT NPHASE
#endif
    for (int k = 0; k < STOP_AT; ++k) {
        p.ph_lo = k; p.ph_hi = k + 1;
        hipLaunchKernelGGL(fwd_kernel, dim3(grid_blocks), dim3(NTHREADS), LDS_BYTES, stream, p);
    }
#if ABTEST
    ab_save<<<1024, 256, 0, stream>>>(p.ws, p.out);
    for (int k = AB_FROM; k < STOP_AT; ++k) {
        p.ph_lo = k; p.ph_hi = k + 1;
        hipLaunchKernelGGL(fwd_kernel, dim3(grid_blocks), dim3(NTHREADS), LDS_BYTES, stream, p);
    }
    ab_diff<<<1024, 256, 0, stream>>>(p.ws, p.out);
    ab_zero<<<1024, 256, 0, stream>>>(p.out);
#endif

#endif
}
```

```cpp
#include <hip/hip_runtime.h>
#include <hip/hip_cooperative_groups.h>
#include <cstdio>
#include <cstdint>
namespace cg = cooperative_groups;

#define DUMP 0
#define ABTEST 0
#define AB_FROM 0
#define AB_SRC WS_SSP2
#define AB_BYTES (2 * MiB)
#ifndef SINGLE_LAUNCH
#define SINGLE_LAUNCH 1
#endif

#define LAS __attribute__((address_space(3)))
typedef unsigned short bf16_t;
typedef short bf16x8 __attribute__((ext_vector_type(8)));
typedef float f32x4 __attribute__((ext_vector_type(4)));
typedef float f32x16 __attribute__((ext_vector_type(16)));
typedef unsigned u32x4 __attribute__((ext_vector_type(4)));
typedef unsigned u32x2 __attribute__((ext_vector_type(2)));

constexpr int D = 1024, SEQ = 8192, NMETA = 16, NB = 2;
constexpr int MX = NB * SEQ;
constexpr int MV = MX + NB * NMETA;
constexpr int M = 16512;
constexpr int LPK = 8256;
constexpr int PROJW = 5128, NPROJ = 5120, DFF = 2816, NUP = 5632;
constexpr float EPS = 1e-6f;
constexpr float LOG2E = 1.4426950408889634f, LN2 = 0.6931471805599453f;
constexpr int NTHREADS = 256;
constexpr int LDS_BYTES = 65536 + 16;
constexpr int NPHASE = 10;

constexpr size_t MiB = 1u << 20;
constexpr size_t WS_CTL = 0;
constexpr size_t WS_R1 = 4096, WS_R2 = WS_R1 + 69632, WS_SS2 = WS_R2 + 69632, WS_SS4 = WS_SS2 + 69632;
constexpr size_t WS_LOGF = WS_SS4 + 69632, WS_CK = WS_LOGF + 528384, WS_UPMETA = WS_CK + 528384;
constexpr size_t WS_BTIN = 2 * MiB, WS_BTOF = WS_BTIN + 10 * MiB, WS_BTOS = WS_BTOF + 1 * MiB, WS_BTOUT = WS_BTOS + 1 * MiB,
                 WS_BTUP = WS_BTOUT + 2 * MiB, WS_BTDN = WS_BTUP + 11 * MiB;
constexpr size_t SZ_M1024 = (size_t)M * 1024 * 2, SZ_M512 = (size_t)M * 512 * 2;
constexpr size_t WS_A = 33 * MiB;
constexpr size_t WS_B = WS_A + SZ_M1024;
constexpr size_t WS_C = WS_B + 2 * SZ_M1024;
constexpr size_t WS_QF = WS_C, WS_KF = WS_QF + SZ_M512, WS_QS = WS_KF + SZ_M512, WS_KS = WS_QS + SZ_M512, WS_VFT = WS_KS + SZ_M512, WS_VST = WS_VFT + SZ_M512;
constexpr size_t WS_GATED = WS_C, WS_MIXED = WS_B + SZ_M1024;
constexpr size_t WS_ACT = WS_B;
constexpr size_t WS_FFN = WS_ACT + 132 * MiB;
constexpr size_t WS_SSP2 = 230 * MiB, WS_SSP4 = 232 * MiB;
constexpr size_t WS_HAL = 234 * MiB;
constexpr size_t WS_XBAR = 240 * MiB;
constexpr size_t WS_END = 241 * MiB;

struct Params {
    const float *x, *meta, *gains, *w_in, *b_forget, *w_o_fox, *w_o_sb, *w_out, *w_up, *conv_w, *conv_b, *w_down;
    float* out; unsigned char* ws; int ph_lo, ph_hi;
};

typedef __bf16 bf16x2_t __attribute__((ext_vector_type(2)));
__device__ __forceinline__ unsigned pk_bf16(float lo, float hi) { bf16x2_t v = {(__bf16)lo, (__bf16)hi}; return __builtin_bit_cast(unsigned, v); }
__device__ __forceinline__ float bf_lo(unsigned u) { return __uint_as_float(u << 16); }
__device__ __forceinline__ float bf_hi(unsigned u) { return __uint_as_float(u & 0xffff0000u); }
__device__ __forceinline__ float ex2(float x) { return __builtin_amdgcn_exp2f(x); }
__device__ __forceinline__ float lg2(float x) { return __builtin_amdgcn_logf(x); }
__device__ __forceinline__ float rcp(float x) { return __builtin_amdgcn_rcpf(x); }
__device__ __forceinline__ float sigmoidf_(float v) { return rcp(1.0f + ex2(-v * LOG2E)); }
__device__ __forceinline__ float wave_sum(float v) {
#pragma unroll
    for (int o = 32; o > 0; o >>= 1) v += __shfl_xor(v, o);
    return v;
}
__device__ __forceinline__ int wave_id() { return __builtin_amdgcn_readfirstlane((int)(threadIdx.x >> 6)); }

__device__ __forceinline__ void transpose_tile(LAS char* lds, const float* src, int ldsrc, int srccol, int k0, const float* gain, bf16_t* dst, int K, int n0) {
    LAS bf16_t* T = (LAS bf16_t*)lds;
    const int tid = threadIdx.x, r = tid >> 4, c4 = tid & 15;
#pragma unroll
    for (int p = 0; p < 4; ++p) {
        const int k = r + 16 * p;
        f32x4 v = *(const f32x4*)(src + (size_t)(k0 + k) * ldsrc + srccol + c4 * 4);
        const float g = gain ? gain[k0 + k] : 1.0f;
        const unsigned a = pk_bf16(v[0] * g, v[1] * g), b = pk_bf16(v[2] * g, v[3] * g);
        T[(c4 * 4 + 0) * 72 + k] = (bf16_t)(a & 0xffff); T[(c4 * 4 + 1) * 72 + k] = (bf16_t)(a >> 16);
        T[(c4 * 4 + 2) * 72 + k] = (bf16_t)(b & 0xffff); T[(c4 * 4 + 3) * 72 + k] = (bf16_t)(b >> 16);
    }
    __syncthreads();
    const int n = tid >> 2, kq = tid & 3;
    const u32x4 lo = *(LAS u32x4*)(T + n * 72 + kq * 16), hi = *(LAS u32x4*)(T + n * 72 + kq * 16 + 8);
    bf16_t* d = dst + (size_t)(n0 + n) * K + k0 + kq * 16;
    *(u32x4*)d = lo; *(u32x4*)(d + 8) = hi;
    __syncthreads();
}

__device__ __forceinline__ void phase0(const Params& p, LAS char* lds) {
    unsigned char* ws = p.ws;
    const int tid = threadIdx.x, lane = tid & 63, w = wave_id();
    LAS float* wfT = (LAS float*)lds;
    const float* g0 = p.gains;
    for (int idx = tid; idx < 8192; idx += NTHREADS) { const int h = idx & 7, k = idx >> 3; wfT[h * 1024 + k] = p.w_in[(size_t)k * PROJW + 1536 + h] * g0[k]; }
    __syncthreads();
    bf16_t* xb = (bf16_t*)(ws + WS_A);
    float* r1 = (float*)(ws + WS_R1);
    float* logf_ = (float*)(ws + WS_LOGF);
    for (int r_ = blockIdx.x * 32 + w; r_ < M; r_ += (r_ & 31) < 28 ? 4 : gridDim.x * 32 - 28) {
        const int r = r_;
        if (r >= MV) {
#pragma unroll
            for (int i = 0; i < 4; ++i) *(u32x2*)(xb + (size_t)r * D + lane * 4 + 256 * i) = (u32x2){0u, 0u};
            if (lane == 0) r1[r] = 0.f;
            continue;
        }
        const float* src = r < MX ? p.x + (size_t)r * D : p.meta + (size_t)((r - MX) & 15) * D;
        f32x4 v[4]; float ss = 0.f;
#pragma unroll
        for (int i = 0; i < 4; ++i) { v[i] = *(const f32x4*)(src + lane * 4 + 256 * i); ss += v[i][0] * v[i][0] + v[i][1] * v[i][1] + v[i][2] * v[i][2] + v[i][3] * v[i][3]; }
#pragma unroll
        for (int i = 0; i < 4; ++i) *(u32x2*)(xb + (size_t)r * D + lane * 4 + 256 * i) = (u32x2){pk_bf16(v[i][0], v[i][1]), pk_bf16(v[i][2], v[i][3])};
        ss = wave_sum(ss);
        const float rs = 1.0f / sqrtf(ss * (1.0f / D) + EPS);
        if (lane == 0) r1[r] = rs;
        float mine = 0.f;
#pragma unroll
        for (int h = 0; h < 8; ++h) {
            float a = 0.f;
#pragma unroll
            for (int i = 0; i < 4; ++i) { const f32x4 wv = *(LAS f32x4*)(wfT + h * 1024 + lane * 4 + 256 * i); a += v[i][0] * wv[0] + v[i][1] * wv[1] + v[i][2] * wv[2] + v[i][3] * wv[3]; }
            a = wave_sum(a);
            if (lane == h) mine = a;
        }
        if (lane < 8) {
            const float f = mine * rs + p.b_forget[lane];
            const float lf = fminf(f, 0.f) - log1pf(expf(-fabsf(f)));
            int b, kidx; if (r < MX) { b = r >> 13; kidx = r & 8191; } else { const int j = r - MX; b = j >> 4; kidx = 8192 + (j & 15); }
            logf_[(size_t)(b * 8 + lane) * LPK + kidx] = lf;
        }
    }
    __syncthreads();
    LAS char* tl = lds + 32768;
    const float* g2 = p.gains + 2 * D;
    constexpr int T_IN = 16 * 80, T_OF = 8 * 16, T_OS = 8 * 16, T_OUT = 16 * 16, T_UP = 16 * 88, T_DN = 44 * 16;
    constexpr int T_ALL = T_IN + T_OF + T_OS + T_OUT + T_UP + T_DN;
    for (int t = blockIdx.x; t < T_ALL; t += gridDim.x) {
        int u = t;
        if (u < T_IN) { const int nt = u % 80, kt = u / 80; const int sc = nt * 64 + (nt * 64 >= 1536 ? 8 : 0); transpose_tile(tl, p.w_in, PROJW, sc, kt * 64, g0, (bf16_t*)(ws + WS_BTIN), 1024, nt * 64); continue; }
        u -= T_IN;
        if (u < T_OF) { const int nt = u % 16, kt = u / 16; transpose_tile(tl, p.w_o_fox, 1024, nt * 64, kt * 64, nullptr, (bf16_t*)(ws + WS_BTOF), 512, nt * 64); continue; }
        u -= T_OF;
        if (u < T_OS) { const int nt = u % 16, kt = u / 16; transpose_tile(tl, p.w_o_sb, 1024, nt * 64, kt * 64, nullptr, (bf16_t*)(ws + WS_BTOS), 512, nt * 64); continue; }
        u -= T_OS;
        if (u < T_OUT) { const int nt = u % 16, kt = u / 16; transpose_tile(tl, p.w_out, 1024, nt * 64, kt * 64, nullptr, (bf16_t*)(ws + WS_BTOUT), 1024, nt * 64); continue; }
        u -= T_OUT;
        if (u < T_UP) { const int nt = u % 88, kt = u / 88; transpose_tile(tl, p.w_up, NUP, (nt & 1) * DFF + (nt >> 1) * 64, kt * 64, g2, (bf16_t*)(ws + WS_BTUP), 1024, nt * 64); continue; }
        u -= T_UP;
        { const int nt = u % 16, kt = u / 16; transpose_tile(tl, p.w_down, 1024, nt * 64, kt * 64, nullptr, (bf16_t*)(ws + WS_BTDN), DFF, nt * 64); }
    }
}

template <bool SWAP>
__device__ __forceinline__ void gemm_main(LAS char* lds, const bf16_t* Ag, int lda, const bf16_t* Bg, int ldb, int nk, f32x4 (&acc)[4][4], int mlim = 4) {
    const int tid = threadIdx.x, lane = tid & 63, w = wave_id(), wr = w >> 1, wc = w & 1;
    const int row_0 = w * 8 + (lane >> 3), c_0 = (lane & 7) ^ ((row_0 >> 1) & 7);
    const bf16_t* pa0 = Ag + (size_t)row_0 * lda + c_0 * 8; const bf16_t* pb0 = Bg + (size_t)row_0 * ldb + c_0 * 8;
    const size_t sa = (size_t)32 * lda, sb_ = (size_t)32 * ldb;
    const int swz = (lane >> 1) & 7;
    int aoff[2], boff[2];
#pragma unroll
    for (int kh = 0; kh < 2; ++kh) {
        aoff[kh] = (wr * 64 + (lane & 15)) * 128 + (((kh * 4 + (lane >> 4)) ^ swz) << 4);
        boff[kh] = 16384 + (wc * 64 + (lane & 15)) * 128 + (((kh * 4 + (lane >> 4)) ^ swz) << 4);
    }
#define GM_STAGE(s, kt) do { _Pragma("unroll") for (int i_ = 0; i_ < 4; ++i_) { \
        __builtin_amdgcn_global_load_lds((const unsigned*)(pa0 + i_ * sa + (kt) * 64), (LAS unsigned*)(lds + (s) * 32768 + (i_ * 4 + w) * 1024), 16, 0, 0); \
        __builtin_amdgcn_global_load_lds((const unsigned*)(pb0 + i_ * sb_ + (kt) * 64), (LAS unsigned*)(lds + (s) * 32768 + 16384 + (i_ * 4 + w) * 1024), 16, 0, 0); } } while (0)
    GM_STAGE(0, 0);
    for (int kt = 0; kt < nk; ++kt) {
        asm volatile("s_waitcnt vmcnt(0)" ::: "memory");
        __syncthreads();
        const int s = kt & 1;
        if (kt + 1 < nk) GM_STAGE(s ^ 1, kt + 1);
        bf16x8 af[4][2], bf[4][2];
#pragma unroll
        for (int kh = 0; kh < 2; ++kh) {
#pragma unroll
            for (int m = 0; m < 4; ++m) if (m < mlim) af[m][kh] = *(LAS bf16x8*)(lds + s * 32768 + aoff[kh] + m * 2048);
#pragma unroll
            for (int n = 0; n < 4; ++n) bf[n][kh] = *(LAS bf16x8*)(lds + s * 32768 + boff[kh] + n * 2048);
        }
        __builtin_amdgcn_s_setprio(1);
#pragma unroll
        for (int kh = 0; kh < 2; ++kh)
#pragma unroll
            for (int m = 0; m < 4; ++m) if (m < mlim) {
#pragma unroll
                for (int n = 0; n < 4; ++n)
                    acc[m][n] = SWAP ? __builtin_amdgcn_mfma_f32_16x16x32_bf16(bf[n][kh], af[m][kh], acc[m][n], 0, 0, 0)
                                     : __builtin_amdgcn_mfma_f32_16x16x32_bf16(af[m][kh], bf[n][kh], acc[m][n], 0, 0, 0);
            }
        __builtin_amdgcn_s_setprio(0);
    }
    __syncthreads();
#undef GM_STAGE
}
__device__ __forceinline__ void zero_acc(f32x4 (&acc)[4][4]) {
#pragma unroll
    for (int m = 0; m < 4; ++m)
#pragma unroll
        for (int n = 0; n < 4; ++n) acc[m][n] = (f32x4){0.f, 0.f, 0.f, 0.f};
}


__device__ __forceinline__ int tile_at(int it, int ntm, int ntn, int& tm, int& tn) {
    const int G = gridDim.x;
    if (G % 256 != 0) { const int t = it * G + blockIdx.x; if (t >= ntm * ntn) return 0; tm = t / ntn; tn = t % ntn; return 1; }
    const int xcd = blockIdx.x & 7, j = blockIdx.x >> 3, ppx = G >> 8;
    const int pcols = (ntn + 3) >> 2, prows = (ntm + 7) >> 3;
    const int patch = (it * ppx + (j >> 5)) * 8 + xcd;
    if (patch >= prows * pcols) return 0;
    const int wi = j & 31;
    tm = (patch / pcols) * 8 + (wi >> 2); tn = (patch % pcols) * 4 + (wi & 3);
    return (tm < ntm && tn < ntn) ? 1 : 2;
}
__device__ __forceinline__ void cumsum_block(const Params& p, LAS char* lds, int bh) {
    const float* lf = (const float*)(p.ws + WS_LOGF) + (size_t)bh * LPK; float* ck = (float*)(p.ws + WS_CK) + (size_t)bh * LPK;
    LAS float* sums = (LAS float*)lds;
    const int tid = threadIdx.x; constexpr int PER = 33, L = SEQ + NMETA;
    float loc = 0.f;
    for (int e = 0; e < PER; ++e) { const int t = tid * PER + e; if (t < L) loc += lf[t < 16 ? 8192 + t : t - 16]; }
    sums[tid] = loc;
    __syncthreads();
    float run = 0.f;
    for (int i = 0; i < tid; ++i) run += sums[i];
    for (int e = 0; e < PER; ++e) { const int t = tid * PER + e; if (t < L) { const int kx = t < 16 ? 8192 + t : t - 16; run += lf[kx]; ck[kx] = run * LOG2E; } }
    __syncthreads();
}

__device__ __forceinline__ void phase1(const Params& p, LAS char* lds) {
    unsigned char* ws = p.ws;
    if (blockIdx.x < 16) cumsum_block(p, lds, blockIdx.x);
    const int lane = threadIdx.x & 63, w = wave_id(), wr = w >> 1, wc = w & 1;
    const bf16_t* xb = (const bf16_t*)(ws + WS_A); const bf16_t* Bt = (const bf16_t*)(ws + WS_BTIN);
    const float* r1 = (const float*)(ws + WS_R1);
    constexpr int NTN = 40, NTM = 129;
    for (int it = 0;; ++it) {
        int tm, tn; int st = tile_at(it, NTM - 1, NTN, tm, tn);
        if (st == 0) { if (it < (1 << 20) && (int)blockIdx.x < NTN) { tm = NTM - 1; tn = blockIdx.x; it = 1 << 20; st = 1; } else break; }
        if (st == 2) continue;
        const int row0 = tm * 128, col0 = tn * 128; const int mlim = tm == NTM - 1 ? (wr == 0 ? 2 : 0) : 4;
        const bool vtile = (tn >= 8 && tn < 12) || (tn >= 20 && tn < 24);
        f32x4 acc[4][4]; zero_acc(acc);
        if (vtile) {
            gemm_main<false>(lds, xb + (size_t)row0 * D, D, Bt + (size_t)col0 * D, D, 16, acc, mlim);
            bf16_t* vT = (bf16_t*)(ws + (tn < 12 ? WS_VFT : WS_VST)); const int cb = tn < 12 ? 1024 : 2560;
            const int g = lane >> 4, gp = ((g & 1) << 1) | (g >> 1);
#pragma unroll
            for (int m = 0; m < 4; ++m) {
                const int rb = row0 + wr * 64 + m * 16; int b, kb16;
                if (rb < MX) { b = rb >> 13; kb16 = rb & 8191; } else { const int j = rb - MX; if (j >= 32) continue; b = j >> 4; kb16 = 8192; }
                const f32x4 rs = *(const f32x4*)(r1 + rb + g * 4);
#pragma unroll
                for (int n = 0; n < 4; ++n) {
                    const int dc = col0 + wc * 64 + n * 16 + (lane & 15) - cb, h = dc >> 6, d = dc & 63;
                    const f32x4 v = acc[m][n] * rs;
                    *(u32x2*)(vT + ((size_t)(b * 8 + h) * 64 + d) * LPK + kb16 + gp * 4) = (u32x2){pk_bf16(v[0], v[1]), pk_bf16(v[2], v[3])};
                }
            }
        } else {
            gemm_main<true>(lds, xb + (size_t)row0 * D, D, Bt + (size_t)col0 * D, D, 16, acc, mlim);
            bf16_t* dst; int ld, cb; float sc = 1.f; bool sg = false;
            if (tn < 4) { dst = (bf16_t*)(ws + WS_QF); ld = 512; cb = 0; sc = 0.125f * LOG2E; }
            else if (tn < 8) { dst = (bf16_t*)(ws + WS_KF); ld = 512; cb = 512; }
            else if (tn < 16) { dst = (bf16_t*)(ws + WS_QS); ld = 512; cb = 1536; sc = 0.125f; }
            else if (tn < 20) { dst = (bf16_t*)(ws + WS_KS); ld = 512; cb = 2048; }
            else if (tn < 32) { dst = (bf16_t*)(ws + WS_B); ld = 1024; cb = 3072; sg = true; }
            else { dst = (bf16_t*)(ws + WS_B + SZ_M1024); ld = 1024; cb = 4096; sg = true; }
            const bool kfox = tn >= 4 && tn < 8;
            float wmax = 0.f;
#pragma unroll
            for (int m = 0; m < 4; ++m) {
                const int row = row0 + wr * 64 + m * 16 + (lane & 15); const float rs = r1[row] * sc;
                float s2 = 0.f;
#pragma unroll
                for (int n = 0; n < 4; ++n) {
                    const int col = col0 + wc * 64 + n * 16 + (lane >> 4) * 4 - cb;
                    f32x4 v = acc[m][n] * rs;
                    if (sg) { v[0] = sigmoidf_(v[0]); v[1] = sigmoidf_(v[1]); v[2] = sigmoidf_(v[2]); v[3] = sigmoidf_(v[3]); }
                    s2 += v[0] * v[0] + v[1] * v[1] + v[2] * v[2] + v[3] * v[3];
                    *(u32x2*)(dst + (size_t)row * ld + col) = (u32x2){pk_bf16(v[0], v[1]), pk_bf16(v[2], v[3])};
                }
                if (kfox) { s2 += __shfl_xor(s2, 16); s2 += __shfl_xor(s2, 32); wmax = fmaxf(wmax, s2); }
            }
            if (kfox) {
#pragma unroll
                for (int o = 1; o < 16; o <<= 1) wmax = fmaxf(wmax, __shfl_xor(wmax, o));
                if (lane == 0) {
                    unsigned* km = (unsigned*)(ws + WS_CTL) + 32; const int head = (tn - 4) * 2 + wc; const unsigned bits = __float_as_uint(wmax);
                    if (row0 < MX) atomicMax(km + (row0 >> 13) * 8 + head, bits);
                    else { atomicMax(km + head, bits); atomicMax(km + 8 + head, bits); }
                }
            }
        }
    }
}

constexpr int AT_STAGE = 16640;
template <int TYPE>
__device__ __forceinline__ void attn_unit(LAS char* lds, const Params& p, int b, int h, int qb) {
    unsigned char* ws = p.ws;
    const int tid = threadIdx.x, lane = tid & 63, w = wave_id(), ql = lane & 31, hi = lane >> 5;
    const bf16_t* Q = (const bf16_t*)(ws + (TYPE == 0 ? WS_QF : WS_QS));
    const bf16_t* Kp = (const bf16_t*)(ws + (TYPE == 0 ? WS_KF : WS_KS));
    const bf16_t* VT = (const bf16_t*)(ws + (TYPE == 0 ? WS_VFT : WS_VST)) + (size_t)(b * 8 + h) * 64 * LPK;
    const float* cK = (const float*)(ws + WS_CK) + (size_t)(b * 8 + h) * LPK;
    bf16_t* Oo = (bf16_t*)(ws + WS_A + (TYPE == 0 ? 0 : SZ_M512));
    const bool meta_unit = qb < 0;
    const int qrow0 = meta_unit ? MX + 16 * b : b * SEQ + qb * 128;
    const int nt = meta_unit ? 1 : 2 * qb + 3;
    int qrow = qrow0 + 32 * w + ql; if (qrow > M - 1) qrow = M - 1;
    bf16x8 qf[4];
#pragma unroll
    for (int ds = 0; ds < 4; ++ds) qf[ds] = *(const bf16x8*)(Q + (size_t)qrow * 512 + h * 64 + ds * 16 + hi * 8);
    f32x16 O0, O1;
#pragma unroll
    for (int i = 0; i < 16; ++i) { O0[i] = 0.f; O1[i] = 0.f; }
    float m_run = -INFINITY, lsum = 0.f, R = 0.f;
    float qbound = 0.f;
    if (TYPE == 0) {
        float q2 = 0.f;
#pragma unroll
        for (int ds = 0; ds < 4; ++ds)
#pragma unroll
            for (int e = 0; e < 8; ++e) { const float x = __uint_as_float((unsigned)(unsigned short)qf[ds][e] << 16); q2 += x * x; }
        q2 += __shfl_xor(q2, 32);
        const unsigned kb = __hip_atomic_load((unsigned*)(ws + WS_CTL) + 32 + b * 8 + h, __ATOMIC_RELAXED, __HIP_MEMORY_SCOPE_AGENT);
        qbound = sqrtf(q2) * sqrtf(__uint_as_float(kb)) * 1.02f + 1.0f;
    }
    u32x4 kreg[2], vreg[2]; float creg = 0.f;
    const int srow = tid >> 3, spos = tid & 7;
    const int swz_st = (spos ^ ((srow >> 1) & 7)) << 4;
    const int swz = (lane >> 1) & 7;
    LAS unsigned* flags = (LAS unsigned*)(lds + 2 * AT_STAGE);
#define AT_LOAD(j) do { int krow0_, kidx0_; if (!meta_unit && (j) < nt - 1) { const int kt_ = nt - 2 - (j); krow0_ = b * SEQ + 64 * kt_; kidx0_ = 64 * kt_; } else { krow0_ = MX + 16 * b; kidx0_ = 8192; } \
        _Pragma("unroll") for (int i_ = 0; i_ < 2; ++i_) { \
            kreg[i_] = *(const u32x4*)(Kp + (size_t)(krow0_ + srow + 32 * i_) * 512 + h * 64 + spos * 8); \
            vreg[i_] = *(const u32x4*)(VT + (size_t)(srow + 32 * i_) * LPK + kidx0_ + spos * 8); } \
        if (TYPE == 0 && tid < 64) creg = cK[kidx0_ + tid]; } while (0)
#define AT_WRITE(s) do { _Pragma("unroll") for (int i_ = 0; i_ < 2; ++i_) { \
            *(LAS u32x4*)(lds + (s) * AT_STAGE + (srow + 32 * i_) * 128 + swz_st) = kreg[i_]; \
            *(LAS u32x4*)(lds + (s) * AT_STAGE + 8192 + (srow + 32 * i_) * 128 + swz_st) = vreg[i_]; } \
        if (TYPE == 0 && tid < 64) *(LAS float*)(lds + (s) * AT_STAGE + 16384 + tid * 4) = creg; } while (0)
    AT_LOAD(0); AT_WRITE(0);
    __syncthreads();
    for (int j = 0; j < nt; ++j) {
        const bool more = j + 1 < nt;
        if (more) AT_LOAD(j + 1);
        int klim, d0;
        if (meta_unit) { klim = 16; d0 = 0; }
        else if (j == nt - 1) { klim = 16; d0 = 1 << 20; }
        else { klim = 64; d0 = 128 * qb - 64 * (nt - 2 - j); if (d0 >= 64) d0 = 1 << 20; }
        const int limw = 32 * w + d0 - TYPE;
        bool wdone = false, nomax = false;
        if (TYPE == 0) {
            const float clast = *(const LAS float*)(lds + (j & 1) * AT_STAGE + 16384 + (klim - 1) * 4);
            wdone = __all((qbound - clast - m_run) < -126.0f) != 0;
            nomax = __all((qbound - clast) <= m_run) != 0;
        }
        if (limw + 31 >= 0 && !(TYPE == 0 && wdone)) {
            const LAS char* sb = lds + (j & 1) * AT_STAGE;
            int kmax = limw + ql; if (kmax > klim - 1) kmax = klim - 1;
            const bool needmask = (klim < 64) || (limw < 63);
            f32x16 S0, S1;
#pragma unroll
            for (int i = 0; i < 16; ++i) { S0[i] = 0.f; S1[i] = 0.f; }
#pragma unroll
            for (int ds = 0; ds < 4; ++ds) {
                const bf16x8 k0 = *(const LAS bf16x8*)(sb + ql * 128 + (((2 * ds + hi) ^ swz) << 4));
                const bf16x8 k1 = *(const LAS bf16x8*)(sb + (32 + ql) * 128 + (((2 * ds + hi) ^ swz) << 4));
                S0 = __builtin_amdgcn_mfma_f32_32x32x16_bf16(k0, qf[ds], S0, 0, 0, 0);
                S1 = __builtin_amdgcn_mfma_f32_32x32x16_bf16(k1, qf[ds], S1, 0, 0, 0);
            }
            if (TYPE == 0) {
#pragma unroll
                for (int g = 0; g < 4; ++g) {
                    const f32x4 c0 = *(const LAS f32x4*)(sb + 16384 + (8 * g + 4 * hi) * 4), c1 = *(const LAS f32x4*)(sb + 16384 + (32 + 8 * g + 4 * hi) * 4);
#pragma unroll
                    for (int i = 0; i < 4; ++i) { S0[4 * g + i] -= c0[i]; S1[4 * g + i] -= c1[i]; }
                }
                if (needmask) {
#pragma unroll
                    for (int r = 0; r < 16; ++r) { const int kl = (r & 3) + 8 * (r >> 2) + 4 * hi; if (kl > kmax) S0[r] = -INFINITY; if (kl + 32 > kmax) S1[r] = -INFINITY; }
                }
                if (!nomax) {
                    float mx = -INFINITY;
#pragma unroll
                    for (int r = 0; r < 16; ++r) mx = fmaxf(mx, fmaxf(S0[r], S1[r]));
                    mx = fmaxf(mx, __shfl_xor(mx, 32));
                    const float m_new = fmaxf(m_run, mx), alpha = ex2(m_run - m_new);
                    m_run = m_new;
                    lsum *= alpha;
#pragma unroll
                    for (int r = 0; r < 16; ++r) { O0[r] *= alpha; O1[r] *= alpha; }
                }
                float ps = 0.f;
#pragma unroll
                for (int r = 0; r < 16; ++r) { S0[r] = ex2(S0[r] - m_run); S1[r] = ex2(S1[r] - m_run); ps += S0[r] + S1[r]; }
                lsum += ps;
            } else {
                float G0[4], G1[4];
                f32x16 L0, L1;
#pragma unroll
                for (int r = 0; r < 16; ++r) {
                    const int kl = (r & 3) + 8 * (r >> 2) + 4 * hi;
                    const float z0 = S0[r], z1 = S1[r];
                    const float sp0 = fmaxf(z0, 0.f) + lg2(1.0f + ex2(-fabsf(z0) * LOG2E)) * LN2;
                    const float sp1 = fmaxf(z1, 0.f) + lg2(1.0f + ex2(-fabsf(z1) * LOG2E)) * LN2;
                    L0[r] = (!needmask || kl <= kmax) ? -sp0 : 0.f;
                    L1[r] = (!needmask || kl + 32 <= kmax) ? -sp1 : 0.f;
                }
#pragma unroll
                for (int g = 0; g < 4; ++g) {
                    L0[4 * g + 2] += L0[4 * g + 3]; L0[4 * g + 1] += L0[4 * g + 2]; L0[4 * g] += L0[4 * g + 1]; G0[g] = L0[4 * g];
                    L1[4 * g + 2] += L1[4 * g + 3]; L1[4 * g + 1] += L1[4 * g + 2]; L1[4 * g] += L1[4 * g + 1]; G1[g] = L1[4 * g];
                }
                float run = R;
#pragma unroll
                for (int g = 3; g >= 0; --g) {
                    const float gp = __shfl_xor(G1[g], 32);
                    const float off = hi ? run : run + gp;
#pragma unroll
                    for (int i = 0; i < 4; ++i) { const int r = 4 * g + i; const int kl = 32 + i + 8 * g + 4 * hi;
                        const float a = ex2((S1[r] + L1[r] + off) * LOG2E); S1[r] = (!needmask || kl <= kmax) ? a : 0.f; }
                    run += G1[g] + gp;
                }
#pragma unroll
                for (int g = 3; g >= 0; --g) {
                    const float gp = __shfl_xor(G0[g], 32);
                    const float off = hi ? run : run + gp;
#pragma unroll
                    for (int i = 0; i < 4; ++i) { const int r = 4 * g + i; const int kl = i + 8 * g + 4 * hi;
                        const float a = ex2((S0[r] + L0[r] + off) * LOG2E); S0[r] = (!needmask || kl <= kmax) ? a : 0.f; }
                    run += G0[g] + gp;
                }
                R = run;
                wdone = __all(R < -120.0f) != 0;
            }
#pragma unroll
            for (int ks = 0; ks < 4; ++ks) {
                bf16x8 pf; u32x4 pu;
                if (ks < 2) { pu = (u32x4){pk_bf16(S0[8 * ks + 0], S0[8 * ks + 1]), pk_bf16(S0[8 * ks + 2], S0[8 * ks + 3]), pk_bf16(S0[8 * ks + 4], S0[8 * ks + 5]), pk_bf16(S0[8 * ks + 6], S0[8 * ks + 7])}; }
                else { const int k2 = ks - 2; pu = (u32x4){pk_bf16(S1[8 * k2 + 0], S1[8 * k2 + 1]), pk_bf16(S1[8 * k2 + 2], S1[8 * k2 + 3]), pk_bf16(S1[8 * k2 + 4], S1[8 * k2 + 5]), pk_bf16(S1[8 * k2 + 6], S1[8 * k2 + 7])}; }
                pf = __builtin_bit_cast(bf16x8, pu);
                const bf16x8 v0 = *(const LAS bf16x8*)(sb + 8192 + ql * 128 + (((2 * ks + hi) ^ swz) << 4));
                const bf16x8 v1 = *(const LAS bf16x8*)(sb + 8192 + (32 + ql) * 128 + (((2 * ks + hi) ^ swz) << 4));
                O0 = __builtin_amdgcn_mfma_f32_32x32x16_bf16(v0, pf, O0, 0, 0, 0);
                O1 = __builtin_amdgcn_mfma_f32_32x32x16_bf16(v1, pf, O1, 0, 0, 0);
            }
        }
        if (more) AT_WRITE((j + 1) & 1);
        if (lane == 0) flags[(j & 1) * 4 + w] = wdone ? 1u : 0u;
        __syncthreads();
        { const LAS unsigned* fl = flags + (j & 1) * 4; const unsigned f = fl[0] & fl[1] & fl[2] & fl[3]; if (f) break; }
    }
    float inv = 1.0f;
    if (TYPE == 0) { const float l = lsum + __shfl_xor(lsum, 32); inv = 1.0f / l; }
    const bool qvalid = meta_unit ? (w == 0 && ql < 16) : true;
    if (qvalid) {
        bf16_t* op = Oo + (size_t)qrow * 512 + h * 64 + 4 * hi;
#pragma unroll
        for (int g = 0; g < 4; ++g) {
            *(u32x2*)(op + 8 * g) = (u32x2){pk_bf16(O0[4 * g] * inv, O0[4 * g + 1] * inv), pk_bf16(O0[4 * g + 2] * inv, O0[4 * g + 3] * inv)};
            *(u32x2*)(op + 32 + 8 * g) = (u32x2){pk_bf16(O1[4 * g] * inv, O1[4 * g + 1] * inv), pk_bf16(O1[4 * g + 2] * inv, O1[4 * g + 3] * inv)};
        }
    }
    __syncthreads();
#undef AT_LOAD
#undef AT_WRITE
}

__device__ __forceinline__ void phase2(const Params& p, LAS char* lds) {
    unsigned* ctr = (unsigned*)(p.ws + WS_CTL);
    LAS unsigned* shu = (LAS unsigned*)(lds + 2 * AT_STAGE + 64);
    constexpr int NU = 2048 + 32;
    for (;;) {
        if (threadIdx.x == 0) shu[0] = __hip_atomic_fetch_add(ctr, 1u, __ATOMIC_RELAXED, __HIP_MEMORY_SCOPE_AGENT);
        __syncthreads();
        const int u = (int)shu[0];
        __syncthreads();
        if (u >= NU) break;
        if (u < 1024) attn_unit<0>(lds, p, (u & 15) >> 3, u & 7, 63 - (u >> 4));
        else if (u < 2048) { const int v = u - 1024; attn_unit<1>(lds, p, (v & 15) >> 3, v & 7, 63 - (v >> 4)); }
        else if (u < 2064) { const int v = u - 2048; attn_unit<0>(lds, p, v >> 3, v & 7, -1); }
        else { const int v = u - 2064; attn_unit<1>(lds, p, v >> 3, v & 7, -1); }
    }
}

__device__ __forceinline__ void phase3a(const Params& p, LAS char* lds) {
    unsigned char* ws = p.ws;
    const int lane = threadIdx.x & 63, w = wave_id(), wr = w >> 1, wc = w & 1;
    const bf16_t* oa = (const bf16_t*)(ws + WS_A); const bf16_t* ob = oa + (size_t)M * 512;
    const bf16_t* ga = (const bf16_t*)(ws + WS_B); const bf16_t* gb = ga + (size_t)M * 1024;
    bf16_t* gated = (bf16_t*)(ws + WS_GATED);
    for (int it = 0;; ++it) {
        int tm, tn; int st = tile_at(it, 128, 8, tm, tn);
        if (st == 0) { if (it < (1 << 20) && (int)blockIdx.x < 8) { tm = 128; tn = blockIdx.x; it = 1 << 20; st = 1; } else break; }
        if (st == 2) continue;
        const int row0 = tm * 128, col0 = tn * 128; const int mlim = tm == 128 ? (wr == 0 ? 2 : 0) : 4;
        f32x4 acc[4][4]; zero_acc(acc);
        gemm_main<true>(lds, oa + (size_t)row0 * 512, 512, (const bf16_t*)(ws + WS_BTOF) + (size_t)col0 * 512, 512, 8, acc, mlim);
#pragma unroll
        for (int m = 0; m < 4; ++m) {
            const int row = row0 + wr * 64 + m * 16 + (lane & 15);
#pragma unroll
            for (int n = 0; n < 4; ++n) {
                const int col = col0 + wc * 64 + n * 16 + (lane >> 4) * 4;
                const u32x2 a = *(const u32x2*)(ga + (size_t)row * 1024 + col);
                const f32x4 x = acc[m][n];
                *(u32x2*)(gated + (size_t)row * 1024 + col) = (u32x2){pk_bf16(bf_lo(a[0]) * x[0], bf_hi(a[0]) * x[1]), pk_bf16(bf_lo(a[1]) * x[2], bf_hi(a[1]) * x[3])};
            }
        }
        zero_acc(acc);
        gemm_main<true>(lds, ob + (size_t)row0 * 512, 512, (const bf16_t*)(ws + WS_BTOS) + (size_t)col0 * 512, 512, 8, acc, mlim);
#pragma unroll
        for (int m = 0; m < 4; ++m) {
            const int row = row0 + wr * 64 + m * 16 + (lane & 15);
#pragma unroll
            for (int n = 0; n < 4; ++n) {
                const int col = col0 + wc * 64 + n * 16 + (lane >> 4) * 4;
                const u32x2 b = *(const u32x2*)(gb + (size_t)row * 1024 + col);
                const f32x4 y = acc[m][n]; const u32x2 q = *(const u32x2*)(gated + (size_t)row * 1024 + col);
                const float o0 = bf_lo(q[0]) + bf_lo(b[0]) * y[0], o1 = bf_hi(q[0]) + bf_hi(b[0]) * y[1];
                const float o2 = bf_lo(q[1]) + bf_lo(b[1]) * y[2], o3 = bf_hi(q[1]) + bf_hi(b[1]) * y[3];
                *(u32x2*)(gated + (size_t)row * 1024 + col) = (u32x2){pk_bf16(o0, o1), pk_bf16(o2, o3)};
            }
        }
    }
}
__device__ __forceinline__ void epi_store_ss(const f32x4 (&acc)[4][4], bf16_t* out, int ldo, int orow0, int col0, float* ssp, int ssrow0, int wr, int wc, int lane) {
#pragma unroll
    for (int m = 0; m < 4; ++m) {
        const int rl = wr * 64 + m * 16 + (lane & 15);
        float s = 0.f;
#pragma unroll
        for (int n = 0; n < 4; ++n) {
            const int col = col0 + wc * 64 + n * 16 + (lane >> 4) * 4;
            const f32x4 v = acc[m][n];
            s += v[0] * v[0] + v[1] * v[1] + v[2] * v[2] + v[3] * v[3];
            *(u32x2*)(out + (size_t)(orow0 + rl) * ldo + col) = (u32x2){pk_bf16(v[0], v[1]), pk_bf16(v[2], v[3])};
        }
#if 1
        s += __shfl_xor(s, 16); s += __shfl_xor(s, 32);
        if (lane < 16) ssp[(size_t)((col0 >> 7) * 2 + wc) * M + ssrow0 + rl] = s;
#endif
    }
}
__device__ __forceinline__ void phase3b(const Params& p, LAS char* lds) {
    unsigned char* ws = p.ws;
    const int lane = threadIdx.x & 63, w = wave_id(), wr = w >> 1, wc = w & 1;
    const bf16_t* gated = (const bf16_t*)(ws + WS_GATED); bf16_t* mixed = (bf16_t*)(ws + WS_MIXED);
    for (int it = 0;; ++it) {
        int tm, tn; int st = tile_at(it, 128, 8, tm, tn);
        if (st == 0) { if (it < (1 << 20) && (int)blockIdx.x < 8) { tm = 128; tn = blockIdx.x; it = 1 << 20; st = 1; } else break; }
        if (st == 2) continue;
        const int row0 = tm * 128, col0 = tn * 128; const int mlim = tm == 128 ? (wr == 0 ? 2 : 0) : 4;
        f32x4 acc[4][4]; zero_acc(acc);
        gemm_main<true>(lds, gated + (size_t)row0 * 1024, 1024, (const bf16_t*)(ws + WS_BTOUT) + (size_t)col0 * 1024, 1024, 16, acc, mlim);
        epi_store_ss(acc, mixed, 1024, row0, col0, (float*)(ws + WS_SSP2), row0, wr, wc, lane);
    }
}
__device__ __forceinline__ void phase3c(const Params& p) {
    unsigned char* ws = p.ws;
    const int lane = threadIdx.x & 63, w = wave_id();
    const bf16_t* mixed = (const bf16_t*)(ws + WS_MIXED); bf16_t* hb = (bf16_t*)(ws + WS_A);
    const float* ssp2 = (const float*)(ws + WS_SSP2); float* r2 = (float*)(ws + WS_R2);
    const float* g1 = p.gains + D;
    for (int r_ = blockIdx.x * 32 + w; r_ < M; r_ += (r_ & 31) < 28 ? 4 : gridDim.x * 32 - 28) {
        const int r = r_;
        if (r >= MV) continue;
        const float* src = r < MX ? p.x + (size_t)r * D : p.meta + (size_t)((r - MX) & 15) * D;
        float sq = lane < 16 ? ssp2[(size_t)lane * M + r] : 0.f;
        sq = wave_sum(sq);
        const float a = 1.0f / sqrtf(sq * (1.0f / D) + EPS);
        float ss = 0.f;
#pragma unroll
        for (int i = 0; i < 4; ++i) {
            const int col = lane * 4 + 256 * i;
            const f32x4 v = *(const f32x4*)(src + col), g = *(const f32x4*)(g1 + col);
            const u32x2 mx = *(const u32x2*)(mixed + (size_t)r * D + col);
            f32x4 hh;
            hh[0] = v[0] + bf_lo(mx[0]) * a * g[0]; hh[1] = v[1] + bf_hi(mx[0]) * a * g[1];
            hh[2] = v[2] + bf_lo(mx[1]) * a * g[2]; hh[3] = v[3] + bf_hi(mx[1]) * a * g[3];
            ss += hh[0] * hh[0] + hh[1] * hh[1] + hh[2] * hh[2] + hh[3] * hh[3];
            *(u32x2*)(hb + (size_t)r * D + col) = (u32x2){pk_bf16(hh[0], hh[1]), pk_bf16(hh[2], hh[3])};
            if (r < MX) *(f32x4*)(p.out + (size_t)r * D + col) = hh;
        }
        ss = wave_sum(ss);
        if (lane == 0) r2[r] = 1.0f / sqrtf(ss * (1.0f / D) + EPS);
    }
}
constexpr int UST = 272;
__device__ __forceinline__ f32x4 unpack4(const u32x2 u) { return (f32x4){bf_lo(u[0]), bf_hi(u[0]), bf_lo(u[1]), bf_hi(u[1])}; }
struct ConvW { f32x4 w0g, w1g, w2g, bg, w0v, w1v, w2v, bv; };
__device__ __forceinline__ ConvW load_convw(const Params& p, int c) {
    ConvW q;
    q.w0g = *(const f32x4*)(p.conv_w + c); q.w1g = *(const f32x4*)(p.conv_w + NUP + c); q.w2g = *(const f32x4*)(p.conv_w + 2 * NUP + c); q.bg = *(const f32x4*)(p.conv_b + c);
    q.w0v = *(const f32x4*)(p.conv_w + DFF + c); q.w1v = *(const f32x4*)(p.conv_w + NUP + DFF + c); q.w2v = *(const f32x4*)(p.conv_w + 2 * NUP + DFF + c); q.bv = *(const f32x4*)(p.conv_b + DFF + c);
    return q;
}
__device__ __forceinline__ u32x2 conv_gelu4(const ConvW& q, const f32x4 g2, const f32x4 g1, const f32x4 g0, const f32x4 v2, const f32x4 v1, const f32x4 v0) {
    float o[4];
#pragma unroll
    for (int e = 0; e < 4; ++e) {
        const float ug = q.bg[e] + q.w0g[e] * g2[e] + q.w1g[e] * g1[e] + q.w2g[e] * g0[e];
        const float uv = q.bv[e] + q.w0v[e] * v2[e] + q.w1v[e] * v1[e] + q.w2v[e] * v0[e];
        const float t = 0.7978845608028654f * (ug + 0.044715f * ug * ug * ug);
        o[e] = ug * rcp(1.0f + ex2(-2.0f * LOG2E * t)) * uv;
    }
    return (u32x2){pk_bf16(o[0], o[1]), pk_bf16(o[2], o[3])};
}
__device__ __forceinline__ void phase4(const Params& p, LAS char* lds) {
    unsigned char* ws = p.ws;
    const int tid = threadIdx.x, lane = tid & 63, w = wave_id(), wr = w >> 1, wc = w & 1;
    const bf16_t* hb = (const bf16_t*)(ws + WS_A); const bf16_t* Bt = (const bf16_t*)(ws + WS_BTUP);
    const float* r2 = (const float*)(ws + WS_R2);
    bf16_t* act = (bf16_t*)(ws + WS_ACT); bf16_t* hal = (bf16_t*)(ws + WS_HAL);
    for (int it = 0;; ++it) {
        int tm, tn; int st = tile_at(it, 128, 44, tm, tn);
        if (st == 0) { if (it < (1 << 20) && (int)blockIdx.x < 44) { tm = 128; tn = blockIdx.x; it = 1 << 20; st = 1; } else break; }
        if (st == 2) continue;
        const bool mt = tm == 128; const int row0 = mt ? MX : tm * 128, col0 = tn * 128;
        f32x4 acc[4][4]; zero_acc(acc);
        gemm_main<true>(lds, hb + (size_t)row0 * D, D, Bt + (size_t)col0 * D, D, 16, acc, mt ? (wr == 0 ? 2 : 0) : 4);
#pragma unroll
        for (int m = 0; m < 4; ++m) {
            const int rl = wr * 64 + m * 16 + (lane & 15); const float rs = r2[row0 + rl];
#pragma unroll
            for (int n = 0; n < 4; ++n) {
                const int cl = wc * 64 + n * 16 + (lane >> 4) * 4; const f32x4 v = acc[m][n] * rs;
                *(LAS u32x2*)(lds + rl * UST + cl * 2) = (u32x2){pk_bf16(v[0], v[1]), pk_bf16(v[2], v[3])};
            }
        }
        __syncthreads();
        if (!mt) {
            const int cg = tid & 15, rb = tid >> 4, c = tn * 64 + cg * 4;
            const ConvW q = load_convw(p, c);
            const int hr = rb == 0 ? 0 : rb * 8 - 2;
            f32x4 g2 = unpack4(*(const LAS u32x2*)(lds + hr * UST + cg * 8)), v2 = unpack4(*(const LAS u32x2*)(lds + hr * UST + 128 + cg * 8));
            f32x4 g1 = unpack4(*(const LAS u32x2*)(lds + (hr + 1) * UST + cg * 8)), v1 = unpack4(*(const LAS u32x2*)(lds + (hr + 1) * UST + 128 + cg * 8));
            for (int r = hr + 2; r < rb * 8 + 8; ++r) {
                const f32x4 g0 = unpack4(*(const LAS u32x2*)(lds + r * UST + cg * 8)), v0 = unpack4(*(const LAS u32x2*)(lds + r * UST + 128 + cg * 8));
                *(u32x2*)(act + (size_t)(row0 + r) * DFF + c) = conv_gelu4(q, g2, g1, g0, v2, v1, v0);
                g2 = g1; g1 = g0; v2 = v1; v1 = v0;
            }
            if (tid < 64) { const int qq = tid >> 4, ch = tid & 15, rl = qq < 2 ? qq : 124 + qq;
                *(u32x4*)(hal + ((size_t)tm * 4 + qq) * NUP + col0 + ch * 8) = *(const LAS u32x4*)(lds + rl * UST + ch * 16); }
        } else {
            if (tid < 64) { const int qq = tid >> 4, ch = tid & 15, rl = (qq >> 1) * 16 + 14 + (qq & 1);
                *(u32x4*)(hal + ((size_t)(128 + (qq >> 1)) * 4 + 2 + (qq & 1)) * NUP + col0 + ch * 8) = *(const LAS u32x4*)(lds + rl * UST + ch * 16); }
        }
        __syncthreads();
    }
}
__device__ __forceinline__ void phase_fix(const Params& p) {
    unsigned char* ws = p.ws;
    const bf16_t* hal = (const bf16_t*)(ws + WS_HAL); bf16_t* act = (bf16_t*)(ws + WS_ACT);
    constexpr int NCG = DFF / 4;
    for (int it = blockIdx.x * NTHREADS + threadIdx.x; it < 128 * NCG; it += gridDim.x * NTHREADS) {
        const int tmg = it / NCG, c = (it % NCG) * 4, colg = (c >> 6) * 128 + (c & 63), colv = colg + 64;
        const bf16_t* own = hal + (size_t)tmg * 4 * NUP;
        const bf16_t* prv = hal + (size_t)((tmg & 63) ? tmg - 1 : 128 + (tmg >> 6)) * 4 * NUP;
        const ConvW q = load_convw(p, c);
        const f32x4 pg2 = unpack4(*(const u32x2*)(prv + 2 * NUP + colg)), pv2 = unpack4(*(const u32x2*)(prv + 2 * NUP + colv));
        const f32x4 pg3 = unpack4(*(const u32x2*)(prv + 3 * NUP + colg)), pv3 = unpack4(*(const u32x2*)(prv + 3 * NUP + colv));
        const f32x4 og0 = unpack4(*(const u32x2*)(own + colg)), ov0 = unpack4(*(const u32x2*)(own + colv));
        const f32x4 og1 = unpack4(*(const u32x2*)(own + NUP + colg)), ov1 = unpack4(*(const u32x2*)(own + NUP + colv));
        *(u32x2*)(act + (size_t)(tmg * 128) * DFF + c) = conv_gelu4(q, pg2, pg3, og0, pv2, pv3, ov0);
        *(u32x2*)(act + (size_t)(tmg * 128 + 1) * DFF + c) = conv_gelu4(q, pg3, og0, og1, pv3, ov0, ov1);
    }
}
__device__ __forceinline__ void phase6(const Params& p, LAS char* lds) {
    unsigned char* ws = p.ws;
    const int lane = threadIdx.x & 63, w = wave_id(), wr = w >> 1, wc = w & 1;
    const bf16_t* act = (const bf16_t*)(ws + WS_ACT); bf16_t* ffn = (bf16_t*)(ws + WS_FFN);
    for (int it = 0;; ++it) {
        int tm, tn; const int st = tile_at(it, 128, 8, tm, tn); if (st == 0) break; if (st == 2) continue;
        const int col0 = tn * 128;
        f32x4 acc[4][4]; zero_acc(acc);
        gemm_main<true>(lds, act + (size_t)(tm * 128) * DFF, DFF, (const bf16_t*)(ws + WS_BTDN) + (size_t)col0 * DFF, DFF, 44, acc);
        epi_store_ss(acc, ffn, 1024, tm * 128, col0, (float*)(ws + WS_SSP4), tm * 128, wr, wc, lane);
    }
}
__device__ __forceinline__ void phase7(const Params& p) {
    unsigned char* ws = p.ws;
    const bf16_t* ffn = (const bf16_t*)(ws + WS_FFN); const float* ssp4 = (const float*)(ws + WS_SSP4); const float* g3 = p.gains + 3 * D;
    for (int it = blockIdx.x * NTHREADS + threadIdx.x; it < MX * 256; it += gridDim.x * NTHREADS) {
        const int row = it >> 8, col = (it & 255) * 4;
        float sq = 0.f;
#pragma unroll
        for (int sl = 0; sl < 16; ++sl) sq += ssp4[(size_t)sl * M + row];
        const float a = 1.0f / sqrtf(sq * (1.0f / D) + EPS);
        const f32x4 hh = *(const f32x4*)(p.out + (size_t)row * D + col), g = *(const f32x4*)(g3 + col);
        const u32x2 f = *(const u32x2*)(ffn + (size_t)row * D + col);
        f32x4 o;
        o[0] = hh[0] + bf_lo(f[0]) * a * g[0]; o[1] = hh[1] + bf_hi(f[0]) * a * g[1];
        o[2] = hh[2] + bf_lo(f[1]) * a * g[2]; o[3] = hh[3] + bf_hi(f[1]) * a * g[3];
        *(f32x4*)(p.out + (size_t)row * D + col) = o;
    }
}


#ifndef DUMP
#define DUMP 0
#endif
__device__ __forceinline__ void phase_dump(const Params& p) {
    unsigned char* ws = p.ws;
    const bf16_t* s0; const bf16_t* s1; int ld;
    if (DUMP == 1) { s0 = (const bf16_t*)(ws + WS_B); s1 = s0 + 512; ld = 1024; }
    else if (DUMP == 2) { s0 = (const bf16_t*)(ws + WS_QF); s1 = (const bf16_t*)(ws + WS_KF); ld = 512; }
    else if (DUMP == 3) { s0 = (const bf16_t*)(ws + WS_A); s1 = s0 + (size_t)M * 512; ld = 512; }
    else if (DUMP == 4) { s0 = (const bf16_t*)(ws + WS_GATED); s1 = s0 + 512; ld = 1024; }
    else if (DUMP == 8) { s0 = (const bf16_t*)(ws + WS_A); s1 = s0 + 512; ld = 1024; }
    else if (DUMP == 9) { s0 = (const bf16_t*)(ws + WS_ACT) + 1024; s1 = (const bf16_t*)(ws + WS_ACT) + 2304 - 512 + 512; ld = DFF; }
    else if (DUMP == 10) { s0 = (const bf16_t*)(ws + WS_FFN); s1 = s0 + 512; ld = 1024; }
    else if (DUMP == 6) { s0 = (const bf16_t*)(ws + WS_QS); s1 = (const bf16_t*)(ws + WS_KS); ld = 512; }
    else { s0 = (const bf16_t*)(ws + WS_MIXED); s1 = s0 + 512; ld = 1024; }
    for (int it = blockIdx.x * NTHREADS + threadIdx.x; it < MX * 1024; it += gridDim.x * NTHREADS) {
        const int row = it >> 10, col = it & 1023;
        if (DUMP >= 9 && row >= 8192) { p.out[it] = 0.f; continue; }
        const bf16_t v = col < 512 ? s0[(size_t)row * ld + col] : s1[(size_t)row * ld + col - 512];
        p.out[it] = __uint_as_float((unsigned)v << 16);
    }
}

__device__ __forceinline__ void l2_scrub(const Params& p) {
    const f32x4* src = (const f32x4*)p.x + (size_t)(blockIdx.x & 511) * 8192;
    f32x4 a = (f32x4){0.f, 0.f, 0.f, 0.f};
    for (int i = threadIdx.x; i < 8192; i += NTHREADS) a += src[i];
    if (a[0] + a[1] + a[2] + a[3] == 1.2345e-30f) ((float*)(p.ws + WS_CTL))[32 + (threadIdx.x & 7)] = a[0];
}


#define XB_TMO      128
#define XB_XCNT(j)  (256  + 64 * (j))
#define XB_XSUB(j)  (1280 + 64 * (j))
#define XB_XGEN(j)  (2304 + 64 * (j))
#define XB_TOP      3328
#define XB_TOPGEN   3392
#define XCD_BAR_WORDS 3456
#define XB_SPIN_CAP (1u << 18)
__device__ __forceinline__ unsigned xb_ld(unsigned* p)              { return __hip_atomic_load(p, __ATOMIC_RELAXED, __HIP_MEMORY_SCOPE_AGENT); }
__device__ __forceinline__ unsigned xb_add(unsigned* p, unsigned v) { return __hip_atomic_fetch_add(p, v, __ATOMIC_RELAXED, __HIP_MEMORY_SCOPE_AGENT); }
__device__ __forceinline__ unsigned xb_xcc_id() { return (unsigned)__builtin_amdgcn_s_getreg((3 << 11) | 20) & 0xFu; }
#define XB_SPIN(cond, bar) do { unsigned _sp = 0; while (cond) { __builtin_amdgcn_s_sleep(1); \
    if ((++_sp & 255u) == 0u) { if (xb_ld(&(bar)[XB_TMO])) break; if (_sp > XB_SPIN_CAP) { atomicAdd(&(bar)[XB_TMO], 1u); break; } } } } while (0)
struct XcdBarrier { unsigned* bar; unsigned x; volatile LAS unsigned* st; };
__device__ __forceinline__ XcdBarrier xcd_barrier_post(unsigned* bar, volatile LAS unsigned* st) {
    XcdBarrier b; b.bar = bar; b.x = xb_xcc_id(); b.st = st;
    if (threadIdx.x == 0) (void)xb_add(&bar[XB_XCNT(b.x)], 1u);
    return b;
}
__device__ __forceinline__ void xcd_barrier_complete(unsigned* bar, unsigned x, unsigned& nloc, unsigned& nx) {
    const unsigned G = gridDim.x * gridDim.y * gridDim.z;
    unsigned sum, cnt, mine, sp = 0u;
    for (;;) {
        sum = 0u; cnt = 0u; mine = 0u;
#pragma unroll
        for (unsigned j = 0; j < 16; ++j) { const unsigned c = xb_ld(&bar[XB_XCNT(j)]); sum += c; cnt += (c > 0u) ? 1u : 0u; mine = (j == x) ? c : mine; }
        if (sum == G) break;
        __builtin_amdgcn_s_sleep(1);
        if ((++sp & 255u) == 0u) { if (xb_ld(&bar[XB_TMO])) break; if (sp > XB_SPIN_CAP) { atomicAdd(&bar[XB_TMO], 1u); break; } }
    }
    nloc = mine > 0u ? mine : 1u; nx = cnt > 0u ? cnt : 1u;
}
__device__ __forceinline__ void xcd_barrier(const XcdBarrier& b) {
    asm volatile("s_waitcnt vmcnt(0)" ::: "memory");
    __syncthreads();
    if (threadIdx.x == 0) {
        unsigned* bar = b.bar;
        __builtin_amdgcn_s_waitcnt(0);
        unsigned nloc = b.st[0], nx = b.st[1];
        if (nloc == 0u) { xcd_barrier_complete(bar, b.x, nloc, nx); b.st[0] = nloc; b.st[1] = nx; }
        const unsigned old = xb_add(&bar[XB_XSUB(b.x)], 1u);
        const unsigned gen = old / nloc;
        if (old + 1u == (gen + 1u) * nloc) {
            __builtin_amdgcn_fence(__ATOMIC_RELEASE, "agent");
            asm volatile("s_waitcnt vmcnt(0)" ::: "memory");
            const unsigned og = xb_add(&bar[XB_TOP], 1u);
            const unsigned tg = og / nx;
            if (og + 1u == (tg + 1u) * nx) xb_add(&bar[XB_TOPGEN], 1u);
            else XB_SPIN(xb_ld(&bar[XB_TOPGEN]) == tg, bar);
            __builtin_amdgcn_fence(__ATOMIC_ACQUIRE, "agent");
            xb_add(&bar[XB_XGEN(b.x)], 1u);
            asm volatile("s_waitcnt vmcnt(0)" ::: "memory");
        } else {
            XB_SPIN(xb_ld(&bar[XB_XGEN(b.x)]) == gen, bar);
            __builtin_amdgcn_fence(__ATOMIC_ACQUIRE, "agent");
            asm volatile("s_waitcnt vmcnt(0)" ::: "memory");
        }
    }
    __syncthreads();
}

__device__ __forceinline__ void my_grid_sync(const Params& p, unsigned& target) {
    unsigned* bar = (unsigned*)(p.ws + WS_CTL) + 16;
    asm volatile("s_waitcnt vmcnt(0)" ::: "memory");
    __syncthreads();
    target += gridDim.x;
    if (threadIdx.x == 0) {
        __builtin_amdgcn_fence(__ATOMIC_RELEASE, "agent");
        asm volatile("s_waitcnt vmcnt(0)" ::: "memory");
        __hip_atomic_fetch_add(bar, 1u, __ATOMIC_RELAXED, __HIP_MEMORY_SCOPE_AGENT);
        while (__hip_atomic_load(bar, __ATOMIC_RELAXED, __HIP_MEMORY_SCOPE_AGENT) < target) __builtin_amdgcn_s_sleep(2);
        __builtin_amdgcn_fence(__ATOMIC_ACQUIRE, "agent");
        asm volatile("s_waitcnt vmcnt(0)" ::: "memory");
    }
    __syncthreads();
}
__global__ void __launch_bounds__(NTHREADS, 2) fwd_kernel(Params p) {
    extern __shared__ __attribute__((aligned(16))) unsigned char lds_raw[];
    LAS char* lds = (LAS char*)lds_raw;
    cg::grid_group grid = cg::this_grid();
#define IN(k) (p.ph_lo <= (k) && (k) < p.ph_hi)
#define SEAM(k) do { if (IN(k) && IN((k) + 1)) { if (p.ph_hi > 1000) grid.sync(); xcd_barrier(xbar); } } while (0)
    volatile LAS unsigned* xst = (volatile LAS unsigned*)(lds + 65536);
    if (threadIdx.x < 4) xst[threadIdx.x] = 0u;
    __syncthreads();
    const XcdBarrier xbar = xcd_barrier_post((unsigned*)(p.ws + WS_XBAR), xst);
    if (IN(0)) phase0(p, lds);
    SEAM(0);
    if (IN(1)) phase1(p, lds);
    SEAM(1);
    if (IN(2)) phase2(p, lds);
    SEAM(2);
    if (IN(3)) phase3a(p, lds);
    SEAM(3);
    if (IN(4)) phase3b(p, lds);
    SEAM(4);
    if (IN(5)) phase3c(p);
    SEAM(5);
    if (IN(6)) phase4(p, lds);
    SEAM(6);
    if (IN(7)) phase_fix(p);
    SEAM(7);
    if (IN(8)) phase6(p, lds);
    SEAM(8);
    if (IN(9)) phase7(p);
#undef IN
#undef SEAM
}


__global__ void ab_save(const unsigned char* ws, float* out) {
    const u32x4* src = (const u32x4*)(ws + AB_SRC); u32x4* dst = (u32x4*)((unsigned char*)out + (size_t)32 * MiB);
    for (size_t i = blockIdx.x * (size_t)blockDim.x + threadIdx.x; i < (size_t)AB_BYTES / 16; i += (size_t)gridDim.x * blockDim.x) dst[i] = src[i];
}
__global__ void ab_diff(const unsigned char* ws, float* out) {
    const bf16_t* src = (const bf16_t*)(ws + AB_SRC); const bf16_t* sav = (const bf16_t*)((unsigned char*)out + (size_t)32 * MiB);
    for (size_t i = blockIdx.x * (size_t)blockDim.x + threadIdx.x; i < (size_t)8192 * 1024; i += (size_t)gridDim.x * blockDim.x) {
        if (i >= (size_t)AB_BYTES / 2) { out[i] = 0.f; continue; }
        out[i] = src[i] != sav[i] ? 1000.0f : 0.f;
    }
}
__global__ void ab_zero(float* out) {
    for (size_t i = blockIdx.x * (size_t)blockDim.x + threadIdx.x; i < (size_t)8192 * 1024; i += (size_t)gridDim.x * blockDim.x) out[(size_t)8192 * 1024 + i] = 0.f;
}
extern "C" void kernel_launch(void* const* d_in, const int* in_sizes, int n_in, void* d_out, int out_size, void* d_ws, size_t ws_size, hipStream_t stream) {
    static int grid_blocks = 0;
    if (grid_blocks == 0) {
        if (n_in != 12 || ws_size < WS_END) { fprintf(stderr, "kernel_launch: unexpected n_in %d or ws_size %zu (need %zu)\n", n_in, ws_size, (size_t)WS_END); grid_blocks = -1; return; }
        int dev = 0, cus = 0, per_cu = 0;
        (void)hipGetDevice(&dev);
        (void)hipDeviceGetAttribute(&cus, hipDeviceAttributeMultiprocessorCount, dev);
        (void)hipFuncSetAttribute((const void*)fwd_kernel, hipFuncAttributeMaxDynamicSharedMemorySize, LDS_BYTES);
        (void)hipOccupancyMaxActiveBlocksPerMultiprocessor(&per_cu, (const void*)fwd_kernel, NTHREADS, LDS_BYTES);
        if (per_cu < 1) per_cu = 1;
        if (per_cu > 2) per_cu = 2;
        grid_blocks = cus * per_cu;
        (void)hipGetLastError();
    }
    if (grid_blocks < 0) return;
    Params p{};
    p.x = (const float*)d_in[0]; p.meta = (const float*)d_in[1]; p.gains = (const float*)d_in[2]; p.w_in = (const float*)d_in[3];
    p.b_forget = (const float*)d_in[4]; p.w_o_fox = (const float*)d_in[5]; p.w_o_sb = (const float*)d_in[6]; p.w_out = (const float*)d_in[7];
    p.w_up = (const float*)d_in[8]; p.conv_w = (const float*)d_in[9]; p.conv_b = (const float*)d_in[10]; p.w_down = (const float*)d_in[11];
    p.out = (float*)d_out; p.ws = (unsigned char*)d_ws;
#if SINGLE_LAUNCH
    (void)hipMemsetAsync((unsigned char*)d_ws + WS_CTL, 0, 256, stream);
    (void)hipMemsetAsync((unsigned char*)d_ws + WS_XBAR, 0, XCD_BAR_WORDS * 4, stream);
    p.ph_lo = 0; p.ph_hi = NPHASE;
    void* args[] = {&p};
    hipError_t e = hipLaunchCooperativeKernel((const void*)fwd_kernel, dim3(grid_blocks), dim3(NTHREADS), args, LDS_BYTES, stream);
    if (e != hipSuccess) fprintf(stderr, "cooperative launch failed: %s (grid %d)\n", hipGetErrorString(e), grid_blocks);
#else
#ifndef STOP_AT
#define STOP_AT NPHASE
#endif
    for (int k = 0; k < STOP_AT; ++k) {
        p.ph_lo = k; p.ph_hi = k + 1;
        hipLaunchKernelGGL(fwd_kernel, dim3(grid_blocks), dim3(NTHREADS), LDS_BYTES, stream, p);
    }
#if ABTEST
    ab_save<<<1024, 256, 0, stream>>>(p.ws, p.out);
    for (int k = AB_FROM; k < STOP_AT; ++k) {
        p.ph_lo = k; p.ph_hi = k + 1;
        hipLaunchKernelGGL(fwd_kernel, dim3(grid_blocks), dim3(NTHREADS), LDS_BYTES, stream, p);
    }
    ab_diff<<<1024, 256, 0, stream>>>(p.ws, p.out);
    ab_zero<<<1024, 256, 0, stream>>>(p.out);
#endif

#endif
}
```

```cpp
#include <hip/hip_runtime.h>
#include <hip/hip_cooperative_groups.h>
#include <cstdio>
#include <cstdint>
namespace cg = cooperative_groups;

#define DUMP 0
#define ABTEST 0
#define AB_FROM 0
#define AB_SRC WS_SSP2
#define AB_BYTES (2 * MiB)
#ifndef SINGLE_LAUNCH
#define SINGLE_LAUNCH 1
#endif

#define LAS __attribute__((address_space(3)))
typedef unsigned short bf16_t;
typedef short bf16x8 __attribute__((ext_vector_type(8)));
typedef float f32x4 __attribute__((ext_vector_type(4)));
typedef float f32x16 __attribute__((ext_vector_type(16)));
typedef unsigned u32x4 __attribute__((ext_vector_type(4)));
typedef unsigned u32x2 __attribute__((ext_vector_type(2)));

constexpr int D = 1024, SEQ = 8192, NMETA = 16, NB = 2;
constexpr int MX = NB * SEQ;
constexpr int MV = MX + NB * NMETA;
constexpr int M = 16512;
constexpr int LPK = 8256;
constexpr int PROJW = 5128, NPROJ = 5120, DFF = 2816, NUP = 5632;
constexpr float EPS = 1e-6f;
constexpr float LOG2E = 1.4426950408889634f, LN2 = 0.6931471805599453f;
constexpr int NTHREADS = 256;
constexpr int LDS_BYTES = 65536 + 16;
constexpr int NPHASE = 10;

constexpr size_t MiB = 1u << 20;
constexpr size_t WS_CTL = 0;
constexpr size_t WS_R1 = 4096, WS_R2 = WS_R1 + 69632, WS_SS2 = WS_R2 + 69632, WS_SS4 = WS_SS2 + 69632;
constexpr size_t WS_LOGF = WS_SS4 + 69632, WS_CK = WS_LOGF + 528384, WS_UPMETA = WS_CK + 528384;
constexpr size_t WS_BTIN = 2 * MiB, WS_BTOF = WS_BTIN + 10 * MiB, WS_BTOS = WS_BTOF + 1 * MiB, WS_BTOUT = WS_BTOS + 1 * MiB,
                 WS_BTUP = WS_BTOUT + 2 * MiB, WS_BTDN = WS_BTUP + 11 * MiB;
constexpr size_t SZ_M1024 = (size_t)M * 1024 * 2, SZ_M512 = (size_t)M * 512 * 2;
constexpr size_t WS_A = 33 * MiB;
constexpr size_t WS_B = WS_A + SZ_M1024;
constexpr size_t WS_C = WS_B + 2 * SZ_M1024;
constexpr size_t WS_QF = WS_C, WS_KF = WS_QF + SZ_M512, WS_QS = WS_KF + SZ_M512, WS_KS = WS_QS + SZ_M512, WS_VFT = WS_KS + SZ_M512, WS_VST = WS_VFT + SZ_M512;
constexpr size_t WS_GATED = WS_C, WS_MIXED = WS_B + SZ_M1024;
constexpr size_t WS_ACT = WS_B;
constexpr size_t WS_FFN = WS_ACT + 132 * MiB;
constexpr size_t WS_SSP2 = 230 * MiB, WS_SSP4 = 232 * MiB;
constexpr size_t WS_HAL = 234 * MiB;
constexpr size_t WS_XBAR = 240 * MiB;
constexpr size_t WS_END = 241 * MiB;

struct Params {
    const float *x, *meta, *gains, *w_in, *b_forget, *w_o_fox, *w_o_sb, *w_out, *w_up, *conv_w, *conv_b, *w_down;
    float* out; unsigned char* ws; int ph_lo, ph_hi;
};

typedef __bf16 bf16x2_t __attribute__((ext_vector_type(2)));
__device__ __forceinline__ unsigned pk_bf16(float lo, float hi) { bf16x2_t v = {(__bf16)lo, (__bf16)hi}; return __builtin_bit_cast(unsigned, v); }
__device__ __forceinline__ float bf_lo(unsigned u) { return __uint_as_float(u << 16); }
__device__ __forceinline__ float bf_hi(unsigned u) { return __uint_as_float(u & 0xffff0000u); }
__device__ __forceinline__ float ex2(float x) { return __builtin_amdgcn_exp2f(x); }
__device__ __forceinline__ float lg2(float x) { return __builtin_amdgcn_logf(x); }
__device__ __forceinline__ float rcp(float x) { return __builtin_amdgcn_rcpf(x); }
__device__ __forceinline__ float sigmoidf_(float v) { return rcp(1.0f + ex2(-v * LOG2E)); }
__device__ __forceinline__ float wave_sum(float v) {
#pragma unroll
    for (int o = 32; o > 0; o >>= 1) v += __shfl_xor(v, o);
    return v;
}
__device__ __forceinline__ int wave_id() { return __builtin_amdgcn_readfirstlane((int)(threadIdx.x >> 6)); }

__device__ __forceinline__ void transpose_tile(LAS char* lds, const float* src, int ldsrc, int srccol, int k0, const float* gain, bf16_t* dst, int K, int n0) {
    LAS bf16_t* T = (LAS bf16_t*)lds;
    const int tid = threadIdx.x, r = tid >> 4, c4 = tid & 15;
#pragma unroll
    for (int p = 0; p < 4; ++p) {
        const int k = r + 16 * p;
        f32x4 v = *(const f32x4*)(src + (size_t)(k0 + k) * ldsrc + srccol + c4 * 4);
        const float g = gain ? gain[k0 + k] : 1.0f;
        const unsigned a = pk_bf16(v[0] * g, v[1] * g), b = pk_bf16(v[2] * g, v[3] * g);
        T[(c4 * 4 + 0) * 72 + k] = (bf16_t)(a & 0xffff); T[(c4 * 4 + 1) * 72 + k] = (bf16_t)(a >> 16);
        T[(c4 * 4 + 2) * 72 + k] = (bf16_t)(b & 0xffff); T[(c4 * 4 + 3) * 72 + k] = (bf16_t)(b >> 16);
    }
    __syncthreads();
    const int n = tid >> 2, kq = tid & 3;
    const u32x4 lo = *(LAS u32x4*)(T + n * 72 + kq * 16), hi = *(LAS u32x4*)(T + n * 72 + kq * 16 + 8);
    bf16_t* d = dst + (size_t)(n0 + n) * K + k0 + kq * 16;
    *(u32x4*)d = lo; *(u32x4*)(d + 8) = hi;
    __syncthreads();
}

__device__ __forceinline__ void phase0(const Params& p, LAS char* lds) {
    unsigned char* ws = p.ws;
    const int tid = threadIdx.x, lane = tid & 63, w = wave_id();
    LAS float* wfT = (LAS float*)lds;
    const float* g0 = p.gains;
    for (int idx = tid; idx < 8192; idx += NTHREADS) { const int h = idx & 7, k = idx >> 3; wfT[h * 1024 + k] = p.w_in[(size_t)k * PROJW + 1536 + h] * g0[k]; }
    __syncthreads();
    bf16_t* xb = (bf16_t*)(ws + WS_A);
    float* r1 = (float*)(ws + WS_R1);
    float* logf_ = (float*)(ws + WS_LOGF);
    for (int r_ = blockIdx.x * 32 + w; r_ < M; r_ += (r_ & 31) < 28 ? 4 : gridDim.x * 32 - 28) {
        const int r = r_;
        if (r >= MV) {
#pragma unroll
            for (int i = 0; i < 4; ++i) *(u32x2*)(xb + (size_t)r * D + lane * 4 + 256 * i) = (u32x2){0u, 0u};
            if (lane == 0) r1[r] = 0.f;
            continue;
        }
        const float* src = r < MX ? p.x + (size_t)r * D : p.meta + (size_t)((r - MX) & 15) * D;
        f32x4 v[4]; float ss = 0.f;
#pragma unroll
        for (int i = 0; i < 4; ++i) { v[i] = *(const f32x4*)(src + lane * 4 + 256 * i); ss += v[i][0] * v[i][0] + v[i][1] * v[i][1] + v[i][2] * v[i][2] + v[i][3] * v[i][3]; }
#pragma unroll
        for (int i = 0; i < 4; ++i) *(u32x2*)(xb + (size_t)r * D + lane * 4 + 256 * i) = (u32x2){pk_bf16(v[i][0], v[i][1]), pk_bf16(v[i][2], v[i][3])};
        ss = wave_sum(ss);
        const float rs = 1.0f / sqrtf(ss * (1.0f / D) + EPS);
        if (lane == 0) r1[r] = rs;
        float mine = 0.f;
#pragma unroll
        for (int h = 0; h < 8; ++h) {
            float a = 0.f;
#pragma unroll
            for (int i = 0; i < 4; ++i) { const f32x4 wv = *(LAS f32x4*)(wfT + h * 1024 + lane * 4 + 256 * i); a += v[i][0] * wv[0] + v[i][1] * wv[1] + v[i][2] * wv[2] + v[i][3] * wv[3]; }
            a = wave_sum(a);
            if (lane == h) mine = a;
        }
        if (lane < 8) {
            const float f = mine * rs + p.b_forget[lane];
            const float lf = fminf(f, 0.f) - log1pf(expf(-fabsf(f)));
            int b, kidx; if (r < MX) { b = r >> 13; kidx = r & 8191; } else { const int j = r - MX; b = j >> 4; kidx = 8192 + (j & 15); }
            logf_[(size_t)(b * 8 + lane) * LPK + kidx] = lf;
        }
    }
    __syncthreads();
    LAS char* tl = lds + 32768;
    const float* g2 = p.gains + 2 * D;
    constexpr int T_IN = 16 * 80, T_OF = 8 * 16, T_OS = 8 * 16, T_OUT = 16 * 16, T_UP = 16 * 88, T_DN = 44 * 16;
    constexpr int T_ALL = T_IN + T_OF + T_OS + T_OUT + T_UP + T_DN;
    for (int t = blockIdx.x; t < T_ALL; t += gridDim.x) {
        int u = t;
        if (u < T_IN) { const int nt = u % 80, kt = u / 80; const int sc = nt * 64 + (nt * 64 >= 1536 ? 8 : 0); transpose_tile(tl, p.w_in, PROJW, sc, kt * 64, g0, (bf16_t*)(ws + WS_BTIN), 1024, nt * 64); continue; }
        u -= T_IN;
        if (u < T_OF) { const int nt = u % 16, kt = u / 16; transpose_tile(tl, p.w_o_fox, 1024, nt * 64, kt * 64, nullptr, (bf16_t*)(ws + WS_BTOF), 512, nt * 64); continue; }
        u -= T_OF;
        if (u < T_OS) { const int nt = u % 16, kt = u / 16; transpose_tile(tl, p.w_o_sb, 1024, nt * 64, kt * 64, nullptr, (bf16_t*)(ws + WS_BTOS), 512, nt * 64); continue; }
        u -= T_OS;
        if (u < T_OUT) { const int nt = u % 16, kt = u / 16; transpose_tile(tl, p.w_out, 1024, nt * 64, kt * 64, nullptr, (bf16_t*)(ws + WS_BTOUT), 1024, nt * 64); continue; }
        u -= T_OUT;
        if (u < T_UP) { const int nt = u % 88, kt = u / 88; transpose_tile(tl, p.w_up, NUP, (nt & 1) * DFF + (nt >> 1) * 64, kt * 64, g2, (bf16_t*)(ws + WS_BTUP), 1024, nt * 64); continue; }
        u -= T_UP;
        { const int nt = u % 16, kt = u / 16; transpose_tile(tl, p.w_down, 1024, nt * 64, kt * 64, nullptr, (bf16_t*)(ws + WS_BTDN), DFF, nt * 64); }
    }
}

template <bool SWAP, bool FULL>
__device__ __forceinline__ void gemm_kloop(LAS char* lds, const bf16_t* Ag, int lda, const bf16_t* Bg, int ldb, int nk, f32x4 (&acc)[4][4], int mlim) {
    const int tid = threadIdx.x, lane = tid & 63, w = wave_id(), wr = w >> 1, wc = w & 1;
    const int row_0 = w * 8 + (lane >> 3), c_0 = (lane & 7) ^ ((row_0 >> 1) & 7);
    const bf16_t* pa0 = Ag + (size_t)row_0 * lda + c_0 * 8; const bf16_t* pb0 = Bg + (size_t)row_0 * ldb + c_0 * 8;
    const size_t sa = (size_t)32 * lda, sb_ = (size_t)32 * ldb;
    const int swz = (lane >> 1) & 7;
    int aoff[2], boff[2];
#pragma unroll
    for (int kh = 0; kh < 2; ++kh) {
        aoff[kh] = (wr * 64 + (lane & 15)) * 128 + (((kh * 4 + (lane >> 4)) ^ swz) << 4);
        boff[kh] = 16384 + (wc * 64 + (lane & 15)) * 128 + (((kh * 4 + (lane >> 4)) ^ swz) << 4);
    }
#define GM_STAGE(s, kt) do { _Pragma("unroll") for (int i_ = 0; i_ < 4; ++i_) { \
        __builtin_amdgcn_global_load_lds((const unsigned*)(pa0 + i_ * sa + (kt) * 64), (LAS unsigned*)(lds + (s) * 32768 + (i_ * 4 + w) * 1024), 16, 0, 0); \
        __builtin_amdgcn_global_load_lds((const unsigned*)(pb0 + i_ * sb_ + (kt) * 64), (LAS unsigned*)(lds + (s) * 32768 + 16384 + (i_ * 4 + w) * 1024), 16, 0, 0); } } while (0)
    GM_STAGE(0, 0);
    for (int kt = 0; kt < nk; ++kt) {
        asm volatile("s_waitcnt vmcnt(0)" ::: "memory");
        __syncthreads();
        const int s = kt & 1;
        if (kt + 1 < nk) GM_STAGE(s ^ 1, kt + 1);
        bf16x8 af[4][2], bf[4][2];
#pragma unroll
        for (int kh = 0; kh < 2; ++kh) {
#pragma unroll
            for (int m = 0; m < 4; ++m) if (FULL || m < mlim) af[m][kh] = *(LAS bf16x8*)(lds + s * 32768 + aoff[kh] + m * 2048);
#pragma unroll
            for (int n = 0; n < 4; ++n) bf[n][kh] = *(LAS bf16x8*)(lds + s * 32768 + boff[kh] + n * 2048);
        }
        __builtin_amdgcn_s_setprio(1);
#pragma unroll
        for (int kh = 0; kh < 2; ++kh)
#pragma unroll
            for (int m = 0; m < 4; ++m) if (FULL || m < mlim) {
#pragma unroll
                for (int n = 0; n < 4; ++n)
                    acc[m][n] = SWAP ? __builtin_amdgcn_mfma_f32_16x16x32_bf16(bf[n][kh], af[m][kh], acc[m][n], 0, 0, 0)
                                     : __builtin_amdgcn_mfma_f32_16x16x32_bf16(af[m][kh], bf[n][kh], acc[m][n], 0, 0, 0);
            }
        __builtin_amdgcn_s_setprio(0);
    }
    __syncthreads();
#undef GM_STAGE
}
template <bool SWAP>
__device__ __forceinline__ void gemm_main(LAS char* lds, const bf16_t* Ag, int lda, const bf16_t* Bg, int ldb, int nk, f32x4 (&acc)[4][4], int mlim = 4) {
    if (mlim == 4) gemm_kloop<SWAP, true>(lds, Ag, lda, Bg, ldb, nk, acc, 4);
    else gemm_kloop<SWAP, false>(lds, Ag, lda, Bg, ldb, nk, acc, mlim);
}
__device__ __forceinline__ void zero_acc(f32x4 (&acc)[4][4]) {
#pragma unroll
    for (int m = 0; m < 4; ++m)
#pragma unroll
        for (int n = 0; n < 4; ++n) acc[m][n] = (f32x4){0.f, 0.f, 0.f, 0.f};
}


__device__ __forceinline__ int tile_at(int it, int ntm, int ntn, int& tm, int& tn) {
    const int G = gridDim.x;
    if (G % 256 != 0) { const int t = it * G + blockIdx.x; if (t >= ntm * ntn) return 0; tm = t / ntn; tn = t % ntn; return 1; }
    const int xcd = blockIdx.x & 7, j = blockIdx.x >> 3, ppx = G >> 8;
    const int pcols = (ntn + 3) >> 2, prows = (ntm + 7) >> 3;
    const int patch = (it * ppx + (j >> 5)) * 8 + xcd;
    if (patch >= prows * pcols) return 0;
    const int wi = j & 31;
    tm = (patch / pcols) * 8 + (wi >> 2); tn = (patch % pcols) * 4 + (wi & 3);
    return (tm < ntm && tn < ntn) ? 1 : 2;
}
__device__ __forceinline__ void cumsum_block(const Params& p, LAS char* lds, int bh) {
    const float* lf = (const float*)(p.ws + WS_LOGF) + (size_t)bh * LPK; float* ck = (float*)(p.ws + WS_CK) + (size_t)bh * LPK;
    LAS float* wsum = (LAS float*)lds;
    const int tid = threadIdx.x, lane = tid & 63, w = wave_id(); constexpr int PER = 33, L = SEQ + NMETA;
    float v[PER];
#pragma unroll
    for (int e = 0; e < PER; ++e) { const int t = e * NTHREADS + tid; const int tc = t < L ? t : L - 1; const float x = lf[tc < 16 ? 8192 + tc : tc - 16]; v[e] = t < L ? x : 0.f; }
    float carry = 0.f;
#pragma unroll
    for (int e = 0; e < PER; ++e) {
        float x = v[e];
#pragma unroll
        for (int o = 1; o < 64; o <<= 1) { const float y = __shfl_up(x, o); if (lane >= o) x += y; }
        if (lane == 63) wsum[(e & 1) * 4 + w] = x;
        __syncthreads();
        const float s0 = wsum[(e & 1) * 4 + 0], s1 = wsum[(e & 1) * 4 + 1], s2 = wsum[(e & 1) * 4 + 2], s3 = wsum[(e & 1) * 4 + 3];
        const float pre = (w > 0 ? s0 : 0.f) + (w > 1 ? s1 : 0.f) + (w > 2 ? s2 : 0.f);
        const int t = e * NTHREADS + tid;
        if (t < L) ck[t < 16 ? 8192 + t : t - 16] = (carry + pre + x) * LOG2E;
        carry += (s0 + s1) + (s2 + s3);
    }
    __syncthreads();
}

__device__ __forceinline__ void phase1(const Params& p, LAS char* lds) {
    unsigned char* ws = p.ws;
    if ((int)blockIdx.x >= (int)gridDim.x - 16) cumsum_block(p, lds, gridDim.x - 1 - blockIdx.x);
    const int lane = threadIdx.x & 63, w = wave_id(), wr = w >> 1, wc = w & 1;
    const bf16_t* xb = (const bf16_t*)(ws + WS_A); const bf16_t* Bt = (const bf16_t*)(ws + WS_BTIN);
    const float* r1 = (const float*)(ws + WS_R1);
    constexpr int NTN = 40, NTM = 129;
    for (int it = 0;; ++it) {
        int tm, tn; int st = tile_at(it, NTM - 1, NTN, tm, tn);
        if (st == 0) { if (it < (1 << 20) && (int)blockIdx.x < NTN) { tm = NTM - 1; tn = blockIdx.x; it = 1 << 20; st = 1; } else break; }
        if (st == 2) continue;
        const int row0 = tm * 128, col0 = tn * 128; const int mlim = tm == NTM - 1 ? (wr == 0 ? 2 : 0) : 4;
        const bool vtile = (tn >= 8 && tn < 12) || (tn >= 20 && tn < 24);
        f32x4 acc[4][4]; zero_acc(acc);
        if (vtile) {
            gemm_main<false>(lds, xb + (size_t)row0 * D, D, Bt + (size_t)col0 * D, D, 16, acc, mlim);
            bf16_t* vT = (bf16_t*)(ws + (tn < 12 ? WS_VFT : WS_VST)); const int cb = tn < 12 ? 1024 : 2560;
            const int g = lane >> 4, gp = ((g & 1) << 1) | (g >> 1);
#pragma unroll
            for (int m = 0; m < 4; ++m) {
                const int rb = row0 + wr * 64 + m * 16; int b, kb16;
                if (rb < MX) { b = rb >> 13; kb16 = rb & 8191; } else { const int j = rb - MX; if (j >= 32) continue; b = j >> 4; kb16 = 8192; }
                const f32x4 rs = *(const f32x4*)(r1 + rb + g * 4);
#pragma unroll
                for (int n = 0; n < 4; ++n) {
                    const int dc = col0 + wc * 64 + n * 16 + (lane & 15) - cb, h = dc >> 6, d = dc & 63;
                    const f32x4 v = acc[m][n] * rs;
                    *(u32x2*)(vT + ((size_t)(b * 8 + h) * 64 + d) * LPK + kb16 + gp * 4) = (u32x2){pk_bf16(v[0], v[1]), pk_bf16(v[2], v[3])};
                }
            }
        } else {
            gemm_main<true>(lds, xb + (size_t)row0 * D, D, Bt + (size_t)col0 * D, D, 16, acc, mlim);
            bf16_t* dst; int ld, cb; float sc = 1.f; bool sg = false;
            if (tn < 4) { dst = (bf16_t*)(ws + WS_QF); ld = 512; cb = 0; sc = 0.125f * LOG2E; }
            else if (tn < 8) { dst = (bf16_t*)(ws + WS_KF); ld = 512; cb = 512; }
            else if (tn < 16) { dst = (bf16_t*)(ws + WS_QS); ld = 512; cb = 1536; sc = 0.125f; }
            else if (tn < 20) { dst = (bf16_t*)(ws + WS_KS); ld = 512; cb = 2048; }
            else if (tn < 32) { dst = (bf16_t*)(ws + WS_B); ld = 1024; cb = 3072; sg = true; }
            else { dst = (bf16_t*)(ws + WS_B + SZ_M1024); ld = 1024; cb = 4096; sg = true; }
            const bool kfox = tn >= 4 && tn < 8;
            float wmax = 0.f;
#pragma unroll
            for (int m = 0; m < 4; ++m) {
                const int row = row0 + wr * 64 + m * 16 + (lane & 15); const float rs = r1[row] * sc;
                float s2 = 0.f;
#pragma unroll
                for (int n = 0; n < 4; ++n) {
                    const int col = col0 + wc * 64 + n * 16 + (lane >> 4) * 4 - cb;
                    f32x4 v = acc[m][n] * rs;
                    if (sg) { v[0] = sigmoidf_(v[0]); v[1] = sigmoidf_(v[1]); v[2] = sigmoidf_(v[2]); v[3] = sigmoidf_(v[3]); }
                    s2 += v[0] * v[0] + v[1] * v[1] + v[2] * v[2] + v[3] * v[3];
                    *(u32x2*)(dst + (size_t)row * ld + col) = (u32x2){pk_bf16(v[0], v[1]), pk_bf16(v[2], v[3])};
                }
                if (kfox) { s2 += __shfl_xor(s2, 16); s2 += __shfl_xor(s2, 32); wmax = fmaxf(wmax, s2); }
            }
            if (kfox) {
#pragma unroll
                for (int o = 1; o < 16; o <<= 1) wmax = fmaxf(wmax, __shfl_xor(wmax, o));
                if (lane == 0) {
                    unsigned* km = (unsigned*)(ws + WS_CTL) + 32; const int head = (tn - 4) * 2 + wc; const unsigned bits = __float_as_uint(wmax);
                    if (row0 < MX) atomicMax(km + (row0 >> 13) * 8 + head, bits);
                    else { atomicMax(km + head, bits); atomicMax(km + 8 + head, bits); }
                }
            }
        }
    }
}

constexpr int AT_STAGE = 16640;
template <int TYPE>
__device__ __forceinline__ void attn_unit(LAS char* lds, const Params& p, int b, int h, int qb) {
    unsigned char* ws = p.ws;
    const int tid = threadIdx.x, lane = tid & 63, w = wave_id(), ql = lane & 31, hi = lane >> 5;
    const bf16_t* Q = (const bf16_t*)(ws + (TYPE == 0 ? WS_QF : WS_QS));
    const bf16_t* Kp = (const bf16_t*)(ws + (TYPE == 0 ? WS_KF : WS_KS));
    const bf16_t* VT = (const bf16_t*)(ws + (TYPE == 0 ? WS_VFT : WS_VST)) + (size_t)(b * 8 + h) * 64 * LPK;
    const float* cK = (const float*)(ws + WS_CK) + (size_t)(b * 8 + h) * LPK;
    bf16_t* Oo = (bf16_t*)(ws + WS_A + (TYPE == 0 ? 0 : SZ_M512));
    const bool meta_unit = qb < 0;
    const int qrow0 = meta_unit ? MX + 16 * b : b * SEQ + qb * 128;
    const int nt = meta_unit ? 1 : 2 * qb + 3;
    int qrow = qrow0 + 32 * w + ql; if (qrow > M - 1) qrow = M - 1;
    bf16x8 qf[4];
#pragma unroll
    for (int ds = 0; ds < 4; ++ds) qf[ds] = *(const bf16x8*)(Q + (size_t)qrow * 512 + h * 64 + ds * 16 + hi * 8);
    f32x16 O0, O1;
#pragma unroll
    for (int i = 0; i < 16; ++i) { O0[i] = 0.f; O1[i] = 0.f; }
    float m_run = -INFINITY, lsum = 0.f, R = 0.f;
    float qbound = 0.f;
    if (TYPE == 0) {
        float q2 = 0.f;
#pragma unroll
        for (int ds = 0; ds < 4; ++ds)
#pragma unroll
            for (int e = 0; e < 8; ++e) { const float x = __uint_as_float((unsigned)(unsigned short)qf[ds][e] << 16); q2 += x * x; }
        q2 += __shfl_xor(q2, 32);
        const unsigned kb = __hip_atomic_load((unsigned*)(ws + WS_CTL) + 32 + b * 8 + h, __ATOMIC_RELAXED, __HIP_MEMORY_SCOPE_AGENT);
        qbound = sqrtf(q2) * sqrtf(__uint_as_float(kb)) * 1.02f + 1.0f;
    }
    u32x4 kreg[2], vreg[2]; float creg = 0.f;
    const int srow = tid >> 3, spos = tid & 7;
    const int swz_st = (spos ^ ((srow >> 1) & 7)) << 4;
    const int swz = (lane >> 1) & 7;
    LAS unsigned* flags = (LAS unsigned*)(lds + 2 * AT_STAGE);
#define AT_LOAD(j) do { int krow0_, kidx0_; if (!meta_unit && (j) < nt - 1) { const int kt_ = nt - 2 - (j); krow0_ = b * SEQ + 64 * kt_; kidx0_ = 64 * kt_; } else { krow0_ = MX + 16 * b; kidx0_ = 8192; } \
        _Pragma("unroll") for (int i_ = 0; i_ < 2; ++i_) { \
            kreg[i_] = *(const u32x4*)(Kp + (size_t)(krow0_ + srow + 32 * i_) * 512 + h * 64 + spos * 8); \
            vreg[i_] = *(const u32x4*)(VT + (size_t)(srow + 32 * i_) * LPK + kidx0_ + spos * 8); } \
        if (TYPE == 0 && tid < 64) creg = cK[kidx0_ + tid]; } while (0)
#define AT_WRITE(s) do { _Pragma("unroll") for (int i_ = 0; i_ < 2; ++i_) { \
            *(LAS u32x4*)(lds + (s) * AT_STAGE + (srow + 32 * i_) * 128 + swz_st) = kreg[i_]; \
            *(LAS u32x4*)(lds + (s) * AT_STAGE + 8192 + (srow + 32 * i_) * 128 + swz_st) = vreg[i_]; } \
        if (TYPE == 0 && tid < 64) *(LAS float*)(lds + (s) * AT_STAGE + 16384 + tid * 4) = creg; } while (0)
    AT_LOAD(0); AT_WRITE(0);
    __syncthreads();
    for (int j = 0; j < nt; ++j) {
        const bool more = j + 1 < nt;
        if (more) AT_LOAD(j + 1);
        int klim, d0;
        if (meta_unit) { klim = 16; d0 = 0; }
        else if (j == nt - 1) { klim = 16; d0 = 1 << 20; }
        else { klim = 64; d0 = 128 * qb - 64 * (nt - 2 - j); if (d0 >= 64) d0 = 1 << 20; }
        const int limw = 32 * w + d0 - TYPE;
        bool wdone = false, nomax = false;
        if (TYPE == 0) {
            const float clast = *(const LAS float*)(lds + (j & 1) * AT_STAGE + 16384 + (klim - 1) * 4);
            wdone = __all((qbound - clast - m_run) < -126.0f) != 0;
            nomax = __all((qbound - clast) <= m_run) != 0;
        }
        if (limw + 31 >= 0 && !(TYPE == 0 && wdone)) {
            const LAS char* sb = lds + (j & 1) * AT_STAGE;
            int kmax = limw + ql; if (kmax > klim - 1) kmax = klim - 1;
            const bool needmask = (klim < 64) || (limw < 63);
            f32x16 S0, S1;
#pragma unroll
            for (int i = 0; i < 16; ++i) { S0[i] = 0.f; S1[i] = 0.f; }
#pragma unroll
            for (int ds = 0; ds < 4; ++ds) {
                const bf16x8 k0 = *(const LAS bf16x8*)(sb + ql * 128 + (((2 * ds + hi) ^ swz) << 4));
                const bf16x8 k1 = *(const LAS bf16x8*)(sb + (32 + ql) * 128 + (((2 * ds + hi) ^ swz) << 4));
                S0 = __builtin_amdgcn_mfma_f32_32x32x16_bf16(k0, qf[ds], S0, 0, 0, 0);
                S1 = __builtin_amdgcn_mfma_f32_32x32x16_bf16(k1, qf[ds], S1, 0, 0, 0);
            }
            if (TYPE == 0) {
#pragma unroll
                for (int g = 0; g < 4; ++g) {
                    const f32x4 c0 = *(const LAS f32x4*)(sb + 16384 + (8 * g + 4 * hi) * 4), c1 = *(const LAS f32x4*)(sb + 16384 + (32 + 8 * g + 4 * hi) * 4);
#pragma unroll
                    for (int i = 0; i < 4; ++i) { S0[4 * g + i] -= c0[i]; S1[4 * g + i] -= c1[i]; }
                }
                if (needmask) {
#pragma unroll
                    for (int r = 0; r < 16; ++r) { const int kl = (r & 3) + 8 * (r >> 2) + 4 * hi; if (kl > kmax) S0[r] = -INFINITY; if (kl + 32 > kmax) S1[r] = -INFINITY; }
                }
                if (!nomax) {
                    float mx = -INFINITY;
#pragma unroll
                    for (int r = 0; r < 16; ++r) mx = fmaxf(mx, fmaxf(S0[r], S1[r]));
                    mx = fmaxf(mx, __shfl_xor(mx, 32));
                    const float m_new = fmaxf(m_run, mx), alpha = ex2(m_run - m_new);
                    m_run = m_new;
                    lsum *= alpha;
#pragma unroll
                    for (int r = 0; r < 16; ++r) { O0[r] *= alpha; O1[r] *= alpha; }
                }
                float ps = 0.f;
#pragma unroll
                for (int r = 0; r < 16; ++r) { S0[r] = ex2(S0[r] - m_run); S1[r] = ex2(S1[r] - m_run); ps += S0[r] + S1[r]; }
                lsum += ps;
            } else {
                float G0[4], G1[4];
                f32x16 L0, L1;
#pragma unroll
                for (int r = 0; r < 16; ++r) {
                    const int kl = (r & 3) + 8 * (r >> 2) + 4 * hi;
                    const float z0 = S0[r], z1 = S1[r];
                    const float sp0 = fmaxf(z0, 0.f) + lg2(1.0f + ex2(-fabsf(z0) * LOG2E)) * LN2;
                    const float sp1 = fmaxf(z1, 0.f) + lg2(1.0f + ex2(-fabsf(z1) * LOG2E)) * LN2;
                    L0[r] = (!needmask || kl <= kmax) ? -sp0 : 0.f;
                    L1[r] = (!needmask || kl + 32 <= kmax) ? -sp1 : 0.f;
                }
#pragma unroll
                for (int g = 0; g < 4; ++g) {
                    L0[4 * g + 2] += L0[4 * g + 3]; L0[4 * g + 1] += L0[4 * g + 2]; L0[4 * g] += L0[4 * g + 1]; G0[g] = L0[4 * g];
                    L1[4 * g + 2] += L1[4 * g + 3]; L1[4 * g + 1] += L1[4 * g + 2]; L1[4 * g] += L1[4 * g + 1]; G1[g] = L1[4 * g];
                }
                float run = R;
#pragma unroll
                for (int g = 3; g >= 0; --g) {
                    const float gp = __shfl_xor(G1[g], 32);
                    const float off = hi ? run : run + gp;
#pragma unroll
                    for (int i = 0; i < 4; ++i) { const int r = 4 * g + i; const int kl = 32 + i + 8 * g + 4 * hi;
                        const float a = ex2((S1[r] + L1[r] + off) * LOG2E); S1[r] = (!needmask || kl <= kmax) ? a : 0.f; }
                    run += G1[g] + gp;
                }
#pragma unroll
                for (int g = 3; g >= 0; --g) {
                    const float gp = __shfl_xor(G0[g], 32);
                    const float off = hi ? run : run + gp;
#pragma unroll
                    for (int i = 0; i < 4; ++i) { const int r = 4 * g + i; const int kl = i + 8 * g + 4 * hi;
                        const float a = ex2((S0[r] + L0[r] + off) * LOG2E); S0[r] = (!needmask || kl <= kmax) ? a : 0.f; }
                    run += G0[g] + gp;
                }
                R = run;
                wdone = __all(R < -120.0f) != 0;
            }
#pragma unroll
            for (int ks = 0; ks < 4; ++ks) {
                bf16x8 pf; u32x4 pu;
                if (ks < 2) { pu = (u32x4){pk_bf16(S0[8 * ks + 0], S0[8 * ks + 1]), pk_bf16(S0[8 * ks + 2], S0[8 * ks + 3]), pk_bf16(S0[8 * ks + 4], S0[8 * ks + 5]), pk_bf16(S0[8 * ks + 6], S0[8 * ks + 7])}; }
                else { const int k2 = ks - 2; pu = (u32x4){pk_bf16(S1[8 * k2 + 0], S1[8 * k2 + 1]), pk_bf16(S1[8 * k2 + 2], S1[8 * k2 + 3]), pk_bf16(S1[8 * k2 + 4], S1[8 * k2 + 5]), pk_bf16(S1[8 * k2 + 6], S1[8 * k2 + 7])}; }
                pf = __builtin_bit_cast(bf16x8, pu);
                const bf16x8 v0 = *(const LAS bf16x8*)(sb + 8192 + ql * 128 + (((2 * ks + hi) ^ swz) << 4));
                const bf16x8 v1 = *(const LAS bf16x8*)(sb + 8192 + (32 + ql) * 128 + (((2 * ks + hi) ^ swz) << 4));
                O0 = __builtin_amdgcn_mfma_f32_32x32x16_bf16(v0, pf, O0, 0, 0, 0);
                O1 = __builtin_amdgcn_mfma_f32_32x32x16_bf16(v1, pf, O1, 0, 0, 0);
            }
        }
        if (more) AT_WRITE((j + 1) & 1);
        if (lane == 0) flags[(j & 1) * 4 + w] = wdone ? 1u : 0u;
        __syncthreads();
        { const LAS unsigned* fl = flags + (j & 1) * 4; const unsigned f = fl[0] & fl[1] & fl[2] & fl[3]; if (f) break; }
    }
    float inv = 1.0f;
    if (TYPE == 0) { const float l = lsum + __shfl_xor(lsum, 32); inv = 1.0f / l; }
    const bool qvalid = meta_unit ? (w == 0 && ql < 16) : true;
    if (qvalid) {
        bf16_t* op = Oo + (size_t)qrow * 512 + h * 64 + 4 * hi;
#pragma unroll
        for (int g = 0; g < 4; ++g) {
            *(u32x2*)(op + 8 * g) = (u32x2){pk_bf16(O0[4 * g] * inv, O0[4 * g + 1] * inv), pk_bf16(O0[4 * g + 2] * inv, O0[4 * g + 3] * inv)};
            *(u32x2*)(op + 32 + 8 * g) = (u32x2){pk_bf16(O1[4 * g] * inv, O1[4 * g + 1] * inv), pk_bf16(O1[4 * g + 2] * inv, O1[4 * g + 3] * inv)};
        }
    }
    __syncthreads();
#undef AT_LOAD
#undef AT_WRITE
}

__device__ __forceinline__ void phase2(const Params& p, LAS char* lds) {
    unsigned* ctr = (unsigned*)(p.ws + WS_CTL);
    LAS unsigned* shu = (LAS unsigned*)(lds + 2 * AT_STAGE + 64);
    constexpr int NU = 2048 + 32;
    for (;;) {
        if (threadIdx.x == 0) shu[0] = __hip_atomic_fetch_add(ctr, 1u, __ATOMIC_RELAXED, __HIP_MEMORY_SCOPE_AGENT);
        __syncthreads();
        const int u = (int)shu[0];
        __syncthreads();
        if (u >= NU) break;
        if (u < 1024) attn_unit<0>(lds, p, (u & 15) >> 3, u & 7, 63 - (u >> 4));
        else if (u < 2048) { const int v = u - 1024; attn_unit<1>(lds, p, (v & 15) >> 3, v & 7, 63 - (v >> 4)); }
        else if (u < 2064) { const int v = u - 2048; attn_unit<0>(lds, p, v >> 3, v & 7, -1); }
        else { const int v = u - 2064; attn_unit<1>(lds, p, v >> 3, v & 7, -1); }
    }
}

__device__ __forceinline__ void phase3a(const Params& p, LAS char* lds) {
    unsigned char* ws = p.ws;
    const int lane = threadIdx.x & 63, w = wave_id(), wr = w >> 1, wc = w & 1;
    const bf16_t* oa = (const bf16_t*)(ws + WS_A); const bf16_t* ob = oa + (size_t)M * 512;
    const bf16_t* ga = (const bf16_t*)(ws + WS_B); const bf16_t* gb = ga + (size_t)M * 1024;
    bf16_t* gated = (bf16_t*)(ws + WS_GATED);
    for (int it = 0;; ++it) {
        int tm, tn; int st = tile_at(it, 128, 8, tm, tn);
        if (st == 0) { if (it < (1 << 20) && (int)blockIdx.x < 8) { tm = 128; tn = blockIdx.x; it = 1 << 20; st = 1; } else break; }
        if (st == 2) continue;
        const int row0 = tm * 128, col0 = tn * 128; const int mlim = tm == 128 ? (wr == 0 ? 2 : 0) : 4;
        f32x4 acc[4][4]; zero_acc(acc);
        gemm_main<true>(lds, oa + (size_t)row0 * 512, 512, (const bf16_t*)(ws + WS_BTOF) + (size_t)col0 * 512, 512, 8, acc, mlim);
#pragma unroll
        for (int m = 0; m < 4; ++m) {
            const int row = row0 + wr * 64 + m * 16 + (lane & 15);
#pragma unroll
            for (int n = 0; n < 4; ++n) {
                const int col = col0 + wc * 64 + n * 16 + (lane >> 4) * 4;
                const u32x2 a = *(const u32x2*)(ga + (size_t)row * 1024 + col);
                const f32x4 x = acc[m][n];
                *(u32x2*)(gated + (size_t)row * 1024 + col) = (u32x2){pk_bf16(bf_lo(a[0]) * x[0], bf_hi(a[0]) * x[1]), pk_bf16(bf_lo(a[1]) * x[2], bf_hi(a[1]) * x[3])};
            }
        }
        zero_acc(acc);
        gemm_main<true>(lds, ob + (size_t)row0 * 512, 512, (const bf16_t*)(ws + WS_BTOS) + (size_t)col0 * 512, 512, 8, acc, mlim);
#pragma unroll
        for (int m = 0; m < 4; ++m) {
            const int row = row0 + wr * 64 + m * 16 + (lane & 15);
#pragma unroll
            for (int n = 0; n < 4; ++n) {
                const int col = col0 + wc * 64 + n * 16 + (lane >> 4) * 4;
                const u32x2 b = *(const u32x2*)(gb + (size_t)row * 1024 + col);
                const f32x4 y = acc[m][n]; const u32x2 q = *(const u32x2*)(gated + (size_t)row * 1024 + col);
                const float o0 = bf_lo(q[0]) + bf_lo(b[0]) * y[0], o1 = bf_hi(q[0]) + bf_hi(b[0]) * y[1];
                const float o2 = bf_lo(q[1]) + bf_lo(b[1]) * y[2], o3 = bf_hi(q[1]) + bf_hi(b[1]) * y[3];
                *(u32x2*)(gated + (size_t)row * 1024 + col) = (u32x2){pk_bf16(o0, o1), pk_bf16(o2, o3)};
            }
        }
    }
}
__device__ __forceinline__ void epi_store_ss(const f32x4 (&acc)[4][4], bf16_t* out, int ldo, int orow0, int col0, float* ssp, int ssrow0, int wr, int wc, int lane) {
#pragma unroll
    for (int m = 0; m < 4; ++m) {
        const int rl = wr * 64 + m * 16 + (lane & 15);
        float s = 0.f;
#pragma unroll
        for (int n = 0; n < 4; ++n) {
            const int col = col0 + wc * 64 + n * 16 + (lane >> 4) * 4;
            const f32x4 v = acc[m][n];
            s += v[0] * v[0] + v[1] * v[1] + v[2] * v[2] + v[3] * v[3];
            *(u32x2*)(out + (size_t)(orow0 + rl) * ldo + col) = (u32x2){pk_bf16(v[0], v[1]), pk_bf16(v[2], v[3])};
        }
#if 1
        s += __shfl_xor(s, 16); s += __shfl_xor(s, 32);
        if (lane < 16) ssp[(size_t)((col0 >> 7) * 2 + wc) * M + ssrow0 + rl] = s;
#endif
    }
}
__device__ __forceinline__ void phase3b(const Params& p, LAS char* lds) {
    unsigned char* ws = p.ws;
    const int lane = threadIdx.x & 63, w = wave_id(), wr = w >> 1, wc = w & 1;
    const bf16_t* gated = (const bf16_t*)(ws + WS_GATED); bf16_t* mixed = (bf16_t*)(ws + WS_MIXED);
    for (int it = 0;; ++it) {
        int tm, tn; int st = tile_at(it, 128, 8, tm, tn);
        if (st == 0) { if (it < (1 << 20) && (int)blockIdx.x < 8) { tm = 128; tn = blockIdx.x; it = 1 << 20; st = 1; } else break; }
        if (st == 2) continue;
        const int row0 = tm * 128, col0 = tn * 128; const int mlim = tm == 128 ? (wr == 0 ? 2 : 0) : 4;
        f32x4 acc[4][4]; zero_acc(acc);
        gemm_main<true>(lds, gated + (size_t)row0 * 1024, 1024, (const bf16_t*)(ws + WS_BTOUT) + (size_t)col0 * 1024, 1024, 16, acc, mlim);
        epi_store_ss(acc, mixed, 1024, row0, col0, (float*)(ws + WS_SSP2), row0, wr, wc, lane);
    }
}
__device__ __forceinline__ void phase3c(const Params& p) {
    unsigned char* ws = p.ws;
    const int lane = threadIdx.x & 63, w = wave_id();
    const bf16_t* mixed = (const bf16_t*)(ws + WS_MIXED); bf16_t* hb = (bf16_t*)(ws + WS_A);
    const float* ssp2 = (const float*)(ws + WS_SSP2); float* r2 = (float*)(ws + WS_R2);
    const float* g1 = p.gains + D;
    for (int r_ = blockIdx.x * 32 + w; r_ < M; r_ += (r_ & 31) < 28 ? 4 : gridDim.x * 32 - 28) {
        const int r = r_;
        if (r >= MV) continue;
        const float* src = r < MX ? p.x + (size_t)r * D : p.meta + (size_t)((r - MX) & 15) * D;
        float sq = lane < 16 ? ssp2[(size_t)lane * M + r] : 0.f;
        sq = wave_sum(sq);
        const float a = 1.0f / sqrtf(sq * (1.0f / D) + EPS);
        float ss = 0.f;
#pragma unroll
        for (int i = 0; i < 4; ++i) {
            const int col = lane * 4 + 256 * i;
            const f32x4 v = *(const f32x4*)(src + col), g = *(const f32x4*)(g1 + col);
            const u32x2 mx = *(const u32x2*)(mixed + (size_t)r * D + col);
            f32x4 hh;
            hh[0] = v[0] + bf_lo(mx[0]) * a * g[0]; hh[1] = v[1] + bf_hi(mx[0]) * a * g[1];
            hh[2] = v[2] + bf_lo(mx[1]) * a * g[2]; hh[3] = v[3] + bf_hi(mx[1]) * a * g[3];
            ss += hh[0] * hh[0] + hh[1] * hh[1] + hh[2] * hh[2] + hh[3] * hh[3];
            *(u32x2*)(hb + (size_t)r * D + col) = (u32x2){pk_bf16(hh[0], hh[1]), pk_bf16(hh[2], hh[3])};
            if (r < MX) *(f32x4*)(p.out + (size_t)r * D + col) = hh;
        }
        ss = wave_sum(ss);
        if (lane == 0) r2[r] = 1.0f / sqrtf(ss * (1.0f / D) + EPS);
    }
}
constexpr int UST = 272;
__device__ __forceinline__ f32x4 unpack4(const u32x2 u) { return (f32x4){bf_lo(u[0]), bf_hi(u[0]), bf_lo(u[1]), bf_hi(u[1])}; }
struct ConvW { f32x4 w0g, w1g, w2g, bg, w0v, w1v, w2v, bv; };
__device__ __forceinline__ ConvW load_convw(const Params& p, int c) {
    ConvW q;
    q.w0g = *(const f32x4*)(p.conv_w + c); q.w1g = *(const f32x4*)(p.conv_w + NUP + c); q.w2g = *(const f32x4*)(p.conv_w + 2 * NUP + c); q.bg = *(const f32x4*)(p.conv_b + c);
    q.w0v = *(const f32x4*)(p.conv_w + DFF + c); q.w1v = *(const f32x4*)(p.conv_w + NUP + DFF + c); q.w2v = *(const f32x4*)(p.conv_w + 2 * NUP + DFF + c); q.bv = *(const f32x4*)(p.conv_b + DFF + c);
    return q;
}
__device__ __forceinline__ u32x2 conv_gelu4(const ConvW& q, const f32x4 g2, const f32x4 g1, const f32x4 g0, const f32x4 v2, const f32x4 v1, const f32x4 v0) {
    float o[4];
#pragma unroll
    for (int e = 0; e < 4; ++e) {
        const float ug = q.bg[e] + q.w0g[e] * g2[e] + q.w1g[e] * g1[e] + q.w2g[e] * g0[e];
        const float uv = q.bv[e] + q.w0v[e] * v2[e] + q.w1v[e] * v1[e] + q.w2v[e] * v0[e];
        const float t = 0.7978845608028654f * (ug + 0.044715f * ug * ug * ug);
        o[e] = ug * rcp(1.0f + ex2(-2.0f * LOG2E * t)) * uv;
    }
    return (u32x2){pk_bf16(o[0], o[1]), pk_bf16(o[2], o[3])};
}
__device__ __forceinline__ void phase4(const Params& p, LAS char* lds) {
    unsigned char* ws = p.ws;
    const int tid = threadIdx.x, lane = tid & 63, w = wave_id(), wr = w >> 1, wc = w & 1;
    const bf16_t* hb = (const bf16_t*)(ws + WS_A); const bf16_t* Bt = (const bf16_t*)(ws + WS_BTUP);
    const float* r2 = (const float*)(ws + WS_R2);
    bf16_t* act = (bf16_t*)(ws + WS_ACT); bf16_t* hal = (bf16_t*)(ws + WS_HAL);
    for (int it = 0;; ++it) {
        int tm, tn; int st = tile_at(it, 128, 44, tm, tn);
        if (st == 0) { if (it < (1 << 20) && (int)blockIdx.x < 44) { tm = 128; tn = blockIdx.x; it = 1 << 20; st = 1; } else break; }
        if (st == 2) continue;
        const bool mt = tm == 128; const int row0 = mt ? MX : tm * 128, col0 = tn * 128;
        f32x4 acc[4][4]; zero_acc(acc);
        gemm_main<true>(lds, hb + (size_t)row0 * D, D, Bt + (size_t)col0 * D, D, 16, acc, mt ? (wr == 0 ? 2 : 0) : 4);
#pragma unroll
        for (int m = 0; m < 4; ++m) {
            const int rl = wr * 64 + m * 16 + (lane & 15); const float rs = r2[row0 + rl];
#pragma unroll
            for (int n = 0; n < 4; ++n) {
                const int cl = wc * 64 + n * 16 + (lane >> 4) * 4; const f32x4 v = acc[m][n] * rs;
                *(LAS u32x2*)(lds + rl * UST + cl * 2) = (u32x2){pk_bf16(v[0], v[1]), pk_bf16(v[2], v[3])};
            }
        }
        __syncthreads();
        if (!mt) {
            const int cg = tid & 15, rb = tid >> 4, c = tn * 64 + cg * 4;
            const ConvW q = load_convw(p, c);
            const int hr = rb == 0 ? 0 : rb * 8 - 2;
            f32x4 g2 = unpack4(*(const LAS u32x2*)(lds + hr * UST + cg * 8)), v2 = unpack4(*(const LAS u32x2*)(lds + hr * UST + 128 + cg * 8));
            f32x4 g1 = unpack4(*(const LAS u32x2*)(lds + (hr + 1) * UST + cg * 8)), v1 = unpack4(*(const LAS u32x2*)(lds + (hr + 1) * UST + 128 + cg * 8));
            for (int r = hr + 2; r < rb * 8 + 8; ++r) {
                const f32x4 g0 = unpack4(*(const LAS u32x2*)(lds + r * UST + cg * 8)), v0 = unpack4(*(const LAS u32x2*)(lds + r * UST + 128 + cg * 8));
                *(u32x2*)(act + (size_t)(row0 + r) * DFF + c) = conv_gelu4(q, g2, g1, g0, v2, v1, v0);
                g2 = g1; g1 = g0; v2 = v1; v1 = v0;
            }
            if (tid < 64) { const int qq = tid >> 4, ch = tid & 15, rl = qq < 2 ? qq : 124 + qq;
                *(u32x4*)(hal + ((size_t)tm * 4 + qq) * NUP + col0 + ch * 8) = *(const LAS u32x4*)(lds + rl * UST + ch * 16); }
        } else {
            if (tid < 64) { const int qq = tid >> 4, ch = tid & 15, rl = (qq >> 1) * 16 + 14 + (qq & 1);
                *(u32x4*)(hal + ((size_t)(128 + (qq >> 1)) * 4 + 2 + (qq & 1)) * NUP + col0 + ch * 8) = *(const LAS u32x4*)(lds + rl * UST + ch * 16); }
        }
        __syncthreads();
    }
}
__device__ __forceinline__ void phase_fix(const Params& p) {
    unsigned char* ws = p.ws;
    const bf16_t* hal = (const bf16_t*)(ws + WS_HAL); bf16_t* act = (bf16_t*)(ws + WS_ACT);
    constexpr int NCG = DFF / 4;
    for (int it = blockIdx.x * NTHREADS + threadIdx.x; it < 128 * NCG; it += gridDim.x * NTHREADS) {
        const int tmg = it / NCG, c = (it % NCG) * 4, colg = (c >> 6) * 128 + (c & 63), colv = colg + 64;
        const bf16_t* own = hal + (size_t)tmg * 4 * NUP;
        const bf16_t* prv = hal + (size_t)((tmg & 63) ? tmg - 1 : 128 + (tmg >> 6)) * 4 * NUP;
        const ConvW q = load_convw(p, c);
        const f32x4 pg2 = unpack4(*(const u32x2*)(prv + 2 * NUP + colg)), pv2 = unpack4(*(const u32x2*)(prv + 2 * NUP + colv));
        const f32x4 pg3 = unpack4(*(const u32x2*)(prv + 3 * NUP + colg)), pv3 = unpack4(*(const u32x2*)(prv + 3 * NUP + colv));
        const f32x4 og0 = unpack4(*(const u32x2*)(own + colg)), ov0 = unpack4(*(const u32x2*)(own + colv));
        const f32x4 og1 = unpack4(*(const u32x2*)(own + NUP + colg)), ov1 = unpack4(*(const u32x2*)(own + NUP + colv));
        *(u32x2*)(act + (size_t)(tmg * 128) * DFF + c) = conv_gelu4(q, pg2, pg3, og0, pv2, pv3, ov0);
        *(u32x2*)(act + (size_t)(tmg * 128 + 1) * DFF + c) = conv_gelu4(q, pg3, og0, og1, pv3, ov0, ov1);
    }
}
__device__ __forceinline__ void phase6(const Params& p, LAS char* lds) {
    unsigned char* ws = p.ws;
    const int lane = threadIdx.x & 63, w = wave_id(), wr = w >> 1, wc = w & 1;
    const bf16_t* act = (const bf16_t*)(ws + WS_ACT); bf16_t* ffn = (bf16_t*)(ws + WS_FFN);
    for (int it = 0;; ++it) {
        int tm, tn; const int st = tile_at(it, 128, 8, tm, tn); if (st == 0) break; if (st == 2) continue;
        const int col0 = tn * 128;
        f32x4 acc[4][4]; zero_acc(acc);
        gemm_main<true>(lds, act + (size_t)(tm * 128) * DFF, DFF, (const bf16_t*)(ws + WS_BTDN) + (size_t)col0 * DFF, DFF, 44, acc);
        epi_store_ss(acc, ffn, 1024, tm * 128, col0, (float*)(ws + WS_SSP4), tm * 128, wr, wc, lane);
    }
}
__device__ __forceinline__ void phase7(const Params& p) {
    unsigned char* ws = p.ws;
    const bf16_t* ffn = (const bf16_t*)(ws + WS_FFN); const float* ssp4 = (const float*)(ws + WS_SSP4); const float* g3 = p.gains + 3 * D;
    for (int it = blockIdx.x * NTHREADS + threadIdx.x; it < MX * 256; it += gridDim.x * NTHREADS) {
        const int row = it >> 8, col = (it & 255) * 4;
        float sq = 0.f;
#pragma unroll
        for (int sl = 0; sl < 16; ++sl) sq += ssp4[(size_t)sl * M + row];
        const float a = 1.0f / sqrtf(sq * (1.0f / D) + EPS);
        const f32x4 hh = *(const f32x4*)(p.out + (size_t)row * D + col), g = *(const f32x4*)(g3 + col);
        const u32x2 f = *(const u32x2*)(ffn + (size_t)row * D + col);
        f32x4 o;
        o[0] = hh[0] + bf_lo(f[0]) * a * g[0]; o[1] = hh[1] + bf_hi(f[0]) * a * g[1];
        o[2] = hh[2] + bf_lo(f[1]) * a * g[2]; o[3] = hh[3] + bf_hi(f[1]) * a * g[3];
        *(f32x4*)(p.out + (size_t)row * D + col) = o;
    }
}


#ifndef DUMP
#define DUMP 0
#endif
__device__ __forceinline__ void phase_dump(const Params& p) {
    unsigned char* ws = p.ws;
    const bf16_t* s0; const bf16_t* s1; int ld;
    if (DUMP == 1) { s0 = (const bf16_t*)(ws + WS_B); s1 = s0 + 512; ld = 1024; }
    else if (DUMP == 2) { s0 = (const bf16_t*)(ws + WS_QF); s1 = (const bf16_t*)(ws + WS_KF); ld = 512; }
    else if (DUMP == 3) { s0 = (const bf16_t*)(ws + WS_A); s1 = s0 + (size_t)M * 512; ld = 512; }
    else if (DUMP == 4) { s0 = (const bf16_t*)(ws + WS_GATED); s1 = s0 + 512; ld = 1024; }
    else if (DUMP == 8) { s0 = (const bf16_t*)(ws + WS_A); s1 = s0 + 512; ld = 1024; }
    else if (DUMP == 9) { s0 = (const bf16_t*)(ws + WS_ACT) + 1024; s1 = (const bf16_t*)(ws + WS_ACT) + 2304 - 512 + 512; ld = DFF; }
    else if (DUMP == 10) { s0 = (const bf16_t*)(ws + WS_FFN); s1 = s0 + 512; ld = 1024; }
    else if (DUMP == 6) { s0 = (const bf16_t*)(ws + WS_QS); s1 = (const bf16_t*)(ws + WS_KS); ld = 512; }
    else { s0 = (const bf16_t*)(ws + WS_MIXED); s1 = s0 + 512; ld = 1024; }
    for (int it = blockIdx.x * NTHREADS + threadIdx.x; it < MX * 1024; it += gridDim.x * NTHREADS) {
        const int row = it >> 10, col = it & 1023;
        if (DUMP >= 9 && row >= 8192) { p.out[it] = 0.f; continue; }
        const bf16_t v = col < 512 ? s0[(size_t)row * ld + col] : s1[(size_t)row * ld + col - 512];
        p.out[it] = __uint_as_float((unsigned)v << 16);
    }
}

__device__ __forceinline__ void l2_scrub(const Params& p) {
    const f32x4* src = (const f32x4*)p.x + (size_t)(blockIdx.x & 511) * 8192;
    f32x4 a = (f32x4){0.f, 0.f, 0.f, 0.f};
    for (int i = threadIdx.x; i < 8192; i += NTHREADS) a += src[i];
    if (a[0] + a[1] + a[2] + a[3] == 1.2345e-30f) ((float*)(p.ws + WS_CTL))[32 + (threadIdx.x & 7)] = a[0];
}


#define XB_TMO      128
#define XB_XCNT(j)  (256  + 64 * (j))
#define XB_XSUB(j)  (1280 + 64 * (j))
#define XB_XGEN(j)  (2304 + 64 * (j))
#define XB_TOP      3328
#define XB_TOPGEN   3392
#define XCD_BAR_WORDS 3456
#define XB_SPIN_CAP (1u << 18)
__device__ __forceinline__ unsigned xb_ld(unsigned* p)              { return __hip_atomic_load(p, __ATOMIC_RELAXED, __HIP_MEMORY_SCOPE_AGENT); }
__device__ __forceinline__ unsigned xb_add(unsigned* p, unsigned v) { return __hip_atomic_fetch_add(p, v, __ATOMIC_RELAXED, __HIP_MEMORY_SCOPE_AGENT); }
__device__ __forceinline__ unsigned xb_xcc_id() { return (unsigned)__builtin_amdgcn_s_getreg((3 << 11) | 20) & 0xFu; }
#define XB_SPIN(cond, bar) do { unsigned _sp = 0; while (cond) { __builtin_amdgcn_s_sleep(1); \
    if ((++_sp & 255u) == 0u) { if (xb_ld(&(bar)[XB_TMO])) break; if (_sp > XB_SPIN_CAP) { atomicAdd(&(bar)[XB_TMO], 1u); break; } } } } while (0)
struct XcdBarrier { unsigned* bar; unsigned x; volatile LAS unsigned* st; };
__device__ __forceinline__ XcdBarrier xcd_barrier_post(unsigned* bar, volatile LAS unsigned* st) {
    XcdBarrier b; b.bar = bar; b.x = xb_xcc_id(); b.st = st;
    if (threadIdx.x == 0) (void)xb_add(&bar[XB_XCNT(b.x)], 1u);
    return b;
}
__device__ __forceinline__ void xcd_barrier_complete(unsigned* bar, unsigned x, unsigned& nloc, unsigned& nx) {
    const unsigned G = gridDim.x * gridDim.y * gridDim.z;
    unsigned sum, cnt, mine, sp = 0u;
    for (;;) {
        sum = 0u; cnt = 0u; mine = 0u;
#pragma unroll
        for (unsigned j = 0; j < 16; ++j) { const unsigned c = xb_ld(&bar[XB_XCNT(j)]); sum += c; cnt += (c > 0u) ? 1u : 0u; mine = (j == x) ? c : mine; }
        if (sum == G) break;
        __builtin_amdgcn_s_sleep(1);
        if ((++sp & 255u) == 0u) { if (xb_ld(&bar[XB_TMO])) break; if (sp > XB_SPIN_CAP) { atomicAdd(&bar[XB_TMO], 1u); break; } }
    }
    nloc = mine > 0u ? mine : 1u; nx = cnt > 0u ? cnt : 1u;
}
__device__ __forceinline__ void xcd_barrier(const XcdBarrier& b) {
    asm volatile("s_waitcnt vmcnt(0)" ::: "memory");
    __syncthreads();
    if (threadIdx.x == 0) {
        unsigned* bar = b.bar;
        __builtin_amdgcn_s_waitcnt(0);
        unsigned nloc = b.st[0], nx = b.st[1];
        if (nloc == 0u) { xcd_barrier_complete(bar, b.x, nloc, nx); b.st[0] = nloc; b.st[1] = nx; }
        const unsigned old = xb_add(&bar[XB_XSUB(b.x)], 1u);
        const unsigned gen = old / nloc;
        if (old + 1u == (gen + 1u) * nloc) {
            __builtin_amdgcn_fence(__ATOMIC_RELEASE, "agent");
            asm volatile("s_waitcnt vmcnt(0)" ::: "memory");
            const unsigned og = xb_add(&bar[XB_TOP], 1u);
            const unsigned tg = og / nx;
            if (og + 1u == (tg + 1u) * nx) xb_add(&bar[XB_TOPGEN], 1u);
            else XB_SPIN(xb_ld(&bar[XB_TOPGEN]) == tg, bar);
            __builtin_amdgcn_fence(__ATOMIC_ACQUIRE, "agent");
            xb_add(&bar[XB_XGEN(b.x)], 1u);
            asm volatile("s_waitcnt vmcnt(0)" ::: "memory");
        } else {
            XB_SPIN(xb_ld(&bar[XB_XGEN(b.x)]) == gen, bar);
            __builtin_amdgcn_fence(__ATOMIC_ACQUIRE, "agent");
            asm volatile("s_waitcnt vmcnt(0)" ::: "memory");
        }
    }
    __syncthreads();
}

__device__ __forceinline__ void my_grid_sync(const Params& p, unsigned& target) {
    unsigned* bar = (unsigned*)(p.ws + WS_CTL) + 16;
    asm volatile("s_waitcnt vmcnt(0)" ::: "memory");
    __syncthreads();
    target += gridDim.x;
    if (threadIdx.x == 0) {
        __builtin_amdgcn_fence(__ATOMIC_RELEASE, "agent");
        asm volatile("s_waitcnt vmcnt(0)" ::: "memory");
        __hip_atomic_fetch_add(bar, 1u, __ATOMIC_RELAXED, __HIP_MEMORY_SCOPE_AGENT);
        while (__hip_atomic_load(bar, __ATOMIC_RELAXED, __HIP_MEMORY_SCOPE_AGENT) < target) __builtin_amdgcn_s_sleep(2);
        __builtin_amdgcn_fence(__ATOMIC_ACQUIRE, "agent");
        asm volatile("s_waitcnt vmcnt(0)" ::: "memory");
    }
    __syncthreads();
}
__global__ void __launch_bounds__(NTHREADS, 2) fwd_kernel(Params p) {
    extern __shared__ __attribute__((aligned(16))) unsigned char lds_raw[];
    LAS char* lds = (LAS char*)lds_raw;
    cg::grid_group grid = cg::this_grid();
#define IN(k) (p.ph_lo <= (k) && (k) < p.ph_hi)
#define SEAM(k) do { if (IN(k) && IN((k) + 1)) { if (p.ph_hi > 1000) grid.sync(); xcd_barrier(xbar); } } while (0)
    volatile LAS unsigned* xst = (volatile LAS unsigned*)(lds + 65536);
    if (threadIdx.x < 4) xst[threadIdx.x] = 0u;
    __syncthreads();
    const XcdBarrier xbar = xcd_barrier_post((unsigned*)(p.ws + WS_XBAR), xst);
    if (IN(0)) phase0(p, lds);
    SEAM(0);
    if (IN(1)) phase1(p, lds);
    SEAM(1);
    if (IN(2)) phase2(p, lds);
    SEAM(2);
    if (IN(3)) phase3a(p, lds);
    SEAM(3);
    if (IN(4)) phase3b(p, lds);
    SEAM(4);
    if (IN(5)) phase3c(p);
    SEAM(5);
    if (IN(6)) phase4(p, lds);
    SEAM(6);
    if (IN(7)) phase_fix(p);
    SEAM(7);
    if (IN(8)) phase6(p, lds);
    SEAM(8);
    if (IN(9)) phase7(p);
#undef IN
#undef SEAM
}


__global__ void ab_save(const unsigned char* ws, float* out) {
    const u32x4* src = (const u32x4*)(ws + AB_SRC); u32x4* dst = (u32x4*)((unsigned char*)out + (size_t)32 * MiB);
    for (size_t i = blockIdx.x * (size_t)blockDim.x + threadIdx.x; i < (size_t)AB_BYTES / 16; i += (size_t)gridDim.x * blockDim.x) dst[i] = src[i];
}
__global__ void ab_diff(const unsigned char* ws, float* out) {
    const bf16_t* src = (const bf16_t*)(ws + AB_SRC); const bf16_t* sav = (const bf16_t*)((unsigned char*)out + (size_t)32 * MiB);
    for (size_t i = blockIdx.x * (size_t)blockDim.x + threadIdx.x; i < (size_t)8192 * 1024; i += (size_t)gridDim.x * blockDim.x) {
        if (i >= (size_t)AB_BYTES / 2) { out[i] = 0.f; continue; }
        out[i] = src[i] != sav[i] ? 1000.0f : 0.f;
    }
}
__global__ void ab_zero(float* out) {
    for (size_t i = blockIdx.x * (size_t)blockDim.x + threadIdx.x; i < (size_t)8192 * 1024; i += (size_t)gridDim.x * blockDim.x) out[(size_t)8192 * 1024 + i] = 0.f;
}
extern "C" void kernel_launch(void* const* d_in, const int* in_sizes, int n_in, void* d_out, int out_size, void* d_ws, size_t ws_size, hipStream_t stream) {
    static int grid_blocks = 0;
    if (grid_blocks == 0) {
        if (n_in != 12 || ws_size < WS_END) { fprintf(stderr, "kernel_launch: unexpected n_in %d or ws_size %zu (need %zu)\n", n_in, ws_size, (size_t)WS_END); grid_blocks = -1; return; }
        int dev = 0, cus = 0, per_cu = 0;
        (void)hipGetDevice(&dev);
        (void)hipDeviceGetAttribute(&cus, hipDeviceAttributeMultiprocessorCount, dev);
        (void)hipFuncSetAttribute((const void*)fwd_kernel, hipFuncAttributeMaxDynamicSharedMemorySize, LDS_BYTES);
        (void)hipOccupancyMaxActiveBlocksPerMultiprocessor(&per_cu, (const void*)fwd_kernel, NTHREADS, LDS_BYTES);
        if (per_cu < 1) per_cu = 1;
        if (per_cu > 2) per_cu = 2;
        grid_blocks = cus * per_cu;
        (void)hipGetLastError();
    }
    if (grid_blocks < 0) return;
    Params p{};
    p.x = (const float*)d_in[0]; p.meta = (const float*)d_in[1]; p.gains = (const float*)d_in[2]; p.w_in = (const float*)d_in[3];
    p.b_forget = (const float*)d_in[4]; p.w_o_fox = (const float*)d_in[5]; p.w_o_sb = (const float*)d_in[6]; p.w_out = (const float*)d_in[7];
    p.w_up = (const float*)d_in[8]; p.conv_w = (const float*)d_in[9]; p.conv_b = (const float*)d_in[10]; p.w_down = (const float*)d_in[11];
    p.out = (float*)d_out; p.ws = (unsigned char*)d_ws;
#if SINGLE_LAUNCH
    (void)hipMemsetAsync((unsigned char*)d_ws + WS_CTL, 0, 256, stream);
    (void)hipMemsetAsync((unsigned char*)d_ws + WS_XBAR, 0, XCD_BAR_WORDS * 4, stream);
    p.ph_lo = 0; p.ph_hi = NPHASE;
    void* args[] = {&p};
    hipError_t e = hipLaunchCooperativeKernel((const void*)fwd_kernel, dim3(grid_blocks), dim3(NTHREADS), args, LDS_BYTES, stream);
    if (e != hipSuccess) fprintf(stderr, "cooperative launch failed: %s (grid %d)\n", hipGetErrorString(e), grid_blocks);
#else
#ifndef STOP_AT
#define STOP_AT NPHASE
#endif
    for (int k = 0; k < STOP_AT; ++k) {
        p.ph_lo = k; p.ph_hi = k + 1;
        hipLaunchKernelGGL(fwd_kernel, dim3(grid_blocks), dim3(NTHREADS), LDS_BYTES, stream, p);
    }
#if ABTEST
    ab_save<<<1024, 256, 0, stream>>>(p.ws, p.out);
    for (int k = AB_FROM; k < STOP_AT; ++k) {
        p.ph_lo = k; p.ph_hi = k + 1;
        hipLaunchKernelGGL(fwd_kernel, dim3(grid_blocks), dim3(NTHREADS), LDS_BYTES, stream, p);
    }
    ab_diff<<<1024, 256, 0, stream>>>(p.ws, p.out);
    ab_zero<<<1024, 256, 0, stream>>>(p.out);
#endif

#endif
}
```

```cpp
#include <hip/hip_runtime.h>
#include <hip/hip_cooperative_groups.h>
#include <cstdio>
#include <cstdint>
namespace cg = cooperative_groups;

#define DUMP 0
#define ABTEST 0
#define AB_FROM 0
#define AB_SRC WS_SSP2
#define AB_BYTES (2 * MiB)
#ifndef SINGLE_LAUNCH
#define SINGLE_LAUNCH 1
#endif

#define LAS __attribute__((address_space(3)))
typedef unsigned short bf16_t;
typedef short bf16x8 __attribute__((ext_vector_type(8)));
typedef float f32x4 __attribute__((ext_vector_type(4)));
typedef float f32x16 __attribute__((ext_vector_type(16)));
typedef unsigned u32x4 __attribute__((ext_vector_type(4)));
typedef unsigned u32x2 __attribute__((ext_vector_type(2)));

constexpr int D = 1024, SEQ = 8192, NMETA = 16, NB = 2;
constexpr int MX = NB * SEQ;
constexpr int MV = MX + NB * NMETA;
constexpr int M = 16512;
constexpr int LPK = 8256;
constexpr int PROJW = 5128, NPROJ = 5120, DFF = 2816, NUP = 5632;
constexpr float EPS = 1e-6f;
constexpr float LOG2E = 1.4426950408889634f, LN2 = 0.6931471805599453f;
constexpr int NTHREADS = 256;
constexpr int LDS_BYTES = 65536 + 16;
constexpr int NPHASE = 10;

constexpr size_t MiB = 1u << 20;
constexpr size_t WS_CTL = 0;
constexpr size_t WS_R1 = 4096, WS_R2 = WS_R1 + 69632, WS_SS2 = WS_R2 + 69632, WS_SS4 = WS_SS2 + 69632;
constexpr size_t WS_LOGF = WS_SS4 + 69632, WS_CK = WS_LOGF + 528384, WS_UPMETA = WS_CK + 528384;
constexpr size_t WS_BTIN = 2 * MiB, WS_BTOF = WS_BTIN + 10 * MiB, WS_BTOS = WS_BTOF + 1 * MiB, WS_BTOUT = WS_BTOS + 1 * MiB,
                 WS_BTUP = WS_BTOUT + 2 * MiB, WS_BTDN = WS_BTUP + 11 * MiB;
constexpr size_t SZ_M1024 = (size_t)M * 1024 * 2, SZ_M512 = (size_t)M * 512 * 2;
constexpr size_t WS_A = 33 * MiB;
constexpr size_t WS_B = WS_A + SZ_M1024;
constexpr size_t WS_C = WS_B + 2 * SZ_M1024;
constexpr size_t WS_QF = WS_C, WS_KF = WS_QF + SZ_M512, WS_QS = WS_KF + SZ_M512, WS_KS = WS_QS + SZ_M512, WS_VFT = WS_KS + SZ_M512, WS_VST = WS_VFT + SZ_M512;
constexpr size_t WS_GATED = WS_C, WS_MIXED = WS_B + SZ_M1024;
constexpr size_t WS_ACT = WS_B;
constexpr size_t WS_FFN = WS_ACT + 132 * MiB;
constexpr size_t WS_SSP2 = 230 * MiB, WS_SSP4 = 232 * MiB;
constexpr size_t WS_HAL = 234 * MiB;
constexpr size_t WS_XBAR = 240 * MiB;
constexpr size_t WS_END = 241 * MiB;

struct Params {
    const float *x, *meta, *gains, *w_in, *b_forget, *w_o_fox, *w_o_sb, *w_out, *w_up, *conv_w, *conv_b, *w_down;
    float* out; unsigned char* ws; int ph_lo, ph_hi;
};

typedef __bf16 bf16x2_t __attribute__((ext_vector_type(2)));
__device__ __forceinline__ unsigned pk_bf16(float lo, float hi) { bf16x2_t v = {(__bf16)lo, (__bf16)hi}; return __builtin_bit_cast(unsigned, v); }
__device__ __forceinline__ float bf_lo(unsigned u) { return __uint_as_float(u << 16); }
__device__ __forceinline__ float bf_hi(unsigned u) { return __uint_as_float(u & 0xffff0000u); }
__device__ __forceinline__ float ex2(float x) { return __builtin_amdgcn_exp2f(x); }
__device__ __forceinline__ float lg2(float x) { return __builtin_amdgcn_logf(x); }
__device__ __forceinline__ float rcp(float x) { return __builtin_amdgcn_rcpf(x); }
__device__ __forceinline__ float sigmoidf_(float v) { return rcp(1.0f + ex2(-v * LOG2E)); }
__device__ __forceinline__ float wave_sum(float v) {
#pragma unroll
    for (int o = 32; o > 0; o >>= 1) v += __shfl_xor(v, o);
    return v;
}
__device__ __forceinline__ int wave_id() { return __builtin_amdgcn_readfirstlane((int)(threadIdx.x >> 6)); }

__device__ __forceinline__ void transpose_tile(LAS char* lds, const float* src, int ldsrc, int srccol, int k0, const float* gain, bf16_t* dst, int K, int n0) {
    LAS bf16_t* T = (LAS bf16_t*)lds;
    const int tid = threadIdx.x, r = tid >> 4, c4 = tid & 15;
#pragma unroll
    for (int p = 0; p < 4; ++p) {
        const int k = r + 16 * p;
        f32x4 v = *(const f32x4*)(src + (size_t)(k0 + k) * ldsrc + srccol + c4 * 4);
        const float g = gain ? gain[k0 + k] : 1.0f;
        const unsigned a = pk_bf16(v[0] * g, v[1] * g), b = pk_bf16(v[2] * g, v[3] * g);
        T[(c4 * 4 + 0) * 72 + k] = (bf16_t)(a & 0xffff); T[(c4 * 4 + 1) * 72 + k] = (bf16_t)(a >> 16);
        T[(c4 * 4 + 2) * 72 + k] = (bf16_t)(b & 0xffff); T[(c4 * 4 + 3) * 72 + k] = (bf16_t)(b >> 16);
    }
    __syncthreads();
    const int n = tid >> 2, kq = tid & 3;
    const u32x4 lo = *(LAS u32x4*)(T + n * 72 + kq * 16), hi = *(LAS u32x4*)(T + n * 72 + kq * 16 + 8);
    bf16_t* d = dst + (size_t)(n0 + n) * K + k0 + kq * 16;
    *(u32x4*)d = lo; *(u32x4*)(d + 8) = hi;
    __syncthreads();
}

__device__ __forceinline__ void phase0(const Params& p, LAS char* lds) {
    unsigned char* ws = p.ws;
    const int tid = threadIdx.x, lane = tid & 63, w = wave_id();
    LAS float* wfT = (LAS float*)lds;
    const float* g0 = p.gains;
    for (int idx = tid; idx < 8192; idx += NTHREADS) { const int h = idx & 7, k = idx >> 3; wfT[h * 1024 + k] = p.w_in[(size_t)k * PROJW + 1536 + h] * g0[k]; }
    __syncthreads();
    bf16_t* xb = (bf16_t*)(ws + WS_A);
    float* r1 = (float*)(ws + WS_R1);
    float* logf_ = (float*)(ws + WS_LOGF);
    for (int r_ = blockIdx.x * 32 + w; r_ < M; r_ += (r_ & 31) < 28 ? 4 : gridDim.x * 32 - 28) {
        const int r = r_;
        if (r >= MV) {
#pragma unroll
            for (int i = 0; i < 4; ++i) *(u32x2*)(xb + (size_t)r * D + lane * 4 + 256 * i) = (u32x2){0u, 0u};
            if (lane == 0) r1[r] = 0.f;
            continue;
        }
        const float* src = r < MX ? p.x + (size_t)r * D : p.meta + (size_t)((r - MX) & 15) * D;
        f32x4 v[4]; float ss = 0.f;
#pragma unroll
        for (int i = 0; i < 4; ++i) { v[i] = *(const f32x4*)(src + lane * 4 + 256 * i); ss += v[i][0] * v[i][0] + v[i][1] * v[i][1] + v[i][2] * v[i][2] + v[i][3] * v[i][3]; }
#pragma unroll
        for (int i = 0; i < 4; ++i) *(u32x2*)(xb + (size_t)r * D + lane * 4 + 256 * i) = (u32x2){pk_bf16(v[i][0], v[i][1]), pk_bf16(v[i][2], v[i][3])};
        ss = wave_sum(ss);
        const float rs = 1.0f / sqrtf(ss * (1.0f / D) + EPS);
        if (lane == 0) r1[r] = rs;
        float mine = 0.f;
#pragma unroll
        for (int h = 0; h < 8; ++h) {
            float a = 0.f;
#pragma unroll
            for (int i = 0; i < 4; ++i) { const f32x4 wv = *(LAS f32x4*)(wfT + h * 1024 + lane * 4 + 256 * i); a += v[i][0] * wv[0] + v[i][1] * wv[1] + v[i][2] * wv[2] + v[i][3] * wv[3]; }
            a = wave_sum(a);
            if (lane == h) mine = a;
        }
        if (lane < 8) {
            const float f = mine * rs + p.b_forget[lane];
            const float lf = fminf(f, 0.f) - log1pf(expf(-fabsf(f)));
            int b, kidx; if (r < MX) { b = r >> 13; kidx = r & 8191; } else { const int j = r - MX; b = j >> 4; kidx = 8192 + (j & 15); }
            logf_[(size_t)(b * 8 + lane) * LPK + kidx] = lf;
        }
    }
    __syncthreads();
    LAS char* tl = lds + 32768;
    const float* g2 = p.gains + 2 * D;
    constexpr int T_IN = 16 * 80, T_OF = 8 * 16, T_OS = 8 * 16, T_OUT = 16 * 16, T_UP = 16 * 88, T_DN = 44 * 16;
    constexpr int T_ALL = T_IN + T_OF + T_OS + T_OUT + T_UP + T_DN;
    for (int t = blockIdx.x; t < T_ALL; t += gridDim.x) {
        int u = t;
        if (u < T_IN) { const int nt = u % 80, kt = u / 80; const int sc = nt * 64 + (nt * 64 >= 1536 ? 8 : 0); transpose_tile(tl, p.w_in, PROJW, sc, kt * 64, g0, (bf16_t*)(ws + WS_BTIN), 1024, nt * 64); continue; }
        u -= T_IN;
        if (u < T_OF) { const int nt = u % 16, kt = u / 16; transpose_tile(tl, p.w_o_fox, 1024, nt * 64, kt * 64, nullptr, (bf16_t*)(ws + WS_BTOF), 512, nt * 64); continue; }
        u -= T_OF;
        if (u < T_OS) { const int nt = u % 16, kt = u / 16; transpose_tile(tl, p.w_o_sb, 1024, nt * 64, kt * 64, nullptr, (bf16_t*)(ws + WS_BTOS), 512, nt * 64); continue; }
        u -= T_OS;
        if (u < T_OUT) { const int nt = u % 16, kt = u / 16; transpose_tile(tl, p.w_out, 1024, nt * 64, kt * 64, nullptr, (bf16_t*)(ws + WS_BTOUT), 1024, nt * 64); continue; }
        u -= T_OUT;
        if (u < T_UP) { const int nt = u % 88, kt = u / 88; transpose_tile(tl, p.w_up, NUP, (nt & 1) * DFF + (nt >> 1) * 64, kt * 64, g2, (bf16_t*)(ws + WS_BTUP), 1024, nt * 64); continue; }
        u -= T_UP;
        { const int nt = u % 16, kt = u / 16; transpose_tile(tl, p.w_down, 1024, nt * 64, kt * 64, nullptr, (bf16_t*)(ws + WS_BTDN), DFF, nt * 64); }
    }
}

template <bool SWAP, bool FULL>
__device__ __forceinline__ void gemm_kloop(LAS char* lds, const bf16_t* Ag, int lda, const bf16_t* Bg, int ldb, int nk, f32x4 (&acc)[4][4], int mlim) {
    const int tid = threadIdx.x, lane = tid & 63, w = wave_id(), wr = w >> 1, wc = w & 1;
    const int row_0 = w * 8 + (lane >> 3), c_0 = (lane & 7) ^ ((row_0 >> 1) & 7);
    const bf16_t* pa0 = Ag + (size_t)row_0 * lda + c_0 * 8; const bf16_t* pb0 = Bg + (size_t)row_0 * ldb + c_0 * 8;
    const size_t sa = (size_t)32 * lda, sb_ = (size_t)32 * ldb;
    const int swz = (lane >> 1) & 7;
    int aoff[2], boff[2];
#pragma unroll
    for (int kh = 0; kh < 2; ++kh) {
        aoff[kh] = (wr * 64 + (lane & 15)) * 128 + (((kh * 4 + (lane >> 4)) ^ swz) << 4);
        boff[kh] = 16384 + (wc * 64 + (lane & 15)) * 128 + (((kh * 4 + (lane >> 4)) ^ swz) << 4);
    }
#define GM_STAGE(s, kt) do { _Pragma("unroll") for (int i_ = 0; i_ < 4; ++i_) { \
        __builtin_amdgcn_global_load_lds((const unsigned*)(pa0 + i_ * sa + (kt) * 64), (LAS unsigned*)(lds + (s) * 32768 + (i_ * 4 + w) * 1024), 16, 0, 0); \
        __builtin_amdgcn_global_load_lds((const unsigned*)(pb0 + i_ * sb_ + (kt) * 64), (LAS unsigned*)(lds + (s) * 32768 + 16384 + (i_ * 4 + w) * 1024), 16, 0, 0); } } while (0)
    GM_STAGE(0, 0);
    for (int kt = 0; kt < nk; ++kt) {
        asm volatile("s_waitcnt vmcnt(0)" ::: "memory");
        __syncthreads();
        const int s = kt & 1;
        if (kt + 1 < nk) GM_STAGE(s ^ 1, kt + 1);
        bf16x8 af[4][2], bf[4][2];
#pragma unroll
        for (int kh = 0; kh < 2; ++kh) {
#pragma unroll
            for (int m = 0; m < 4; ++m) if (FULL || m < mlim) af[m][kh] = *(LAS bf16x8*)(lds + s * 32768 + aoff[kh] + m * 2048);
#pragma unroll
            for (int n = 0; n < 4; ++n) bf[n][kh] = *(LAS bf16x8*)(lds + s * 32768 + boff[kh] + n * 2048);
        }
        __builtin_amdgcn_s_setprio(1);
#pragma unroll
        for (int kh = 0; kh < 2; ++kh)
#pragma unroll
            for (int m = 0; m < 4; ++m) if (FULL || m < mlim) {
#pragma unroll
                for (int n = 0; n < 4; ++n)
                    acc[m][n] = SWAP ? __builtin_amdgcn_mfma_f32_16x16x32_bf16(bf[n][kh], af[m][kh], acc[m][n], 0, 0, 0)
                                     : __builtin_amdgcn_mfma_f32_16x16x32_bf16(af[m][kh], bf[n][kh], acc[m][n], 0, 0, 0);
            }
        __builtin_amdgcn_s_setprio(0);
    }
    __syncthreads();
#undef GM_STAGE
}
template <bool SWAP>
__device__ __forceinline__ void gemm_main(LAS char* lds, const bf16_t* Ag, int lda, const bf16_t* Bg, int ldb, int nk, f32x4 (&acc)[4][4], int mlim = 4) {
    if (mlim == 4) gemm_kloop<SWAP, true>(lds, Ag, lda, Bg, ldb, nk, acc, 4);
    else gemm_kloop<SWAP, false>(lds, Ag, lda, Bg, ldb, nk, acc, mlim);
}
__device__ __forceinline__ void zero_acc(f32x4 (&acc)[4][4]) {
#pragma unroll
    for (int m = 0; m < 4; ++m)
#pragma unroll
        for (int n = 0; n < 4; ++n) acc[m][n] = (f32x4){0.f, 0.f, 0.f, 0.f};
}


__device__ __forceinline__ int tile_at(int it, int ntm, int ntn, int& tm, int& tn) {
    const int G = gridDim.x;
    if (G % 256 != 0) { const int t = it * G + blockIdx.x; if (t >= ntm * ntn) return 0; tm = t / ntn; tn = t % ntn; return 1; }
    const int xcd = blockIdx.x & 7, j = blockIdx.x >> 3, ppx = G >> 8;
    const int pcols = (ntn + 3) >> 2, prows = (ntm + 7) >> 3;
    const int patch = (it * ppx + (j >> 5)) * 8 + xcd;
    if (patch >= prows * pcols) return 0;
    const int wi = j & 31;
    tm = (patch / pcols) * 8 + (wi >> 2); tn = (patch % pcols) * 4 + (wi & 3);
    return (tm < ntm && tn < ntn) ? 1 : 2;
}
__device__ __forceinline__ void cumsum_block(const Params& p, LAS char* lds, int bh) {
    const float* lf = (const float*)(p.ws + WS_LOGF) + (size_t)bh * LPK; float* ck = (float*)(p.ws + WS_CK) + (size_t)bh * LPK;
    LAS float* wsum = (LAS float*)lds;
    const int tid = threadIdx.x, lane = tid & 63, w = wave_id(); constexpr int PER = 33, L = SEQ + NMETA;
    float v[PER];
#pragma unroll
    for (int e = 0; e < PER; ++e) { const int t = e * NTHREADS + tid; const int tc = t < L ? t : L - 1; const float x = lf[tc < 16 ? 8192 + tc : tc - 16]; v[e] = t < L ? x : 0.f; }
    float carry = 0.f;
#pragma unroll
    for (int e = 0; e < PER; ++e) {
        float x = v[e];
#pragma unroll
        for (int o = 1; o < 64; o <<= 1) { const float y = __shfl_up(x, o); if (lane >= o) x += y; }
        if (lane == 63) wsum[(e & 1) * 4 + w] = x;
        __syncthreads();
        const float s0 = wsum[(e & 1) * 4 + 0], s1 = wsum[(e & 1) * 4 + 1], s2 = wsum[(e & 1) * 4 + 2], s3 = wsum[(e & 1) * 4 + 3];
        const float pre = (w > 0 ? s0 : 0.f) + (w > 1 ? s1 : 0.f) + (w > 2 ? s2 : 0.f);
        const int t = e * NTHREADS + tid;
        if (t < L) ck[t < 16 ? 8192 + t : t - 16] = (carry + pre + x) * LOG2E;
        carry += (s0 + s1) + (s2 + s3);
    }
    __syncthreads();
}

__device__ __forceinline__ void phase1(const Params& p, LAS char* lds) {
    unsigned char* ws = p.ws;
    if ((int)blockIdx.x >= (int)gridDim.x - 16) cumsum_block(p, lds, gridDim.x - 1 - blockIdx.x);
    const int lane = threadIdx.x & 63, w = wave_id(), wr = w >> 1, wc = w & 1;
    const bf16_t* xb = (const bf16_t*)(ws + WS_A); const bf16_t* Bt = (const bf16_t*)(ws + WS_BTIN);
    const float* r1 = (const float*)(ws + WS_R1);
    constexpr int NTN = 40, NTM = 129;
    for (int it = 0;; ++it) {
        int tm, tn; int st = tile_at(it, NTM - 1, NTN, tm, tn);
        if (st == 0) { if (it < (1 << 20) && (int)blockIdx.x < NTN) { tm = NTM - 1; tn = blockIdx.x; it = 1 << 20; st = 1; } else break; }
        if (st == 2) continue;
        const int row0 = tm * 128, col0 = tn * 128; const int mlim = tm == NTM - 1 ? (wr == 0 ? 2 : 0) : 4;
        const bool vtile = (tn >= 8 && tn < 12) || (tn >= 20 && tn < 24);
        f32x4 acc[4][4]; zero_acc(acc);
        if (vtile) {
            gemm_main<false>(lds, xb + (size_t)row0 * D, D, Bt + (size_t)col0 * D, D, 16, acc, mlim);
            bf16_t* vT = (bf16_t*)(ws + (tn < 12 ? WS_VFT : WS_VST)); const int cb = tn < 12 ? 1024 : 2560;
            const int g = lane >> 4, gp = ((g & 1) << 1) | (g >> 1);
#pragma unroll
            for (int m = 0; m < 4; ++m) {
                const int rb = row0 + wr * 64 + m * 16; int b, kb16;
                if (rb < MX) { b = rb >> 13; kb16 = rb & 8191; } else { const int j = rb - MX; if (j >= 32) continue; b = j >> 4; kb16 = 8192; }
                const f32x4 rs = *(const f32x4*)(r1 + rb + g * 4);
#pragma unroll
                for (int n = 0; n < 4; ++n) {
                    const int dc = col0 + wc * 64 + n * 16 + (lane & 15) - cb, h = dc >> 6, d = dc & 63;
                    const f32x4 v = acc[m][n] * rs;
                    *(u32x2*)(vT + ((size_t)(b * 8 + h) * 64 + d) * LPK + kb16 + gp * 4) = (u32x2){pk_bf16(v[0], v[1]), pk_bf16(v[2], v[3])};
                }
            }
        } else {
            gemm_main<true>(lds, xb + (size_t)row0 * D, D, Bt + (size_t)col0 * D, D, 16, acc, mlim);
            bf16_t* dst; int ld, cb; float sc = 1.f; bool sg = false;
            if (tn < 4) { dst = (bf16_t*)(ws + WS_QF); ld = 512; cb = 0; sc = 0.125f * LOG2E; }
            else if (tn < 8) { dst = (bf16_t*)(ws + WS_KF); ld = 512; cb = 512; }
            else if (tn < 16) { dst = (bf16_t*)(ws + WS_QS); ld = 512; cb = 1536; sc = 0.125f; }
            else if (tn < 20) { dst = (bf16_t*)(ws + WS_KS); ld = 512; cb = 2048; }
            else if (tn < 32) { dst = (bf16_t*)(ws + WS_B); ld = 1024; cb = 3072; sg = true; }
            else { dst = (bf16_t*)(ws + WS_B + SZ_M1024); ld = 1024; cb = 4096; sg = true; }
            const bool kfox = tn >= 4 && tn < 8;
            float wmax = 0.f;
#pragma unroll
            for (int m = 0; m < 4; ++m) {
                const int row = row0 + wr * 64 + m * 16 + (lane & 15); const float rs = r1[row] * sc;
                float s2 = 0.f;
#pragma unroll
                for (int n = 0; n < 4; ++n) {
                    const int col = col0 + wc * 64 + n * 16 + (lane >> 4) * 4 - cb;
                    f32x4 v = acc[m][n] * rs;
                    if (sg) { v[0] = sigmoidf_(v[0]); v[1] = sigmoidf_(v[1]); v[2] = sigmoidf_(v[2]); v[3] = sigmoidf_(v[3]); }
                    s2 += v[0] * v[0] + v[1] * v[1] + v[2] * v[2] + v[3] * v[3];
                    *(u32x2*)(dst + (size_t)row * ld + col) = (u32x2){pk_bf16(v[0], v[1]), pk_bf16(v[2], v[3])};
                }
                if (kfox) { s2 += __shfl_xor(s2, 16); s2 += __shfl_xor(s2, 32); wmax = fmaxf(wmax, s2); }
            }
            if (kfox) {
#pragma unroll
                for (int o = 1; o < 16; o <<= 1) wmax = fmaxf(wmax, __shfl_xor(wmax, o));
                if (lane == 0) {
                    unsigned* km = (unsigned*)(ws + WS_CTL) + 32; const int head = (tn - 4) * 2 + wc; const unsigned bits = __float_as_uint(wmax);
                    if (row0 < MX) atomicMax(km + (row0 >> 13) * 8 + head, bits);
                    else { atomicMax(km + head, bits); atomicMax(km + 8 + head, bits); }
                }
            }
        }
    }
}

constexpr int AT_STAGE = 16640;
template <int TYPE>
__device__ __forceinline__ void attn_unit(LAS char* lds, const Params& p, int b, int h, int qb) {
    unsigned char* ws = p.ws;
    const int tid = threadIdx.x, lane = tid & 63, w = wave_id(), ql = lane & 31, hi = lane >> 5;
    const bf16_t* Q = (const bf16_t*)(ws + (TYPE == 0 ? WS_QF : WS_QS));
    const bf16_t* Kp = (const bf16_t*)(ws + (TYPE == 0 ? WS_KF : WS_KS));
    const bf16_t* VT = (const bf16_t*)(ws + (TYPE == 0 ? WS_VFT : WS_VST)) + (size_t)(b * 8 + h) * 64 * LPK;
    const float* cK = (const float*)(ws + WS_CK) + (size_t)(b * 8 + h) * LPK;
    bf16_t* Oo = (bf16_t*)(ws + WS_A + (TYPE == 0 ? 0 : SZ_M512));
    const bool meta_unit = qb < 0;
    const int qrow0 = meta_unit ? MX + 16 * b : b * SEQ + qb * 128;
    const int nt = meta_unit ? 1 : 2 * qb + 3;
    int qrow = qrow0 + 32 * w + ql; if (qrow > M - 1) qrow = M - 1;
    bf16x8 qf[4];
#pragma unroll
    for (int ds = 0; ds < 4; ++ds) qf[ds] = *(const bf16x8*)(Q + (size_t)qrow * 512 + h * 64 + ds * 16 + hi * 8);
    f32x16 O0, O1;
#pragma unroll
    for (int i = 0; i < 16; ++i) { O0[i] = 0.f; O1[i] = 0.f; }
    float m_run = -INFINITY, lsum = 0.f, R = 0.f;
    float qbound = 0.f;
    if (TYPE == 0) {
        float q2 = 0.f;
#pragma unroll
        for (int ds = 0; ds < 4; ++ds)
#pragma unroll
            for (int e = 0; e < 8; ++e) { const float x = __uint_as_float((unsigned)(unsigned short)qf[ds][e] << 16); q2 += x * x; }
        q2 += __shfl_xor(q2, 32);
        const unsigned kb = __hip_atomic_load((unsigned*)(ws + WS_CTL) + 32 + b * 8 + h, __ATOMIC_RELAXED, __HIP_MEMORY_SCOPE_AGENT);
        qbound = sqrtf(q2) * sqrtf(__uint_as_float(kb)) * 1.02f + 1.0f;
    }
    u32x4 kreg[2], vreg[2]; float creg = 0.f;
    const int srow = tid >> 3, spos = tid & 7;
    const int swz_st = (spos ^ ((srow >> 1) & 7)) << 4;
    const int swz = (lane >> 1) & 7;
    LAS unsigned* flags = (LAS unsigned*)(lds + 2 * AT_STAGE);
#define AT_LOAD(j) do { int krow0_, kidx0_; if (!meta_unit && (j) < nt - 1) { const int kt_ = nt - 2 - (j); krow0_ = b * SEQ + 64 * kt_; kidx0_ = 64 * kt_; } else { krow0_ = MX + 16 * b; kidx0_ = 8192; } \
        _Pragma("unroll") for (int i_ = 0; i_ < 2; ++i_) { \
            kreg[i_] = *(const u32x4*)(Kp + (size_t)(krow0_ + srow + 32 * i_) * 512 + h * 64 + spos * 8); \
            vreg[i_] = *(const u32x4*)(VT + (size_t)(srow + 32 * i_) * LPK + kidx0_ + spos * 8); } \
        if (TYPE == 0 && tid < 64) creg = cK[kidx0_ + tid]; } while (0)
#define AT_WRITE(s) do { _Pragma("unroll") for (int i_ = 0; i_ < 2; ++i_) { \
            *(LAS u32x4*)(lds + (s) * AT_STAGE + (srow + 32 * i_) * 128 + swz_st) = kreg[i_]; \
            *(LAS u32x4*)(lds + (s) * AT_STAGE + 8192 + (srow + 32 * i_) * 128 + swz_st) = vreg[i_]; } \
        if (TYPE == 0 && tid < 64) *(LAS float*)(lds + (s) * AT_STAGE + 16384 + tid * 4) = creg; } while (0)
    AT_LOAD(0); AT_WRITE(0);
    __syncthreads();
    for (int j = 0; j < nt; ++j) {
        const bool more = j + 1 < nt;
        if (more) AT_LOAD(j + 1);
        int klim, d0;
        if (meta_unit) { klim = 16; d0 = 0; }
        else if (j == nt - 1) { klim = 16; d0 = 1 << 20; }
        else { klim = 64; d0 = 128 * qb - 64 * (nt - 2 - j); if (d0 >= 64) d0 = 1 << 20; }
        const int limw = 32 * w + d0 - TYPE;
        bool wdone = false, nomax = false;
        if (TYPE == 0) {
            const float clast = *(const LAS float*)(lds + (j & 1) * AT_STAGE + 16384 + (klim - 1) * 4);
            wdone = __all((qbound - clast - m_run) < -126.0f) != 0;
            nomax = __all((qbound - clast) <= m_run) != 0;
        }
        if (limw + 31 >= 0 && !(TYPE == 0 && wdone)) {
            const LAS char* sb = lds + (j & 1) * AT_STAGE;
            int kmax = limw + ql; if (kmax > klim - 1) kmax = klim - 1;
            const bool needmask = (klim < 64) || (limw < 63);
            f32x16 S0, S1;
#pragma unroll
            for (int i = 0; i < 16; ++i) { S0[i] = 0.f; S1[i] = 0.f; }
#pragma unroll
            for (int ds = 0; ds < 4; ++ds) {
                const bf16x8 k0 = *(const LAS bf16x8*)(sb + ql * 128 + (((2 * ds + hi) ^ swz) << 4));
                const bf16x8 k1 = *(const LAS bf16x8*)(sb + (32 + ql) * 128 + (((2 * ds + hi) ^ swz) << 4));
                S0 = __builtin_amdgcn_mfma_f32_32x32x16_bf16(k0, qf[ds], S0, 0, 0, 0);
                S1 = __builtin_amdgcn_mfma_f32_32x32x16_bf16(k1, qf[ds], S1, 0, 0, 0);
            }
            if (TYPE == 0) {
#pragma unroll
                for (int g = 0; g < 4; ++g) {
                    const f32x4 c0 = *(const LAS f32x4*)(sb + 16384 + (8 * g + 4 * hi) * 4), c1 = *(const LAS f32x4*)(sb + 16384 + (32 + 8 * g + 4 * hi) * 4);
#pragma unroll
                    for (int i = 0; i < 4; ++i) { S0[4 * g + i] -= c0[i]; S1[4 * g + i] -= c1[i]; }
                }
                if (needmask) {
#pragma unroll
                    for (int r = 0; r < 16; ++r) { const int kl = (r & 3) + 8 * (r >> 2) + 4 * hi; if (kl > kmax) S0[r] = -INFINITY; if (kl + 32 > kmax) S1[r] = -INFINITY; }
                }
                if (!nomax) {
                    float mx = -INFINITY;
#pragma unroll
                    for (int r = 0; r < 16; ++r) mx = fmaxf(mx, fmaxf(S0[r], S1[r]));
                    mx = fmaxf(mx, __shfl_xor(mx, 32));
                    const float m_new = fmaxf(m_run, mx), alpha = ex2(m_run - m_new);
                    m_run = m_new;
                    lsum *= alpha;
#pragma unroll
                    for (int r = 0; r < 16; ++r) { O0[r] *= alpha; O1[r] *= alpha; }
                }
                float ps = 0.f;
#pragma unroll
                for (int r = 0; r < 16; ++r) { S0[r] = ex2(S0[r] - m_run); S1[r] = ex2(S1[r] - m_run); ps += S0[r] + S1[r]; }
                lsum += ps;
            } else {
                float G0[4], G1[4];
                f32x16 L0, L1;
#pragma unroll
                for (int r = 0; r < 16; ++r) {
                    const int kl = (r & 3) + 8 * (r >> 2) + 4 * hi;
                    const float z0 = S0[r], z1 = S1[r];
                    const float sp0 = fmaxf(z0, 0.f) + lg2(1.0f + ex2(-fabsf(z0) * LOG2E)) * LN2;
                    const float sp1 = fmaxf(z1, 0.f) + lg2(1.0f + ex2(-fabsf(z1) * LOG2E)) * LN2;
                    L0[r] = (!needmask || kl <= kmax) ? -sp0 : 0.f;
                    L1[r] = (!needmask || kl + 32 <= kmax) ? -sp1 : 0.f;
                }
#pragma unroll
                for (int g = 0; g < 4; ++g) {
                    L0[4 * g + 2] += L0[4 * g + 3]; L0[4 * g + 1] += L0[4 * g + 2]; L0[4 * g] += L0[4 * g + 1]; G0[g] = L0[4 * g];
                    L1[4 * g + 2] += L1[4 * g + 3]; L1[4 * g + 1] += L1[4 * g + 2]; L1[4 * g] += L1[4 * g + 1]; G1[g] = L1[4 * g];
                }
                float run = R;
#pragma unroll
                for (int g = 3; g >= 0; --g) {
                    const float gp = __shfl_xor(G1[g], 32);
                    const float off = hi ? run : run + gp;
#pragma unroll
                    for (int i = 0; i < 4; ++i) { const int r = 4 * g + i; const int kl = 32 + i + 8 * g + 4 * hi;
                        const float a = ex2((S1[r] + L1[r] + off) * LOG2E); S1[r] = (!needmask || kl <= kmax) ? a : 0.f; }
                    run += G1[g] + gp;
                }
#pragma unroll
                for (int g = 3; g >= 0; --g) {
                    const float gp = __shfl_xor(G0[g], 32);
                    const float off = hi ? run : run + gp;
#pragma unroll
                    for (int i = 0; i < 4; ++i) { const int r = 4 * g + i; const int kl = i + 8 * g + 4 * hi;
                        const float a = ex2((S0[r] + L0[r] + off) * LOG2E); S0[r] = (!needmask || kl <= kmax) ? a : 0.f; }
                    run += G0[g] + gp;
                }
                R = run;
                wdone = __all(R < -120.0f) != 0;
            }
#pragma unroll
            for (int ks = 0; ks < 4; ++ks) {
                bf16x8 pf; u32x4 pu;
                if (ks < 2) { pu = (u32x4){pk_bf16(S0[8 * ks + 0], S0[8 * ks + 1]), pk_bf16(S0[8 * ks + 2], S0[8 * ks + 3]), pk_bf16(S0[8 * ks + 4], S0[8 * ks + 5]), pk_bf16(S0[8 * ks + 6], S0[8 * ks + 7])}; }
                else { const int k2 = ks - 2; pu = (u32x4){pk_bf16(S1[8 * k2 + 0], S1[8 * k2 + 1]), pk_bf16(S1[8 * k2 + 2], S1[8 * k2 + 3]), pk_bf16(S1[8 * k2 + 4], S1[8 * k2 + 5]), pk_bf16(S1[8 * k2 + 6], S1[8 * k2 + 7])}; }
                pf = __builtin_bit_cast(bf16x8, pu);
                const bf16x8 v0 = *(const LAS bf16x8*)(sb + 8192 + ql * 128 + (((2 * ks + hi) ^ swz) << 4));
                const bf16x8 v1 = *(const LAS bf16x8*)(sb + 8192 + (32 + ql) * 128 + (((2 * ks + hi) ^ swz) << 4));
                O0 = __builtin_amdgcn_mfma_f32_32x32x16_bf16(v0, pf, O0, 0, 0, 0);
                O1 = __builtin_amdgcn_mfma_f32_32x32x16_bf16(v1, pf, O1, 0, 0, 0);
            }
        }
        if (more) AT_WRITE((j + 1) & 1);
        if (lane == 0) flags[(j & 1) * 4 + w] = wdone ? 1u : 0u;
        __syncthreads();
        { const LAS unsigned* fl = flags + (j & 1) * 4; const unsigned f = fl[0] & fl[1] & fl[2] & fl[3]; if (f) break; }
    }
    float inv = 1.0f;
    if (TYPE == 0) { const float l = lsum + __shfl_xor(lsum, 32); inv = 1.0f / l; }
    const bool qvalid = meta_unit ? (w == 0 && ql < 16) : true;
    if (qvalid) {
        bf16_t* op = Oo + (size_t)qrow * 512 + h * 64 + 4 * hi;
#pragma unroll
        for (int g = 0; g < 4; ++g) {
            *(u32x2*)(op + 8 * g) = (u32x2){pk_bf16(O0[4 * g] * inv, O0[4 * g + 1] * inv), pk_bf16(O0[4 * g + 2] * inv, O0[4 * g + 3] * inv)};
            *(u32x2*)(op + 32 + 8 * g) = (u32x2){pk_bf16(O1[4 * g] * inv, O1[4 * g + 1] * inv), pk_bf16(O1[4 * g + 2] * inv, O1[4 * g + 3] * inv)};
        }
    }
    __syncthreads();
#undef AT_LOAD
#undef AT_WRITE
}

__device__ __forceinline__ void phase2(const Params& p, LAS char* lds) {
    unsigned* ctr = (unsigned*)(p.ws + WS_CTL);
    LAS unsigned* shu = (LAS unsigned*)(lds + 2 * AT_STAGE + 64);
    constexpr int NU = 2048 + 32;
    for (;;) {
        if (threadIdx.x == 0) shu[0] = __hip_atomic_fetch_add(ctr, 1u, __ATOMIC_RELAXED, __HIP_MEMORY_SCOPE_AGENT);
        __syncthreads();
        const int u = (int)shu[0];
        __syncthreads();
        if (u >= NU) break;
        if (u < 1024) attn_unit<0>(lds, p, (u & 15) >> 3, u & 7, 63 - (u >> 4));
        else if (u < 2048) { const int v = u - 1024; attn_unit<1>(lds, p, (v & 15) >> 3, v & 7, 63 - (v >> 4)); }
        else if (u < 2064) { const int v = u - 2048; attn_unit<0>(lds, p, v >> 3, v & 7, -1); }
        else { const int v = u - 2064; attn_unit<1>(lds, p, v >> 3, v & 7, -1); }
    }
}

__device__ __forceinline__ void phase3a(const Params& p, LAS char* lds) {
    unsigned char* ws = p.ws;
    const int lane = threadIdx.x & 63, w = wave_id(), wr = w >> 1, wc = w & 1;
    const bf16_t* oa = (const bf16_t*)(ws + WS_A); const bf16_t* ob = oa + (size_t)M * 512;
    const bf16_t* ga = (const bf16_t*)(ws + WS_B); const bf16_t* gb = ga + (size_t)M * 1024;
    bf16_t* gated = (bf16_t*)(ws + WS_GATED);
    for (int it = 0;; ++it) {
        int tm, tn; int st = tile_at(it, 128, 8, tm, tn);
        if (st == 0) { if (it < (1 << 20) && (int)blockIdx.x < 8) { tm = 128; tn = blockIdx.x; it = 1 << 20; st = 1; } else break; }
        if (st == 2) continue;
        const int row0 = tm * 128, col0 = tn * 128; const int mlim = tm == 128 ? (wr == 0 ? 2 : 0) : 4;
        f32x4 acc[4][4]; zero_acc(acc);
        gemm_main<true>(lds, oa + (size_t)row0 * 512, 512, (const bf16_t*)(ws + WS_BTOF) + (size_t)col0 * 512, 512, 8, acc, mlim);
#pragma unroll
        for (int m = 0; m < 4; ++m) {
            const int row = row0 + wr * 64 + m * 16 + (lane & 15);
#pragma unroll
            for (int n = 0; n < 4; ++n) {
                const int col = col0 + wc * 64 + n * 16 + (lane >> 4) * 4;
                const u32x2 a = *(const u32x2*)(ga + (size_t)row * 1024 + col);
                const f32x4 x = acc[m][n];
                *(u32x2*)(gated + (size_t)row * 1024 + col) = (u32x2){pk_bf16(bf_lo(a[0]) * x[0], bf_hi(a[0]) * x[1]), pk_bf16(bf_lo(a[1]) * x[2], bf_hi(a[1]) * x[3])};
            }
        }
        zero_acc(acc);
        gemm_main<true>(lds, ob + (size_t)row0 * 512, 512, (const bf16_t*)(ws + WS_BTOS) + (size_t)col0 * 512, 512, 8, acc, mlim);
#pragma unroll
        for (int m = 0; m < 4; ++m) {
            const int row = row0 + wr * 64 + m * 16 + (lane & 15);
#pragma unroll
            for (int n = 0; n < 4; ++n) {
                const int col = col0 + wc * 64 + n * 16 + (lane >> 4) * 4;
                const u32x2 b = *(const u32x2*)(gb + (size_t)row * 1024 + col);
                const f32x4 y = acc[m][n]; const u32x2 q = *(const u32x2*)(gated + (size_t)row * 1024 + col);
                const float o0 = bf_lo(q[0]) + bf_lo(b[0]) * y[0], o1 = bf_hi(q[0]) + bf_hi(b[0]) * y[1];
                const float o2 = bf_lo(q[1]) + bf_lo(b[1]) * y[2], o3 = bf_hi(q[1]) + bf_hi(b[1]) * y[3];
                *(u32x2*)(gated + (size_t)row * 1024 + col) = (u32x2){pk_bf16(o0, o1), pk_bf16(o2, o3)};
            }
        }
    }
}
__device__ __forceinline__ void epi_store_ss(const f32x4 (&acc)[4][4], bf16_t* out, int ldo, int orow0, int col0, float* ssp, int ssrow0, int wr, int wc, int lane) {
#pragma unroll
    for (int m = 0; m < 4; ++m) {
        const int rl = wr * 64 + m * 16 + (lane & 15);
        float s = 0.f;
#pragma unroll
        for (int n = 0; n < 4; ++n) {
            const int col = col0 + wc * 64 + n * 16 + (lane >> 4) * 4;
            const f32x4 v = acc[m][n];
            s += v[0] * v[0] + v[1] * v[1] + v[2] * v[2] + v[3] * v[3];
            *(u32x2*)(out + (size_t)(orow0 + rl) * ldo + col) = (u32x2){pk_bf16(v[0], v[1]), pk_bf16(v[2], v[3])};
        }
#if 1
        s += __shfl_xor(s, 16); s += __shfl_xor(s, 32);
        if (lane < 16) ssp[(size_t)((col0 >> 7) * 2 + wc) * M + ssrow0 + rl] = s;
#endif
    }
}
__device__ __forceinline__ void phase3b(const Params& p, LAS char* lds) {
    unsigned char* ws = p.ws;
    const int lane = threadIdx.x & 63, w = wave_id(), wr = w >> 1, wc = w & 1;
    const bf16_t* gated = (const bf16_t*)(ws + WS_GATED); bf16_t* mixed = (bf16_t*)(ws + WS_MIXED);
    for (int it = 0;; ++it) {
        int tm, tn; int st = tile_at(it, 128, 8, tm, tn);
        if (st == 0) { if (it < (1 << 20) && (int)blockIdx.x < 8) { tm = 128; tn = blockIdx.x; it = 1 << 20; st = 1; } else break; }
        if (st == 2) continue;
        const int row0 = tm * 128, col0 = tn * 128; const int mlim = tm == 128 ? (wr == 0 ? 2 : 0) : 4;
        f32x4 acc[4][4]; zero_acc(acc);
        gemm_main<true>(lds, gated + (size_t)row0 * 1024, 1024, (const bf16_t*)(ws + WS_BTOUT) + (size_t)col0 * 1024, 1024, 16, acc, mlim);
        epi_store_ss(acc, mixed, 1024, row0, col0, (float*)(ws + WS_SSP2), row0, wr, wc, lane);
    }
}
__device__ __forceinline__ void phase3c(const Params& p) {
    unsigned char* ws = p.ws;
    const int lane = threadIdx.x & 63, w = wave_id();
    const bf16_t* mixed = (const bf16_t*)(ws + WS_MIXED); bf16_t* hb = (bf16_t*)(ws + WS_A);
    const float* ssp2 = (const float*)(ws + WS_SSP2); float* r2 = (float*)(ws + WS_R2);
    const float* g1 = p.gains + D;
    f32x4 g[4];
#pragma unroll
    for (int i = 0; i < 4; ++i) g[i] = *(const f32x4*)(g1 + lane * 4 + 256 * i);
    for (int grp = blockIdx.x; grp * 32 < MV; grp += gridDim.x) {
#pragma unroll 1
        for (int k = 0; k < 8; k += 2) {
            int r[2]; bool ok[2]; f32x4 v[2][4]; u32x2 mx[2][4]; float sq[2];
#pragma unroll
            for (int j = 0; j < 2; ++j) {
                r[j] = grp * 32 + w + 4 * (k + j); ok[j] = r[j] < MV; const int rr = ok[j] ? r[j] : 0;
                const float* src = rr < MX ? p.x + (size_t)rr * D : p.meta + (size_t)((rr - MX) & 15) * D;
                sq[j] = lane < 16 ? ssp2[(size_t)lane * M + rr] : 0.f;
#pragma unroll
                for (int i = 0; i < 4; ++i) { v[j][i] = *(const f32x4*)(src + lane * 4 + 256 * i); mx[j][i] = *(const u32x2*)(mixed + (size_t)rr * D + lane * 4 + 256 * i); }
            }
#pragma unroll
            for (int j = 0; j < 2; ++j) {
                const float a = 1.0f / sqrtf(wave_sum(sq[j]) * (1.0f / D) + EPS);
                float ss = 0.f;
#pragma unroll
                for (int i = 0; i < 4; ++i) {
                    const int col = lane * 4 + 256 * i;
                    f32x4 hh;
                    hh[0] = v[j][i][0] + bf_lo(mx[j][i][0]) * a * g[i][0]; hh[1] = v[j][i][1] + bf_hi(mx[j][i][0]) * a * g[i][1];
                    hh[2] = v[j][i][2] + bf_lo(mx[j][i][1]) * a * g[i][2]; hh[3] = v[j][i][3] + bf_hi(mx[j][i][1]) * a * g[i][3];
                    ss += hh[0] * hh[0] + hh[1] * hh[1] + hh[2] * hh[2] + hh[3] * hh[3];
                    if (ok[j]) {
                        *(u32x2*)(hb + (size_t)r[j] * D + col) = (u32x2){pk_bf16(hh[0], hh[1]), pk_bf16(hh[2], hh[3])};
                        if (r[j] < MX) *(f32x4*)(p.out + (size_t)r[j] * D + col) = hh;
                    }
                }
                ss = wave_sum(ss);
                if (ok[j] && lane == 0) r2[r[j]] = 1.0f / sqrtf(ss * (1.0f / D) + EPS);
            }
        }
    }
}
constexpr int UST = 272;
__device__ __forceinline__ f32x4 unpack4(const u32x2 u) { return (f32x4){bf_lo(u[0]), bf_hi(u[0]), bf_lo(u[1]), bf_hi(u[1])}; }
struct ConvW { f32x4 w0g, w1g, w2g, bg, w0v, w1v, w2v, bv; };
__device__ __forceinline__ ConvW load_convw(const Params& p, int c) {
    ConvW q;
    q.w0g = *(const f32x4*)(p.conv_w + c); q.w1g = *(const f32x4*)(p.conv_w + NUP + c); q.w2g = *(const f32x4*)(p.conv_w + 2 * NUP + c); q.bg = *(const f32x4*)(p.conv_b + c);
    q.w0v = *(const f32x4*)(p.conv_w + DFF + c); q.w1v = *(const f32x4*)(p.conv_w + NUP + DFF + c); q.w2v = *(const f32x4*)(p.conv_w + 2 * NUP + DFF + c); q.bv = *(const f32x4*)(p.conv_b + DFF + c);
    return q;
}
__device__ __forceinline__ u32x2 conv_gelu4(const ConvW& q, const f32x4 g2, const f32x4 g1, const f32x4 g0, const f32x4 v2, const f32x4 v1, const f32x4 v0) {
    float o[4];
#pragma unroll
    for (int e = 0; e < 4; ++e) {
        const float ug = q.bg[e] + q.w0g[e] * g2[e] + q.w1g[e] * g1[e] + q.w2g[e] * g0[e];
        const float uv = q.bv[e] + q.w0v[e] * v2[e] + q.w1v[e] * v1[e] + q.w2v[e] * v0[e];
        const float t = 0.7978845608028654f * (ug + 0.044715f * ug * ug * ug);
        o[e] = ug * rcp(1.0f + ex2(-2.0f * LOG2E * t)) * uv;
    }
    return (u32x2){pk_bf16(o[0], o[1]), pk_bf16(o[2], o[3])};
}
__device__ __forceinline__ void phase4(const Params& p, LAS char* lds) {
    unsigned char* ws = p.ws;
    const int tid = threadIdx.x, lane = tid & 63, w = wave_id(), wr = w >> 1, wc = w & 1;
    const bf16_t* hb = (const bf16_t*)(ws + WS_A); const bf16_t* Bt = (const bf16_t*)(ws + WS_BTUP);
    const float* r2 = (const float*)(ws + WS_R2);
    bf16_t* act = (bf16_t*)(ws + WS_ACT); bf16_t* hal = (bf16_t*)(ws + WS_HAL);
    for (int it = 0;; ++it) {
        int tm, tn; int st = tile_at(it, 128, 44, tm, tn);
        if (st == 0) { if (it < (1 << 20) && (int)blockIdx.x < 44) { tm = 128; tn = blockIdx.x; it = 1 << 20; st = 1; } else break; }
        if (st == 2) continue;
        const bool mt = tm == 128; const int row0 = mt ? MX : tm * 128, col0 = tn * 128;
        f32x4 acc[4][4]; zero_acc(acc);
        gemm_main<true>(lds, hb + (size_t)row0 * D, D, Bt + (size_t)col0 * D, D, 16, acc, mt ? (wr == 0 ? 2 : 0) : 4);
#pragma unroll
        for (int m = 0; m < 4; ++m) {
            const int rl = wr * 64 + m * 16 + (lane & 15); const float rs = r2[row0 + rl];
#pragma unroll
            for (int n = 0; n < 4; ++n) {
                const int cl = wc * 64 + n * 16 + (lane >> 4) * 4; const f32x4 v = acc[m][n] * rs;
                *(LAS u32x2*)(lds + rl * UST + cl * 2) = (u32x2){pk_bf16(v[0], v[1]), pk_bf16(v[2], v[3])};
            }
        }
        __syncthreads();
        if (!mt) {
            const int cg = tid & 15, rb = tid >> 4, c = tn * 64 + cg * 4;
            const ConvW q = load_convw(p, c);
            const int hr = rb == 0 ? 0 : rb * 8 - 2;
            f32x4 g2 = unpack4(*(const LAS u32x2*)(lds + hr * UST + cg * 8)), v2 = unpack4(*(const LAS u32x2*)(lds + hr * UST + 128 + cg * 8));
            f32x4 g1 = unpack4(*(const LAS u32x2*)(lds + (hr + 1) * UST + cg * 8)), v1 = unpack4(*(const LAS u32x2*)(lds + (hr + 1) * UST + 128 + cg * 8));
            for (int r = hr + 2; r < rb * 8 + 8; ++r) {
                const f32x4 g0 = unpack4(*(const LAS u32x2*)(lds + r * UST + cg * 8)), v0 = unpack4(*(const LAS u32x2*)(lds + r * UST + 128 + cg * 8));
                *(u32x2*)(act + (size_t)(row0 + r) * DFF + c) = conv_gelu4(q, g2, g1, g0, v2, v1, v0);
                g2 = g1; g1 = g0; v2 = v1; v1 = v0;
            }
            if (tid < 64) { const int qq = tid >> 4, ch = tid & 15, rl = qq < 2 ? qq : 124 + qq;
                *(u32x4*)(hal + ((size_t)tm * 4 + qq) * NUP + col0 + ch * 8) = *(const LAS u32x4*)(lds + rl * UST + ch * 16); }
        } else {
            if (tid < 64) { const int qq = tid >> 4, ch = tid & 15, rl = (qq >> 1) * 16 + 14 + (qq & 1);
                *(u32x4*)(hal + ((size_t)(128 + (qq >> 1)) * 4 + 2 + (qq & 1)) * NUP + col0 + ch * 8) = *(const LAS u32x4*)(lds + rl * UST + ch * 16); }
        }
        __syncthreads();
    }
}
__device__ __forceinline__ void phase_fix(const Params& p) {
    unsigned char* ws = p.ws;
    const bf16_t* hal = (const bf16_t*)(ws + WS_HAL); bf16_t* act = (bf16_t*)(ws + WS_ACT);
    constexpr int NCG = DFF / 4;
    for (int it = blockIdx.x * NTHREADS + threadIdx.x; it < 128 * NCG; it += gridDim.x * NTHREADS) {
        const int tmg = it / NCG, c = (it % NCG) * 4, colg = (c >> 6) * 128 + (c & 63), colv = colg + 64;
        const bf16_t* own = hal + (size_t)tmg * 4 * NUP;
        const bf16_t* prv = hal + (size_t)((tmg & 63) ? tmg - 1 : 128 + (tmg >> 6)) * 4 * NUP;
        const ConvW q = load_convw(p, c);
        const f32x4 pg2 = unpack4(*(const u32x2*)(prv + 2 * NUP + colg)), pv2 = unpack4(*(const u32x2*)(prv + 2 * NUP + colv));
        const f32x4 pg3 = unpack4(*(const u32x2*)(prv + 3 * NUP + colg)), pv3 = unpack4(*(const u32x2*)(prv + 3 * NUP + colv));
        const f32x4 og0 = unpack4(*(const u32x2*)(own + colg)), ov0 = unpack4(*(const u32x2*)(own + colv));
        const f32x4 og1 = unpack4(*(const u32x2*)(own + NUP + colg)), ov1 = unpack4(*(const u32x2*)(own + NUP + colv));
        *(u32x2*)(act + (size_t)(tmg * 128) * DFF + c) = conv_gelu4(q, pg2, pg3, og0, pv2, pv3, ov0);
        *(u32x2*)(act + (size_t)(tmg * 128 + 1) * DFF + c) = conv_gelu4(q, pg3, og0, og1, pv3, ov0, ov1);
    }
}
__device__ __forceinline__ void phase6(const Params& p, LAS char* lds) {
    unsigned char* ws = p.ws;
    const int lane = threadIdx.x & 63, w = wave_id(), wr = w >> 1, wc = w & 1;
    const bf16_t* act = (const bf16_t*)(ws + WS_ACT); bf16_t* ffn = (bf16_t*)(ws + WS_FFN);
    for (int it = 0;; ++it) {
        int tm, tn; const int st = tile_at(it, 128, 8, tm, tn); if (st == 0) break; if (st == 2) continue;
        const int col0 = tn * 128;
        f32x4 acc[4][4]; zero_acc(acc);
        gemm_main<true>(lds, act + (size_t)(tm * 128) * DFF, DFF, (const bf16_t*)(ws + WS_BTDN) + (size_t)col0 * DFF, DFF, 44, acc);
        epi_store_ss(acc, ffn, 1024, tm * 128, col0, (float*)(ws + WS_SSP4), tm * 128, wr, wc, lane);
    }
}
__device__ __forceinline__ void phase7(const Params& p) {
    unsigned char* ws = p.ws;
    const int lane = threadIdx.x & 63, w = wave_id();
    const bf16_t* ffn = (const bf16_t*)(ws + WS_FFN); const float* ssp4 = (const float*)(ws + WS_SSP4); const float* g3 = p.gains + 3 * D;
    f32x4 g[4];
#pragma unroll
    for (int i = 0; i < 4; ++i) g[i] = *(const f32x4*)(g3 + lane * 4 + 256 * i);
    for (int r0 = (blockIdx.x * 4 + w) * 2; r0 < MX; r0 += gridDim.x * 8) {
        f32x4 hh[2][4]; u32x2 f[2][4]; float sq[2];
#pragma unroll
        for (int j = 0; j < 2; ++j) {
            const int row = r0 + j;
            sq[j] = lane < 16 ? ssp4[(size_t)lane * M + row] : 0.f;
#pragma unroll
            for (int i = 0; i < 4; ++i) { hh[j][i] = *(const f32x4*)(p.out + (size_t)row * D + lane * 4 + 256 * i); f[j][i] = *(const u32x2*)(ffn + (size_t)row * D + lane * 4 + 256 * i); }
        }
#pragma unroll
        for (int j = 0; j < 2; ++j) {
            const float a = 1.0f / sqrtf(wave_sum(sq[j]) * (1.0f / D) + EPS);
#pragma unroll
            for (int i = 0; i < 4; ++i) {
                f32x4 o;
                o[0] = hh[j][i][0] + bf_lo(f[j][i][0]) * a * g[i][0]; o[1] = hh[j][i][1] + bf_hi(f[j][i][0]) * a * g[i][1];
                o[2] = hh[j][i][2] + bf_lo(f[j][i][1]) * a * g[i][2]; o[3] = hh[j][i][3] + bf_hi(f[j][i][1]) * a * g[i][3];
                *(f32x4*)(p.out + (size_t)(r0 + j) * D + lane * 4 + 256 * i) = o;
            }
        }
    }
}


#ifndef DUMP
#define DUMP 0
#endif
__device__ __forceinline__ void phase_dump(const Params& p) {
    unsigned char* ws = p.ws;
    const bf16_t* s0; const bf16_t* s1; int ld;
    if (DUMP == 1) { s0 = (const bf16_t*)(ws + WS_B); s1 = s0 + 512; ld = 1024; }
    else if (DUMP == 2) { s0 = (const bf16_t*)(ws + WS_QF); s1 = (const bf16_t*)(ws + WS_KF); ld = 512; }
    else if (DUMP == 3) { s0 = (const bf16_t*)(ws + WS_A); s1 = s0 + (size_t)M * 512; ld = 512; }
    else if (DUMP == 4) { s0 = (const bf16_t*)(ws + WS_GATED); s1 = s0 + 512; ld = 1024; }
    else if (DUMP == 8) { s0 = (const bf16_t*)(ws + WS_A); s1 = s0 + 512; ld = 1024; }
    else if (DUMP == 9) { s0 = (const bf16_t*)(ws + WS_ACT) + 1024; s1 = (const bf16_t*)(ws + WS_ACT) + 2304 - 512 + 512; ld = DFF; }
    else if (DUMP == 10) { s0 = (const bf16_t*)(ws + WS_FFN); s1 = s0 + 512; ld = 1024; }
    else if (DUMP == 6) { s0 = (const bf16_t*)(ws + WS_QS); s1 = (const bf16_t*)(ws + WS_KS); ld = 512; }
    else { s0 = (const bf16_t*)(ws + WS_MIXED); s1 = s0 + 512; ld = 1024; }
    for (int it = blockIdx.x * NTHREADS + threadIdx.x; it < MX * 1024; it += gridDim.x * NTHREADS) {
        const int row = it >> 10, col = it & 1023;
        if (DUMP >= 9 && row >= 8192) { p.out[it] = 0.f; continue; }
        const bf16_t v = col < 512 ? s0[(size_t)row * ld + col] : s1[(size_t)row * ld + col - 512];
        p.out[it] = __uint_as_float((unsigned)v << 16);
    }
}

__device__ __forceinline__ void l2_scrub(const Params& p) {
    const f32x4* src = (const f32x4*)p.x + (size_t)(blockIdx.x & 511) * 8192;
    f32x4 a = (f32x4){0.f, 0.f, 0.f, 0.f};
    for (int i = threadIdx.x; i < 8192; i += NTHREADS) a += src[i];
    if (a[0] + a[1] + a[2] + a[3] == 1.2345e-30f) ((float*)(p.ws + WS_CTL))[32 + (threadIdx.x & 7)] = a[0];
}


#define XB_TMO      128
#define XB_XCNT(j)  (256  + 64 * (j))
#define XB_XSUB(j)  (1280 + 64 * (j))
#define XB_XGEN(j)  (2304 + 64 * (j))
#define XB_TOP      3328
#define XB_TOPGEN   3392
#define XCD_BAR_WORDS 3456
#define XB_SPIN_CAP (1u << 18)
__device__ __forceinline__ unsigned xb_ld(unsigned* p)              { return __hip_atomic_load(p, __ATOMIC_RELAXED, __HIP_MEMORY_SCOPE_AGENT); }
__device__ __forceinline__ unsigned xb_add(unsigned* p, unsigned v) { return __hip_atomic_fetch_add(p, v, __ATOMIC_RELAXED, __HIP_MEMORY_SCOPE_AGENT); }
__device__ __forceinline__ unsigned xb_xcc_id() { return (unsigned)__builtin_amdgcn_s_getreg((3 << 11) | 20) & 0xFu; }
#define XB_SPIN(cond, bar) do { unsigned _sp = 0; while (cond) { __builtin_amdgcn_s_sleep(1); \
    if ((++_sp & 255u) == 0u) { if (xb_ld(&(bar)[XB_TMO])) break; if (_sp > XB_SPIN_CAP) { atomicAdd(&(bar)[XB_TMO], 1u); break; } } } } while (0)
struct XcdBarrier { unsigned* bar; unsigned x; volatile LAS unsigned* st; };
__device__ __forceinline__ XcdBarrier xcd_barrier_post(unsigned* bar, volatile LAS unsigned* st) {
    XcdBarrier b; b.bar = bar; b.x = xb_xcc_id(); b.st = st;
    if (threadIdx.x == 0) (void)xb_add(&bar[XB_XCNT(b.x)], 1u);
    return b;
}
__device__ __forceinline__ void xcd_barrier_complete(unsigned* bar, unsigned x, unsigned& nloc, unsigned& nx) {
    const unsigned G = gridDim.x * gridDim.y * gridDim.z;
    unsigned sum, cnt, mine, sp = 0u;
    for (;;) {
        sum = 0u; cnt = 0u; mine = 0u;
#pragma unroll
        for (unsigned j = 0; j < 16; ++j) { const unsigned c = xb_ld(&bar[XB_XCNT(j)]); sum += c; cnt += (c > 0u) ? 1u : 0u; mine = (j == x) ? c : mine; }
        if (sum == G) break;
        __builtin_amdgcn_s_sleep(1);
        if ((++sp & 255u) == 0u) { if (xb_ld(&bar[XB_TMO])) break; if (sp > XB_SPIN_CAP) { atomicAdd(&bar[XB_TMO], 1u); break; } }
    }
    nloc = mine > 0u ? mine : 1u; nx = cnt > 0u ? cnt : 1u;
}
__device__ __forceinline__ void xcd_barrier(const XcdBarrier& b) {
    asm volatile("s_waitcnt vmcnt(0)" ::: "memory");
    __syncthreads();
    if (threadIdx.x == 0) {
        unsigned* bar = b.bar;
        __builtin_amdgcn_s_waitcnt(0);
        unsigned nloc = b.st[0], nx = b.st[1];
        if (nloc == 0u) { xcd_barrier_complete(bar, b.x, nloc, nx); b.st[0] = nloc; b.st[1] = nx; }
        const unsigned old = xb_add(&bar[XB_XSUB(b.x)], 1u);
        const unsigned gen = old / nloc;
        if (old + 1u == (gen + 1u) * nloc) {
            __builtin_amdgcn_fence(__ATOMIC_RELEASE, "agent");
            asm volatile("s_waitcnt vmcnt(0)" ::: "memory");
            const unsigned og = xb_add(&bar[XB_TOP], 1u);
            const unsigned tg = og / nx;
            if (og + 1u == (tg + 1u) * nx) xb_add(&bar[XB_TOPGEN], 1u);
            else XB_SPIN(xb_ld(&bar[XB_TOPGEN]) == tg, bar);
            __builtin_amdgcn_fence(__ATOMIC_ACQUIRE, "agent");
            xb_add(&bar[XB_XGEN(b.x)], 1u);
            asm volatile("s_waitcnt vmcnt(0)" ::: "memory");
        } else {
            XB_SPIN(xb_ld(&bar[XB_XGEN(b.x)]) == gen, bar);
            __builtin_amdgcn_fence(__ATOMIC_ACQUIRE, "agent");
            asm volatile("s_waitcnt vmcnt(0)" ::: "memory");
        }
    }
    __syncthreads();
}

__device__ __forceinline__ void my_grid_sync(const Params& p, unsigned& target) {
    unsigned* bar = (unsigned*)(p.ws + WS_CTL) + 16;
    asm volatile("s_waitcnt vmcnt(0)" ::: "memory");
    __syncthreads();
    target += gridDim.x;
    if (threadIdx.x == 0) {
        __builtin_amdgcn_fence(__ATOMIC_RELEASE, "agent");
        asm volatile("s_waitcnt vmcnt(0)" ::: "memory");
        __hip_atomic_fetch_add(bar, 1u, __ATOMIC_RELAXED, __HIP_MEMORY_SCOPE_AGENT);
        while (__hip_atomic_load(bar, __ATOMIC_RELAXED, __HIP_MEMORY_SCOPE_AGENT) < target) __builtin_amdgcn_s_sleep(2);
        __builtin_amdgcn_fence(__ATOMIC_ACQUIRE, "agent");
        asm volatile("s_waitcnt vmcnt(0)" ::: "memory");
    }
    __syncthreads();
}
__global__ void __launch_bounds__(NTHREADS, 2) fwd_kernel(Params p) {
    extern __shared__ __attribute__((aligned(16))) unsigned char lds_raw[];
    LAS char* lds = (LAS char*)lds_raw;
    cg::grid_group grid = cg::this_grid();
#define IN(k) (p.ph_lo <= (k) && (k) < p.ph_hi)
#define SEAM(k) do { if (IN(k) && IN((k) + 1)) { if (p.ph_hi > 1000) grid.sync(); xcd_barrier(xbar); } } while (0)
    volatile LAS unsigned* xst = (volatile LAS unsigned*)(lds + 65536);
    if (threadIdx.x < 4) xst[threadIdx.x] = 0u;
    __syncthreads();
    const XcdBarrier xbar = xcd_barrier_post((unsigned*)(p.ws + WS_XBAR), xst);
    if (IN(0)) phase0(p, lds);
    SEAM(0);
    if (IN(1)) phase1(p, lds);
    SEAM(1);
    if (IN(2)) phase2(p, lds);
    SEAM(2);
    if (IN(3)) phase3a(p, lds);
    SEAM(3);
    if (IN(4)) phase3b(p, lds);
    SEAM(4);
    if (IN(5)) phase3c(p);
    SEAM(5);
    if (IN(6)) phase4(p, lds);
    SEAM(6);
    if (IN(7)) phase_fix(p);
    SEAM(7);
    if (IN(8)) phase6(p, lds);
    SEAM(8);
    if (IN(9)) phase7(p);
#undef IN
#undef SEAM
}


__global__ void ab_save(const unsigned char* ws, float* out) {
    const u32x4* src = (const u32x4*)(ws + AB_SRC); u32x4* dst = (u32x4*)((unsigned char*)out + (size_t)32 * MiB);
    for (size_t i = blockIdx.x * (size_t)blockDim.x + threadIdx.x; i < (size_t)AB_BYTES / 16; i += (size_t)gridDim.x * blockDim.x) dst[i] = src[i];
}
__global__ void ab_diff(const unsigned char* ws, float* out) {
    const bf16_t* src = (const bf16_t*)(ws + AB_SRC); const bf16_t* sav = (const bf16_t*)((unsigned char*)out + (size_t)32 * MiB);
    for (size_t i = blockIdx.x * (size_t)blockDim.x + threadIdx.x; i < (size_t)8192 * 1024; i += (size_t)gridDim.x * blockDim.x) {
        if (i >= (size_t)AB_BYTES / 2) { out[i] = 0.f; continue; }
        out[i] = src[i] != sav[i] ? 1000.0f : 0.f;
    }
}
__global__ void ab_zero(float* out) {
    for (size_t i = blockIdx.x * (size_t)blockDim.x + threadIdx.x; i < (size_t)8192 * 1024; i += (size_t)gridDim.x * blockDim.x) out[(size_t)8192 * 1024 + i] = 0.f;
}
extern "C" void kernel_launch(void* const* d_in, const int* in_sizes, int n_in, void* d_out, int out_size, void* d_ws, size_t ws_size, hipStream_t stream) {
    static int grid_blocks = 0;
    if (grid_blocks == 0) {
        if (n_in != 12 || ws_size < WS_END) { fprintf(stderr, "kernel_launch: unexpected n_in %d or ws_size %zu (need %zu)\n", n_in, ws_size, (size_t)WS_END); grid_blocks = -1; return; }
        int dev = 0, cus = 0, per_cu = 0;
        (void)hipGetDevice(&dev);
        (void)hipDeviceGetAttribute(&cus, hipDeviceAttributeMultiprocessorCount, dev);
        (void)hipFuncSetAttribute((const void*)fwd_kernel, hipFuncAttributeMaxDynamicSharedMemorySize, LDS_BYTES);
        (void)hipOccupancyMaxActiveBlocksPerMultiprocessor(&per_cu, (const void*)fwd_kernel, NTHREADS, LDS_BYTES);
        if (per_cu < 1) per_cu = 1;
        if (per_cu > 2) per_cu = 2;
        grid_blocks = cus * per_cu;
        (void)hipGetLastError();
    }
    if (grid_blocks < 0) return;
    Params p{};
    p.x = (const float*)d_in[0]; p.meta = (const float*)d_in[1]; p.gains = (const float*)d_in[2]; p.w_in = (const float*)d_in[3];
    p.b_forget = (const float*)d_in[4]; p.w_o_fox = (const float*)d_in[5]; p.w_o_sb = (const float*)d_in[6]; p.w_out = (const float*)d_in[7];
    p.w_up = (const float*)d_in[8]; p.conv_w = (const float*)d_in[9]; p.conv_b = (const float*)d_in[10]; p.w_down = (const float*)d_in[11];
    p.out = (float*)d_out; p.ws = (unsigned char*)d_ws;
#if SINGLE_LAUNCH
    (void)hipMemsetAsync((unsigned char*)d_ws + WS_CTL, 0, 256, stream);
    (void)hipMemsetAsync((unsigned char*)d_ws + WS_XBAR, 0, XCD_BAR_WORDS * 4, stream);
    p.ph_lo = 0; p.ph_hi = NPHASE;
    void* args[] = {&p};
    hipError_t e = hipLaunchCooperativeKernel((const void*)fwd_kernel, dim3(grid_blocks), dim3(NTHREADS), args, LDS_BYTES, stream);
    if (e != hipSuccess) fprintf(stderr, "cooperative launch failed: %s (grid %d)\n", hipGetErrorString(e), grid_blocks);
#else
#ifndef STOP_AT
#define STOP_AT NPHASE
#endif
    for (int k = 0; k < STOP_AT; ++k) {
        p.ph_lo = k; p.ph_hi = k + 1;
        hipLaunchKernelGGL(fwd_kernel, dim3(grid_blocks), dim3(NTHREADS), LDS_BYTES, stream, p);
    }
#if ABTEST
    ab_save<<<1024, 256, 0, stream>>>(p.ws, p.out);
    for (int k = AB_FROM; k < STOP_AT; ++k) {
        p.ph_lo = k; p.ph_hi = k + 1;
        hipLaunchKernelGGL(fwd_kernel, dim3(grid_blocks), dim3(NTHREADS), LDS_BYTES, stream, p);
    }
    ab_diff<<<1024, 256, 0, stream>>>(p.ws, p.out);
    ab_zero<<<1024, 256, 0, stream>>>(p.out);
#endif

#endif
}
```

```cpp
#include <hip/hip_runtime.h>
#include <hip/hip_cooperative_groups.h>
#include <cstdio>
#include <cstdint>
namespace cg = cooperative_groups;

#define DUMP 0
#define ABTEST 0
#define AB_FROM 0
#define AB_SRC WS_SSP2
#define AB_BYTES (2 * MiB)
#ifndef SINGLE_LAUNCH
#define SINGLE_LAUNCH 1
#endif

#define LAS __attribute__((address_space(3)))
typedef unsigned short bf16_t;
typedef short bf16x8 __attribute__((ext_vector_type(8)));
typedef float f32x4 __attribute__((ext_vector_type(4)));
typedef float f32x16 __attribute__((ext_vector_type(16)));
typedef unsigned u32x4 __attribute__((ext_vector_type(4)));
typedef unsigned u32x2 __attribute__((ext_vector_type(2)));

constexpr int D = 1024, SEQ = 8192, NMETA = 16, NB = 2;
constexpr int MX = NB * SEQ;
constexpr int MV = MX + NB * NMETA;
constexpr int M = 16512;
constexpr int LPK = 8256;
constexpr int PROJW = 5128, NPROJ = 5120, DFF = 2816, NUP = 5632;
constexpr float EPS = 1e-6f;
constexpr float LOG2E = 1.4426950408889634f, LN2 = 0.6931471805599453f;
constexpr int NTHREADS = 256;
constexpr int LDS_BYTES = 65536 + 16;
constexpr int NPHASE = 11;

constexpr size_t MiB = 1u << 20;
constexpr size_t WS_CTL = 0;
constexpr size_t WS_R1 = 4096, WS_R2 = WS_R1 + 69632, WS_SS2 = WS_R2 + 69632, WS_SS4 = WS_SS2 + 69632;
constexpr size_t WS_LOGF = WS_SS4 + 69632, WS_CK = WS_LOGF + 528384, WS_UPMETA = WS_CK + 528384;
constexpr size_t WS_BTIN = 2 * MiB, WS_BTOF = WS_BTIN + 10 * MiB, WS_BTOS = WS_BTOF + 1 * MiB, WS_BTOUT = WS_BTOS + 1 * MiB,
                 WS_BTUP = WS_BTOUT + 2 * MiB, WS_BTDN = WS_BTUP + 11 * MiB;
constexpr size_t SZ_M1024 = (size_t)M * 1024 * 2, SZ_M512 = (size_t)M * 512 * 2;
constexpr size_t WS_A = 33 * MiB;
constexpr size_t WS_B = WS_A + SZ_M1024;
constexpr size_t WS_C = WS_B + 2 * SZ_M1024;
constexpr size_t WS_QF = WS_C, WS_KF = WS_QF + SZ_M512, WS_QS = WS_KF + SZ_M512, WS_KS = WS_QS + SZ_M512, WS_VFT = WS_KS + SZ_M512, WS_VST = WS_VFT + SZ_M512;
constexpr size_t WS_GATED = WS_C, WS_MIXED = WS_B + SZ_M1024;
constexpr size_t WS_ACT = WS_B;
constexpr size_t WS_FFN = WS_ACT + 132 * MiB;
constexpr size_t WS_SSP2 = 230 * MiB, WS_SSP4 = 232 * MiB;
constexpr size_t WS_HAL = 234 * MiB;
constexpr size_t WS_XBAR = 240 * MiB;
constexpr size_t WS_END = 241 * MiB;

struct Params {
    const float *x, *meta, *gains, *w_in, *b_forget, *w_o_fox, *w_o_sb, *w_out, *w_up, *conv_w, *conv_b, *w_down;
    float* out; unsigned char* ws; int ph_lo, ph_hi;
};

typedef __bf16 bf16x2_t __attribute__((ext_vector_type(2)));
__device__ __forceinline__ unsigned pk_bf16(float lo, float hi) { bf16x2_t v = {(__bf16)lo, (__bf16)hi}; return __builtin_bit_cast(unsigned, v); }
__device__ __forceinline__ float bf_lo(unsigned u) { return __uint_as_float(u << 16); }
__device__ __forceinline__ float bf_hi(unsigned u) { return __uint_as_float(u & 0xffff0000u); }
__device__ __forceinline__ float ex2(float x) { return __builtin_amdgcn_exp2f(x); }
__device__ __forceinline__ float lg2(float x) { return __builtin_amdgcn_logf(x); }
__device__ __forceinline__ float rcp(float x) { return __builtin_amdgcn_rcpf(x); }
__device__ __forceinline__ float sigmoidf_(float v) { return rcp(1.0f + ex2(-v * LOG2E)); }
__device__ __forceinline__ float wave_sum(float v) {
#pragma unroll
    for (int o = 32; o > 0; o >>= 1) v += __shfl_xor(v, o);
    return v;
}
__device__ __forceinline__ int wave_id() { return __builtin_amdgcn_readfirstlane((int)(threadIdx.x >> 6)); }

__device__ __forceinline__ void transpose_tile(LAS char* lds, const float* src, int ldsrc, int srccol, int k0, const float* gain, bf16_t* dst, int K, int n0) {
    LAS bf16_t* T = (LAS bf16_t*)lds;
    const int tid = threadIdx.x, r = tid >> 4, c4 = tid & 15;
#pragma unroll
    for (int p = 0; p < 4; ++p) {
        const int k = r + 16 * p;
        f32x4 v = *(const f32x4*)(src + (size_t)(k0 + k) * ldsrc + srccol + c4 * 4);
        const float g = gain ? gain[k0 + k] : 1.0f;
        const unsigned a = pk_bf16(v[0] * g, v[1] * g), b = pk_bf16(v[2] * g, v[3] * g);
        T[(c4 * 4 + 0) * 72 + k] = (bf16_t)(a & 0xffff); T[(c4 * 4 + 1) * 72 + k] = (bf16_t)(a >> 16);
        T[(c4 * 4 + 2) * 72 + k] = (bf16_t)(b & 0xffff); T[(c4 * 4 + 3) * 72 + k] = (bf16_t)(b >> 16);
    }
    __syncthreads();
    const int n = tid >> 2, kq = tid & 3;
    const u32x4 lo = *(LAS u32x4*)(T + n * 72 + kq * 16), hi = *(LAS u32x4*)(T + n * 72 + kq * 16 + 8);
    bf16_t* d = dst + (size_t)(n0 + n) * K + k0 + kq * 16;
    *(u32x4*)d = lo; *(u32x4*)(d + 8) = hi;
    __syncthreads();
}

__device__ __forceinline__ void phase0(const Params& p, LAS char* lds) {
    unsigned char* ws = p.ws;
    const int tid = threadIdx.x, lane = tid & 63, w = wave_id();
    LAS float* wfT = (LAS float*)lds;
    const float* g0 = p.gains;
    for (int idx = tid; idx < 8192; idx += NTHREADS) { const int h = idx & 7, k = idx >> 3; wfT[h * 1024 + k] = p.w_in[(size_t)k * PROJW + 1536 + h] * g0[k]; }
    __syncthreads();
    bf16_t* xb = (bf16_t*)(ws + WS_A);
    float* r1 = (float*)(ws + WS_R1);
    float* logf_ = (float*)(ws + WS_LOGF);
    for (int r_ = blockIdx.x * 32 + w; r_ < M; r_ += (r_ & 31) < 28 ? 4 : gridDim.x * 32 - 28) {
        const int r = r_;
        if (r >= MV) {
#pragma unroll
            for (int i = 0; i < 4; ++i) *(u32x2*)(xb + (size_t)r * D + lane * 4 + 256 * i) = (u32x2){0u, 0u};
            if (lane == 0) r1[r] = 0.f;
            continue;
        }
        const float* src = r < MX ? p.x + (size_t)r * D : p.meta + (size_t)((r - MX) & 15) * D;
        f32x4 v[4]; float ss = 0.f;
#pragma unroll
        for (int i = 0; i < 4; ++i) { v[i] = *(const f32x4*)(src + lane * 4 + 256 * i); ss += v[i][0] * v[i][0] + v[i][1] * v[i][1] + v[i][2] * v[i][2] + v[i][3] * v[i][3]; }
#pragma unroll
        for (int i = 0; i < 4; ++i) *(u32x2*)(xb + (size_t)r * D + lane * 4 + 256 * i) = (u32x2){pk_bf16(v[i][0], v[i][1]), pk_bf16(v[i][2], v[i][3])};
        ss = wave_sum(ss);
        const float rs = 1.0f / sqrtf(ss * (1.0f / D) + EPS);
        if (lane == 0) r1[r] = rs;
        float mine = 0.f;
#pragma unroll
        for (int h = 0; h < 8; ++h) {
            float a = 0.f;
#pragma unroll
            for (int i = 0; i < 4; ++i) { const f32x4 wv = *(LAS f32x4*)(wfT + h * 1024 + lane * 4 + 256 * i); a += v[i][0] * wv[0] + v[i][1] * wv[1] + v[i][2] * wv[2] + v[i][3] * wv[3]; }
            a = wave_sum(a);
            if (lane == h) mine = a;
        }
        if (lane < 8) {
            const float f = mine * rs + p.b_forget[lane];
            const float lf = fminf(f, 0.f) - log1pf(expf(-fabsf(f)));
            int b, kidx; if (r < MX) { b = r >> 13; kidx = r & 8191; } else { const int j = r - MX; b = j >> 4; kidx = 8192 + (j & 15); }
            logf_[(size_t)(b * 8 + lane) * LPK + kidx] = lf;
        }
    }
    __syncthreads();
    LAS char* tl = lds + 32768;
    const float* g2 = p.gains + 2 * D;
    constexpr int T_IN = 16 * 80, T_OF = 8 * 16, T_OS = 8 * 16, T_OUT = 16 * 16, T_UP = 16 * 88, T_DN = 44 * 16;
    constexpr int T_ALL = T_IN + T_OF + T_OS + T_OUT + T_UP + T_DN;
    for (int t = blockIdx.x; t < T_ALL; t += gridDim.x) {
        int u = t;
        if (u < T_IN) { const int nt = u % 80, kt = u / 80; const int sc = nt * 64 + (nt * 64 >= 1536 ? 8 : 0); transpose_tile(tl, p.w_in, PROJW, sc, kt * 64, g0, (bf16_t*)(ws + WS_BTIN), 1024, nt * 64); continue; }
        u -= T_IN;
        if (u < T_OF) { const int nt = u % 16, kt = u / 16; transpose_tile(tl, p.w_o_fox, 1024, nt * 64, kt * 64, nullptr, (bf16_t*)(ws + WS_BTOF), 512, nt * 64); continue; }
        u -= T_OF;
        if (u < T_OS) { const int nt = u % 16, kt = u / 16; transpose_tile(tl, p.w_o_sb, 1024, nt * 64, kt * 64, nullptr, (bf16_t*)(ws + WS_BTOS), 512, nt * 64); continue; }
        u -= T_OS;
        if (u < T_OUT) { const int nt = u % 16, kt = u / 16; transpose_tile(tl, p.w_out, 1024, nt * 64, kt * 64, nullptr, (bf16_t*)(ws + WS_BTOUT), 1024, nt * 64); continue; }
        u -= T_OUT;
        if (u < T_UP) { const int nt = u % 88, kt = u / 88; transpose_tile(tl, p.w_up, NUP, (nt & 1) * DFF + (nt >> 1) * 64, kt * 64, g2, (bf16_t*)(ws + WS_BTUP), 1024, nt * 64); continue; }
        u -= T_UP;
        { const int nt = u % 16, kt = u / 16; transpose_tile(tl, p.w_down, 1024, nt * 64, kt * 64, nullptr, (bf16_t*)(ws + WS_BTDN), DFF, nt * 64); }
    }
}

template <bool SWAP, bool FULL>
__device__ __forceinline__ void gemm_kloop(LAS char* lds, const bf16_t* Ag, int lda, const bf16_t* Bg, int ldb, int nk, f32x4 (&acc)[4][4], int mlim) {
    const int tid = threadIdx.x, lane = tid & 63, w = wave_id(), wr = w >> 1, wc = w & 1;
    const int row_0 = w * 8 + (lane >> 3), c_0 = (lane & 7) ^ ((row_0 >> 1) & 7);
    const bf16_t* pa0 = Ag + (size_t)row_0 * lda + c_0 * 8; const bf16_t* pb0 = Bg + (size_t)row_0 * ldb + c_0 * 8;
    const size_t sa = (size_t)32 * lda, sb_ = (size_t)32 * ldb;
    const int swz = (lane >> 1) & 7;
    int aoff[2], boff[2];
#pragma unroll
    for (int kh = 0; kh < 2; ++kh) {
        aoff[kh] = (wr * 64 + (lane & 15)) * 128 + (((kh * 4 + (lane >> 4)) ^ swz) << 4);
        boff[kh] = 16384 + (wc * 64 + (lane & 15)) * 128 + (((kh * 4 + (lane >> 4)) ^ swz) << 4);
    }
#define GM_STAGE(s, kt) do { _Pragma("unroll") for (int i_ = 0; i_ < 4; ++i_) { \
        __builtin_amdgcn_global_load_lds((const unsigned*)(pa0 + i_ * sa + (kt) * 64), (LAS unsigned*)(lds + (s) * 32768 + (i_ * 4 + w) * 1024), 16, 0, 0); \
        __builtin_amdgcn_global_load_lds((const unsigned*)(pb0 + i_ * sb_ + (kt) * 64), (LAS unsigned*)(lds + (s) * 32768 + 16384 + (i_ * 4 + w) * 1024), 16, 0, 0); } } while (0)
    GM_STAGE(0, 0);
    for (int kt = 0; kt < nk; ++kt) {
        asm volatile("s_waitcnt vmcnt(0)" ::: "memory");
        __syncthreads();
        const int s = kt & 1;
        if (kt + 1 < nk) GM_STAGE(s ^ 1, kt + 1);
        bf16x8 af[4][2], bf[4][2];
#pragma unroll
        for (int kh = 0; kh < 2; ++kh) {
#pragma unroll
            for (int m = 0; m < 4; ++m) if (FULL || m < mlim) af[m][kh] = *(LAS bf16x8*)(lds + s * 32768 + aoff[kh] + m * 2048);
#pragma unroll
            for (int n = 0; n < 4; ++n) bf[n][kh] = *(LAS bf16x8*)(lds + s * 32768 + boff[kh] + n * 2048);
        }
        __builtin_amdgcn_s_setprio(1);
#pragma unroll
        for (int kh = 0; kh < 2; ++kh)
#pragma unroll
            for (int m = 0; m < 4; ++m) if (FULL || m < mlim) {
#pragma unroll
                for (int n = 0; n < 4; ++n)
                    acc[m][n] = SWAP ? __builtin_amdgcn_mfma_f32_16x16x32_bf16(bf[n][kh], af[m][kh], acc[m][n], 0, 0, 0)
                                     : __builtin_amdgcn_mfma_f32_16x16x32_bf16(af[m][kh], bf[n][kh], acc[m][n], 0, 0, 0);
            }
        __builtin_amdgcn_s_setprio(0);
    }
    __syncthreads();
#undef GM_STAGE
}
template <bool SWAP>
__device__ __forceinline__ void gemm_main(LAS char* lds, const bf16_t* Ag, int lda, const bf16_t* Bg, int ldb, int nk, f32x4 (&acc)[4][4], int mlim = 4) {
    if (mlim == 4) gemm_kloop<SWAP, true>(lds, Ag, lda, Bg, ldb, nk, acc, 4);
    else gemm_kloop<SWAP, false>(lds, Ag, lda, Bg, ldb, nk, acc, mlim);
}
__device__ __forceinline__ void zero_acc(f32x4 (&acc)[4][4]) {
#pragma unroll
    for (int m = 0; m < 4; ++m)
#pragma unroll
        for (int n = 0; n < 4; ++n) acc[m][n] = (f32x4){0.f, 0.f, 0.f, 0.f};
}


__device__ __forceinline__ int tile_at(int it, int ntm, int ntn, int& tm, int& tn) {
    const int G = gridDim.x;
    if (G % 256 != 0) { const int t = it * G + blockIdx.x; if (t >= ntm * ntn) return 0; tm = t / ntn; tn = t % ntn; return 1; }
    const int xcd = blockIdx.x & 7, j = blockIdx.x >> 3, ppx = G >> 8;
    const int pcols = (ntn + 3) >> 2, prows = (ntm + 7) >> 3;
    const int patch = (it * ppx + (j >> 5)) * 8 + xcd;
    if (patch >= prows * pcols) return 0;
    const int wi = j & 31;
    tm = (patch / pcols) * 8 + (wi >> 2); tn = (patch % pcols) * 4 + (wi & 3);
    return (tm < ntm && tn < ntn) ? 1 : 2;
}
__device__ __forceinline__ void cumsum_block(const Params& p, LAS char* lds, int bh) {
    const float* lf = (const float*)(p.ws + WS_LOGF) + (size_t)bh * LPK; float* ck = (float*)(p.ws + WS_CK) + (size_t)bh * LPK;
    LAS float* wsum = (LAS float*)lds;
    const int tid = threadIdx.x, lane = tid & 63, w = wave_id(); constexpr int PER = 33, L = SEQ + NMETA;
    float v[PER];
#pragma unroll
    for (int e = 0; e < PER; ++e) { const int t = e * NTHREADS + tid; const int tc = t < L ? t : L - 1; const float x = lf[tc < 16 ? 8192 + tc : tc - 16]; v[e] = t < L ? x : 0.f; }
    float carry = 0.f;
#pragma unroll
    for (int e = 0; e < PER; ++e) {
        float x = v[e];
#pragma unroll
        for (int o = 1; o < 64; o <<= 1) { const float y = __shfl_up(x, o); if (lane >= o) x += y; }
        if (lane == 63) wsum[(e & 1) * 4 + w] = x;
        __syncthreads();
        const float s0 = wsum[(e & 1) * 4 + 0], s1 = wsum[(e & 1) * 4 + 1], s2 = wsum[(e & 1) * 4 + 2], s3 = wsum[(e & 1) * 4 + 3];
        const float pre = (w > 0 ? s0 : 0.f) + (w > 1 ? s1 : 0.f) + (w > 2 ? s2 : 0.f);
        const int t = e * NTHREADS + tid;
        if (t < L) ck[t < 16 ? 8192 + t : t - 16] = (carry + pre + x) * LOG2E;
        carry += (s0 + s1) + (s2 + s3);
    }
    __syncthreads();
}

__device__ __forceinline__ void phase1(const Params& p, LAS char* lds) {
    unsigned char* ws = p.ws;
    if ((int)blockIdx.x >= (int)gridDim.x - 16) cumsum_block(p, lds, gridDim.x - 1 - blockIdx.x);
    const int lane = threadIdx.x & 63, w = wave_id(), wr = w >> 1, wc = w & 1;
    const bf16_t* xb = (const bf16_t*)(ws + WS_A); const bf16_t* Bt = (const bf16_t*)(ws + WS_BTIN);
    const float* r1 = (const float*)(ws + WS_R1);
    constexpr int NTN = 40, NTM = 129;
    for (int it = 0;; ++it) {
        int tm, tn; int st = tile_at(it, NTM - 1, NTN, tm, tn);
        if (st == 0) { if (it < (1 << 20) && (int)blockIdx.x < NTN) { tm = NTM - 1; tn = blockIdx.x; it = 1 << 20; st = 1; } else break; }
        if (st == 2) continue;
        const int row0 = tm * 128, col0 = tn * 128; const int mlim = tm == NTM - 1 ? (wr == 0 ? 2 : 0) : 4;
        const bool vtile = (tn >= 8 && tn < 12) || (tn >= 20 && tn < 24);
        f32x4 acc[4][4]; zero_acc(acc);
        if (vtile) {
            gemm_main<false>(lds, xb + (size_t)row0 * D, D, Bt + (size_t)col0 * D, D, 16, acc, mlim);
            bf16_t* vT = (bf16_t*)(ws + (tn < 12 ? WS_VFT : WS_VST)); const int cb = tn < 12 ? 1024 : 2560;
            const int g = lane >> 4, gp = ((g & 1) << 1) | (g >> 1);
#pragma unroll
            for (int m = 0; m < 4; ++m) {
                const int rb = row0 + wr * 64 + m * 16; int b, kb16;
                if (rb < MX) { b = rb >> 13; kb16 = rb & 8191; } else { const int j = rb - MX; if (j >= 32) continue; b = j >> 4; kb16 = 8192; }
                const f32x4 rs = *(const f32x4*)(r1 + rb + g * 4);
#pragma unroll
                for (int n = 0; n < 4; ++n) {
                    const int dc = col0 + wc * 64 + n * 16 + (lane & 15) - cb, h = dc >> 6, d = dc & 63;
                    const f32x4 v = acc[m][n] * rs;
                    *(u32x2*)(vT + ((size_t)(b * 8 + h) * 64 + d) * LPK + kb16 + gp * 4) = (u32x2){pk_bf16(v[0], v[1]), pk_bf16(v[2], v[3])};
                }
            }
        } else {
            gemm_main<true>(lds, xb + (size_t)row0 * D, D, Bt + (size_t)col0 * D, D, 16, acc, mlim);
            bf16_t* dst; int ld, cb; float sc = 1.f; bool sg = false;
            if (tn < 4) { dst = (bf16_t*)(ws + WS_QF); ld = 512; cb = 0; sc = 0.125f * LOG2E; }
            else if (tn < 8) { dst = (bf16_t*)(ws + WS_KF); ld = 512; cb = 512; }
            else if (tn < 16) { dst = (bf16_t*)(ws + WS_QS); ld = 512; cb = 1536; sc = 0.125f; }
            else if (tn < 20) { dst = (bf16_t*)(ws + WS_KS); ld = 512; cb = 2048; }
            else if (tn < 32) { dst = (bf16_t*)(ws + WS_B); ld = 1024; cb = 3072; sg = true; }
            else { dst = (bf16_t*)(ws + WS_B + SZ_M1024); ld = 1024; cb = 4096; sg = true; }
            const bool kfox = tn >= 4 && tn < 8;
            float wmax = 0.f;
#pragma unroll
            for (int m = 0; m < 4; ++m) {
                const int row = row0 + wr * 64 + m * 16 + (lane & 15); const float rs = r1[row] * sc;
                float s2 = 0.f;
#pragma unroll
                for (int n = 0; n < 4; ++n) {
                    const int col = col0 + wc * 64 + n * 16 + (lane >> 4) * 4 - cb;
                    f32x4 v = acc[m][n] * rs;
                    if (sg) { v[0] = sigmoidf_(v[0]); v[1] = sigmoidf_(v[1]); v[2] = sigmoidf_(v[2]); v[3] = sigmoidf_(v[3]); }
                    s2 += v[0] * v[0] + v[1] * v[1] + v[2] * v[2] + v[3] * v[3];
                    *(u32x2*)(dst + (size_t)row * ld + col) = (u32x2){pk_bf16(v[0], v[1]), pk_bf16(v[2], v[3])};
                }
                if (kfox) { s2 += __shfl_xor(s2, 16); s2 += __shfl_xor(s2, 32); wmax = fmaxf(wmax, s2); }
            }
            if (kfox) {
#pragma unroll
                for (int o = 1; o < 16; o <<= 1) wmax = fmaxf(wmax, __shfl_xor(wmax, o));
                if (lane == 0) {
                    unsigned* km = (unsigned*)(ws + WS_CTL) + 32; const int head = (tn - 4) * 2 + wc; const unsigned bits = __float_as_uint(wmax);
                    if (row0 < MX) atomicMax(km + (row0 >> 13) * 8 + head, bits);
                    else { atomicMax(km + head, bits); atomicMax(km + 8 + head, bits); }
                }
            }
        }
    }
}

constexpr int AT_STAGE = 16640;
template <int TYPE>
__device__ __forceinline__ void attn_unit(LAS char* lds, const Params& p, int b, int h, int qb, int part = 0) {
    unsigned char* ws = p.ws;
    const int tid = threadIdx.x, lane = tid & 63, w = wave_id(), ql = lane & 31, hi = lane >> 5;
    const bf16_t* Q = (const bf16_t*)(ws + (TYPE == 0 ? WS_QF : WS_QS));
    const bf16_t* Kp = (const bf16_t*)(ws + (TYPE == 0 ? WS_KF : WS_KS));
    const bf16_t* VT = (const bf16_t*)(ws + (TYPE == 0 ? WS_VFT : WS_VST)) + (size_t)(b * 8 + h) * 64 * LPK;
    const float* cK = (const float*)(ws + WS_CK) + (size_t)(b * 8 + h) * LPK;
    bf16_t* Oo = (bf16_t*)(ws + WS_A + (TYPE == 0 ? 0 : SZ_M512));
    const bool meta_unit = qb < 0;
    const int qrow0 = meta_unit ? MX + 16 * b : b * SEQ + qb * 128;
    const int nt = meta_unit ? 1 : 2 * qb + 3;
    int qrow = qrow0 + 32 * w + ql; if (qrow > M - 1) qrow = M - 1;
    bf16x8 qf[4];
#pragma unroll
    for (int ds = 0; ds < 4; ++ds) qf[ds] = *(const bf16x8*)(Q + (size_t)qrow * 512 + h * 64 + ds * 16 + hi * 8);
    f32x16 O0, O1;
#pragma unroll
    for (int i = 0; i < 16; ++i) { O0[i] = 0.f; O1[i] = 0.f; }
    float m_run = -INFINITY, lsum = 0.f, R = 0.f;
    const int JA = qb + 2;
    const int j0 = part == 2 ? JA : 0, j1 = part == 1 ? JA : nt;
    if (TYPE == 0 && part == 2) {
        float dg = 0.f;
#pragma unroll
        for (int ds = 0; ds < 4; ++ds) {
            const bf16x8 kd = *(const bf16x8*)(Kp + (size_t)qrow * 512 + h * 64 + ds * 16 + hi * 8);
#pragma unroll
            for (int e = 0; e < 8; ++e) dg += __uint_as_float((unsigned)(unsigned short)qf[ds][e] << 16) * __uint_as_float((unsigned)(unsigned short)kd[e] << 16);
        }
        dg += __shfl_xor(dg, 32);
        m_run = dg - cK[qb * 128 + 32 * w + ql] - 1.0f;
    }
    float qbound = 0.f;
    if (TYPE == 0) {
        float q2 = 0.f;
#pragma unroll
        for (int ds = 0; ds < 4; ++ds)
#pragma unroll
            for (int e = 0; e < 8; ++e) { const float x = __uint_as_float((unsigned)(unsigned short)qf[ds][e] << 16); q2 += x * x; }
        q2 += __shfl_xor(q2, 32);
        const unsigned kb = __hip_atomic_load((unsigned*)(ws + WS_CTL) + 32 + b * 8 + h, __ATOMIC_RELAXED, __HIP_MEMORY_SCOPE_AGENT);
        qbound = sqrtf(q2) * sqrtf(__uint_as_float(kb)) * 1.02f + 1.0f;
    }
    u32x4 kreg[2], vreg[2]; float creg = 0.f;
    const int srow = tid >> 3, spos = tid & 7;
    const int swz_st = (spos ^ ((srow >> 1) & 7)) << 4;
    const int swz = (lane >> 1) & 7;
    LAS unsigned* flags = (LAS unsigned*)(lds + 2 * AT_STAGE);
#define AT_LOAD(j) do { int krow0_, kidx0_; if (!meta_unit && (j) < nt - 1) { const int kt_ = nt - 2 - (j); krow0_ = b * SEQ + 64 * kt_; kidx0_ = 64 * kt_; } else { krow0_ = MX + 16 * b; kidx0_ = 8192; } \
        _Pragma("unroll") for (int i_ = 0; i_ < 2; ++i_) { \
            kreg[i_] = *(const u32x4*)(Kp + (size_t)(krow0_ + srow + 32 * i_) * 512 + h * 64 + spos * 8); \
            vreg[i_] = *(const u32x4*)(VT + (size_t)(srow + 32 * i_) * LPK + kidx0_ + spos * 8); } \
        if (TYPE == 0 && tid < 64) creg = cK[kidx0_ + tid]; } while (0)
#define AT_WRITE(s) do { _Pragma("unroll") for (int i_ = 0; i_ < 2; ++i_) { \
            *(LAS u32x4*)(lds + (s) * AT_STAGE + (srow + 32 * i_) * 128 + swz_st) = kreg[i_]; \
            *(LAS u32x4*)(lds + (s) * AT_STAGE + 8192 + (srow + 32 * i_) * 128 + swz_st) = vreg[i_]; } \
        if (TYPE == 0 && tid < 64) *(LAS float*)(lds + (s) * AT_STAGE + 16384 + tid * 4) = creg; } while (0)
    AT_LOAD(j0); AT_WRITE(j0 & 1);
    __syncthreads();
    for (int j = j0; j < j1; ++j) {
        const bool more = j + 1 < j1;
        if (more) AT_LOAD(j + 1);
        int klim, d0;
        if (meta_unit) { klim = 16; d0 = 0; }
        else if (j == nt - 1) { klim = 16; d0 = 1 << 20; }
        else { klim = 64; d0 = 128 * qb - 64 * (nt - 2 - j); if (d0 >= 64) d0 = 1 << 20; }
        const int limw = 32 * w + d0 - TYPE;
        bool wdone = false, nomax = false;
        if (TYPE == 0) {
            const float clast = *(const LAS float*)(lds + (j & 1) * AT_STAGE + 16384 + (klim - 1) * 4);
            wdone = __all((qbound - clast - m_run) < -126.0f) != 0;
            nomax = __all((qbound - clast) <= m_run) != 0;
        }
        if (limw + 31 >= 0 && !(TYPE == 0 && wdone)) {
            const LAS char* sb = lds + (j & 1) * AT_STAGE;
            int kmax = limw + ql; if (kmax > klim - 1) kmax = klim - 1;
            const bool needmask = (klim < 64) || (limw < 63);
            f32x16 S0, S1;
#pragma unroll
            for (int i = 0; i < 16; ++i) { S0[i] = 0.f; S1[i] = 0.f; }
#pragma unroll
            for (int ds = 0; ds < 4; ++ds) {
                const bf16x8 k0 = *(const LAS bf16x8*)(sb + ql * 128 + (((2 * ds + hi) ^ swz) << 4));
                const bf16x8 k1 = *(const LAS bf16x8*)(sb + (32 + ql) * 128 + (((2 * ds + hi) ^ swz) << 4));
                S0 = __builtin_amdgcn_mfma_f32_32x32x16_bf16(k0, qf[ds], S0, 0, 0, 0);
                S1 = __builtin_amdgcn_mfma_f32_32x32x16_bf16(k1, qf[ds], S1, 0, 0, 0);
            }
            if (TYPE == 0) {
#pragma unroll
                for (int g = 0; g < 4; ++g) {
                    const f32x4 c0 = *(const LAS f32x4*)(sb + 16384 + (8 * g + 4 * hi) * 4), c1 = *(const LAS f32x4*)(sb + 16384 + (32 + 8 * g + 4 * hi) * 4);
#pragma unroll
                    for (int i = 0; i < 4; ++i) { S0[4 * g + i] -= c0[i]; S1[4 * g + i] -= c1[i]; }
                }
                if (needmask) {
#pragma unroll
                    for (int r = 0; r < 16; ++r) { const int kl = (r & 3) + 8 * (r >> 2) + 4 * hi; if (kl > kmax) S0[r] = -INFINITY; if (kl + 32 > kmax) S1[r] = -INFINITY; }
                }
                if (!nomax) {
                    float mx = -INFINITY;
#pragma unroll
                    for (int r = 0; r < 16; ++r) mx = fmaxf(mx, fmaxf(S0[r], S1[r]));
                    mx = fmaxf(mx, __shfl_xor(mx, 32));
                    const float m_new = fmaxf(m_run, mx), alpha = ex2(m_run - m_new);
                    m_run = m_new;
                    lsum *= alpha;
#pragma unroll
                    for (int r = 0; r < 16; ++r) { O0[r] *= alpha; O1[r] *= alpha; }
                }
                float ps = 0.f;
#pragma unroll
                for (int r = 0; r < 16; ++r) { S0[r] = ex2(S0[r] - m_run); S1[r] = ex2(S1[r] - m_run); ps += S0[r] + S1[r]; }
                lsum += ps;
            } else {
                float G0[4], G1[4];
                f32x16 L0, L1;
#pragma unroll
                for (int r = 0; r < 16; ++r) {
                    const int kl = (r & 3) + 8 * (r >> 2) + 4 * hi;
                    const float z0 = S0[r], z1 = S1[r];
                    const float sp0 = fmaxf(z0, 0.f) + lg2(1.0f + ex2(-fabsf(z0) * LOG2E)) * LN2;
                    const float sp1 = fmaxf(z1, 0.f) + lg2(1.0f + ex2(-fabsf(z1) * LOG2E)) * LN2;
                    L0[r] = (!needmask || kl <= kmax) ? -sp0 : 0.f;
                    L1[r] = (!needmask || kl + 32 <= kmax) ? -sp1 : 0.f;
                }
#pragma unroll
                for (int g = 0; g < 4; ++g) {
                    L0[4 * g + 2] += L0[4 * g + 3]; L0[4 * g + 1] += L0[4 * g + 2]; L0[4 * g] += L0[4 * g + 1]; G0[g] = L0[4 * g];
                    L1[4 * g + 2] += L1[4 * g + 3]; L1[4 * g + 1] += L1[4 * g + 2]; L1[4 * g] += L1[4 * g + 1]; G1[g] = L1[4 * g];
                }
                float run = R;
#pragma unroll
                for (int g = 3; g >= 0; --g) {
                    const float gp = __shfl_xor(G1[g], 32);
                    const float off = hi ? run : run + gp;
#pragma unroll
                    for (int i = 0; i < 4; ++i) { const int r = 4 * g + i; const int kl = 32 + i + 8 * g + 4 * hi;
                        const float a = ex2((S1[r] + L1[r] + off) * LOG2E); S1[r] = (!needmask || kl <= kmax) ? a : 0.f; }
                    run += G1[g] + gp;
                }
#pragma unroll
                for (int g = 3; g >= 0; --g) {
                    const float gp = __shfl_xor(G0[g], 32);
                    const float off = hi ? run : run + gp;
#pragma unroll
                    for (int i = 0; i < 4; ++i) { const int r = 4 * g + i; const int kl = i + 8 * g + 4 * hi;
                        const float a = ex2((S0[r] + L0[r] + off) * LOG2E); S0[r] = (!needmask || kl <= kmax) ? a : 0.f; }
                    run += G0[g] + gp;
                }
                R = run;
                wdone = __all(R < -120.0f) != 0;
            }
#pragma unroll
            for (int ks = 0; ks < 4; ++ks) {
                bf16x8 pf; u32x4 pu;
                if (ks < 2) { pu = (u32x4){pk_bf16(S0[8 * ks + 0], S0[8 * ks + 1]), pk_bf16(S0[8 * ks + 2], S0[8 * ks + 3]), pk_bf16(S0[8 * ks + 4], S0[8 * ks + 5]), pk_bf16(S0[8 * ks + 6], S0[8 * ks + 7])}; }
                else { const int k2 = ks - 2; pu = (u32x4){pk_bf16(S1[8 * k2 + 0], S1[8 * k2 + 1]), pk_bf16(S1[8 * k2 + 2], S1[8 * k2 + 3]), pk_bf16(S1[8 * k2 + 4], S1[8 * k2 + 5]), pk_bf16(S1[8 * k2 + 6], S1[8 * k2 + 7])}; }
                pf = __builtin_bit_cast(bf16x8, pu);
                const bf16x8 v0 = *(const LAS bf16x8*)(sb + 8192 + ql * 128 + (((2 * ks + hi) ^ swz) << 4));
                const bf16x8 v1 = *(const LAS bf16x8*)(sb + 8192 + (32 + ql) * 128 + (((2 * ks + hi) ^ swz) << 4));
                O0 = __builtin_amdgcn_mfma_f32_32x32x16_bf16(v0, pf, O0, 0, 0, 0);
                O1 = __builtin_amdgcn_mfma_f32_32x32x16_bf16(v1, pf, O1, 0, 0, 0);
            }
        }
        if (more) AT_WRITE((j + 1) & 1);
        if (lane == 0) flags[(j & 1) * 4 + w] = wdone ? 1u : 0u;
        __syncthreads();
        { const LAS unsigned* fl = flags + (j & 1) * 4; const unsigned f = fl[0] & fl[1] & fl[2] & fl[3]; if (f) break; }
    }
    float inv = 1.0f;
    if (TYPE == 0) { const float l = lsum + __shfl_xor(lsum, 32); inv = 1.0f / l; }
    const bool qvalid = meta_unit ? (w == 0 && ql < 16) : true;
    if (TYPE == 0 && part != 0) {
        float* rec = p.out + ((size_t)((((63 - qb) * 16 + b * 8 + h) * 2 + (part - 1)) * 128 + 32 * w + ql)) * 68;
        const float l = lsum + __shfl_xor(lsum, 32);
#pragma unroll
        for (int g = 0; g < 4; ++g) {
            *(f32x4*)(rec + 8 * g + 4 * hi) = (f32x4){O0[4 * g], O0[4 * g + 1], O0[4 * g + 2], O0[4 * g + 3]};
            *(f32x4*)(rec + 32 + 8 * g + 4 * hi) = (f32x4){O1[4 * g], O1[4 * g + 1], O1[4 * g + 2], O1[4 * g + 3]};
        }
        if (hi == 0) { rec[64] = m_run; rec[65] = l; }
    } else if (qvalid) {
        bf16_t* op = Oo + (size_t)qrow * 512 + h * 64 + 4 * hi;
#pragma unroll
        for (int g = 0; g < 4; ++g) {
            *(u32x2*)(op + 8 * g) = (u32x2){pk_bf16(O0[4 * g] * inv, O0[4 * g + 1] * inv), pk_bf16(O0[4 * g + 2] * inv, O0[4 * g + 3] * inv)};
            *(u32x2*)(op + 32 + 8 * g) = (u32x2){pk_bf16(O1[4 * g] * inv, O1[4 * g + 1] * inv), pk_bf16(O1[4 * g + 2] * inv, O1[4 * g + 3] * inv)};
        }
    }
    __syncthreads();
#undef AT_LOAD
#undef AT_WRITE
}


__device__ __forceinline__ void phase_comb(const Params& p) {
    bf16_t* oa = (bf16_t*)(p.ws + WS_A);
    for (int it = blockIdx.x * NTHREADS + threadIdx.x; it < 512 * 128 * 16; it += gridDim.x * NTHREADS) {
        const int d4 = it & 15, row = (it >> 4) & 127, su = it >> 11;
        const float* ra = p.out + ((size_t)((su * 2) * 128 + row)) * 68; const float* rb = ra + (size_t)128 * 68;
        const float ma = ra[64], la = ra[65], mb = rb[64], lb = rb[65];
        const float m = fmaxf(ma, mb), wa = ex2(ma - m), wb = ex2(mb - m), inv = 1.0f / (la * wa + lb * wb);
        const f32x4 a = *(const f32x4*)(ra + d4 * 4), bq = *(const f32x4*)(rb + d4 * 4);
        const f32x4 o = (a * wa + bq * wb) * inv;
        const int qb = 63 - (su >> 4), bh = su & 15;
        *(u32x2*)(oa + (size_t)((bh >> 3) * SEQ + qb * 128 + row) * 512 + (bh & 7) * 64 + d4 * 4) = (u32x2){pk_bf16(o[0], o[1]), pk_bf16(o[2], o[3])};
    }
}
__device__ __forceinline__ void phase2(const Params& p, LAS char* lds) {
    unsigned* ctr = (unsigned*)(p.ws + WS_CTL);
    LAS unsigned* shu = (LAS unsigned*)(lds + 2 * AT_STAGE + 64);
    constexpr int NU = 2560 + 32;
    for (;;) {
        if (threadIdx.x == 0) shu[0] = __hip_atomic_fetch_add(ctr, 1u, __ATOMIC_RELAXED, __HIP_MEMORY_SCOPE_AGENT);
        __syncthreads();
        const int u = (int)shu[0];
        __syncthreads();
        if (u >= NU) break;
        if (u < 1024) { const int v = u >> 1; attn_unit<0>(lds, p, (v & 15) >> 3, v & 7, 63 - (v >> 4), 1 + (u & 1)); }
        else if (u < 1536) { const int v = u - 1024; attn_unit<0>(lds, p, (v & 15) >> 3, v & 7, 31 - (v >> 4)); }
        else if (u < 2560) { const int v = u - 1536; attn_unit<1>(lds, p, (v & 15) >> 3, v & 7, 63 - (v >> 4)); }
        else if (u < 2576) { const int v = u - 2560; attn_unit<0>(lds, p, v >> 3, v & 7, -1); }
        else { const int v = u - 2576; attn_unit<1>(lds, p, v >> 3, v & 7, -1); }
    }
}

__device__ __forceinline__ void phase3a(const Params& p, LAS char* lds) {
    unsigned char* ws = p.ws;
    const int lane = threadIdx.x & 63, w = wave_id(), wr = w >> 1, wc = w & 1;
    const bf16_t* oa = (const bf16_t*)(ws + WS_A); const bf16_t* ob = oa + (size_t)M * 512;
    const bf16_t* ga = (const bf16_t*)(ws + WS_B); const bf16_t* gb = ga + (size_t)M * 1024;
    bf16_t* gated = (bf16_t*)(ws + WS_GATED);
    for (int it = 0;; ++it) {
        int tm, tn; int st = tile_at(it, 128, 8, tm, tn);
        if (st == 0) { if (it < (1 << 20) && (int)blockIdx.x < 8) { tm = 128; tn = blockIdx.x; it = 1 << 20; st = 1; } else break; }
        if (st == 2) continue;
        const int row0 = tm * 128, col0 = tn * 128; const int mlim = tm == 128 ? (wr == 0 ? 2 : 0) : 4;
        f32x4 acc[4][4]; zero_acc(acc);
        gemm_main<true>(lds, oa + (size_t)row0 * 512, 512, (const bf16_t*)(ws + WS_BTOF) + (size_t)col0 * 512, 512, 8, acc, mlim);
#pragma unroll
        for (int m = 0; m < 4; ++m) {
            const int row = row0 + wr * 64 + m * 16 + (lane & 15);
#pragma unroll
            for (int n = 0; n < 4; ++n) {
                const int col = col0 + wc * 64 + n * 16 + (lane >> 4) * 4;
                const u32x2 a = *(const u32x2*)(ga + (size_t)row * 1024 + col);
                const f32x4 x = acc[m][n];
                *(u32x2*)(gated + (size_t)row * 1024 + col) = (u32x2){pk_bf16(bf_lo(a[0]) * x[0], bf_hi(a[0]) * x[1]), pk_bf16(bf_lo(a[1]) * x[2], bf_hi(a[1]) * x[3])};
            }
        }
        zero_acc(acc);
        gemm_main<true>(lds, ob + (size_t)row0 * 512, 512, (const bf16_t*)(ws + WS_BTOS) + (size_t)col0 * 512, 512, 8, acc, mlim);
#pragma unroll
        for (int m = 0; m < 4; ++m) {
            const int row = row0 + wr * 64 + m * 16 + (lane & 15);
#pragma unroll
            for (int n = 0; n < 4; ++n) {
                const int col = col0 + wc * 64 + n * 16 + (lane >> 4) * 4;
                const u32x2 b = *(const u32x2*)(gb + (size_t)row * 1024 + col);
                const f32x4 y = acc[m][n]; const u32x2 q = *(const u32x2*)(gated + (size_t)row * 1024 + col);
                const float o0 = bf_lo(q[0]) + bf_lo(b[0]) * y[0], o1 = bf_hi(q[0]) + bf_hi(b[0]) * y[1];
                const float o2 = bf_lo(q[1]) + bf_lo(b[1]) * y[2], o3 = bf_hi(q[1]) + bf_hi(b[1]) * y[3];
                *(u32x2*)(gated + (size_t)row * 1024 + col) = (u32x2){pk_bf16(o0, o1), pk_bf16(o2, o3)};
            }
        }
    }
}
__device__ __forceinline__ void epi_store_ss(const f32x4 (&acc)[4][4], bf16_t* out, int ldo, int orow0, int col0, float* ssp, int ssrow0, int wr, int wc, int lane) {
#pragma unroll
    for (int m = 0; m < 4; ++m) {
        const int rl = wr * 64 + m * 16 + (lane & 15);
        float s = 0.f;
#pragma unroll
        for (int n = 0; n < 4; ++n) {
            const int col = col0 + wc * 64 + n * 16 + (lane >> 4) * 4;
            const f32x4 v = acc[m][n];
            s += v[0] * v[0] + v[1] * v[1] + v[2] * v[2] + v[3] * v[3];
            *(u32x2*)(out + (size_t)(orow0 + rl) * ldo + col) = (u32x2){pk_bf16(v[0], v[1]), pk_bf16(v[2], v[3])};
        }
#if 1
        s += __shfl_xor(s, 16); s += __shfl_xor(s, 32);
        if (lane < 16) ssp[(size_t)((col0 >> 7) * 2 + wc) * M + ssrow0 + rl] = s;
#endif
    }
}
__device__ __forceinline__ void phase3b(const Params& p, LAS char* lds) {
    unsigned char* ws = p.ws;
    const int lane = threadIdx.x & 63, w = wave_id(), wr = w >> 1, wc = w & 1;
    const bf16_t* gated = (const bf16_t*)(ws + WS_GATED); bf16_t* mixed = (bf16_t*)(ws + WS_MIXED);
    for (int it = 0;; ++it) {
        int tm, tn; int st = tile_at(it, 128, 8, tm, tn);
        if (st == 0) { if (it < (1 << 20) && (int)blockIdx.x < 8) { tm = 128; tn = blockIdx.x; it = 1 << 20; st = 1; } else break; }
        if (st == 2) continue;
        const int row0 = tm * 128, col0 = tn * 128; const int mlim = tm == 128 ? (wr == 0 ? 2 : 0) : 4;
        f32x4 acc[4][4]; zero_acc(acc);
        gemm_main<true>(lds, gated + (size_t)row0 * 1024, 1024, (const bf16_t*)(ws + WS_BTOUT) + (size_t)col0 * 1024, 1024, 16, acc, mlim);
        epi_store_ss(acc, mixed, 1024, row0, col0, (float*)(ws + WS_SSP2), row0, wr, wc, lane);
    }
}
__device__ __forceinline__ void phase3c(const Params& p) {
    unsigned char* ws = p.ws;
    const int lane = threadIdx.x & 63, w = wave_id();
    const bf16_t* mixed = (const bf16_t*)(ws + WS_MIXED); bf16_t* hb = (bf16_t*)(ws + WS_A);
    const float* ssp2 = (const float*)(ws + WS_SSP2); float* r2 = (float*)(ws + WS_R2);
    const float* g1 = p.gains + D;
    f32x4 g[4];
#pragma unroll
    for (int i = 0; i < 4; ++i) g[i] = *(const f32x4*)(g1 + lane * 4 + 256 * i);
    for (int grp = blockIdx.x; grp * 32 < MV; grp += gridDim.x) {
#pragma unroll 1
        for (int k = 0; k < 8; k += 2) {
            int r[2]; bool ok[2]; f32x4 v[2][4]; u32x2 mx[2][4]; float sq[2];
#pragma unroll
            for (int j = 0; j < 2; ++j) {
                r[j] = grp * 32 + w + 4 * (k + j); ok[j] = r[j] < MV; const int rr = ok[j] ? r[j] : 0;
                const float* src = rr < MX ? p.x + (size_t)rr * D : p.meta + (size_t)((rr - MX) & 15) * D;
                sq[j] = lane < 16 ? ssp2[(size_t)lane * M + rr] : 0.f;
#pragma unroll
                for (int i = 0; i < 4; ++i) { v[j][i] = *(const f32x4*)(src + lane * 4 + 256 * i); mx[j][i] = *(const u32x2*)(mixed + (size_t)rr * D + lane * 4 + 256 * i); }
            }
#pragma unroll
            for (int j = 0; j < 2; ++j) {
                const float a = 1.0f / sqrtf(wave_sum(sq[j]) * (1.0f / D) + EPS);
                float ss = 0.f;
#pragma unroll
                for (int i = 0; i < 4; ++i) {
                    const int col = lane * 4 + 256 * i;
                    f32x4 hh;
                    hh[0] = v[j][i][0] + bf_lo(mx[j][i][0]) * a * g[i][0]; hh[1] = v[j][i][1] + bf_hi(mx[j][i][0]) * a * g[i][1];
                    hh[2] = v[j][i][2] + bf_lo(mx[j][i][1]) * a * g[i][2]; hh[3] = v[j][i][3] + bf_hi(mx[j][i][1]) * a * g[i][3];
                    ss += hh[0] * hh[0] + hh[1] * hh[1] + hh[2] * hh[2] + hh[3] * hh[3];
                    if (ok[j]) {
                        *(u32x2*)(hb + (size_t)r[j] * D + col) = (u32x2){pk_bf16(hh[0], hh[1]), pk_bf16(hh[2], hh[3])};
                        if (r[j] < MX) *(f32x4*)(p.out + (size_t)r[j] * D + col) = hh;
                    }
                }
                ss = wave_sum(ss);
                if (ok[j] && lane == 0) r2[r[j]] = 1.0f / sqrtf(ss * (1.0f / D) + EPS);
            }
        }
    }
}
constexpr int UST = 272;
__device__ __forceinline__ f32x4 unpack4(const u32x2 u) { return (f32x4){bf_lo(u[0]), bf_hi(u[0]), bf_lo(u[1]), bf_hi(u[1])}; }
struct ConvW { f32x4 w0g, w1g, w2g, bg, w0v, w1v, w2v, bv; };
__device__ __forceinline__ ConvW load_convw(const Params& p, int c) {
    ConvW q;
    q.w0g = *(const f32x4*)(p.conv_w + c); q.w1g = *(const f32x4*)(p.conv_w + NUP + c); q.w2g = *(const f32x4*)(p.conv_w + 2 * NUP + c); q.bg = *(const f32x4*)(p.conv_b + c);
    q.w0v = *(const f32x4*)(p.conv_w + DFF + c); q.w1v = *(const f32x4*)(p.conv_w + NUP + DFF + c); q.w2v = *(const f32x4*)(p.conv_w + 2 * NUP + DFF + c); q.bv = *(const f32x4*)(p.conv_b + DFF + c);
    return q;
}
__device__ __forceinline__ u32x2 conv_gelu4(const ConvW& q, const f32x4 g2, const f32x4 g1, const f32x4 g0, const f32x4 v2, const f32x4 v1, const f32x4 v0) {
    float o[4];
#pragma unroll
    for (int e = 0; e < 4; ++e) {
        const float ug = q.bg[e] + q.w0g[e] * g2[e] + q.w1g[e] * g1[e] + q.w2g[e] * g0[e];
        const float uv = q.bv[e] + q.w0v[e] * v2[e] + q.w1v[e] * v1[e] + q.w2v[e] * v0[e];
        const float t = 0.7978845608028654f * (ug + 0.044715f * ug * ug * ug);
        o[e] = ug * rcp(1.0f + ex2(-2.0f * LOG2E * t)) * uv;
    }
    return (u32x2){pk_bf16(o[0], o[1]), pk_bf16(o[2], o[3])};
}
__device__ __forceinline__ void phase4(const Params& p, LAS char* lds) {
    unsigned char* ws = p.ws;
    const int tid = threadIdx.x, lane = tid & 63, w = wave_id(), wr = w >> 1, wc = w & 1;
    const bf16_t* hb = (const bf16_t*)(ws + WS_A); const bf16_t* Bt = (const bf16_t*)(ws + WS_BTUP);
    const float* r2 = (const float*)(ws + WS_R2);
    bf16_t* act = (bf16_t*)(ws + WS_ACT); bf16_t* hal = (bf16_t*)(ws + WS_HAL);
    for (int it = 0;; ++it) {
        int tm, tn; int st = tile_at(it, 128, 44, tm, tn);
        if (st == 0) { if (it < (1 << 20) && (int)blockIdx.x < 44) { tm = 128; tn = blockIdx.x; it = 1 << 20; st = 1; } else break; }
        if (st == 2) continue;
        const bool mt = tm == 128; const int row0 = mt ? MX : tm * 128, col0 = tn * 128;
        f32x4 acc[4][4]; zero_acc(acc);
        gemm_main<true>(lds, hb + (size_t)row0 * D, D, Bt + (size_t)col0 * D, D, 16, acc, mt ? (wr == 0 ? 2 : 0) : 4);
#pragma unroll
        for (int m = 0; m < 4; ++m) {
            const int rl = wr * 64 + m * 16 + (lane & 15); const float rs = r2[row0 + rl];
#pragma unroll
            for (int n = 0; n < 4; ++n) {
                const int cl = wc * 64 + n * 16 + (lane >> 4) * 4; const f32x4 v = acc[m][n] * rs;
                *(LAS u32x2*)(lds + rl * UST + cl * 2) = (u32x2){pk_bf16(v[0], v[1]), pk_bf16(v[2], v[3])};
            }
        }
        __syncthreads();
        if (!mt) {
            const int cg = tid & 15, rb = tid >> 4, c = tn * 64 + cg * 4;
            const ConvW q = load_convw(p, c);
            const int hr = rb == 0 ? 0 : rb * 8 - 2;
            f32x4 g2 = unpack4(*(const LAS u32x2*)(lds + hr * UST + cg * 8)), v2 = unpack4(*(const LAS u32x2*)(lds + hr * UST + 128 + cg * 8));
            f32x4 g1 = unpack4(*(const LAS u32x2*)(lds + (hr + 1) * UST + cg * 8)), v1 = unpack4(*(const LAS u32x2*)(lds + (hr + 1) * UST + 128 + cg * 8));
            for (int r = hr + 2; r < rb * 8 + 8; ++r) {
                const f32x4 g0 = unpack4(*(const LAS u32x2*)(lds + r * UST + cg * 8)), v0 = unpack4(*(const LAS u32x2*)(lds + r * UST + 128 + cg * 8));
                *(u32x2*)(act + (size_t)(row0 + r) * DFF + c) = conv_gelu4(q, g2, g1, g0, v2, v1, v0);
                g2 = g1; g1 = g0; v2 = v1; v1 = v0;
            }
            if (tid < 64) { const int qq = tid >> 4, ch = tid & 15, rl = qq < 2 ? qq : 124 + qq;
                *(u32x4*)(hal + ((size_t)tm * 4 + qq) * NUP + col0 + ch * 8) = *(const LAS u32x4*)(lds + rl * UST + ch * 16); }
        } else {
            if (tid < 64) { const int qq = tid >> 4, ch = tid & 15, rl = (qq >> 1) * 16 + 14 + (qq & 1);
                *(u32x4*)(hal + ((size_t)(128 + (qq >> 1)) * 4 + 2 + (qq & 1)) * NUP + col0 + ch * 8) = *(const LAS u32x4*)(lds + rl * UST + ch * 16); }
        }
        __syncthreads();
    }
}
__device__ __forceinline__ void phase_fix(const Params& p) {
    unsigned char* ws = p.ws;
    const bf16_t* hal = (const bf16_t*)(ws + WS_HAL); bf16_t* act = (bf16_t*)(ws + WS_ACT);
    constexpr int NCG = DFF / 4;
    for (int it = blockIdx.x * NTHREADS + threadIdx.x; it < 128 * NCG; it += gridDim.x * NTHREADS) {
        const int tmg = it / NCG, c = (it % NCG) * 4, colg = (c >> 6) * 128 + (c & 63), colv = colg + 64;
        const bf16_t* own = hal + (size_t)tmg * 4 * NUP;
        const bf16_t* prv = hal + (size_t)((tmg & 63) ? tmg - 1 : 128 + (tmg >> 6)) * 4 * NUP;
        const ConvW q = load_convw(p, c);
        const f32x4 pg2 = unpack4(*(const u32x2*)(prv + 2 * NUP + colg)), pv2 = unpack4(*(const u32x2*)(prv + 2 * NUP + colv));
        const f32x4 pg3 = unpack4(*(const u32x2*)(prv + 3 * NUP + colg)), pv3 = unpack4(*(const u32x2*)(prv + 3 * NUP + colv));
        const f32x4 og0 = unpack4(*(const u32x2*)(own + colg)), ov0 = unpack4(*(const u32x2*)(own + colv));
        const f32x4 og1 = unpack4(*(const u32x2*)(own + NUP + colg)), ov1 = unpack4(*(const u32x2*)(own + NUP + colv));
        *(u32x2*)(act + (size_t)(tmg * 128) * DFF + c) = conv_gelu4(q, pg2, pg3, og0, pv2, pv3, ov0);
        *(u32x2*)(act + (size_t)(tmg * 128 + 1) * DFF + c) = conv_gelu4(q, pg3, og0, og1, pv3, ov0, ov1);
    }
}
__device__ __forceinline__ void phase6(const Params& p, LAS char* lds) {
    unsigned char* ws = p.ws;
    const int lane = threadIdx.x & 63, w = wave_id(), wr = w >> 1, wc = w & 1;
    const bf16_t* act = (const bf16_t*)(ws + WS_ACT); bf16_t* ffn = (bf16_t*)(ws + WS_FFN);
    for (int it = 0;; ++it) {
        int tm, tn; const int st = tile_at(it, 128, 8, tm, tn); if (st == 0) break; if (st == 2) continue;
        const int col0 = tn * 128;
        f32x4 acc[4][4]; zero_acc(acc);
        gemm_main<true>(lds, act + (size_t)(tm * 128) * DFF, DFF, (const bf16_t*)(ws + WS_BTDN) + (size_t)col0 * DFF, DFF, 44, acc);
        epi_store_ss(acc, ffn, 1024, tm * 128, col0, (float*)(ws + WS_SSP4), tm * 128, wr, wc, lane);
    }
}
__device__ __forceinline__ void phase7(const Params& p) {
    unsigned char* ws = p.ws;
    const int lane = threadIdx.x & 63, w = wave_id();
    const bf16_t* ffn = (const bf16_t*)(ws + WS_FFN); const float* ssp4 = (const float*)(ws + WS_SSP4); const float* g3 = p.gains + 3 * D;
    f32x4 g[4];
#pragma unroll
    for (int i = 0; i < 4; ++i) g[i] = *(const f32x4*)(g3 + lane * 4 + 256 * i);
    for (int r0 = (blockIdx.x * 4 + w) * 2; r0 < MX; r0 += gridDim.x * 8) {
        f32x4 hh[2][4]; u32x2 f[2][4]; float sq[2];
#pragma unroll
        for (int j = 0; j < 2; ++j) {
            const int row = r0 + j;
            sq[j] = lane < 16 ? ssp4[(size_t)lane * M + row] : 0.f;
#pragma unroll
            for (int i = 0; i < 4; ++i) { hh[j][i] = *(const f32x4*)(p.out + (size_t)row * D + lane * 4 + 256 * i); f[j][i] = *(const u32x2*)(ffn + (size_t)row * D + lane * 4 + 256 * i); }
        }
#pragma unroll
        for (int j = 0; j < 2; ++j) {
            const float a = 1.0f / sqrtf(wave_sum(sq[j]) * (1.0f / D) + EPS);
#pragma unroll
            for (int i = 0; i < 4; ++i) {
                f32x4 o;
                o[0] = hh[j][i][0] + bf_lo(f[j][i][0]) * a * g[i][0]; o[1] = hh[j][i][1] + bf_hi(f[j][i][0]) * a * g[i][1];
                o[2] = hh[j][i][2] + bf_lo(f[j][i][1]) * a * g[i][2]; o[3] = hh[j][i][3] + bf_hi(f[j][i][1]) * a * g[i][3];
                *(f32x4*)(p.out + (size_t)(r0 + j) * D + lane * 4 + 256 * i) = o;
            }
        }
    }
}


#ifndef DUMP
#define DUMP 0
#endif
__device__ __forceinline__ void phase_dump(const Params& p) {
    unsigned char* ws = p.ws;
    const bf16_t* s0; const bf16_t* s1; int ld;
    if (DUMP == 1) { s0 = (const bf16_t*)(ws + WS_B); s1 = s0 + 512; ld = 1024; }
    else if (DUMP == 2) { s0 = (const bf16_t*)(ws + WS_QF); s1 = (const bf16_t*)(ws + WS_KF); ld = 512; }
    else if (DUMP == 3) { s0 = (const bf16_t*)(ws + WS_A); s1 = s0 + (size_t)M * 512; ld = 512; }
    else if (DUMP == 4) { s0 = (const bf16_t*)(ws + WS_GATED); s1 = s0 + 512; ld = 1024; }
    else if (DUMP == 8) { s0 = (const bf16_t*)(ws + WS_A); s1 = s0 + 512; ld = 1024; }
    else if (DUMP == 9) { s0 = (const bf16_t*)(ws + WS_ACT) + 1024; s1 = (const bf16_t*)(ws + WS_ACT) + 2304 - 512 + 512; ld = DFF; }
    else if (DUMP == 10) { s0 = (const bf16_t*)(ws + WS_FFN); s1 = s0 + 512; ld = 1024; }
    else if (DUMP == 6) { s0 = (const bf16_t*)(ws + WS_QS); s1 = (const bf16_t*)(ws + WS_KS); ld = 512; }
    else { s0 = (const bf16_t*)(ws + WS_MIXED); s1 = s0 + 512; ld = 1024; }
    for (int it = blockIdx.x * NTHREADS + threadIdx.x; it < MX * 1024; it += gridDim.x * NTHREADS) {
        const int row = it >> 10, col = it & 1023;
        if (DUMP >= 9 && row >= 8192) { p.out[it] = 0.f; continue; }
        const bf16_t v = col < 512 ? s0[(size_t)row * ld + col] : s1[(size_t)row * ld + col - 512];
        p.out[it] = __uint_as_float((unsigned)v << 16);
    }
}

__device__ __forceinline__ void l2_scrub(const Params& p) {
    const f32x4* src = (const f32x4*)p.x + (size_t)(blockIdx.x & 511) * 8192;
    f32x4 a = (f32x4){0.f, 0.f, 0.f, 0.f};
    for (int i = threadIdx.x; i < 8192; i += NTHREADS) a += src[i];
    if (a[0] + a[1] + a[2] + a[3] == 1.2345e-30f) ((float*)(p.ws + WS_CTL))[32 + (threadIdx.x & 7)] = a[0];
}


#define XB_TMO      128
#define XB_XCNT(j)  (256  + 64 * (j))
#define XB_XSUB(j)  (1280 + 64 * (j))
#define XB_XGEN(j)  (2304 + 64 * (j))
#define XB_TOP      3328
#define XB_TOPGEN   3392
#define XCD_BAR_WORDS 3456
#define XB_SPIN_CAP (1u << 18)
__device__ __forceinline__ unsigned xb_ld(unsigned* p)              { return __hip_atomic_load(p, __ATOMIC_RELAXED, __HIP_MEMORY_SCOPE_AGENT); }
__device__ __forceinline__ unsigned xb_add(unsigned* p, unsigned v) { return __hip_atomic_fetch_add(p, v, __ATOMIC_RELAXED, __HIP_MEMORY_SCOPE_AGENT); }
__device__ __forceinline__ unsigned xb_xcc_id() { return (unsigned)__builtin_amdgcn_s_getreg((3 << 11) | 20) & 0xFu; }
#define XB_SPIN(cond, bar) do { unsigned _sp = 0; while (cond) { __builtin_amdgcn_s_sleep(1); \
    if ((++_sp & 255u) == 0u) { if (xb_ld(&(bar)[XB_TMO])) break; if (_sp > XB_SPIN_CAP) { atomicAdd(&(bar)[XB_TMO], 1u); break; } } } } while (0)
struct XcdBarrier { unsigned* bar; unsigned x; volatile LAS unsigned* st; };
__device__ __forceinline__ XcdBarrier xcd_barrier_post(unsigned* bar, volatile LAS unsigned* st) {
    XcdBarrier b; b.bar = bar; b.x = xb_xcc_id(); b.st = st;
    if (threadIdx.x == 0) (void)xb_add(&bar[XB_XCNT(b.x)], 1u);
    return b;
}
__device__ __forceinline__ void xcd_barrier_complete(unsigned* bar, unsigned x, unsigned& nloc, unsigned& nx) {
    const unsigned G = gridDim.x * gridDim.y * gridDim.z;
    unsigned sum, cnt, mine, sp = 0u;
    for (;;) {
        sum = 0u; cnt = 0u; mine = 0u;
#pragma unroll
        for (unsigned j = 0; j < 16; ++j) { const unsigned c = xb_ld(&bar[XB_XCNT(j)]); sum += c; cnt += (c > 0u) ? 1u : 0u; mine = (j == x) ? c : mine; }
        if (sum == G) break;
        __builtin_amdgcn_s_sleep(1);
        if ((++sp & 255u) == 0u) { if (xb_ld(&bar[XB_TMO])) break; if (sp > XB_SPIN_CAP) { atomicAdd(&bar[XB_TMO], 1u); break; } }
    }
    nloc = mine > 0u ? mine : 1u; nx = cnt > 0u ? cnt : 1u;
}
__device__ __forceinline__ void xcd_barrier(const XcdBarrier& b) {
    asm volatile("s_waitcnt vmcnt(0)" ::: "memory");
    __syncthreads();
    if (threadIdx.x == 0) {
        unsigned* bar = b.bar;
        __builtin_amdgcn_s_waitcnt(0);
        unsigned nloc = b.st[0], nx = b.st[1];
        if (nloc == 0u) { xcd_barrier_complete(bar, b.x, nloc, nx); b.st[0] = nloc; b.st[1] = nx; }
        const unsigned old = xb_add(&bar[XB_XSUB(b.x)], 1u);
        const unsigned gen = old / nloc;
        if (old + 1u == (gen + 1u) * nloc) {
            __builtin_amdgcn_fence(__ATOMIC_RELEASE, "agent");
            asm volatile("s_waitcnt vmcnt(0)" ::: "memory");
            const unsigned og = xb_add(&bar[XB_TOP], 1u);
            const unsigned tg = og / nx;
            if (og + 1u == (tg + 1u) * nx) xb_add(&bar[XB_TOPGEN], 1u);
            else XB_SPIN(xb_ld(&bar[XB_TOPGEN]) == tg, bar);
            __builtin_amdgcn_fence(__ATOMIC_ACQUIRE, "agent");
            xb_add(&bar[XB_XGEN(b.x)], 1u);
            asm volatile("s_waitcnt vmcnt(0)" ::: "memory");
        } else {
            XB_SPIN(xb_ld(&bar[XB_XGEN(b.x)]) == gen, bar);
            __builtin_amdgcn_fence(__ATOMIC_ACQUIRE, "agent");
            asm volatile("s_waitcnt vmcnt(0)" ::: "memory");
        }
    }
    __syncthreads();
}

__device__ __forceinline__ void my_grid_sync(const Params& p, unsigned& target) {
    unsigned* bar = (unsigned*)(p.ws + WS_CTL) + 16;
    asm volatile("s_waitcnt vmcnt(0)" ::: "memory");
    __syncthreads();
    target += gridDim.x;
    if (threadIdx.x == 0) {
        __builtin_amdgcn_fence(__ATOMIC_RELEASE, "agent");
        asm volatile("s_waitcnt vmcnt(0)" ::: "memory");
        __hip_atomic_fetch_add(bar, 1u, __ATOMIC_RELAXED, __HIP_MEMORY_SCOPE_AGENT);
        while (__hip_atomic_load(bar, __ATOMIC_RELAXED, __HIP_MEMORY_SCOPE_AGENT) < target) __builtin_amdgcn_s_sleep(2);
        __builtin_amdgcn_fence(__ATOMIC_ACQUIRE, "agent");
        asm volatile("s_waitcnt vmcnt(0)" ::: "memory");
    }
    __syncthreads();
}
__global__ void __launch_bounds__(NTHREADS, 2) fwd_kernel(Params p) {
    extern __shared__ __attribute__((aligned(16))) unsigned char lds_raw[];
    LAS char* lds = (LAS char*)lds_raw;
    cg::grid_group grid = cg::this_grid();
#define IN(k) (p.ph_lo <= (k) && (k) < p.ph_hi)
#define SEAM(k) do { if (IN(k) && IN((k) + 1)) { if (p.ph_hi > 1000) grid.sync(); xcd_barrier(xbar); } } while (0)
    volatile LAS unsigned* xst = (volatile LAS unsigned*)(lds + 65536);
    if (threadIdx.x < 4) xst[threadIdx.x] = 0u;
    __syncthreads();
    const XcdBarrier xbar = xcd_barrier_post((unsigned*)(p.ws + WS_XBAR), xst);
    if (IN(0)) phase0(p, lds);
    SEAM(0);
    if (IN(1)) phase1(p, lds);
    SEAM(1);
    if (IN(2)) phase2(p, lds);
    SEAM(2);
    if (IN(3)) phase_comb(p);
    SEAM(3);
    if (IN(4)) phase3a(p, lds);
    SEAM(4);
    if (IN(5)) phase3b(p, lds);
    SEAM(5);
    if (IN(6)) phase3c(p);
    SEAM(6);
    if (IN(7)) phase4(p, lds);
    SEAM(7);
    if (IN(8)) phase_fix(p);
    SEAM(8);
    if (IN(9)) phase6(p, lds);
    SEAM(9);
    if (IN(10)) phase7(p);
#undef IN
#undef SEAM
}


__global__ void ab_save(const unsigned char* ws, float* out) {
    const u32x4* src = (const u32x4*)(ws + AB_SRC); u32x4* dst = (u32x4*)((unsigned char*)out + (size_t)32 * MiB);
    for (size_t i = blockIdx.x * (size_t)blockDim.x + threadIdx.x; i < (size_t)AB_BYTES / 16; i += (size_t)gridDim.x * blockDim.x) dst[i] = src[i];
}
__global__ void ab_diff(const unsigned char* ws, float* out) {
    const bf16_t* src = (const bf16_t*)(ws + AB_SRC); const bf16_t* sav = (const bf16_t*)((unsigned char*)out + (size_t)32 * MiB);
    for (size_t i = blockIdx.x * (size_t)blockDim.x + threadIdx.x; i < (size_t)8192 * 1024; i += (size_t)gridDim.x * blockDim.x) {
        if (i >= (size_t)AB_BYTES / 2) { out[i] = 0.f; continue; }
        out[i] = src[i] != sav[i] ? 1000.0f : 0.f;
    }
}
__global__ void ab_zero(float* out) {
    for (size_t i = blockIdx.x * (size_t)blockDim.x + threadIdx.x; i < (size_t)8192 * 1024; i += (size_t)gridDim.x * blockDim.x) out[(size_t)8192 * 1024 + i] = 0.f;
}
extern "C" void kernel_launch(void* const* d_in, const int* in_sizes, int n_in, void* d_out, int out_size, void* d_ws, size_t ws_size, hipStream_t stream) {
    static int grid_blocks = 0;
    if (grid_blocks == 0) {
        if (n_in != 12 || ws_size < WS_END) { fprintf(stderr, "kernel_launch: unexpected n_in %d or ws_size %zu (need %zu)\n", n_in, ws_size, (size_t)WS_END); grid_blocks = -1; return; }
        int dev = 0, cus = 0, per_cu = 0;
        (void)hipGetDevice(&dev);
        (void)hipDeviceGetAttribute(&cus, hipDeviceAttributeMultiprocessorCount, dev);
        (void)hipFuncSetAttribute((const void*)fwd_kernel, hipFuncAttributeMaxDynamicSharedMemorySize, LDS_BYTES);
        (void)hipOccupancyMaxActiveBlocksPerMultiprocessor(&per_cu, (const void*)fwd_kernel, NTHREADS, LDS_BYTES);
        if (per_cu < 1) per_cu = 1;
        if (per_cu > 2) per_cu = 2;
        grid_blocks = cus * per_cu;
        (void)hipGetLastError();
    }
    if (grid_blocks < 0) return;
    Params p{};
    p.x = (const float*)d_in[0]; p.meta = (const float*)d_in[1]; p.gains = (const float*)d_in[2]; p.w_in = (const float*)d_in[3];
    p.b_forget = (const float*)d_in[4]; p.w_o_fox = (const float*)d_in[5]; p.w_o_sb = (const float*)d_in[6]; p.w_out = (const float*)d_in[7];
    p.w_up = (const float*)d_in[8]; p.conv_w = (const float*)d_in[9]; p.conv_b = (const float*)d_in[10]; p.w_down = (const float*)d_in[11];
    p.out = (float*)d_out; p.ws = (unsigned char*)d_ws;
#if SINGLE_LAUNCH
    (void)hipMemsetAsync((unsigned char*)d_ws + WS_CTL, 0, 256, stream);
    (void)hipMemsetAsync((unsigned char*)d_ws + WS_XBAR, 0, XCD_BAR_WORDS * 4, stream);
    p.ph_lo = 0; p.ph_hi = NPHASE;
    void* args[] = {&p};
    hipError_t e = hipLaunchCooperativeKernel((const void*)fwd_kernel, dim3(grid_blocks), dim3(NTHREADS), args, LDS_BYTES, stream);
    if (e != hipSuccess) fprintf(stderr, "cooperative launch failed: %s (grid %d)\n", hipGetErrorString(e), grid_blocks);
#else
#ifndef STOP_AT
#define STOP_AT NPHASE
#endif
    for (int k = 0; k < STOP_AT; ++k) {
        p.ph_lo = k; p.ph_hi = k + 1;
        hipLaunchKernelGGL(fwd_kernel, dim3(grid_blocks), dim3(NTHREADS), LDS_BYTES, stream, p);
    }
#if ABTEST
    ab_save<<<1024, 256, 0, stream>>>(p.ws, p.out);
    for (int k = AB_FROM; k < STOP_AT; ++k) {
        p.ph_lo = k; p.ph_hi = k + 1;
        hipLaunchKernelGGL(fwd_kernel, dim3(grid_blocks), dim3(NTHREADS), LDS_BYTES, stream, p);
    }
    ab_diff<<<1024, 256, 0, stream>>>(p.ws, p.out);
    ab_zero<<<1024, 256, 0, stream>>>(p.out);
#endif

#endif
}
```

```cpp
#include <hip/hip_runtime.h>
#include <hip/hip_cooperative_groups.h>
#include <cstdio>
#include <cstdint>
namespace cg = cooperative_groups;

#define DUMP 0
#define ABTEST 0
#define AB_FROM 0
#define AB_SRC WS_SSP2
#define AB_BYTES (2 * MiB)
#ifndef SINGLE_LAUNCH
#define SINGLE_LAUNCH 1
#endif

#define LAS __attribute__((address_space(3)))
typedef unsigned short bf16_t;
typedef short bf16x8 __attribute__((ext_vector_type(8)));
typedef float f32x4 __attribute__((ext_vector_type(4)));
typedef float f32x16 __attribute__((ext_vector_type(16)));
typedef unsigned u32x4 __attribute__((ext_vector_type(4)));
typedef unsigned u32x2 __attribute__((ext_vector_type(2)));

constexpr int D = 1024, SEQ = 8192, NMETA = 16, NB = 2;
constexpr int MX = NB * SEQ;
constexpr int MV = MX + NB * NMETA;
constexpr int M = 16512;
constexpr int LPK = 8256;
constexpr int PROJW = 5128, NPROJ = 5120, DFF = 2816, NUP = 5632;
constexpr float EPS = 1e-6f;
constexpr float LOG2E = 1.4426950408889634f, LN2 = 0.6931471805599453f;
constexpr int NTHREADS = 256;
constexpr int LDS_BYTES = 65536 + 16;
constexpr int NPHASE = 11;

constexpr size_t MiB = 1u << 20;
constexpr size_t WS_CTL = 0;
constexpr size_t WS_R1 = 4096, WS_R2 = WS_R1 + 69632, WS_SS2 = WS_R2 + 69632, WS_SS4 = WS_SS2 + 69632;
constexpr size_t WS_LOGF = WS_SS4 + 69632, WS_CK = WS_LOGF + 528384, WS_UPMETA = WS_CK + 528384;
constexpr size_t WS_BTIN = 2 * MiB, WS_BTOF = WS_BTIN + 10 * MiB, WS_BTOS = WS_BTOF + 1 * MiB, WS_BTOUT = WS_BTOS + 1 * MiB,
                 WS_BTUP = WS_BTOUT + 2 * MiB, WS_BTDN = WS_BTUP + 11 * MiB;
constexpr size_t SZ_M1024 = (size_t)M * 1024 * 2, SZ_M512 = (size_t)M * 512 * 2;
constexpr size_t WS_A = 33 * MiB;
constexpr size_t WS_B = WS_A + SZ_M1024;
constexpr size_t WS_C = WS_B + 2 * SZ_M1024;
constexpr size_t WS_QF = WS_C, WS_KF = WS_QF + SZ_M512, WS_QS = WS_KF + SZ_M512, WS_KS = WS_QS + SZ_M512, WS_VFT = WS_KS + SZ_M512, WS_VST = WS_VFT + SZ_M512;
constexpr size_t WS_GATED = WS_C, WS_MIXED = WS_B + SZ_M1024;
constexpr size_t WS_ACT = WS_B;
constexpr size_t WS_FFN = WS_ACT + 132 * MiB;
constexpr size_t WS_SSP2 = 230 * MiB, WS_SSP4 = 232 * MiB;
constexpr size_t WS_HAL = 234 * MiB;
constexpr size_t WS_XBAR = 240 * MiB;
constexpr size_t WS_END = 241 * MiB;

struct Params {
    const float *x, *meta, *gains, *w_in, *b_forget, *w_o_fox, *w_o_sb, *w_out, *w_up, *conv_w, *conv_b, *w_down;
    float* out; unsigned char* ws; int ph_lo, ph_hi;
};

typedef __bf16 bf16x2_t __attribute__((ext_vector_type(2)));
__device__ __forceinline__ unsigned pk_bf16(float lo, float hi) { bf16x2_t v = {(__bf16)lo, (__bf16)hi}; return __builtin_bit_cast(unsigned, v); }
__device__ __forceinline__ float bf_lo(unsigned u) { return __uint_as_float(u << 16); }
__device__ __forceinline__ float bf_hi(unsigned u) { return __uint_as_float(u & 0xffff0000u); }
__device__ __forceinline__ float ex2(float x) { return __builtin_amdgcn_exp2f(x); }
__device__ __forceinline__ float lg2(float x) { return __builtin_amdgcn_logf(x); }
__device__ __forceinline__ float rcp(float x) { return __builtin_amdgcn_rcpf(x); }
__device__ __forceinline__ float sigmoidf_(float v) { return rcp(1.0f + ex2(-v * LOG2E)); }
__device__ __forceinline__ float wave_sum(float v) {
#pragma unroll
    for (int o = 32; o > 0; o >>= 1) v += __shfl_xor(v, o);
    return v;
}
__device__ __forceinline__ int wave_id() { return __builtin_amdgcn_readfirstlane((int)(threadIdx.x >> 6)); }

__device__ __forceinline__ void transpose_tile(LAS char* lds, const float* src, int ldsrc, int srccol, int k0, const float* gain, bf16_t* dst, int K, int n0) {
    LAS bf16_t* T = (LAS bf16_t*)lds;
    const int tid = threadIdx.x, r = tid >> 4, c4 = tid & 15;
#pragma unroll
    for (int p = 0; p < 4; ++p) {
        const int k = r + 16 * p;
        f32x4 v = *(const f32x4*)(src + (size_t)(k0 + k) * ldsrc + srccol + c4 * 4);
        const float g = gain ? gain[k0 + k] : 1.0f;
        const unsigned a = pk_bf16(v[0] * g, v[1] * g), b = pk_bf16(v[2] * g, v[3] * g);
        T[(c4 * 4 + 0) * 72 + k] = (bf16_t)(a & 0xffff); T[(c4 * 4 + 1) * 72 + k] = (bf16_t)(a >> 16);
        T[(c4 * 4 + 2) * 72 + k] = (bf16_t)(b & 0xffff); T[(c4 * 4 + 3) * 72 + k] = (bf16_t)(b >> 16);
    }
    __syncthreads();
    const int n = tid >> 2, kq = tid & 3;
    const u32x4 lo = *(LAS u32x4*)(T + n * 72 + kq * 16), hi = *(LAS u32x4*)(T + n * 72 + kq * 16 + 8);
    bf16_t* d = dst + (size_t)(n0 + n) * K + k0 + kq * 16;
    *(u32x4*)d = lo; *(u32x4*)(d + 8) = hi;
    __syncthreads();
}

__device__ __forceinline__ void phase0(const Params& p, LAS char* lds) {
    unsigned char* ws = p.ws;
    const int tid = threadIdx.x, lane = tid & 63, w = wave_id();
    LAS float* wfT = (LAS float*)lds;
    const float* g0 = p.gains;
    for (int idx = tid; idx < 8192; idx += NTHREADS) { const int h = idx & 7, k = idx >> 3; wfT[h * 1024 + k] = p.w_in[(size_t)k * PROJW + 1536 + h] * g0[k]; }
    __syncthreads();
    bf16_t* xb = (bf16_t*)(ws + WS_A);
    float* r1 = (float*)(ws + WS_R1);
    float* logf_ = (float*)(ws + WS_LOGF);
    for (int r_ = blockIdx.x * 32 + w; r_ < M; r_ += (r_ & 31) < 28 ? 4 : gridDim.x * 32 - 28) {
        const int r = r_;
        if (r >= MV) {
#pragma unroll
            for (int i = 0; i < 4; ++i) *(u32x2*)(xb + (size_t)r * D + lane * 4 + 256 * i) = (u32x2){0u, 0u};
            if (lane == 0) r1[r] = 0.f;
            continue;
        }
        const float* src = r < MX ? p.x + (size_t)r * D : p.meta + (size_t)((r - MX) & 15) * D;
        f32x4 v[4]; float ss = 0.f;
#pragma unroll
        for (int i = 0; i < 4; ++i) { v[i] = *(const f32x4*)(src + lane * 4 + 256 * i); ss += v[i][0] * v[i][0] + v[i][1] * v[i][1] + v[i][2] * v[i][2] + v[i][3] * v[i][3]; }
#pragma unroll
        for (int i = 0; i < 4; ++i) *(u32x2*)(xb + (size_t)r * D + lane * 4 + 256 * i) = (u32x2){pk_bf16(v[i][0], v[i][1]), pk_bf16(v[i][2], v[i][3])};
        ss = wave_sum(ss);
        const float rs = 1.0f / sqrtf(ss * (1.0f / D) + EPS);
        if (lane == 0) r1[r] = rs;
        float mine = 0.f;
#pragma unroll
        for (int h = 0; h < 8; ++h) {
            float a = 0.f;
#pragma unroll
            for (int i = 0; i < 4; ++i) { const f32x4 wv = *(LAS f32x4*)(wfT + h * 1024 + lane * 4 + 256 * i); a += v[i][0] * wv[0] + v[i][1] * wv[1] + v[i][2] * wv[2] + v[i][3] * wv[3]; }
            a = wave_sum(a);
            if (lane == h) mine = a;
        }
        if (lane < 8) {
            const float f = mine * rs + p.b_forget[lane];
            const float lf = fminf(f, 0.f) - log1pf(expf(-fabsf(f)));
            int b, kidx; if (r < MX) { b = r >> 13; kidx = r & 8191; } else { const int j = r - MX; b = j >> 4; kidx = 8192 + (j & 15); }
            logf_[(size_t)(b * 8 + lane) * LPK + kidx] = lf;
        }
    }
    __syncthreads();
    LAS char* tl = lds + 32768;
    const float* g2 = p.gains + 2 * D;
    constexpr int T_IN = 16 * 80, T_OF = 8 * 16, T_OS = 8 * 16, T_OUT = 16 * 16, T_UP = 16 * 88, T_DN = 44 * 16;
    constexpr int T_ALL = T_IN + T_OF + T_OS + T_OUT + T_UP + T_DN;
    for (int t = blockIdx.x; t < T_ALL; t += gridDim.x) {
        int u = t;
        if (u < T_IN) { const int nt = u % 80, kt = u / 80; const int sc = nt * 64 + (nt * 64 >= 1536 ? 8 : 0); transpose_tile(tl, p.w_in, PROJW, sc, kt * 64, g0, (bf16_t*)(ws + WS_BTIN), 1024, nt * 64); continue; }
        u -= T_IN;
        if (u < T_OF) { const int nt = u % 16, kt = u / 16; transpose_tile(tl, p.w_o_fox, 1024, nt * 64, kt * 64, nullptr, (bf16_t*)(ws + WS_BTOF), 512, nt * 64); continue; }
        u -= T_OF;
        if (u < T_OS) { const int nt = u % 16, kt = u / 16; transpose_tile(tl, p.w_o_sb, 1024, nt * 64, kt * 64, nullptr, (bf16_t*)(ws + WS_BTOS), 512, nt * 64); continue; }
        u -= T_OS;
        if (u < T_OUT) { const int nt = u % 16, kt = u / 16; transpose_tile(tl, p.w_out, 1024, nt * 64, kt * 64, nullptr, (bf16_t*)(ws + WS_BTOUT), 1024, nt * 64); continue; }
        u -= T_OUT;
        if (u < T_UP) { const int nt = u % 88, kt = u / 88; transpose_tile(tl, p.w_up, NUP, (nt & 1) * DFF + (nt >> 1) * 64, kt * 64, g2, (bf16_t*)(ws + WS_BTUP), 1024, nt * 64); continue; }
        u -= T_UP;
        { const int nt = u % 16, kt = u / 16; transpose_tile(tl, p.w_down, 1024, nt * 64, kt * 64, nullptr, (bf16_t*)(ws + WS_BTDN), DFF, nt * 64); }
    }
}

template <bool SWAP, bool FULL>
__device__ __forceinline__ void gemm_kloop(LAS char* lds, const bf16_t* Ag, int lda, const bf16_t* Bg, int ldb, int nk, f32x4 (&acc)[4][4], int mlim) {
    const int tid = threadIdx.x, lane = tid & 63, w = wave_id(), wr = w >> 1, wc = w & 1;
    const int row_0 = w * 8 + (lane >> 3), c_0 = (lane & 7) ^ ((row_0 >> 1) & 7);
    const bf16_t* pa0 = Ag + (size_t)row_0 * lda + c_0 * 8; const bf16_t* pb0 = Bg + (size_t)row_0 * ldb + c_0 * 8;
    const size_t sa = (size_t)32 * lda, sb_ = (size_t)32 * ldb;
    const int swz = (lane >> 1) & 7;
    int aoff[2], boff[2];
#pragma unroll
    for (int kh = 0; kh < 2; ++kh) {
        aoff[kh] = (wr * 64 + (lane & 15)) * 128 + (((kh * 4 + (lane >> 4)) ^ swz) << 4);
        boff[kh] = 16384 + (wc * 64 + (lane & 15)) * 128 + (((kh * 4 + (lane >> 4)) ^ swz) << 4);
    }
#define GM_STAGE(s, kt) do { _Pragma("unroll") for (int i_ = 0; i_ < 4; ++i_) { \
        __builtin_amdgcn_global_load_lds((const unsigned*)(pa0 + i_ * sa + (kt) * 64), (LAS unsigned*)(lds + (s) * 32768 + (i_ * 4 + w) * 1024), 16, 0, 0); \
        __builtin_amdgcn_global_load_lds((const unsigned*)(pb0 + i_ * sb_ + (kt) * 64), (LAS unsigned*)(lds + (s) * 32768 + 16384 + (i_ * 4 + w) * 1024), 16, 0, 0); } } while (0)
    GM_STAGE(0, 0);
    for (int kt = 0; kt < nk; ++kt) {
        asm volatile("s_waitcnt vmcnt(0)" ::: "memory");
        __syncthreads();
        const int s = kt & 1;
        if (kt + 1 < nk) GM_STAGE(s ^ 1, kt + 1);
        bf16x8 af[4][2], bf[4][2];
#pragma unroll
        for (int kh = 0; kh < 2; ++kh) {
#pragma unroll
            for (int m = 0; m < 4; ++m) if (FULL || m < mlim) af[m][kh] = *(LAS bf16x8*)(lds + s * 32768 + aoff[kh] + m * 2048);
#pragma unroll
            for (int n = 0; n < 4; ++n) bf[n][kh] = *(LAS bf16x8*)(lds + s * 32768 + boff[kh] + n * 2048);
        }
        __builtin_amdgcn_s_setprio(1);
#pragma unroll
        for (int kh = 0; kh < 2; ++kh)
#pragma unroll
            for (int m = 0; m < 4; ++m) if (FULL || m < mlim) {
#pragma unroll
                for (int n = 0; n < 4; ++n)
                    acc[m][n] = SWAP ? __builtin_amdgcn_mfma_f32_16x16x32_bf16(bf[n][kh], af[m][kh], acc[m][n], 0, 0, 0)
                                     : __builtin_amdgcn_mfma_f32_16x16x32_bf16(af[m][kh], bf[n][kh], acc[m][n], 0, 0, 0);
            }
        __builtin_amdgcn_s_setprio(0);
    }
    __syncthreads();
#undef GM_STAGE
}
template <bool SWAP>
__device__ __forceinline__ void gemm_main(LAS char* lds, const bf16_t* Ag, int lda, const bf16_t* Bg, int ldb, int nk, f32x4 (&acc)[4][4], int mlim = 4) {
    if (mlim == 4) gemm_kloop<SWAP, true>(lds, Ag, lda, Bg, ldb, nk, acc, 4);
    else gemm_kloop<SWAP, false>(lds, Ag, lda, Bg, ldb, nk, acc, mlim);
}
__device__ __forceinline__ void zero_acc(f32x4 (&acc)[4][4]) {
#pragma unroll
    for (int m = 0; m < 4; ++m)
#pragma unroll
        for (int n = 0; n < 4; ++n) acc[m][n] = (f32x4){0.f, 0.f, 0.f, 0.f};
}


__device__ __forceinline__ int tile_at(int it, int ntm, int ntn, int& tm, int& tn) {
    const int G = gridDim.x;
    if (G % 256 != 0) { const int t = it * G + blockIdx.x; if (t >= ntm * ntn) return 0; tm = t / ntn; tn = t % ntn; return 1; }
    const int xcd = blockIdx.x & 7, j = blockIdx.x >> 3, ppx = G >> 8;
    const int pcols = (ntn + 3) >> 2, prows = (ntm + 7) >> 3;
    const int patch = (it * ppx + (j >> 5)) * 8 + xcd;
    if (patch >= prows * pcols) return 0;
    const int wi = j & 31;
    tm = (patch / pcols) * 8 + (wi >> 2); tn = (patch % pcols) * 4 + (wi & 3);
    return (tm < ntm && tn < ntn) ? 1 : 2;
}
__device__ __forceinline__ void cumsum_block(const Params& p, LAS char* lds, int bh) {
    const float* lf = (const float*)(p.ws + WS_LOGF) + (size_t)bh * LPK; float* ck = (float*)(p.ws + WS_CK) + (size_t)bh * LPK;
    LAS float* wsum = (LAS float*)lds;
    const int tid = threadIdx.x, lane = tid & 63, w = wave_id(); constexpr int PER = 33, L = SEQ + NMETA;
    float v[PER];
#pragma unroll
    for (int e = 0; e < PER; ++e) { const int t = e * NTHREADS + tid; const int tc = t < L ? t : L - 1; const float x = lf[tc < 16 ? 8192 + tc : tc - 16]; v[e] = t < L ? x : 0.f; }
    float carry = 0.f;
#pragma unroll
    for (int e = 0; e < PER; ++e) {
        float x = v[e];
#pragma unroll
        for (int o = 1; o < 64; o <<= 1) { const float y = __shfl_up(x, o); if (lane >= o) x += y; }
        if (lane == 63) wsum[(e & 1) * 4 + w] = x;
        __syncthreads();
        const float s0 = wsum[(e & 1) * 4 + 0], s1 = wsum[(e & 1) * 4 + 1], s2 = wsum[(e & 1) * 4 + 2], s3 = wsum[(e & 1) * 4 + 3];
        const float pre = (w > 0 ? s0 : 0.f) + (w > 1 ? s1 : 0.f) + (w > 2 ? s2 : 0.f);
        const int t = e * NTHREADS + tid;
        if (t < L) ck[t < 16 ? 8192 + t : t - 16] = (carry + pre + x) * LOG2E;
        carry += (s0 + s1) + (s2 + s3);
    }
    __syncthreads();
}

__device__ __forceinline__ void phase1(const Params& p, LAS char* lds) {
    unsigned char* ws = p.ws;
    if ((int)blockIdx.x >= (int)gridDim.x - 16) cumsum_block(p, lds, gridDim.x - 1 - blockIdx.x);
    const int lane = threadIdx.x & 63, w = wave_id(), wr = w >> 1, wc = w & 1;
    const bf16_t* xb = (const bf16_t*)(ws + WS_A); const bf16_t* Bt = (const bf16_t*)(ws + WS_BTIN);
    const float* r1 = (const float*)(ws + WS_R1);
    constexpr int NTN = 40, NTM = 129;
    for (int it = 0;; ++it) {
        int tm, tn; int st = tile_at(it, NTM - 1, NTN, tm, tn);
        if (st == 0) { if (it < (1 << 20) && (int)blockIdx.x < NTN) { tm = NTM - 1; tn = blockIdx.x; it = 1 << 20; st = 1; } else break; }
        if (st == 2) continue;
        const int row0 = tm * 128, col0 = tn * 128; const int mlim = tm == NTM - 1 ? (wr == 0 ? 2 : 0) : 4;
        const bool vtile = (tn >= 8 && tn < 12) || (tn >= 20 && tn < 24);
        f32x4 acc[4][4]; zero_acc(acc);
        if (vtile) {
            gemm_main<false>(lds, xb + (size_t)row0 * D, D, Bt + (size_t)col0 * D, D, 16, acc, mlim);
            bf16_t* vT = (bf16_t*)(ws + (tn < 12 ? WS_VFT : WS_VST)); const int cb = tn < 12 ? 1024 : 2560;
            const int g = lane >> 4, gp = ((g & 1) << 1) | (g >> 1);
#pragma unroll
            for (int m = 0; m < 4; ++m) {
                const int rb = row0 + wr * 64 + m * 16; int b, kb16;
                if (rb < MX) { b = rb >> 13; kb16 = rb & 8191; } else { const int j = rb - MX; if (j >= 32) continue; b = j >> 4; kb16 = 8192; }
                const f32x4 rs = *(const f32x4*)(r1 + rb + g * 4);
#pragma unroll
                for (int n = 0; n < 4; ++n) {
                    const int dc = col0 + wc * 64 + n * 16 + (lane & 15) - cb, h = dc >> 6, d = dc & 63;
                    const f32x4 v = acc[m][n] * rs;
                    *(u32x2*)(vT + ((size_t)(b * 8 + h) * 64 + d) * LPK + kb16 + gp * 4) = (u32x2){pk_bf16(v[0], v[1]), pk_bf16(v[2], v[3])};
                }
            }
        } else {
            gemm_main<true>(lds, xb + (size_t)row0 * D, D, Bt + (size_t)col0 * D, D, 16, acc, mlim);
            bf16_t* dst; int ld, cb; float sc = 1.f; bool sg = false;
            if (tn < 4) { dst = (bf16_t*)(ws + WS_QF); ld = 512; cb = 0; sc = 0.125f * LOG2E; }
            else if (tn < 8) { dst = (bf16_t*)(ws + WS_KF); ld = 512; cb = 512; }
            else if (tn < 16) { dst = (bf16_t*)(ws + WS_QS); ld = 512; cb = 1536; sc = 0.125f; }
            else if (tn < 20) { dst = (bf16_t*)(ws + WS_KS); ld = 512; cb = 2048; }
            else if (tn < 32) { dst = (bf16_t*)(ws + WS_B); ld = 1024; cb = 3072; sg = true; }
            else { dst = (bf16_t*)(ws + WS_B + SZ_M1024); ld = 1024; cb = 4096; sg = true; }
            const bool kfox = tn >= 4 && tn < 8;
            float wmax = 0.f;
#pragma unroll
            for (int m = 0; m < 4; ++m) {
                const int row = row0 + wr * 64 + m * 16 + (lane & 15); const float rs = r1[row] * sc;
                float s2 = 0.f;
#pragma unroll
                for (int n = 0; n < 4; ++n) {
                    const int col = col0 + wc * 64 + n * 16 + (lane >> 4) * 4 - cb;
                    f32x4 v = acc[m][n] * rs;
                    if (sg) { v[0] = sigmoidf_(v[0]); v[1] = sigmoidf_(v[1]); v[2] = sigmoidf_(v[2]); v[3] = sigmoidf_(v[3]); }
                    s2 += v[0] * v[0] + v[1] * v[1] + v[2] * v[2] + v[3] * v[3];
                    *(u32x2*)(dst + (size_t)row * ld + col) = (u32x2){pk_bf16(v[0], v[1]), pk_bf16(v[2], v[3])};
                }
                if (kfox) { s2 += __shfl_xor(s2, 16); s2 += __shfl_xor(s2, 32); wmax = fmaxf(wmax, s2); }
            }
            if (kfox) {
#pragma unroll
                for (int o = 1; o < 16; o <<= 1) wmax = fmaxf(wmax, __shfl_xor(wmax, o));
                if (lane == 0) {
                    unsigned* km = (unsigned*)(ws + WS_CTL) + 32; const int head = (tn - 4) * 2 + wc; const unsigned bits = __float_as_uint(wmax);
                    if (row0 < MX) atomicMax(km + (row0 >> 13) * 8 + head, bits);
                    else { atomicMax(km + head, bits); atomicMax(km + 8 + head, bits); }
                }
            }
        }
    }
}

constexpr int AT_STAGE = 16640;
template <int TYPE>
__device__ __forceinline__ void attn_unit(LAS char* lds, const Params& p, int b, int h, int qb, int part = 0) {
    unsigned char* ws = p.ws;
    const int tid = threadIdx.x, lane = tid & 63, w = wave_id(), ql = lane & 31, hi = lane >> 5;
    const bf16_t* Q = (const bf16_t*)(ws + (TYPE == 0 ? WS_QF : WS_QS));
    const bf16_t* Kp = (const bf16_t*)(ws + (TYPE == 0 ? WS_KF : WS_KS));
    const bf16_t* VT = (const bf16_t*)(ws + (TYPE == 0 ? WS_VFT : WS_VST)) + (size_t)(b * 8 + h) * 64 * LPK;
    const float* cK = (const float*)(ws + WS_CK) + (size_t)(b * 8 + h) * LPK;
    bf16_t* Oo = (bf16_t*)(ws + WS_A + (TYPE == 0 ? 0 : SZ_M512));
    const bool meta_unit = qb < 0;
    const int qrow0 = meta_unit ? MX + 16 * b : b * SEQ + qb * 128;
    const int nt = meta_unit ? 1 : 2 * qb + 3;
    int qrow = qrow0 + 32 * w + ql; if (qrow > M - 1) qrow = M - 1;
    bf16x8 qf[4];
#pragma unroll
    for (int ds = 0; ds < 4; ++ds) qf[ds] = *(const bf16x8*)(Q + (size_t)qrow * 512 + h * 64 + ds * 16 + hi * 8);
    f32x16 O0, O1;
#pragma unroll
    for (int i = 0; i < 16; ++i) { O0[i] = 0.f; O1[i] = 0.f; }
    float m_run = -INFINITY, lsum = 0.f, R = 0.f;
    const int JA = qb + 2;
    const int j0 = part == 2 ? JA : 0, j1 = part == 1 ? JA : nt;
    if (TYPE == 0 && part == 2) {
        float dg = 0.f;
#pragma unroll
        for (int ds = 0; ds < 4; ++ds) {
            const bf16x8 kd = *(const bf16x8*)(Kp + (size_t)qrow * 512 + h * 64 + ds * 16 + hi * 8);
#pragma unroll
            for (int e = 0; e < 8; ++e) dg += __uint_as_float((unsigned)(unsigned short)qf[ds][e] << 16) * __uint_as_float((unsigned)(unsigned short)kd[e] << 16);
        }
        dg += __shfl_xor(dg, 32);
        m_run = dg - cK[qb * 128 + 32 * w + ql] - 1.0f;
    }
    float qbound = 0.f;
    if (TYPE == 0) {
        float q2 = 0.f;
#pragma unroll
        for (int ds = 0; ds < 4; ++ds)
#pragma unroll
            for (int e = 0; e < 8; ++e) { const float x = __uint_as_float((unsigned)(unsigned short)qf[ds][e] << 16); q2 += x * x; }
        q2 += __shfl_xor(q2, 32);
        const unsigned kb = __hip_atomic_load((unsigned*)(ws + WS_CTL) + 32 + b * 8 + h, __ATOMIC_RELAXED, __HIP_MEMORY_SCOPE_AGENT);
        qbound = sqrtf(q2) * sqrtf(__uint_as_float(kb)) * 1.02f + 1.0f;
    }
    u32x4 kreg[2], vreg[2]; float creg = 0.f;
    const int srow = tid >> 3, spos = tid & 7;
    const int swz_st = (spos ^ ((srow >> 1) & 7)) << 4;
    const int swz = (lane >> 1) & 7;
    LAS unsigned* flags = (LAS unsigned*)(lds + 2 * AT_STAGE);
#define AT_LOAD(j) do { int krow0_, kidx0_; if (!meta_unit && (j) < nt - 1) { const int kt_ = nt - 2 - (j); krow0_ = b * SEQ + 64 * kt_; kidx0_ = 64 * kt_; } else { krow0_ = MX + 16 * b; kidx0_ = 8192; } \
        _Pragma("unroll") for (int i_ = 0; i_ < 2; ++i_) { \
            kreg[i_] = *(const u32x4*)(Kp + (size_t)(krow0_ + srow + 32 * i_) * 512 + h * 64 + spos * 8); \
            vreg[i_] = *(const u32x4*)(VT + (size_t)(srow + 32 * i_) * LPK + kidx0_ + spos * 8); } \
        if (TYPE == 0 && tid < 64) creg = cK[kidx0_ + tid]; } while (0)
#define AT_WRITE(s) do { _Pragma("unroll") for (int i_ = 0; i_ < 2; ++i_) { \
            *(LAS u32x4*)(lds + (s) * AT_STAGE + (srow + 32 * i_) * 128 + swz_st) = kreg[i_]; \
            *(LAS u32x4*)(lds + (s) * AT_STAGE + 8192 + (srow + 32 * i_) * 128 + swz_st) = vreg[i_]; } \
        if (TYPE == 0 && tid < 64) *(LAS float*)(lds + (s) * AT_STAGE + 16384 + tid * 4) = creg; } while (0)
    AT_LOAD(j0); AT_WRITE(j0 & 1);
    __syncthreads();
    for (int j = j0; j < j1; ++j) {
        const bool more = j + 1 < j1;
        if (more) AT_LOAD(j + 1);
        int klim, d0;
        if (meta_unit) { klim = 16; d0 = 0; }
        else if (j == nt - 1) { klim = 16; d0 = 1 << 20; }
        else { klim = 64; d0 = 128 * qb - 64 * (nt - 2 - j); if (d0 >= 64) d0 = 1 << 20; }
        const int limw = 32 * w + d0 - TYPE;
        bool wdone = false, nomax = false;
        if (TYPE == 0) {
            const float clast = *(const LAS float*)(lds + (j & 1) * AT_STAGE + 16384 + (klim - 1) * 4);
            wdone = __all((qbound - clast - m_run) < -126.0f) != 0;
            nomax = __all((qbound - clast) <= m_run) != 0;
        }
        if (limw + 31 >= 0 && !(TYPE == 0 && wdone)) {
            const LAS char* sb = lds + (j & 1) * AT_STAGE;
            int kmax = limw + ql; if (kmax > klim - 1) kmax = klim - 1;
            const bool needmask = (klim < 64) || (limw < 63);
            f32x16 S0, S1;
#pragma unroll
            for (int i = 0; i < 16; ++i) { S0[i] = 0.f; S1[i] = 0.f; }
#pragma unroll
            for (int ds = 0; ds < 4; ++ds) {
                const bf16x8 k0 = *(const LAS bf16x8*)(sb + ql * 128 + (((2 * ds + hi) ^ swz) << 4));
                const bf16x8 k1 = *(const LAS bf16x8*)(sb + (32 + ql) * 128 + (((2 * ds + hi) ^ swz) << 4));
                S0 = __builtin_amdgcn_mfma_f32_32x32x16_bf16(k0, qf[ds], S0, 0, 0, 0);
                S1 = __builtin_amdgcn_mfma_f32_32x32x16_bf16(k1, qf[ds], S1, 0, 0, 0);
            }
            if (TYPE == 0) {
#pragma unroll
                for (int g = 0; g < 4; ++g) {
                    const f32x4 c0 = *(const LAS f32x4*)(sb + 16384 + (8 * g + 4 * hi) * 4), c1 = *(const LAS f32x4*)(sb + 16384 + (32 + 8 * g + 4 * hi) * 4);
#pragma unroll
                    for (int i = 0; i < 4; ++i) { S0[4 * g + i] -= c0[i]; S1[4 * g + i] -= c1[i]; }
                }
                if (needmask) {
#pragma unroll
                    for (int r = 0; r < 16; ++r) { const int kl = (r & 3) + 8 * (r >> 2) + 4 * hi; if (kl > kmax) S0[r] = -INFINITY; if (kl + 32 > kmax) S1[r] = -INFINITY; }
                }
                if (!nomax) {
                    float mx = -INFINITY;
#pragma unroll
                    for (int r = 0; r < 16; ++r) mx = fmaxf(mx, fmaxf(S0[r], S1[r]));
                    mx = fmaxf(mx, __shfl_xor(mx, 32));
                    const float m_new = fmaxf(m_run, mx), alpha = ex2(m_run - m_new);
                    m_run = m_new;
                    lsum *= alpha;
#pragma unroll
                    for (int r = 0; r < 16; ++r) { O0[r] *= alpha; O1[r] *= alpha; }
                }
                float ps = 0.f;
#pragma unroll
                for (int r = 0; r < 16; ++r) { S0[r] = ex2(S0[r] - m_run); S1[r] = ex2(S1[r] - m_run); ps += S0[r] + S1[r]; }
                lsum += ps;
            } else {
                float G0[4], G1[4];
                f32x16 L0, L1;
#pragma unroll
                for (int r = 0; r < 16; ++r) {
                    const int kl = (r & 3) + 8 * (r >> 2) + 4 * hi;
                    const float z0 = S0[r], z1 = S1[r];
                    const float sp0 = fmaxf(z0, 0.f) + lg2(1.0f + ex2(-fabsf(z0) * LOG2E)) * LN2;
                    const float sp1 = fmaxf(z1, 0.f) + lg2(1.0f + ex2(-fabsf(z1) * LOG2E)) * LN2;
                    L0[r] = (!needmask || kl <= kmax) ? -sp0 : 0.f;
                    L1[r] = (!needmask || kl + 32 <= kmax) ? -sp1 : 0.f;
                }
#pragma unroll
                for (int g = 0; g < 4; ++g) {
                    L0[4 * g + 2] += L0[4 * g + 3]; L0[4 * g + 1] += L0[4 * g + 2]; L0[4 * g] += L0[4 * g + 1]; G0[g] = L0[4 * g];
                    L1[4 * g + 2] += L1[4 * g + 3]; L1[4 * g + 1] += L1[4 * g + 2]; L1[4 * g] += L1[4 * g + 1]; G1[g] = L1[4 * g];
                }
                float run = R;
#pragma unroll
                for (int g = 3; g >= 0; --g) {
                    const float gp = __shfl_xor(G1[g], 32);
                    const float off = hi ? run : run + gp;
#pragma unroll
                    for (int i = 0; i < 4; ++i) { const int r = 4 * g + i; const int kl = 32 + i + 8 * g + 4 * hi;
                        const float a = ex2((S1[r] + L1[r] + off) * LOG2E); S1[r] = (!needmask || kl <= kmax) ? a : 0.f; }
                    run += G1[g] + gp;
                }
#pragma unroll
                for (int g = 3; g >= 0; --g) {
                    const float gp = __shfl_xor(G0[g], 32);
                    const float off = hi ? run : run + gp;
#pragma unroll
                    for (int i = 0; i < 4; ++i) { const int r = 4 * g + i; const int kl = i + 8 * g + 4 * hi;
                        const float a = ex2((S0[r] + L0[r] + off) * LOG2E); S0[r] = (!needmask || kl <= kmax) ? a : 0.f; }
                    run += G0[g] + gp;
                }
                R = run;
                wdone = __all(R < -120.0f) != 0;
            }
#pragma unroll
            for (int ks = 0; ks < 4; ++ks) {
                bf16x8 pf; u32x4 pu;
                if (ks < 2) { pu = (u32x4){pk_bf16(S0[8 * ks + 0], S0[8 * ks + 1]), pk_bf16(S0[8 * ks + 2], S0[8 * ks + 3]), pk_bf16(S0[8 * ks + 4], S0[8 * ks + 5]), pk_bf16(S0[8 * ks + 6], S0[8 * ks + 7])}; }
                else { const int k2 = ks - 2; pu = (u32x4){pk_bf16(S1[8 * k2 + 0], S1[8 * k2 + 1]), pk_bf16(S1[8 * k2 + 2], S1[8 * k2 + 3]), pk_bf16(S1[8 * k2 + 4], S1[8 * k2 + 5]), pk_bf16(S1[8 * k2 + 6], S1[8 * k2 + 7])}; }
                pf = __builtin_bit_cast(bf16x8, pu);
                const bf16x8 v0 = *(const LAS bf16x8*)(sb + 8192 + ql * 128 + (((2 * ks + hi) ^ swz) << 4));
                const bf16x8 v1 = *(const LAS bf16x8*)(sb + 8192 + (32 + ql) * 128 + (((2 * ks + hi) ^ swz) << 4));
                O0 = __builtin_amdgcn_mfma_f32_32x32x16_bf16(v0, pf, O0, 0, 0, 0);
                O1 = __builtin_amdgcn_mfma_f32_32x32x16_bf16(v1, pf, O1, 0, 0, 0);
            }
        }
        if (more) AT_WRITE((j + 1) & 1);
        if (lane == 0) flags[(j & 1) * 4 + w] = wdone ? 1u : 0u;
        __syncthreads();
        { const LAS unsigned* fl = flags + (j & 1) * 4; const unsigned f = fl[0] & fl[1] & fl[2] & fl[3]; if (f) break; }
    }
    float inv = 1.0f;
    if (TYPE == 0) { const float l = lsum + __shfl_xor(lsum, 32); inv = 1.0f / l; }
    const bool qvalid = meta_unit ? (w == 0 && ql < 16) : true;
    if (TYPE == 0 && part != 0) {
        float* rec = p.out + ((size_t)((((63 - qb) * 16 + b * 8 + h) * 2 + (part - 1)) * 128 + 32 * w + ql)) * 68;
        const float l = lsum + __shfl_xor(lsum, 32);
#pragma unroll
        for (int g = 0; g < 4; ++g) {
            *(f32x4*)(rec + 8 * g + 4 * hi) = (f32x4){O0[4 * g], O0[4 * g + 1], O0[4 * g + 2], O0[4 * g + 3]};
            *(f32x4*)(rec + 32 + 8 * g + 4 * hi) = (f32x4){O1[4 * g], O1[4 * g + 1], O1[4 * g + 2], O1[4 * g + 3]};
        }
        if (hi == 0) { rec[64] = m_run; rec[65] = l; }
    } else if (qvalid) {
        bf16_t* op = Oo + (size_t)qrow * 512 + h * 64 + 4 * hi;
#pragma unroll
        for (int g = 0; g < 4; ++g) {
            *(u32x2*)(op + 8 * g) = (u32x2){pk_bf16(O0[4 * g] * inv, O0[4 * g + 1] * inv), pk_bf16(O0[4 * g + 2] * inv, O0[4 * g + 3] * inv)};
            *(u32x2*)(op + 32 + 8 * g) = (u32x2){pk_bf16(O1[4 * g] * inv, O1[4 * g + 1] * inv), pk_bf16(O1[4 * g + 2] * inv, O1[4 * g + 3] * inv)};
        }
    }
    __syncthreads();
#undef AT_LOAD
#undef AT_WRITE
}


__device__ __forceinline__ void phase_comb(const Params& p) {
    bf16_t* oa = (bf16_t*)(p.ws + WS_A);
    for (int it = blockIdx.x * NTHREADS + threadIdx.x; it < 512 * 128 * 16; it += gridDim.x * NTHREADS) {
        const int d4 = it & 15, row = (it >> 4) & 127, su = it >> 11;
        const float* ra = p.out + ((size_t)((su * 2) * 128 + row)) * 68; const float* rb = ra + (size_t)128 * 68;
        const float ma = ra[64], la = ra[65], mb = rb[64], lb = rb[65];
        const float m = fmaxf(ma, mb), wa = ex2(ma - m), wb = ex2(mb - m), inv = 1.0f / (la * wa + lb * wb);
        const f32x4 a = *(const f32x4*)(ra + d4 * 4), bq = *(const f32x4*)(rb + d4 * 4);
        const f32x4 o = (a * wa + bq * wb) * inv;
        const int qb = 63 - (su >> 4), bh = su & 15;
        *(u32x2*)(oa + (size_t)((bh >> 3) * SEQ + qb * 128 + row) * 512 + (bh & 7) * 64 + d4 * 4) = (u32x2){pk_bf16(o[0], o[1]), pk_bf16(o[2], o[3])};
    }
}
__device__ __forceinline__ void phase2(const Params& p, LAS char* lds) {
    unsigned* ctr = (unsigned*)(p.ws + WS_CTL);
    LAS unsigned* shu = (LAS unsigned*)(lds + 2 * AT_STAGE + 64);
    constexpr int NU = 2560 + 32;
    for (;;) {
        if (threadIdx.x == 0) shu[0] = __hip_atomic_fetch_add(ctr, 1u, __ATOMIC_RELAXED, __HIP_MEMORY_SCOPE_AGENT);
        __syncthreads();
        const int u = (int)shu[0];
        __syncthreads();
        if (u >= NU) break;
        if (u < 1280) {
            const int pr = u / 80, r = u - pr * 80;
            if (r < 32) attn_unit<0>(lds, p, (r >> 1) >> 3, (r >> 1) & 7, 63 - 2 * pr, 1 + (r & 1));
            else if (r < 48) attn_unit<0>(lds, p, (r - 32) >> 3, (r - 32) & 7, 31 - pr);
            else { const int q = r - 48; attn_unit<0>(lds, p, (q >> 1) >> 3, (q >> 1) & 7, 62 - 2 * pr, 1 + (q & 1)); }
        }
        else if (u < 1536) { const int v = u - 1280; attn_unit<0>(lds, p, (v & 15) >> 3, v & 7, 15 - (v >> 4)); }
        else if (u < 2560) { const int v = u - 1536; attn_unit<1>(lds, p, (v & 15) >> 3, v & 7, 63 - (v >> 4)); }
        else if (u < 2576) { const int v = u - 2560; attn_unit<0>(lds, p, v >> 3, v & 7, -1); }
        else { const int v = u - 2576; attn_unit<1>(lds, p, v >> 3, v & 7, -1); }
    }
}

__device__ __forceinline__ void phase3a(const Params& p, LAS char* lds) {
    unsigned char* ws = p.ws;
    const int lane = threadIdx.x & 63, w = wave_id(), wr = w >> 1, wc = w & 1;
    const bf16_t* oa = (const bf16_t*)(ws + WS_A); const bf16_t* ob = oa + (size_t)M * 512;
    const bf16_t* ga = (const bf16_t*)(ws + WS_B); const bf16_t* gb = ga + (size_t)M * 1024;
    bf16_t* gated = (bf16_t*)(ws + WS_GATED);
    for (int it = 0;; ++it) {
        int tm, tn; int st = tile_at(it, 128, 8, tm, tn);
        if (st == 0) { if (it < (1 << 20) && (int)blockIdx.x < 8) { tm = 128; tn = blockIdx.x; it = 1 << 20; st = 1; } else break; }
        if (st == 2) continue;
        const int row0 = tm * 128, col0 = tn * 128; const int mlim = tm == 128 ? (wr == 0 ? 2 : 0) : 4;
        f32x4 acc[4][4]; zero_acc(acc);
        gemm_main<true>(lds, oa + (size_t)row0 * 512, 512, (const bf16_t*)(ws + WS_BTOF) + (size_t)col0 * 512, 512, 8, acc, mlim);
#pragma unroll
        for (int m = 0; m < 4; ++m) {
            const int row = row0 + wr * 64 + m * 16 + (lane & 15);
#pragma unroll
            for (int n = 0; n < 4; ++n) {
                const int col = col0 + wc * 64 + n * 16 + (lane >> 4) * 4;
                const u32x2 a = *(const u32x2*)(ga + (size_t)row * 1024 + col);
                const f32x4 x = acc[m][n];
                *(u32x2*)(gated + (size_t)row * 1024 + col) = (u32x2){pk_bf16(bf_lo(a[0]) * x[0], bf_hi(a[0]) * x[1]), pk_bf16(bf_lo(a[1]) * x[2], bf_hi(a[1]) * x[3])};
            }
        }
        zero_acc(acc);
        gemm_main<true>(lds, ob + (size_t)row0 * 512, 512, (const bf16_t*)(ws + WS_BTOS) + (size_t)col0 * 512, 512, 8, acc, mlim);
#pragma unroll
        for (int m = 0; m < 4; ++m) {
            const int row = row0 + wr * 64 + m * 16 + (lane & 15);
#pragma unroll
            for (int n = 0; n < 4; ++n) {
                const int col = col0 + wc * 64 + n * 16 + (lane >> 4) * 4;
                const u32x2 b = *(const u32x2*)(gb + (size_t)row * 1024 + col);
                const f32x4 y = acc[m][n]; const u32x2 q = *(const u32x2*)(gated + (size_t)row * 1024 + col);
                const float o0 = bf_lo(q[0]) + bf_lo(b[0]) * y[0], o1 = bf_hi(q[0]) + bf_hi(b[0]) * y[1];
                const float o2 = bf_lo(q[1]) + bf_lo(b[1]) * y[2], o3 = bf_hi(q[1]) + bf_hi(b[1]) * y[3];
                *(u32x2*)(gated + (size_t)row * 1024 + col) = (u32x2){pk_bf16(o0, o1), pk_bf16(o2, o3)};
            }
        }
    }
}
__device__ __forceinline__ void epi_store_ss(const f32x4 (&acc)[4][4], bf16_t* out, int ldo, int orow0, int col0, float* ssp, int ssrow0, int wr, int wc, int lane) {
#pragma unroll
    for (int m = 0; m < 4; ++m) {
        const int rl = wr * 64 + m * 16 + (lane & 15);
        float s = 0.f;
#pragma unroll
        for (int n = 0; n < 4; ++n) {
            const int col = col0 + wc * 64 + n * 16 + (lane >> 4) * 4;
            const f32x4 v = acc[m][n];
            s += v[0] * v[0] + v[1] * v[1] + v[2] * v[2] + v[3] * v[3];
            *(u32x2*)(out + (size_t)(orow0 + rl) * ldo + col) = (u32x2){pk_bf16(v[0], v[1]), pk_bf16(v[2], v[3])};
        }
#if 1
        s += __shfl_xor(s, 16); s += __shfl_xor(s, 32);
        if (lane < 16) ssp[(size_t)((col0 >> 7) * 2 + wc) * M + ssrow0 + rl] = s;
#endif
    }
}
__device__ __forceinline__ void phase3b(const Params& p, LAS char* lds) {
    unsigned char* ws = p.ws;
    const int lane = threadIdx.x & 63, w = wave_id(), wr = w >> 1, wc = w & 1;
    const bf16_t* gated = (const bf16_t*)(ws + WS_GATED); bf16_t* mixed = (bf16_t*)(ws + WS_MIXED);
    for (int it = 0;; ++it) {
        int tm, tn; int st = tile_at(it, 128, 8, tm, tn);
        if (st == 0) { if (it < (1 << 20) && (int)blockIdx.x < 8) { tm = 128; tn = blockIdx.x; it = 1 << 20; st = 1; } else break; }
        if (st == 2) continue;
        const int row0 = tm * 128, col0 = tn * 128; const int mlim = tm == 128 ? (wr == 0 ? 2 : 0) : 4;
        f32x4 acc[4][4]; zero_acc(acc);
        gemm_main<true>(lds, gated + (size_t)row0 * 1024, 1024, (const bf16_t*)(ws + WS_BTOUT) + (size_t)col0 * 1024, 1024, 16, acc, mlim);
        epi_store_ss(acc, mixed, 1024, row0, col0, (float*)(ws + WS_SSP2), row0, wr, wc, lane);
    }
}
__device__ __forceinline__ void phase3c(const Params& p) {
    unsigned char* ws = p.ws;
    const int lane = threadIdx.x & 63, w = wave_id();
    const bf16_t* mixed = (const bf16_t*)(ws + WS_MIXED); bf16_t* hb = (bf16_t*)(ws + WS_A);
    const float* ssp2 = (const float*)(ws + WS_SSP2); float* r2 = (float*)(ws + WS_R2);
    const float* g1 = p.gains + D;
    f32x4 g[4];
#pragma unroll
    for (int i = 0; i < 4; ++i) g[i] = *(const f32x4*)(g1 + lane * 4 + 256 * i);
    for (int grp = blockIdx.x; grp * 32 < MV; grp += gridDim.x) {
#pragma unroll 1
        for (int k = 0; k < 8; k += 2) {
            int r[2]; bool ok[2]; f32x4 v[2][4]; u32x2 mx[2][4]; float sq[2];
#pragma unroll
            for (int j = 0; j < 2; ++j) {
                r[j] = grp * 32 + w + 4 * (k + j); ok[j] = r[j] < MV; const int rr = ok[j] ? r[j] : 0;
                const float* src = rr < MX ? p.x + (size_t)rr * D : p.meta + (size_t)((rr - MX) & 15) * D;
                sq[j] = lane < 16 ? ssp2[(size_t)lane * M + rr] : 0.f;
#pragma unroll
                for (int i = 0; i < 4; ++i) { v[j][i] = *(const f32x4*)(src + lane * 4 + 256 * i); mx[j][i] = *(const u32x2*)(mixed + (size_t)rr * D + lane * 4 + 256 * i); }
            }
#pragma unroll
            for (int j = 0; j < 2; ++j) {
                const float a = 1.0f / sqrtf(wave_sum(sq[j]) * (1.0f / D) + EPS);
                float ss = 0.f;
#pragma unroll
                for (int i = 0; i < 4; ++i) {
                    const int col = lane * 4 + 256 * i;
                    f32x4 hh;
                    hh[0] = v[j][i][0] + bf_lo(mx[j][i][0]) * a * g[i][0]; hh[1] = v[j][i][1] + bf_hi(mx[j][i][0]) * a * g[i][1];
                    hh[2] = v[j][i][2] + bf_lo(mx[j][i][1]) * a * g[i][2]; hh[3] = v[j][i][3] + bf_hi(mx[j][i][1]) * a * g[i][3];
                    ss += hh[0] * hh[0] + hh[1] * hh[1] + hh[2] * hh[2] + hh[3] * hh[3];
                    if (ok[j]) {
                        *(u32x2*)(hb + (size_t)r[j] * D + col) = (u32x2){pk_bf16(hh[0], hh[1]), pk_bf16(hh[2], hh[3])};
                        if (r[j] < MX) *(f32x4*)(p.out + (size_t)r[j] * D + col) = hh;
                    }
                }
                ss = wave_sum(ss);
                if (ok[j] && lane == 0) r2[r[j]] = 1.0f / sqrtf(ss * (1.0f / D) + EPS);
            }
        }
    }
}
constexpr int UST = 272;
__device__ __forceinline__ f32x4 unpack4(const u32x2 u) { return (f32x4){bf_lo(u[0]), bf_hi(u[0]), bf_lo(u[1]), bf_hi(u[1])}; }
struct ConvW { f32x4 w0g, w1g, w2g, bg, w0v, w1v, w2v, bv; };
__device__ __forceinline__ ConvW load_convw(const Params& p, int c) {
    ConvW q;
    q.w0g = *(const f32x4*)(p.conv_w + c); q.w1g = *(const f32x4*)(p.conv_w + NUP + c); q.w2g = *(const f32x4*)(p.conv_w + 2 * NUP + c); q.bg = *(const f32x4*)(p.conv_b + c);
    q.w0v = *(const f32x4*)(p.conv_w + DFF + c); q.w1v = *(const f32x4*)(p.conv_w + NUP + DFF + c); q.w2v = *(const f32x4*)(p.conv_w + 2 * NUP + DFF + c); q.bv = *(const f32x4*)(p.conv_b + DFF + c);
    return q;
}
__device__ __forceinline__ u32x2 conv_gelu4(const ConvW& q, const f32x4 g2, const f32x4 g1, const f32x4 g0, const f32x4 v2, const f32x4 v1, const f32x4 v0) {
    float o[4];
#pragma unroll
    for (int e = 0; e < 4; ++e) {
        const float ug = q.bg[e] + q.w0g[e] * g2[e] + q.w1g[e] * g1[e] + q.w2g[e] * g0[e];
        const float uv = q.bv[e] + q.w0v[e] * v2[e] + q.w1v[e] * v1[e] + q.w2v[e] * v0[e];
        const float t = 0.7978845608028654f * (ug + 0.044715f * ug * ug * ug);
        o[e] = ug * rcp(1.0f + ex2(-2.0f * LOG2E * t)) * uv;
    }
    return (u32x2){pk_bf16(o[0], o[1]), pk_bf16(o[2], o[3])};
}
__device__ __forceinline__ void phase4(const Params& p, LAS char* lds) {
    unsigned char* ws = p.ws;
    const int tid = threadIdx.x, lane = tid & 63, w = wave_id(), wr = w >> 1, wc = w & 1;
    const bf16_t* hb = (const bf16_t*)(ws + WS_A); const bf16_t* Bt = (const bf16_t*)(ws + WS_BTUP);
    const float* r2 = (const float*)(ws + WS_R2);
    bf16_t* act = (bf16_t*)(ws + WS_ACT); bf16_t* hal = (bf16_t*)(ws + WS_HAL);
    for (int it = 0;; ++it) {
        int tm, tn; int st = tile_at(it, 128, 44, tm, tn);
        if (st == 0) { if (it < (1 << 20) && (int)blockIdx.x < 44) { tm = 128; tn = blockIdx.x; it = 1 << 20; st = 1; } else break; }
        if (st == 2) continue;
        const bool mt = tm == 128; const int row0 = mt ? MX : tm * 128, col0 = tn * 128;
        f32x4 acc[4][4]; zero_acc(acc);
        gemm_main<true>(lds, hb + (size_t)row0 * D, D, Bt + (size_t)col0 * D, D, 16, acc, mt ? (wr == 0 ? 2 : 0) : 4);
#pragma unroll
        for (int m = 0; m < 4; ++m) {
            const int rl = wr * 64 + m * 16 + (lane & 15); const float rs = r2[row0 + rl];
#pragma unroll
            for (int n = 0; n < 4; ++n) {
                const int cl = wc * 64 + n * 16 + (lane >> 4) * 4; const f32x4 v = acc[m][n] * rs;
                *(LAS u32x2*)(lds + rl * UST + cl * 2) = (u32x2){pk_bf16(v[0], v[1]), pk_bf16(v[2], v[3])};
            }
        }
        __syncthreads();
        if (!mt) {
            const int cg = tid & 15, rb = tid >> 4, c = tn * 64 + cg * 4;
            const ConvW q = load_convw(p, c);
            const int hr = rb == 0 ? 0 : rb * 8 - 2;
            f32x4 g2 = unpack4(*(const LAS u32x2*)(lds + hr * UST + cg * 8)), v2 = unpack4(*(const LAS u32x2*)(lds + hr * UST + 128 + cg * 8));
            f32x4 g1 = unpack4(*(const LAS u32x2*)(lds + (hr + 1) * UST + cg * 8)), v1 = unpack4(*(const LAS u32x2*)(lds + (hr + 1) * UST + 128 + cg * 8));
            for (int r = hr + 2; r < rb * 8 + 8; ++r) {
                const f32x4 g0 = unpack4(*(const LAS u32x2*)(lds + r * UST + cg * 8)), v0 = unpack4(*(const LAS u32x2*)(lds + r * UST + 128 + cg * 8));
                *(u32x2*)(act + (size_t)(row0 + r) * DFF + c) = conv_gelu4(q, g2, g1, g0, v2, v1, v0);
                g2 = g1; g1 = g0; v2 = v1; v1 = v0;
            }
            if (tid < 64) { const int qq = tid >> 4, ch = tid & 15, rl = qq < 2 ? qq : 124 + qq;
                *(u32x4*)(hal + ((size_t)tm * 4 + qq) * NUP + col0 + ch * 8) = *(const LAS u32x4*)(lds + rl * UST + ch * 16); }
        } else {
            if (tid < 64) { const int qq = tid >> 4, ch = tid & 15, rl = (qq >> 1) * 16 + 14 + (qq & 1);
                *(u32x4*)(hal + ((size_t)(128 + (qq >> 1)) * 4 + 2 + (qq & 1)) * NUP + col0 + ch * 8) = *(const LAS u32x4*)(lds + rl * UST + ch * 16); }
        }
        __syncthreads();
    }
}
__device__ __forceinline__ void phase_fix(const Params& p) {
    unsigned char* ws = p.ws;
    const bf16_t* hal = (const bf16_t*)(ws + WS_HAL); bf16_t* act = (bf16_t*)(ws + WS_ACT);
    constexpr int NCG = DFF / 4;
    for (int it = blockIdx.x * NTHREADS + threadIdx.x; it < 128 * NCG; it += gridDim.x * NTHREADS) {
        const int tmg = it / NCG, c = (it % NCG) * 4, colg = (c >> 6) * 128 + (c & 63), colv = colg + 64;
        const bf16_t* own = hal + (size_t)tmg * 4 * NUP;
        const bf16_t* prv = hal + (size_t)((tmg & 63) ? tmg - 1 : 128 + (tmg >> 6)) * 4 * NUP;
        const ConvW q = load_convw(p, c);
        const f32x4 pg2 = unpack4(*(const u32x2*)(prv + 2 * NUP + colg)), pv2 = unpack4(*(const u32x2*)(prv + 2 * NUP + colv));
        const f32x4 pg3 = unpack4(*(const u32x2*)(prv + 3 * NUP + colg)), pv3 = unpack4(*(const u32x2*)(prv + 3 * NUP + colv));
        const f32x4 og0 = unpack4(*(const u32x2*)(own + colg)), ov0 = unpack4(*(const u32x2*)(own + colv));
        const f32x4 og1 = unpack4(*(const u32x2*)(own + NUP + colg)), ov1 = unpack4(*(const u32x2*)(own + NUP + colv));
        *(u32x2*)(act + (size_t)(tmg * 128) * DFF + c) = conv_gelu4(q, pg2, pg3, og0, pv2, pv3, ov0);
        *(u32x2*)(act + (size_t)(tmg * 128 + 1) * DFF + c) = conv_gelu4(q, pg3, og0, og1, pv3, ov0, ov1);
    }
}
__device__ __forceinline__ void phase6(const Params& p, LAS char* lds) {
    unsigned char* ws = p.ws;
    const int lane = threadIdx.x & 63, w = wave_id(), wr = w >> 1, wc = w & 1;
    const bf16_t* act = (const bf16_t*)(ws + WS_ACT); bf16_t* ffn = (bf16_t*)(ws + WS_FFN);
    for (int it = 0;; ++it) {
        int tm, tn; const int st = tile_at(it, 128, 8, tm, tn); if (st == 0) break; if (st == 2) continue;
        const int col0 = tn * 128;
        f32x4 acc[4][4]; zero_acc(acc);
        gemm_main<true>(lds, act + (size_t)(tm * 128) * DFF, DFF, (const bf16_t*)(ws + WS_BTDN) + (size_t)col0 * DFF, DFF, 44, acc);
        epi_store_ss(acc, ffn, 1024, tm * 128, col0, (float*)(ws + WS_SSP4), tm * 128, wr, wc, lane);
    }
}
__device__ __forceinline__ void phase7(const Params& p) {
    unsigned char* ws = p.ws;
    const int lane = threadIdx.x & 63, w = wave_id();
    const bf16_t* ffn = (const bf16_t*)(ws + WS_FFN); const float* ssp4 = (const float*)(ws + WS_SSP4); const float* g3 = p.gains + 3 * D;
    f32x4 g[4];
#pragma unroll
    for (int i = 0; i < 4; ++i) g[i] = *(const f32x4*)(g3 + lane * 4 + 256 * i);
    for (int r0 = (blockIdx.x * 4 + w) * 2; r0 < MX; r0 += gridDim.x * 8) {
        f32x4 hh[2][4]; u32x2 f[2][4]; float sq[2];
#pragma unroll
        for (int j = 0; j < 2; ++j) {
            const int row = r0 + j;
            sq[j] = lane < 16 ? ssp4[(size_t)lane * M + row] : 0.f;
#pragma unroll
            for (int i = 0; i < 4; ++i) { hh[j][i] = *(const f32x4*)(p.out + (size_t)row * D + lane * 4 + 256 * i); f[j][i] = *(const u32x2*)(ffn + (size_t)row * D + lane * 4 + 256 * i); }
        }
#pragma unroll
        for (int j = 0; j < 2; ++j) {
            const float a = 1.0f / sqrtf(wave_sum(sq[j]) * (1.0f / D) + EPS);
#pragma unroll
            for (int i = 0; i < 4; ++i) {
                f32x4 o;
                o[0] = hh[j][i][0] + bf_lo(f[j][i][0]) * a * g[i][0]; o[1] = hh[j][i][1] + bf_hi(f[j][i][0]) * a * g[i][1];
                o[2] = hh[j][i][2] + bf_lo(f[j][i][1]) * a * g[i][2]; o[3] = hh[j][i][3] + bf_hi(f[j][i][1]) * a * g[i][3];
                *(f32x4*)(p.out + (size_t)(r0 + j) * D + lane * 4 + 256 * i) = o;
            }
        }
    }
}


#ifndef DUMP
#define DUMP 0
#endif
__device__ __forceinline__ void phase_dump(const Params& p) {
    unsigned char* ws = p.ws;
    const bf16_t* s0; const bf16_t* s1; int ld;
    if (DUMP == 1) { s0 = (const bf16_t*)(ws + WS_B); s1 = s0 + 512; ld = 1024; }
    else if (DUMP == 2) { s0 = (const bf16_t*)(ws + WS_QF); s1 = (const bf16_t*)(ws + WS_KF); ld = 512; }
    else if (DUMP == 3) { s0 = (const bf16_t*)(ws + WS_A); s1 = s0 + (size_t)M * 512; ld = 512; }
    else if (DUMP == 4) { s0 = (const bf16_t*)(ws + WS_GATED); s1 = s0 + 512; ld = 1024; }
    else if (DUMP == 8) { s0 = (const bf16_t*)(ws + WS_A); s1 = s0 + 512; ld = 1024; }
    else if (DUMP == 9) { s0 = (const bf16_t*)(ws + WS_ACT) + 1024; s1 = (const bf16_t*)(ws + WS_ACT) + 2304 - 512 + 512; ld = DFF; }
    else if (DUMP == 10) { s0 = (const bf16_t*)(ws + WS_FFN); s1 = s0 + 512; ld = 1024; }
    else if (DUMP == 6) { s0 = (const bf16_t*)(ws + WS_QS); s1 = (const bf16_t*)(ws + WS_KS); ld = 512; }
    else { s0 = (const bf16_t*)(ws + WS_MIXED); s1 = s0 + 512; ld = 1024; }
    for (int it = blockIdx.x * NTHREADS + threadIdx.x; it < MX * 1024; it += gridDim.x * NTHREADS) {
        const int row = it >> 10, col = it & 1023;
        if (DUMP >= 9 && row >= 8192) { p.out[it] = 0.f; continue; }
        const bf16_t v = col < 512 ? s0[(size_t)row * ld + col] : s1[(size_t)row * ld + col - 512];
        p.out[it] = __uint_as_float((unsigned)v << 16);
    }
}

__device__ __forceinline__ void l2_scrub(const Params& p) {
    const f32x4* src = (const f32x4*)p.x + (size_t)(blockIdx.x & 511) * 8192;
    f32x4 a = (f32x4){0.f, 0.f, 0.f, 0.f};
    for (int i = threadIdx.x; i < 8192; i += NTHREADS) a += src[i];
    if (a[0] + a[1] + a[2] + a[3] == 1.2345e-30f) ((float*)(p.ws + WS_CTL))[32 + (threadIdx.x & 7)] = a[0];
}


#define XB_TMO      128
#define XB_XCNT(j)  (256  + 64 * (j))
#define XB_XSUB(j)  (1280 + 64 * (j))
#define XB_XGEN(j)  (2304 + 64 * (j))
#define XB_TOP      3328
#define XB_TOPGEN   3392
#define XCD_BAR_WORDS 3456
#define XB_SPIN_CAP (1u << 18)
__device__ __forceinline__ unsigned xb_ld(unsigned* p)              { return __hip_atomic_load(p, __ATOMIC_RELAXED, __HIP_MEMORY_SCOPE_AGENT); }
__device__ __forceinline__ unsigned xb_add(unsigned* p, unsigned v) { return __hip_atomic_fetch_add(p, v, __ATOMIC_RELAXED, __HIP_MEMORY_SCOPE_AGENT); }
__device__ __forceinline__ unsigned xb_xcc_id() { return (unsigned)__builtin_amdgcn_s_getreg((3 << 11) | 20) & 0xFu; }
#define XB_SPIN(cond, bar) do { unsigned _sp = 0; while (cond) { __builtin_amdgcn_s_sleep(1); \
    if ((++_sp & 255u) == 0u) { if (xb_ld(&(bar)[XB_TMO])) break; if (_sp > XB_SPIN_CAP) { atomicAdd(&(bar)[XB_TMO], 1u); break; } } } } while (0)
struct XcdBarrier { unsigned* bar; unsigned x; volatile LAS unsigned* st; };
__device__ __forceinline__ XcdBarrier xcd_barrier_post(unsigned* bar, volatile LAS unsigned* st) {
    XcdBarrier b; b.bar = bar; b.x = xb_xcc_id(); b.st = st;
    if (threadIdx.x == 0) (void)xb_add(&bar[XB_XCNT(b.x)], 1u);
    return b;
}
__device__ __forceinline__ void xcd_barrier_complete(unsigned* bar, unsigned x, unsigned& nloc, unsigned& nx) {
    const unsigned G = gridDim.x * gridDim.y * gridDim.z;
    unsigned sum, cnt, mine, sp = 0u;
    for (;;) {
        sum = 0u; cnt = 0u; mine = 0u;
#pragma unroll
        for (unsigned j = 0; j < 16; ++j) { const unsigned c = xb_ld(&bar[XB_XCNT(j)]); sum += c; cnt += (c > 0u) ? 1u : 0u; mine = (j == x) ? c : mine; }
        if (sum == G) break;
        __builtin_amdgcn_s_sleep(1);
        if ((++sp & 255u) == 0u) { if (xb_ld(&bar[XB_TMO])) break; if (sp > XB_SPIN_CAP) { atomicAdd(&bar[XB_TMO], 1u); break; } }
    }
    nloc = mine > 0u ? mine : 1u; nx = cnt > 0u ? cnt : 1u;
}
__device__ __forceinline__ void xcd_barrier(const XcdBarrier& b) {
    asm volatile("s_waitcnt vmcnt(0)" ::: "memory");
    __syncthreads();
    if (threadIdx.x == 0) {
        unsigned* bar = b.bar;
        __builtin_amdgcn_s_waitcnt(0);
        unsigned nloc = b.st[0], nx = b.st[1];
        if (nloc == 0u) { xcd_barrier_complete(bar, b.x, nloc, nx); b.st[0] = nloc; b.st[1] = nx; }
        const unsigned old = xb_add(&bar[XB_XSUB(b.x)], 1u);
        const unsigned gen = old / nloc;
        if (old + 1u == (gen + 1u) * nloc) {
            __builtin_amdgcn_fence(__ATOMIC_RELEASE, "agent");
            asm volatile("s_waitcnt vmcnt(0)" ::: "memory");
            const unsigned og = xb_add(&bar[XB_TOP], 1u);
            const unsigned tg = og / nx;
            if (og + 1u == (tg + 1u) * nx) xb_add(&bar[XB_TOPGEN], 1u);
            else XB_SPIN(xb_ld(&bar[XB_TOPGEN]) == tg, bar);
            __builtin_amdgcn_fence(__ATOMIC_ACQUIRE, "agent");
            xb_add(&bar[XB_XGEN(b.x)], 1u);
            asm volatile("s_waitcnt vmcnt(0)" ::: "memory");
        } else {
            XB_SPIN(xb_ld(&bar[XB_XGEN(b.x)]) == gen, bar);
            __builtin_amdgcn_fence(__ATOMIC_ACQUIRE, "agent");
            asm volatile("s_waitcnt vmcnt(0)" ::: "memory");
        }
    }
    __syncthreads();
}

__device__ __forceinline__ void my_grid_sync(const Params& p, unsigned& target) {
    unsigned* bar = (unsigned*)(p.ws + WS_CTL) + 16;
    asm volatile("s_waitcnt vmcnt(0)" ::: "memory");
    __syncthreads();
    target += gridDim.x;
    if (threadIdx.x == 0) {
        __builtin_amdgcn_fence(__ATOMIC_RELEASE, "agent");
        asm volatile("s_waitcnt vmcnt(0)" ::: "memory");
        __hip_atomic_fetch_add(bar, 1u, __ATOMIC_RELAXED, __HIP_MEMORY_SCOPE_AGENT);
        while (__hip_atomic_load(bar, __ATOMIC_RELAXED, __HIP_MEMORY_SCOPE_AGENT) < target) __builtin_amdgcn_s_sleep(2);
        __builtin_amdgcn_fence(__ATOMIC_ACQUIRE, "agent");
        asm volatile("s_waitcnt vmcnt(0)" ::: "memory");
    }
    __syncthreads();
}
__global__ void __launch_bounds__(NTHREADS, 2) fwd_kernel(Params p) {
    extern __shared__ __attribute__((aligned(16))) unsigned char lds_raw[];
    LAS char* lds = (LAS char*)lds_raw;
    cg::grid_group grid = cg::this_grid();
#define IN(k) (p.ph_lo <= (k) && (k) < p.ph_hi)
#define SEAM(k) do { if (IN(k) && IN((k) + 1)) { if (p.ph_hi > 1000) grid.sync(); xcd_barrier(xbar); } } while (0)
    volatile LAS unsigned* xst = (volatile LAS unsigned*)(lds + 65536);
    if (threadIdx.x < 4) xst[threadIdx.x] = 0u;
    __syncthreads();
    const XcdBarrier xbar = xcd_barrier_post((unsigned*)(p.ws + WS_XBAR), xst);
    if (IN(0)) phase0(p, lds);
    SEAM(0);
    if (IN(1)) phase1(p, lds);
    SEAM(1);
    if (IN(2)) phase2(p, lds);
    SEAM(2);
    if (IN(3)) phase_comb(p);
    SEAM(3);
    if (IN(4)) phase3a(p, lds);
    SEAM(4);
    if (IN(5)) phase3b(p, lds);
    SEAM(5);
    if (IN(6)) phase3c(p);
    SEAM(6);
    if (IN(7)) phase4(p, lds);
    SEAM(7);
    if (IN(8)) phase_fix(p);
    SEAM(8);
    if (IN(9)) phase6(p, lds);
    SEAM(9);
    if (IN(10)) phase7(p);
#undef IN
#undef SEAM
}


__global__ void ab_save(const unsigned char* ws, float* out) {
    const u32x4* src = (const u32x4*)(ws + AB_SRC); u32x4* dst = (u32x4*)((unsigned char*)out + (size_t)32 * MiB);
    for (size_t i = blockIdx.x * (size_t)blockDim.x + threadIdx.x; i < (size_t)AB_BYTES / 16; i += (size_t)gridDim.x * blockDim.x) dst[i] = src[i];
}
__global__ void ab_diff(const unsigned char* ws, float* out) {
    const bf16_t* src = (const bf16_t*)(ws + AB_SRC); const bf16_t* sav = (const bf16_t*)((unsigned char*)out + (size_t)32 * MiB);
    for (size_t i = blockIdx.x * (size_t)blockDim.x + threadIdx.x; i < (size_t)8192 * 1024; i += (size_t)gridDim.x * blockDim.x) {
        if (i >= (size_t)AB_BYTES / 2) { out[i] = 0.f; continue; }
        out[i] = src[i] != sav[i] ? 1000.0f : 0.f;
    }
}
__global__ void ab_zero(float* out) {
    for (size_t i = blockIdx.x * (size_t)blockDim.x + threadIdx.x; i < (size_t)8192 * 1024; i += (size_t)gridDim.x * blockDim.x) out[(size_t)8192 * 1024 + i] = 0.f;
}
extern "C" void kernel_launch(void* const* d_in, const int* in_sizes, int n_in, void* d_out, int out_size, void* d_ws, size_t ws_size, hipStream_t stream) {
    static int grid_blocks = 0;
    if (grid_blocks == 0) {
        if (n_in != 12 || ws_size < WS_END) { fprintf(stderr, "kernel_launch: unexpected n_in %d or ws_size %zu (need %zu)\n", n_in, ws_size, (size_t)WS_END); grid_blocks = -1; return; }
        int dev = 0, cus = 0, per_cu = 0;
        (void)hipGetDevice(&dev);
        (void)hipDeviceGetAttribute(&cus, hipDeviceAttributeMultiprocessorCount, dev);
        (void)hipFuncSetAttribute((const void*)fwd_kernel, hipFuncAttributeMaxDynamicSharedMemorySize, LDS_BYTES);
        (void)hipOccupancyMaxActiveBlocksPerMultiprocessor(&per_cu, (const void*)fwd_kernel, NTHREADS, LDS_BYTES);
        if (per_cu < 1) per_cu = 1;
        if (per_cu > 2) per_cu = 2;
        grid_blocks = cus * per_cu;
        (void)hipGetLastError();
    }
    if (grid_blocks < 0) return;
    Params p{};
    p.x = (const float*)d_in[0]; p.meta = (const float*)d_in[1]; p.gains = (const float*)d_in[2]; p.w_in = (const float*)d_in[3];
    p.b_forget = (const float*)d_in[4]; p.w_o_fox = (const float*)d_in[5]; p.w_o_sb = (const float*)d_in[6]; p.w_out = (const float*)d_in[7];
    p.w_up = (const float*)d_in[8]; p.conv_w = (const float*)d_in[9]; p.conv_b = (const float*)d_in[10]; p.w_down = (const float*)d_in[11];
    p.out = (float*)d_out; p.ws = (unsigned char*)d_ws;
#if SINGLE_LAUNCH
    (void)hipMemsetAsync((unsigned char*)d_ws + WS_CTL, 0, 256, stream);
    (void)hipMemsetAsync((unsigned char*)d_ws + WS_XBAR, 0, XCD_BAR_WORDS * 4, stream);
    p.ph_lo = 0; p.ph_hi = NPHASE;
    void* args[] = {&p};
    hipError_t e = hipLaunchCooperativeKernel((const void*)fwd_kernel, dim3(grid_blocks), dim3(NTHREADS), args, LDS_BYTES, stream);
    if (e != hipSuccess) fprintf(stderr, "cooperative launch failed: %s (grid %d)\n", hipGetErrorString(e), grid_blocks);
#else
#ifndef STOP_AT
#define STOP_AT NPHASE
#endif
    for (int k = 0; k < STOP_AT; ++k) {
        p.ph_lo = k; p.ph_hi = k + 1;
        hipLaunchKernelGGL(fwd_kernel, dim3(grid_blocks), dim3(NTHREADS), LDS_BYTES, stream, p);
    }
#if ABTEST
    ab_save<<<1024, 256, 0, stream>>>(p.ws, p.out);
    for (int k = AB_FROM; k < STOP_AT; ++k) {
        p.ph_lo = k; p.ph_hi = k + 1;
        hipLaunchKernelGGL(fwd_kernel, dim3(grid_blocks), dim3(NTHREADS), LDS_BYTES, stream, p);
    }
    ab_diff<<<1024, 256, 0, stream>>>(p.ws, p.out);
    ab_zero<<<1024, 256, 0, stream>>>(p.out);
#endif

#endif
}
```

```cpp
#include <hip/hip_runtime.h>
#include <hip/hip_cooperative_groups.h>
#include <cstdio>
#include <cstdint>
namespace cg = cooperative_groups;

#define DUMP 0
#define ABTEST 0
#define AB_FROM 0
#define AB_SRC WS_SSP2
#define AB_BYTES (2 * MiB)
#ifndef SINGLE_LAUNCH
#define SINGLE_LAUNCH 1
#endif

#define LAS __attribute__((address_space(3)))
typedef unsigned short bf16_t;
typedef short bf16x8 __attribute__((ext_vector_type(8)));
typedef float f32x4 __attribute__((ext_vector_type(4)));
typedef float f32x16 __attribute__((ext_vector_type(16)));
typedef unsigned u32x4 __attribute__((ext_vector_type(4)));
typedef unsigned u32x2 __attribute__((ext_vector_type(2)));

constexpr int D = 1024, SEQ = 8192, NMETA = 16, NB = 2;
constexpr int MX = NB * SEQ;
constexpr int MV = MX + NB * NMETA;
constexpr int M = 16512;
constexpr int LPK = 8256;
constexpr int PROJW = 5128, NPROJ = 5120, DFF = 2816, NUP = 5632;
constexpr float EPS = 1e-6f;
constexpr float LOG2E = 1.4426950408889634f, LN2 = 0.6931471805599453f;
constexpr int NTHREADS = 256;
constexpr int LDS_BYTES = 65536 + 16;
constexpr int NPHASE = 11;

constexpr size_t MiB = 1u << 20;
constexpr size_t WS_CTL = 0;
constexpr size_t WS_R1 = 4096, WS_R2 = WS_R1 + 69632, WS_SS2 = WS_R2 + 69632, WS_SS4 = WS_SS2 + 69632;
constexpr size_t WS_LOGF = WS_SS4 + 69632, WS_CK = WS_LOGF + 528384, WS_UPMETA = WS_CK + 528384;
constexpr size_t WS_BTIN = 2 * MiB, WS_BTOF = WS_BTIN + 10 * MiB, WS_BTOS = WS_BTOF + 1 * MiB, WS_BTOUT = WS_BTOS + 1 * MiB,
                 WS_BTUP = WS_BTOUT + 2 * MiB, WS_BTDN = WS_BTUP + 11 * MiB;
constexpr size_t SZ_M1024 = (size_t)M * 1024 * 2, SZ_M512 = (size_t)M * 512 * 2;
constexpr size_t WS_A = 33 * MiB;
constexpr size_t WS_B = WS_A + SZ_M1024;
constexpr size_t WS_C = WS_B + 2 * SZ_M1024;
constexpr size_t WS_QF = WS_C, WS_KF = WS_QF + SZ_M512, WS_QS = WS_KF + SZ_M512, WS_KS = WS_QS + SZ_M512, WS_VFT = WS_KS + SZ_M512, WS_VST = WS_VFT + SZ_M512;
constexpr size_t WS_GATED = WS_C, WS_MIXED = WS_B + SZ_M1024;
constexpr size_t WS_ACT = WS_B;
constexpr size_t WS_FFN = WS_ACT + 132 * MiB;
constexpr size_t WS_SSP2 = 230 * MiB, WS_SSP4 = 232 * MiB;
constexpr size_t WS_HAL = 234 * MiB;
constexpr size_t WS_XBAR = 240 * MiB;
constexpr size_t WS_END = 241 * MiB;

struct Params {
    const float *x, *meta, *gains, *w_in, *b_forget, *w_o_fox, *w_o_sb, *w_out, *w_up, *conv_w, *conv_b, *w_down;
    float* out; unsigned char* ws; int ph_lo, ph_hi;
};

typedef __bf16 bf16x2_t __attribute__((ext_vector_type(2)));
__device__ __forceinline__ unsigned pk_bf16(float lo, float hi) { bf16x2_t v = {(__bf16)lo, (__bf16)hi}; return __builtin_bit_cast(unsigned, v); }
__device__ __forceinline__ float bf_lo(unsigned u) { return __uint_as_float(u << 16); }
__device__ __forceinline__ float bf_hi(unsigned u) { return __uint_as_float(u & 0xffff0000u); }
__device__ __forceinline__ float ex2(float x) { return __builtin_amdgcn_exp2f(x); }
__device__ __forceinline__ float lg2(float x) { return __builtin_amdgcn_logf(x); }
__device__ __forceinline__ float rcp(float x) { return __builtin_amdgcn_rcpf(x); }
__device__ __forceinline__ float sigmoidf_(float v) { return rcp(1.0f + ex2(-v * LOG2E)); }
__device__ __forceinline__ float wave_sum(float v) {
#pragma unroll
    for (int o = 32; o > 0; o >>= 1) v += __shfl_xor(v, o);
    return v;
}
__device__ __forceinline__ int wave_id() { return __builtin_amdgcn_readfirstlane((int)(threadIdx.x >> 6)); }

__device__ __forceinline__ void transpose_tile(LAS char* lds, const float* src, int ldsrc, int srccol, int k0, const float* gain, bf16_t* dst, int K, int n0) {
    LAS bf16_t* T = (LAS bf16_t*)lds;
    const int tid = threadIdx.x, r = tid >> 4, c4 = tid & 15;
#pragma unroll
    for (int p = 0; p < 4; ++p) {
        const int k = r + 16 * p;
        f32x4 v = *(const f32x4*)(src + (size_t)(k0 + k) * ldsrc + srccol + c4 * 4);
        const float g = gain ? gain[k0 + k] : 1.0f;
        const unsigned a = pk_bf16(v[0] * g, v[1] * g), b = pk_bf16(v[2] * g, v[3] * g);
        T[(c4 * 4 + 0) * 72 + k] = (bf16_t)(a & 0xffff); T[(c4 * 4 + 1) * 72 + k] = (bf16_t)(a >> 16);
        T[(c4 * 4 + 2) * 72 + k] = (bf16_t)(b & 0xffff); T[(c4 * 4 + 3) * 72 + k] = (bf16_t)(b >> 16);
    }
    __syncthreads();
    const int n = tid >> 2, kq = tid & 3;
    const u32x4 lo = *(LAS u32x4*)(T + n * 72 + kq * 16), hi = *(LAS u32x4*)(T + n * 72 + kq * 16 + 8);
    bf16_t* d = dst + (size_t)(n0 + n) * K + k0 + kq * 16;
    *(u32x4*)d = lo; *(u32x4*)(d + 8) = hi;
    __syncthreads();
}

__device__ __forceinline__ void phase0(const Params& p, LAS char* lds) {
    unsigned char* ws = p.ws;
    const int tid = threadIdx.x, lane = tid & 63, w = wave_id();
    LAS float* wfT = (LAS float*)lds;
    const float* g0 = p.gains;
    for (int idx = tid; idx < 8192; idx += NTHREADS) { const int h = idx & 7, k = idx >> 3; wfT[h * 1024 + k] = p.w_in[(size_t)k * PROJW + 1536 + h] * g0[k]; }
    __syncthreads();
    bf16_t* xb = (bf16_t*)(ws + WS_A);
    float* r1 = (float*)(ws + WS_R1);
    float* logf_ = (float*)(ws + WS_LOGF);
    for (int r_ = blockIdx.x * 32 + w; r_ < M; r_ += (r_ & 31) < 28 ? 4 : gridDim.x * 32 - 28) {
        const int r = r_;
        if (r >= MV) {
#pragma unroll
            for (int i = 0; i < 4; ++i) *(u32x2*)(xb + (size_t)r * D + lane * 4 + 256 * i) = (u32x2){0u, 0u};
            if (lane == 0) r1[r] = 0.f;
            continue;
        }
        const float* src = r < MX ? p.x + (size_t)r * D : p.meta + (size_t)((r - MX) & 15) * D;
        f32x4 v[4]; float ss = 0.f;
#pragma unroll
        for (int i = 0; i < 4; ++i) { v[i] = *(const f32x4*)(src + lane * 4 + 256 * i); ss += v[i][0] * v[i][0] + v[i][1] * v[i][1] + v[i][2] * v[i][2] + v[i][3] * v[i][3]; }
#pragma unroll
        for (int i = 0; i < 4; ++i) *(u32x2*)(xb + (size_t)r * D + lane * 4 + 256 * i) = (u32x2){pk_bf16(v[i][0], v[i][1]), pk_bf16(v[i][2], v[i][3])};
        ss = wave_sum(ss);
        const float rs = 1.0f / sqrtf(ss * (1.0f / D) + EPS);
        if (lane == 0) r1[r] = rs;
        float mine = 0.f;
#pragma unroll
        for (int h = 0; h < 8; ++h) {
            float a = 0.f;
#pragma unroll
            for (int i = 0; i < 4; ++i) { const f32x4 wv = *(LAS f32x4*)(wfT + h * 1024 + lane * 4 + 256 * i); a += v[i][0] * wv[0] + v[i][1] * wv[1] + v[i][2] * wv[2] + v[i][3] * wv[3]; }
            a = wave_sum(a);
            if (lane == h) mine = a;
        }
        if (lane < 8) {
            const float f = mine * rs + p.b_forget[lane];
            const float lf = fminf(f, 0.f) - log1pf(expf(-fabsf(f)));
            int b, kidx; if (r < MX) { b = r >> 13; kidx = r & 8191; } else { const int j = r - MX; b = j >> 4; kidx = 8192 + (j & 15); }
            logf_[(size_t)(b * 8 + lane) * LPK + kidx] = lf;
        }
    }
    __syncthreads();
    LAS char* tl = lds + 32768;
    const float* g2 = p.gains + 2 * D;
    constexpr int T_IN = 16 * 80, T_OF = 8 * 16, T_OS = 8 * 16, T_OUT = 16 * 16, T_UP = 16 * 88, T_DN = 44 * 16;
    constexpr int T_ALL = T_IN + T_OF + T_OS + T_OUT + T_UP + T_DN;
    for (int t = blockIdx.x; t < T_ALL; t += gridDim.x) {
        int u = t;
        if (u < T_IN) { const int nt = u % 80, kt = u / 80; const int sc = nt * 64 + (nt * 64 >= 1536 ? 8 : 0); transpose_tile(tl, p.w_in, PROJW, sc, kt * 64, g0, (bf16_t*)(ws + WS_BTIN), 1024, nt * 64); continue; }
        u -= T_IN;
        if (u < T_OF) { const int nt = u % 16, kt = u / 16; transpose_tile(tl, p.w_o_fox, 1024, nt * 64, kt * 64, nullptr, (bf16_t*)(ws + WS_BTOF), 512, nt * 64); continue; }
        u -= T_OF;
        if (u < T_OS) { const int nt = u % 16, kt = u / 16; transpose_tile(tl, p.w_o_sb, 1024, nt * 64, kt * 64, nullptr, (bf16_t*)(ws + WS_BTOS), 512, nt * 64); continue; }
        u -= T_OS;
        if (u < T_OUT) { const int nt = u % 16, kt = u / 16; transpose_tile(tl, p.w_out, 1024, nt * 64, kt * 64, nullptr, (bf16_t*)(ws + WS_BTOUT), 1024, nt * 64); continue; }
        u -= T_OUT;
        if (u < T_UP) { const int nt = u % 88, kt = u / 88; transpose_tile(tl, p.w_up, NUP, (nt & 1) * DFF + (nt >> 1) * 64, kt * 64, g2, (bf16_t*)(ws + WS_BTUP), 1024, nt * 64); continue; }
        u -= T_UP;
        { const int nt = u % 16, kt = u / 16; transpose_tile(tl, p.w_down, 1024, nt * 64, kt * 64, nullptr, (bf16_t*)(ws + WS_BTDN), DFF, nt * 64); }
    }
}

template <bool SWAP, bool FULL>
__device__ __forceinline__ void gemm_kloop(LAS char* lds, const bf16_t* Ag, int lda, const bf16_t* Bg, int ldb, int nk, f32x4 (&acc)[4][4], int mlim) {
    const int tid = threadIdx.x, lane = tid & 63, w = wave_id(), wr = w >> 1, wc = w & 1;
    const int row_0 = w * 8 + (lane >> 3), c_0 = (lane & 7) ^ ((row_0 >> 1) & 7);
    const bf16_t* pa0 = Ag + (size_t)row_0 * lda + c_0 * 8; const bf16_t* pb0 = Bg + (size_t)row_0 * ldb + c_0 * 8;
    const size_t sa = (size_t)32 * lda, sb_ = (size_t)32 * ldb;
    const int swz = (lane >> 1) & 7;
    int aoff[2], boff[2];
#pragma unroll
    for (int kh = 0; kh < 2; ++kh) {
        aoff[kh] = (wr * 64 + (lane & 15)) * 128 + (((kh * 4 + (lane >> 4)) ^ swz) << 4);
        boff[kh] = 16384 + (wc * 64 + (lane & 15)) * 128 + (((kh * 4 + (lane >> 4)) ^ swz) << 4);
    }
#define GM_STAGE(s, kt) do { _Pragma("unroll") for (int i_ = 0; i_ < 4; ++i_) { \
        __builtin_amdgcn_global_load_lds((const unsigned*)(pa0 + i_ * sa + (kt) * 64), (LAS unsigned*)(lds + (s) * 32768 + (i_ * 4 + w) * 1024), 16, 0, 0); \
        __builtin_amdgcn_global_load_lds((const unsigned*)(pb0 + i_ * sb_ + (kt) * 64), (LAS unsigned*)(lds + (s) * 32768 + 16384 + (i_ * 4 + w) * 1024), 16, 0, 0); } } while (0)
    GM_STAGE(0, 0);
    for (int kt = 0; kt < nk; ++kt) {
        asm volatile("s_waitcnt vmcnt(0)" ::: "memory");
        __syncthreads();
        const int s = kt & 1;
        if (kt + 1 < nk) GM_STAGE(s ^ 1, kt + 1);
        bf16x8 af[4][2], bf[4][2];
#pragma unroll
        for (int kh = 0; kh < 2; ++kh) {
#pragma unroll
            for (int m = 0; m < 4; ++m) if (FULL || m < mlim) af[m][kh] = *(LAS bf16x8*)(lds + s * 32768 + aoff[kh] + m * 2048);
#pragma unroll
            for (int n = 0; n < 4; ++n) bf[n][kh] = *(LAS bf16x8*)(lds + s * 32768 + boff[kh] + n * 2048);
        }
        __builtin_amdgcn_s_setprio(1);
#pragma unroll
        for (int kh = 0; kh < 2; ++kh)
#pragma unroll
            for (int m = 0; m < 4; ++m) if (FULL || m < mlim) {
#pragma unroll
                for (int n = 0; n < 4; ++n)
                    acc[m][n] = SWAP ? __builtin_amdgcn_mfma_f32_16x16x32_bf16(bf[n][kh], af[m][kh], acc[m][n], 0, 0, 0)
                                     : __builtin_amdgcn_mfma_f32_16x16x32_bf16(af[m][kh], bf[n][kh], acc[m][n], 0, 0, 0);
            }
        __builtin_amdgcn_s_setprio(0);
    }
    __syncthreads();
#undef GM_STAGE
}
template <bool SWAP>
__device__ __forceinline__ void gemm_main(LAS char* lds, const bf16_t* Ag, int lda, const bf16_t* Bg, int ldb, int nk, f32x4 (&acc)[4][4], int mlim = 4) {
    if (mlim == 4) gemm_kloop<SWAP, true>(lds, Ag, lda, Bg, ldb, nk, acc, 4);
    else gemm_kloop<SWAP, false>(lds, Ag, lda, Bg, ldb, nk, acc, mlim);
}
__device__ __forceinline__ void zero_acc(f32x4 (&acc)[4][4]) {
#pragma unroll
    for (int m = 0; m < 4; ++m)
#pragma unroll
        for (int n = 0; n < 4; ++n) acc[m][n] = (f32x4){0.f, 0.f, 0.f, 0.f};
}


__device__ __forceinline__ int tile_at(int it, int ntm, int ntn, int& tm, int& tn) {
    const int G = gridDim.x;
    if (G % 256 != 0) { const int t = it * G + blockIdx.x; if (t >= ntm * ntn) return 0; tm = t / ntn; tn = t % ntn; return 1; }
    const int xcd = blockIdx.x & 7, j = blockIdx.x >> 3, ppx = G >> 8;
    const int pcols = (ntn + 3) >> 2, prows = (ntm + 7) >> 3;
    const int patch = (it * ppx + (j >> 5)) * 8 + xcd;
    if (patch >= prows * pcols) return 0;
    const int wi = j & 31;
    tm = (patch / pcols) * 8 + (wi >> 2); tn = (patch % pcols) * 4 + (wi & 3);
    return (tm < ntm && tn < ntn) ? 1 : 2;
}
__device__ __forceinline__ void cumsum_block(const Params& p, LAS char* lds, int bh) {
    const float* lf = (const float*)(p.ws + WS_LOGF) + (size_t)bh * LPK; float* ck = (float*)(p.ws + WS_CK) + (size_t)bh * LPK;
    LAS float* wsum = (LAS float*)lds;
    const int tid = threadIdx.x, lane = tid & 63, w = wave_id(); constexpr int PER = 33, L = SEQ + NMETA;
    float v[PER];
#pragma unroll
    for (int e = 0; e < PER; ++e) { const int t = e * NTHREADS + tid; const int tc = t < L ? t : L - 1; const float x = lf[tc < 16 ? 8192 + tc : tc - 16]; v[e] = t < L ? x : 0.f; }
    float carry = 0.f;
#pragma unroll
    for (int e = 0; e < PER; ++e) {
        float x = v[e];
#pragma unroll
        for (int o = 1; o < 64; o <<= 1) { const float y = __shfl_up(x, o); if (lane >= o) x += y; }
        if (lane == 63) wsum[(e & 1) * 4 + w] = x;
        __syncthreads();
        const float s0 = wsum[(e & 1) * 4 + 0], s1 = wsum[(e & 1) * 4 + 1], s2 = wsum[(e & 1) * 4 + 2], s3 = wsum[(e & 1) * 4 + 3];
        const float pre = (w > 0 ? s0 : 0.f) + (w > 1 ? s1 : 0.f) + (w > 2 ? s2 : 0.f);
        const int t = e * NTHREADS + tid;
        if (t < L) ck[t < 16 ? 8192 + t : t - 16] = (carry + pre + x) * LOG2E;
        carry += (s0 + s1) + (s2 + s3);
    }
    __syncthreads();
}

__device__ __forceinline__ void phase1(const Params& p, LAS char* lds) {
    unsigned char* ws = p.ws;
    if ((int)blockIdx.x >= (int)gridDim.x - 16) cumsum_block(p, lds, gridDim.x - 1 - blockIdx.x);
    const int lane = threadIdx.x & 63, w = wave_id(), wr = w >> 1, wc = w & 1;
    const bf16_t* xb = (const bf16_t*)(ws + WS_A); const bf16_t* Bt = (const bf16_t*)(ws + WS_BTIN);
    const float* r1 = (const float*)(ws + WS_R1);
    constexpr int NTN = 40, NTM = 129;
    for (int it = 0;; ++it) {
        int tm, tn; int st = tile_at(it, NTM - 1, NTN, tm, tn);
        if (st == 0) { if (it < (1 << 20) && (int)blockIdx.x < NTN) { tm = NTM - 1; tn = blockIdx.x; it = 1 << 20; st = 1; } else break; }
        if (st == 2) continue;
        const int row0 = tm * 128, col0 = tn * 128; const int mlim = tm == NTM - 1 ? (wr == 0 ? 2 : 0) : 4;
        const bool vtile = (tn >= 8 && tn < 12) || (tn >= 20 && tn < 24);
        f32x4 acc[4][4]; zero_acc(acc);
        if (vtile) {
            gemm_main<false>(lds, xb + (size_t)row0 * D, D, Bt + (size_t)col0 * D, D, 16, acc, mlim);
            bf16_t* vT = (bf16_t*)(ws + (tn < 12 ? WS_VFT : WS_VST)); const int cb = tn < 12 ? 1024 : 2560;
            const int g = lane >> 4, gp = ((g & 1) << 1) | (g >> 1);
#pragma unroll
            for (int m = 0; m < 4; ++m) {
                const int rb = row0 + wr * 64 + m * 16; int b, kb16;
                if (rb < MX) { b = rb >> 13; kb16 = rb & 8191; } else { const int j = rb - MX; if (j >= 32) continue; b = j >> 4; kb16 = 8192; }
                const f32x4 rs = *(const f32x4*)(r1 + rb + g * 4);
#pragma unroll
                for (int n = 0; n < 4; ++n) {
                    const int dc = col0 + wc * 64 + n * 16 + (lane & 15) - cb, h = dc >> 6, d = dc & 63;
                    const f32x4 v = acc[m][n] * rs;
                    *(u32x2*)(vT + ((size_t)(b * 8 + h) * 64 + d) * LPK + kb16 + gp * 4) = (u32x2){pk_bf16(v[0], v[1]), pk_bf16(v[2], v[3])};
                }
            }
        } else {
            gemm_main<true>(lds, xb + (size_t)row0 * D, D, Bt + (size_t)col0 * D, D, 16, acc, mlim);
            bf16_t* dst; int ld, cb; float sc = 1.f; bool sg = false;
            if (tn < 4) { dst = (bf16_t*)(ws + WS_QF); ld = 512; cb = 0; sc = 0.125f * LOG2E; }
            else if (tn < 8) { dst = (bf16_t*)(ws + WS_KF); ld = 512; cb = 512; }
            else if (tn < 16) { dst = (bf16_t*)(ws + WS_QS); ld = 512; cb = 1536; sc = 0.125f; }
            else if (tn < 20) { dst = (bf16_t*)(ws + WS_KS); ld = 512; cb = 2048; }
            else if (tn < 32) { dst = (bf16_t*)(ws + WS_B); ld = 1024; cb = 3072; sg = true; }
            else { dst = (bf16_t*)(ws + WS_B + SZ_M1024); ld = 1024; cb = 4096; sg = true; }
            const bool kfox = tn >= 4 && tn < 8;
            float wmax = 0.f;
#pragma unroll
            for (int m = 0; m < 4; ++m) {
                const int row = row0 + wr * 64 + m * 16 + (lane & 15); const float rs = r1[row] * sc;
                float s2 = 0.f;
#pragma unroll
                for (int n = 0; n < 4; ++n) {
                    const int col = col0 + wc * 64 + n * 16 + (lane >> 4) * 4 - cb;
                    f32x4 v = acc[m][n] * rs;
                    if (sg) { v[0] = sigmoidf_(v[0]); v[1] = sigmoidf_(v[1]); v[2] = sigmoidf_(v[2]); v[3] = sigmoidf_(v[3]); }
                    s2 += v[0] * v[0] + v[1] * v[1] + v[2] * v[2] + v[3] * v[3];
                    *(u32x2*)(dst + (size_t)row * ld + col) = (u32x2){pk_bf16(v[0], v[1]), pk_bf16(v[2], v[3])};
                }
                if (kfox) { s2 += __shfl_xor(s2, 16); s2 += __shfl_xor(s2, 32); wmax = fmaxf(wmax, s2); }
            }
            if (kfox) {
#pragma unroll
                for (int o = 1; o < 16; o <<= 1) wmax = fmaxf(wmax, __shfl_xor(wmax, o));
                if (lane == 0) {
                    unsigned* km = (unsigned*)(ws + WS_XBAR) + 32; const int head = (tn - 4) * 2 + wc; const unsigned bits = __float_as_uint(wmax);
                    if (row0 < MX) atomicMax(km + (row0 >> 13) * 8 + head, bits);
                    else { atomicMax(km + head, bits); atomicMax(km + 8 + head, bits); }
                }
            }
        }
    }
}

constexpr int AT_STAGE = 16640;
template <int TYPE>
__device__ __forceinline__ void attn_unit(LAS char* lds, const Params& p, int b, int h, int qb, int part = 0) {
    unsigned char* ws = p.ws;
    const int tid = threadIdx.x, lane = tid & 63, w = wave_id(), ql = lane & 31, hi = lane >> 5;
    const bf16_t* Q = (const bf16_t*)(ws + (TYPE == 0 ? WS_QF : WS_QS));
    const bf16_t* Kp = (const bf16_t*)(ws + (TYPE == 0 ? WS_KF : WS_KS));
    const bf16_t* VT = (const bf16_t*)(ws + (TYPE == 0 ? WS_VFT : WS_VST)) + (size_t)(b * 8 + h) * 64 * LPK;
    const float* cK = (const float*)(ws + WS_CK) + (size_t)(b * 8 + h) * LPK;
    bf16_t* Oo = (bf16_t*)(ws + WS_A + (TYPE == 0 ? 0 : SZ_M512));
    const bool meta_unit = qb < 0;
    const int qrow0 = meta_unit ? MX + 16 * b : b * SEQ + qb * 128;
    const int nt = meta_unit ? 1 : 2 * qb + 3;
    int qrow = qrow0 + 32 * w + ql; if (qrow > M - 1) qrow = M - 1;
    bf16x8 qf[4];
#pragma unroll
    for (int ds = 0; ds < 4; ++ds) qf[ds] = *(const bf16x8*)(Q + (size_t)qrow * 512 + h * 64 + ds * 16 + hi * 8);
    f32x16 O0, O1;
#pragma unroll
    for (int i = 0; i < 16; ++i) { O0[i] = 0.f; O1[i] = 0.f; }
    float m_run = -INFINITY, lsum = 0.f, R = 0.f;
    const int JA = qb + 2;
    const int j0 = part == 2 ? JA : 0, j1 = part == 1 ? JA : nt;
    if (TYPE == 0 && part == 2) {
        float dg = 0.f;
#pragma unroll
        for (int ds = 0; ds < 4; ++ds) {
            const bf16x8 kd = *(const bf16x8*)(Kp + (size_t)qrow * 512 + h * 64 + ds * 16 + hi * 8);
#pragma unroll
            for (int e = 0; e < 8; ++e) dg += __uint_as_float((unsigned)(unsigned short)qf[ds][e] << 16) * __uint_as_float((unsigned)(unsigned short)kd[e] << 16);
        }
        dg += __shfl_xor(dg, 32);
        m_run = dg - cK[qb * 128 + 32 * w + ql] - 1.0f;
    }
    float qbound = 0.f;
    if (TYPE == 0) {
        float q2 = 0.f;
#pragma unroll
        for (int ds = 0; ds < 4; ++ds)
#pragma unroll
            for (int e = 0; e < 8; ++e) { const float x = __uint_as_float((unsigned)(unsigned short)qf[ds][e] << 16); q2 += x * x; }
        q2 += __shfl_xor(q2, 32);
        const unsigned kb = __hip_atomic_load((unsigned*)(ws + WS_XBAR) + 32 + b * 8 + h, __ATOMIC_RELAXED, __HIP_MEMORY_SCOPE_AGENT);
        qbound = sqrtf(q2) * sqrtf(__uint_as_float(kb)) * 1.02f + 1.0f;
    }
    u32x4 kreg[2], vreg[2]; float creg = 0.f;
    const int srow = tid >> 3, spos = tid & 7;
    const int swz_st = (spos ^ ((srow >> 1) & 7)) << 4;
    const int swz = (lane >> 1) & 7;
    LAS unsigned* flags = (LAS unsigned*)(lds + 2 * AT_STAGE);
#define AT_LOAD(j) do { int krow0_, kidx0_; if (!meta_unit && (j) < nt - 1) { const int kt_ = nt - 2 - (j); krow0_ = b * SEQ + 64 * kt_; kidx0_ = 64 * kt_; } else { krow0_ = MX + 16 * b; kidx0_ = 8192; } \
        _Pragma("unroll") for (int i_ = 0; i_ < 2; ++i_) { \
            kreg[i_] = *(const u32x4*)(Kp + (size_t)(krow0_ + srow + 32 * i_) * 512 + h * 64 + spos * 8); \
            vreg[i_] = *(const u32x4*)(VT + (size_t)(srow + 32 * i_) * LPK + kidx0_ + spos * 8); } \
        if (TYPE == 0 && tid < 64) creg = cK[kidx0_ + tid]; } while (0)
#define AT_WRITE(s) do { _Pragma("unroll") for (int i_ = 0; i_ < 2; ++i_) { \
            *(LAS u32x4*)(lds + (s) * AT_STAGE + (srow + 32 * i_) * 128 + swz_st) = kreg[i_]; \
            *(LAS u32x4*)(lds + (s) * AT_STAGE + 8192 + (srow + 32 * i_) * 128 + swz_st) = vreg[i_]; } \
        if (TYPE == 0 && tid < 64) *(LAS float*)(lds + (s) * AT_STAGE + 16384 + tid * 4) = creg; } while (0)
    AT_LOAD(j0); AT_WRITE(j0 & 1);
    __syncthreads();
    for (int j = j0; j < j1; ++j) {
        const bool more = j + 1 < j1;
        if (more) AT_LOAD(j + 1);
        int klim, d0;
        if (meta_unit) { klim = 16; d0 = 0; }
        else if (j == nt - 1) { klim = 16; d0 = 1 << 20; }
        else { klim = 64; d0 = 128 * qb - 64 * (nt - 2 - j); if (d0 >= 64) d0 = 1 << 20; }
        const int limw = 32 * w + d0 - TYPE;
        bool wdone = false, nomax = false;
        if (TYPE == 0) {
            const float clast = *(const LAS float*)(lds + (j & 1) * AT_STAGE + 16384 + (klim - 1) * 4);
            wdone = __all((qbound - clast - m_run) < -126.0f) != 0;
            nomax = __all((qbound - clast) <= m_run) != 0;
        }
        if (limw + 31 >= 0 && !(TYPE == 0 && wdone)) {
            const LAS char* sb = lds + (j & 1) * AT_STAGE;
            int kmax = limw + ql; if (kmax > klim - 1) kmax = klim - 1;
            const bool needmask = (klim < 64) || (limw < 63);
            f32x16 S0, S1;
#pragma unroll
            for (int i = 0; i < 16; ++i) { S0[i] = 0.f; S1[i] = 0.f; }
#pragma unroll
            for (int ds = 0; ds < 4; ++ds) {
                const bf16x8 k0 = *(const LAS bf16x8*)(sb + ql * 128 + (((2 * ds + hi) ^ swz) << 4));
                const bf16x8 k1 = *(const LAS bf16x8*)(sb + (32 + ql) * 128 + (((2 * ds + hi) ^ swz) << 4));
                S0 = __builtin_amdgcn_mfma_f32_32x32x16_bf16(k0, qf[ds], S0, 0, 0, 0);
                S1 = __builtin_amdgcn_mfma_f32_32x32x16_bf16(k1, qf[ds], S1, 0, 0, 0);
            }
            if (TYPE == 0) {
#pragma unroll
                for (int g = 0; g < 4; ++g) {
                    const f32x4 c0 = *(const LAS f32x4*)(sb + 16384 + (8 * g + 4 * hi) * 4), c1 = *(const LAS f32x4*)(sb + 16384 + (32 + 8 * g + 4 * hi) * 4);
#pragma unroll
                    for (int i = 0; i < 4; ++i) { S0[4 * g + i] -= c0[i]; S1[4 * g + i] -= c1[i]; }
                }
                if (needmask) {
#pragma unroll
                    for (int r = 0; r < 16; ++r) { const int kl = (r & 3) + 8 * (r >> 2) + 4 * hi; if (kl > kmax) S0[r] = -INFINITY; if (kl + 32 > kmax) S1[r] = -INFINITY; }
                }
                if (!nomax) {
                    float mx = -INFINITY;
#pragma unroll
                    for (int r = 0; r < 16; ++r) mx = fmaxf(mx, fmaxf(S0[r], S1[r]));
                    mx = fmaxf(mx, __shfl_xor(mx, 32));
                    const float m_new = fmaxf(m_run, mx), alpha = ex2(m_run - m_new);
                    m_run = m_new;
                    lsum *= alpha;
#pragma unroll
                    for (int r = 0; r < 16; ++r) { O0[r] *= alpha; O1[r] *= alpha; }
                }
                float ps = 0.f;
#pragma unroll
                for (int r = 0; r < 16; ++r) { S0[r] = ex2(S0[r] - m_run); S1[r] = ex2(S1[r] - m_run); ps += S0[r] + S1[r]; }
                lsum += ps;
            } else {
                float G0[4], G1[4];
                f32x16 L0, L1;
#pragma unroll
                for (int r = 0; r < 16; ++r) {
                    const int kl = (r & 3) + 8 * (r >> 2) + 4 * hi;
                    const float z0 = S0[r], z1 = S1[r];
                    const float sp0 = fmaxf(z0, 0.f) + lg2(1.0f + ex2(-fabsf(z0) * LOG2E)) * LN2;
                    const float sp1 = fmaxf(z1, 0.f) + lg2(1.0f + ex2(-fabsf(z1) * LOG2E)) * LN2;
                    L0[r] = (!needmask || kl <= kmax) ? -sp0 : 0.f;
                    L1[r] = (!needmask || kl + 32 <= kmax) ? -sp1 : 0.f;
                }
#pragma unroll
                for (int g = 0; g < 4; ++g) {
                    L0[4 * g + 2] += L0[4 * g + 3]; L0[4 * g + 1] += L0[4 * g + 2]; L0[4 * g] += L0[4 * g + 1]; G0[g] = L0[4 * g];
                    L1[4 * g + 2] += L1[4 * g + 3]; L1[4 * g + 1] += L1[4 * g + 2]; L1[4 * g] += L1[4 * g + 1]; G1[g] = L1[4 * g];
                }
                float run = R;
#pragma unroll
                for (int g = 3; g >= 0; --g) {
                    const float gp = __shfl_xor(G1[g], 32);
                    const float off = hi ? run : run + gp;
#pragma unroll
                    for (int i = 0; i < 4; ++i) { const int r = 4 * g + i; const int kl = 32 + i + 8 * g + 4 * hi;
                        const float a = ex2((S1[r] + L1[r] + off) * LOG2E); S1[r] = (!needmask || kl <= kmax) ? a : 0.f; }
                    run += G1[g] + gp;
                }
#pragma unroll
                for (int g = 3; g >= 0; --g) {
                    const float gp = __shfl_xor(G0[g], 32);
                    const float off = hi ? run : run + gp;
#pragma unroll
                    for (int i = 0; i < 4; ++i) { const int r = 4 * g + i; const int kl = i + 8 * g + 4 * hi;
                        const float a = ex2((S0[r] + L0[r] + off) * LOG2E); S0[r] = (!needmask || kl <= kmax) ? a : 0.f; }
                    run += G0[g] + gp;
                }
                R = run;
                wdone = __all(R < -120.0f) != 0;
            }
#pragma unroll
            for (int ks = 0; ks < 4; ++ks) {
                bf16x8 pf; u32x4 pu;
                if (ks < 2) { pu = (u32x4){pk_bf16(S0[8 * ks + 0], S0[8 * ks + 1]), pk_bf16(S0[8 * ks + 2], S0[8 * ks + 3]), pk_bf16(S0[8 * ks + 4], S0[8 * ks + 5]), pk_bf16(S0[8 * ks + 6], S0[8 * ks + 7])}; }
                else { const int k2 = ks - 2; pu = (u32x4){pk_bf16(S1[8 * k2 + 0], S1[8 * k2 + 1]), pk_bf16(S1[8 * k2 + 2], S1[8 * k2 + 3]), pk_bf16(S1[8 * k2 + 4], S1[8 * k2 + 5]), pk_bf16(S1[8 * k2 + 6], S1[8 * k2 + 7])}; }
                pf = __builtin_bit_cast(bf16x8, pu);
                const bf16x8 v0 = *(const LAS bf16x8*)(sb + 8192 + ql * 128 + (((2 * ks + hi) ^ swz) << 4));
                const bf16x8 v1 = *(const LAS bf16x8*)(sb + 8192 + (32 + ql) * 128 + (((2 * ks + hi) ^ swz) << 4));
                O0 = __builtin_amdgcn_mfma_f32_32x32x16_bf16(v0, pf, O0, 0, 0, 0);
                O1 = __builtin_amdgcn_mfma_f32_32x32x16_bf16(v1, pf, O1, 0, 0, 0);
            }
        }
        if (more) AT_WRITE((j + 1) & 1);
        if (lane == 0) flags[(j & 1) * 4 + w] = wdone ? 1u : 0u;
        __syncthreads();
        { const LAS unsigned* fl = flags + (j & 1) * 4; const unsigned f = fl[0] & fl[1] & fl[2] & fl[3]; if (f) break; }
    }
    float inv = 1.0f;
    if (TYPE == 0) { const float l = lsum + __shfl_xor(lsum, 32); inv = 1.0f / l; }
    const bool qvalid = meta_unit ? (w == 0 && ql < 16) : true;
    if (TYPE == 0 && part != 0) {
        float* rec = p.out + ((size_t)((((63 - qb) * 16 + b * 8 + h) * 2 + (part - 1)) * 128 + 32 * w + ql)) * 68;
        const float l = lsum + __shfl_xor(lsum, 32);
#pragma unroll
        for (int g = 0; g < 4; ++g) {
            *(f32x4*)(rec + 8 * g + 4 * hi) = (f32x4){O0[4 * g], O0[4 * g + 1], O0[4 * g + 2], O0[4 * g + 3]};
            *(f32x4*)(rec + 32 + 8 * g + 4 * hi) = (f32x4){O1[4 * g], O1[4 * g + 1], O1[4 * g + 2], O1[4 * g + 3]};
        }
        if (hi == 0) { rec[64] = m_run; rec[65] = l; }
    } else if (qvalid) {
        bf16_t* op = Oo + (size_t)qrow * 512 + h * 64 + 4 * hi;
#pragma unroll
        for (int g = 0; g < 4; ++g) {
            *(u32x2*)(op + 8 * g) = (u32x2){pk_bf16(O0[4 * g] * inv, O0[4 * g + 1] * inv), pk_bf16(O0[4 * g + 2] * inv, O0[4 * g + 3] * inv)};
            *(u32x2*)(op + 32 + 8 * g) = (u32x2){pk_bf16(O1[4 * g] * inv, O1[4 * g + 1] * inv), pk_bf16(O1[4 * g + 2] * inv, O1[4 * g + 3] * inv)};
        }
    }
    __syncthreads();
#undef AT_LOAD
#undef AT_WRITE
}


__device__ __forceinline__ void phase_comb(const Params& p) {
    bf16_t* oa = (bf16_t*)(p.ws + WS_A);
    for (int it = blockIdx.x * NTHREADS + threadIdx.x; it < 512 * 128 * 16; it += gridDim.x * NTHREADS) {
        const int d4 = it & 15, row = (it >> 4) & 127, su = it >> 11;
        const float* ra = p.out + ((size_t)((su * 2) * 128 + row)) * 68; const float* rb = ra + (size_t)128 * 68;
        const float ma = ra[64], la = ra[65], mb = rb[64], lb = rb[65];
        const float m = fmaxf(ma, mb), wa = ex2(ma - m), wb = ex2(mb - m), inv = 1.0f / (la * wa + lb * wb);
        const f32x4 a = *(const f32x4*)(ra + d4 * 4), bq = *(const f32x4*)(rb + d4 * 4);
        const f32x4 o = (a * wa + bq * wb) * inv;
        const int qb = 63 - (su >> 4), bh = su & 15;
        *(u32x2*)(oa + (size_t)((bh >> 3) * SEQ + qb * 128 + row) * 512 + (bh & 7) * 64 + d4 * 4) = (u32x2){pk_bf16(o[0], o[1]), pk_bf16(o[2], o[3])};
    }
}
__device__ __forceinline__ void phase2(const Params& p, LAS char* lds) {
    unsigned* ctr = (unsigned*)(p.ws + WS_XBAR);
    LAS unsigned* shu = (LAS unsigned*)(lds + 2 * AT_STAGE + 64);
    constexpr int NU = 2560 + 32;
    for (;;) {
        if (threadIdx.x == 0) shu[0] = __hip_atomic_fetch_add(ctr, 1u, __ATOMIC_RELAXED, __HIP_MEMORY_SCOPE_AGENT);
        __syncthreads();
        const int u = (int)shu[0];
        __syncthreads();
        if (u >= NU) break;
        if (u < 1280) {
            const int pr = u / 80, r = u - pr * 80;
            if (r < 32) attn_unit<0>(lds, p, (r >> 1) >> 3, (r >> 1) & 7, 63 - 2 * pr, 1 + (r & 1));
            else if (r < 48) attn_unit<0>(lds, p, (r - 32) >> 3, (r - 32) & 7, 31 - pr);
            else { const int q = r - 48; attn_unit<0>(lds, p, (q >> 1) >> 3, (q >> 1) & 7, 62 - 2 * pr, 1 + (q & 1)); }
        }
        else if (u < 1536) { const int v = u - 1280; attn_unit<0>(lds, p, (v & 15) >> 3, v & 7, 15 - (v >> 4)); }
        else if (u < 2560) { const int v = u - 1536; attn_unit<1>(lds, p, (v & 15) >> 3, v & 7, 63 - (v >> 4)); }
        else if (u < 2576) { const int v = u - 2560; attn_unit<0>(lds, p, v >> 3, v & 7, -1); }
        else { const int v = u - 2576; attn_unit<1>(lds, p, v >> 3, v & 7, -1); }
    }
}

__device__ __forceinline__ void phase3a(const Params& p, LAS char* lds) {
    unsigned char* ws = p.ws;
    const int lane = threadIdx.x & 63, w = wave_id(), wr = w >> 1, wc = w & 1;
    const bf16_t* oa = (const bf16_t*)(ws + WS_A); const bf16_t* ob = oa + (size_t)M * 512;
    const bf16_t* ga = (const bf16_t*)(ws + WS_B); const bf16_t* gb = ga + (size_t)M * 1024;
    bf16_t* gated = (bf16_t*)(ws + WS_GATED);
    for (int it = 0;; ++it) {
        int tm, tn; int st = tile_at(it, 128, 8, tm, tn);
        if (st == 0) { if (it < (1 << 20) && (int)blockIdx.x < 8) { tm = 128; tn = blockIdx.x; it = 1 << 20; st = 1; } else break; }
        if (st == 2) continue;
        const int row0 = tm * 128, col0 = tn * 128; const int mlim = tm == 128 ? (wr == 0 ? 2 : 0) : 4;
        f32x4 acc[4][4]; zero_acc(acc);
        gemm_main<true>(lds, oa + (size_t)row0 * 512, 512, (const bf16_t*)(ws + WS_BTOF) + (size_t)col0 * 512, 512, 8, acc, mlim);
#pragma unroll
        for (int m = 0; m < 4; ++m) {
            const int row = row0 + wr * 64 + m * 16 + (lane & 15);
#pragma unroll
            for (int n = 0; n < 4; ++n) {
                const int col = col0 + wc * 64 + n * 16 + (lane >> 4) * 4;
                const u32x2 a = *(const u32x2*)(ga + (size_t)row * 1024 + col);
                const f32x4 x = acc[m][n];
                *(u32x2*)(gated + (size_t)row * 1024 + col) = (u32x2){pk_bf16(bf_lo(a[0]) * x[0], bf_hi(a[0]) * x[1]), pk_bf16(bf_lo(a[1]) * x[2], bf_hi(a[1]) * x[3])};
            }
        }
        zero_acc(acc);
        gemm_main<true>(lds, ob + (size_t)row0 * 512, 512, (const bf16_t*)(ws + WS_BTOS) + (size_t)col0 * 512, 512, 8, acc, mlim);
#pragma unroll
        for (int m = 0; m < 4; ++m) {
            const int row = row0 + wr * 64 + m * 16 + (lane & 15);
#pragma unroll
            for (int n = 0; n < 4; ++n) {
                const int col = col0 + wc * 64 + n * 16 + (lane >> 4) * 4;
                const u32x2 b = *(const u32x2*)(gb + (size_t)row * 1024 + col);
                const f32x4 y = acc[m][n]; const u32x2 q = *(const u32x2*)(gated + (size_t)row * 1024 + col);
                const float o0 = bf_lo(q[0]) + bf_lo(b[0]) * y[0], o1 = bf_hi(q[0]) + bf_hi(b[0]) * y[1];
                const float o2 = bf_lo(q[1]) + bf_lo(b[1]) * y[2], o3 = bf_hi(q[1]) + bf_hi(b[1]) * y[3];
                *(u32x2*)(gated + (size_t)row * 1024 + col) = (u32x2){pk_bf16(o0, o1), pk_bf16(o2, o3)};
            }
        }
    }
}
__device__ __forceinline__ void epi_store_ss(const f32x4 (&acc)[4][4], bf16_t* out, int ldo, int orow0, int col0, float* ssp, int ssrow0, int wr, int wc, int lane) {
#pragma unroll
    for (int m = 0; m < 4; ++m) {
        const int rl = wr * 64 + m * 16 + (lane & 15);
        float s = 0.f;
#pragma unroll
        for (int n = 0; n < 4; ++n) {
            const int col = col0 + wc * 64 + n * 16 + (lane >> 4) * 4;
            const f32x4 v = acc[m][n];
            s += v[0] * v[0] + v[1] * v[1] + v[2] * v[2] + v[3] * v[3];
            *(u32x2*)(out + (size_t)(orow0 + rl) * ldo + col) = (u32x2){pk_bf16(v[0], v[1]), pk_bf16(v[2], v[3])};
        }
#if 1
        s += __shfl_xor(s, 16); s += __shfl_xor(s, 32);
        if (lane < 16) ssp[(size_t)((col0 >> 7) * 2 + wc) * M + ssrow0 + rl] = s;
#endif
    }
}
__device__ __forceinline__ void phase3b(const Params& p, LAS char* lds) {
    unsigned char* ws = p.ws;
    const int lane = threadIdx.x & 63, w = wave_id(), wr = w >> 1, wc = w & 1;
    const bf16_t* gated = (const bf16_t*)(ws + WS_GATED); bf16_t* mixed = (bf16_t*)(ws + WS_MIXED);
    for (int it = 0;; ++it) {
        int tm, tn; int st = tile_at(it, 128, 8, tm, tn);
        if (st == 0) { if (it < (1 << 20) && (int)blockIdx.x < 8) { tm = 128; tn = blockIdx.x; it = 1 << 20; st = 1; } else break; }
        if (st == 2) continue;
        const int row0 = tm * 128, col0 = tn * 128; const int mlim = tm == 128 ? (wr == 0 ? 2 : 0) : 4;
        f32x4 acc[4][4]; zero_acc(acc);
        gemm_main<true>(lds, gated + (size_t)row0 * 1024, 1024, (const bf16_t*)(ws + WS_BTOUT) + (size_t)col0 * 1024, 1024, 16, acc, mlim);
        epi_store_ss(acc, mixed, 1024, row0, col0, (float*)(ws + WS_SSP2), row0, wr, wc, lane);
    }
}
__device__ __forceinline__ void phase3c(const Params& p) {
    unsigned char* ws = p.ws;
    const int lane = threadIdx.x & 63, w = wave_id();
    const bf16_t* mixed = (const bf16_t*)(ws + WS_MIXED); bf16_t* hb = (bf16_t*)(ws + WS_A);
    const float* ssp2 = (const float*)(ws + WS_SSP2); float* r2 = (float*)(ws + WS_R2);
    const float* g1 = p.gains + D;
    f32x4 g[4];
#pragma unroll
    for (int i = 0; i < 4; ++i) g[i] = *(const f32x4*)(g1 + lane * 4 + 256 * i);
    for (int grp = blockIdx.x; grp * 32 < MV; grp += gridDim.x) {
#pragma unroll 1
        for (int k = 0; k < 8; k += 2) {
            int r[2]; bool ok[2]; f32x4 v[2][4]; u32x2 mx[2][4]; float sq[2];
#pragma unroll
            for (int j = 0; j < 2; ++j) {
                r[j] = grp * 32 + w + 4 * (k + j); ok[j] = r[j] < MV; const int rr = ok[j] ? r[j] : 0;
                const float* src = rr < MX ? p.x + (size_t)rr * D : p.meta + (size_t)((rr - MX) & 15) * D;
                sq[j] = lane < 16 ? ssp2[(size_t)lane * M + rr] : 0.f;
#pragma unroll
                for (int i = 0; i < 4; ++i) { v[j][i] = *(const f32x4*)(src + lane * 4 + 256 * i); mx[j][i] = *(const u32x2*)(mixed + (size_t)rr * D + lane * 4 + 256 * i); }
            }
#pragma unroll
            for (int j = 0; j < 2; ++j) {
                const float a = 1.0f / sqrtf(wave_sum(sq[j]) * (1.0f / D) + EPS);
                float ss = 0.f;
#pragma unroll
                for (int i = 0; i < 4; ++i) {
                    const int col = lane * 4 + 256 * i;
                    f32x4 hh;
                    hh[0] = v[j][i][0] + bf_lo(mx[j][i][0]) * a * g[i][0]; hh[1] = v[j][i][1] + bf_hi(mx[j][i][0]) * a * g[i][1];
                    hh[2] = v[j][i][2] + bf_lo(mx[j][i][1]) * a * g[i][2]; hh[3] = v[j][i][3] + bf_hi(mx[j][i][1]) * a * g[i][3];
                    ss += hh[0] * hh[0] + hh[1] * hh[1] + hh[2] * hh[2] + hh[3] * hh[3];
                    if (ok[j]) {
                        *(u32x2*)(hb + (size_t)r[j] * D + col) = (u32x2){pk_bf16(hh[0], hh[1]), pk_bf16(hh[2], hh[3])};
                        if (r[j] < MX) *(f32x4*)(p.out + (size_t)r[j] * D + col) = hh;
                    }
                }
                ss = wave_sum(ss);
                if (ok[j] && lane == 0) r2[r[j]] = 1.0f / sqrtf(ss * (1.0f / D) + EPS);
            }
        }
    }
}
constexpr int UST = 272;
__device__ __forceinline__ f32x4 unpack4(const u32x2 u) { return (f32x4){bf_lo(u[0]), bf_hi(u[0]), bf_lo(u[1]), bf_hi(u[1])}; }
struct ConvW { f32x4 w0g, w1g, w2g, bg, w0v, w1v, w2v, bv; };
__device__ __forceinline__ ConvW load_convw(const Params& p, int c) {
    ConvW q;
    q.w0g = *(const f32x4*)(p.conv_w + c); q.w1g = *(const f32x4*)(p.conv_w + NUP + c); q.w2g = *(const f32x4*)(p.conv_w + 2 * NUP + c); q.bg = *(const f32x4*)(p.conv_b + c);
    q.w0v = *(const f32x4*)(p.conv_w + DFF + c); q.w1v = *(const f32x4*)(p.conv_w + NUP + DFF + c); q.w2v = *(const f32x4*)(p.conv_w + 2 * NUP + DFF + c); q.bv = *(const f32x4*)(p.conv_b + DFF + c);
    return q;
}
__device__ __forceinline__ u32x2 conv_gelu4(const ConvW& q, const f32x4 g2, const f32x4 g1, const f32x4 g0, const f32x4 v2, const f32x4 v1, const f32x4 v0) {
    float o[4];
#pragma unroll
    for (int e = 0; e < 4; ++e) {
        const float ug = q.bg[e] + q.w0g[e] * g2[e] + q.w1g[e] * g1[e] + q.w2g[e] * g0[e];
        const float uv = q.bv[e] + q.w0v[e] * v2[e] + q.w1v[e] * v1[e] + q.w2v[e] * v0[e];
        const float t = 0.7978845608028654f * (ug + 0.044715f * ug * ug * ug);
        o[e] = ug * rcp(1.0f + ex2(-2.0f * LOG2E * t)) * uv;
    }
    return (u32x2){pk_bf16(o[0], o[1]), pk_bf16(o[2], o[3])};
}
__device__ __forceinline__ void phase4(const Params& p, LAS char* lds) {
    unsigned char* ws = p.ws;
    const int tid = threadIdx.x, lane = tid & 63, w = wave_id(), wr = w >> 1, wc = w & 1;
    const bf16_t* hb = (const bf16_t*)(ws + WS_A); const bf16_t* Bt = (const bf16_t*)(ws + WS_BTUP);
    const float* r2 = (const float*)(ws + WS_R2);
    bf16_t* act = (bf16_t*)(ws + WS_ACT); bf16_t* hal = (bf16_t*)(ws + WS_HAL);
    for (int it = 0;; ++it) {
        int tm, tn; int st = tile_at(it, 128, 44, tm, tn);
        if (st == 0) { if (it < (1 << 20) && (int)blockIdx.x < 44) { tm = 128; tn = blockIdx.x; it = 1 << 20; st = 1; } else break; }
        if (st == 2) continue;
        const bool mt = tm == 128; const int row0 = mt ? MX : tm * 128, col0 = tn * 128;
        f32x4 acc[4][4]; zero_acc(acc);
        gemm_main<true>(lds, hb + (size_t)row0 * D, D, Bt + (size_t)col0 * D, D, 16, acc, mt ? (wr == 0 ? 2 : 0) : 4);
#pragma unroll
        for (int m = 0; m < 4; ++m) {
            const int rl = wr * 64 + m * 16 + (lane & 15); const float rs = r2[row0 + rl];
#pragma unroll
            for (int n = 0; n < 4; ++n) {
                const int cl = wc * 64 + n * 16 + (lane >> 4) * 4; const f32x4 v = acc[m][n] * rs;
                *(LAS u32x2*)(lds + rl * UST + cl * 2) = (u32x2){pk_bf16(v[0], v[1]), pk_bf16(v[2], v[3])};
            }
        }
        __syncthreads();
        if (!mt) {
            const int cg = tid & 15, rb = tid >> 4, c = tn * 64 + cg * 4;
            const ConvW q = load_convw(p, c);
            const int hr = rb == 0 ? 0 : rb * 8 - 2;
            f32x4 g2 = unpack4(*(const LAS u32x2*)(lds + hr * UST + cg * 8)), v2 = unpack4(*(const LAS u32x2*)(lds + hr * UST + 128 + cg * 8));
            f32x4 g1 = unpack4(*(const LAS u32x2*)(lds + (hr + 1) * UST + cg * 8)), v1 = unpack4(*(const LAS u32x2*)(lds + (hr + 1) * UST + 128 + cg * 8));
            for (int r = hr + 2; r < rb * 8 + 8; ++r) {
                const f32x4 g0 = unpack4(*(const LAS u32x2*)(lds + r * UST + cg * 8)), v0 = unpack4(*(const LAS u32x2*)(lds + r * UST + 128 + cg * 8));
                *(u32x2*)(act + (size_t)(row0 + r) * DFF + c) = conv_gelu4(q, g2, g1, g0, v2, v1, v0);
                g2 = g1; g1 = g0; v2 = v1; v1 = v0;
            }
            if (tid < 64) { const int qq = tid >> 4, ch = tid & 15, rl = qq < 2 ? qq : 124 + qq;
                *(u32x4*)(hal + ((size_t)tm * 4 + qq) * NUP + col0 + ch * 8) = *(const LAS u32x4*)(lds + rl * UST + ch * 16); }
        } else {
            if (tid < 64) { const int qq = tid >> 4, ch = tid & 15, rl = (qq >> 1) * 16 + 14 + (qq & 1);
                *(u32x4*)(hal + ((size_t)(128 + (qq >> 1)) * 4 + 2 + (qq & 1)) * NUP + col0 + ch * 8) = *(const LAS u32x4*)(lds + rl * UST + ch * 16); }
        }
        __syncthreads();
    }
}
__device__ __forceinline__ void phase_fix(const Params& p) {
    unsigned char* ws = p.ws;
    const bf16_t* hal = (const bf16_t*)(ws + WS_HAL); bf16_t* act = (bf16_t*)(ws + WS_ACT);
    constexpr int NCG = DFF / 4;
    for (int it = blockIdx.x * NTHREADS + threadIdx.x; it < 128 * NCG; it += gridDim.x * NTHREADS) {
        const int tmg = it / NCG, c = (it % NCG) * 4, colg = (c >> 6) * 128 + (c & 63), colv = colg + 64;
        const bf16_t* own = hal + (size_t)tmg * 4 * NUP;
        const bf16_t* prv = hal + (size_t)((tmg & 63) ? tmg - 1 : 128 + (tmg >> 6)) * 4 * NUP;
        const ConvW q = load_convw(p, c);
        const f32x4 pg2 = unpack4(*(const u32x2*)(prv + 2 * NUP + colg)), pv2 = unpack4(*(const u32x2*)(prv + 2 * NUP + colv));
        const f32x4 pg3 = unpack4(*(const u32x2*)(prv + 3 * NUP + colg)), pv3 = unpack4(*(const u32x2*)(prv + 3 * NUP + colv));
        const f32x4 og0 = unpack4(*(const u32x2*)(own + colg)), ov0 = unpack4(*(const u32x2*)(own + colv));
        const f32x4 og1 = unpack4(*(const u32x2*)(own + NUP + colg)), ov1 = unpack4(*(const u32x2*)(own + NUP + colv));
        *(u32x2*)(act + (size_t)(tmg * 128) * DFF + c) = conv_gelu4(q, pg2, pg3, og0, pv2, pv3, ov0);
        *(u32x2*)(act + (size_t)(tmg * 128 + 1) * DFF + c) = conv_gelu4(q, pg3, og0, og1, pv3, ov0, ov1);
    }
}
__device__ __forceinline__ void phase6(const Params& p, LAS char* lds) {
    unsigned char* ws = p.ws;
    const int lane = threadIdx.x & 63, w = wave_id(), wr = w >> 1, wc = w & 1;
    const bf16_t* act = (const bf16_t*)(ws + WS_ACT); bf16_t* ffn = (bf16_t*)(ws + WS_FFN);
    for (int it = 0;; ++it) {
        int tm, tn; const int st = tile_at(it, 128, 8, tm, tn); if (st == 0) break; if (st == 2) continue;
        const int col0 = tn * 128;
        f32x4 acc[4][4]; zero_acc(acc);
        gemm_main<true>(lds, act + (size_t)(tm * 128) * DFF, DFF, (const bf16_t*)(ws + WS_BTDN) + (size_t)col0 * DFF, DFF, 44, acc);
        epi_store_ss(acc, ffn, 1024, tm * 128, col0, (float*)(ws + WS_SSP4), tm * 128, wr, wc, lane);
    }
}
__device__ __forceinline__ void phase7(const Params& p) {
    unsigned char* ws = p.ws;
    const int lane = threadIdx.x & 63, w = wave_id();
    const bf16_t* ffn = (const bf16_t*)(ws + WS_FFN); const float* ssp4 = (const float*)(ws + WS_SSP4); const float* g3 = p.gains + 3 * D;
    f32x4 g[4];
#pragma unroll
    for (int i = 0; i < 4; ++i) g[i] = *(const f32x4*)(g3 + lane * 4 + 256 * i);
    for (int r0 = (blockIdx.x * 4 + w) * 2; r0 < MX; r0 += gridDim.x * 8) {
        f32x4 hh[2][4]; u32x2 f[2][4]; float sq[2];
#pragma unroll
        for (int j = 0; j < 2; ++j) {
            const int row = r0 + j;
            sq[j] = lane < 16 ? ssp4[(size_t)lane * M + row] : 0.f;
#pragma unroll
            for (int i = 0; i < 4; ++i) { hh[j][i] = *(const f32x4*)(p.out + (size_t)row * D + lane * 4 + 256 * i); f[j][i] = *(const u32x2*)(ffn + (size_t)row * D + lane * 4 + 256 * i); }
        }
#pragma unroll
        for (int j = 0; j < 2; ++j) {
            const float a = 1.0f / sqrtf(wave_sum(sq[j]) * (1.0f / D) + EPS);
#pragma unroll
            for (int i = 0; i < 4; ++i) {
                f32x4 o;
                o[0] = hh[j][i][0] + bf_lo(f[j][i][0]) * a * g[i][0]; o[1] = hh[j][i][1] + bf_hi(f[j][i][0]) * a * g[i][1];
                o[2] = hh[j][i][2] + bf_lo(f[j][i][1]) * a * g[i][2]; o[3] = hh[j][i][3] + bf_hi(f[j][i][1]) * a * g[i][3];
                *(f32x4*)(p.out + (size_t)(r0 + j) * D + lane * 4 + 256 * i) = o;
            }
        }
    }
}


#ifndef DUMP
#define DUMP 0
#endif
__device__ __forceinline__ void phase_dump(const Params& p) {
    unsigned char* ws = p.ws;
    const bf16_t* s0; const bf16_t* s1; int ld;
    if (DUMP == 1) { s0 = (const bf16_t*)(ws + WS_B); s1 = s0 + 512; ld = 1024; }
    else if (DUMP == 2) { s0 = (const bf16_t*)(ws + WS_QF); s1 = (const bf16_t*)(ws + WS_KF); ld = 512; }
    else if (DUMP == 3) { s0 = (const bf16_t*)(ws + WS_A); s1 = s0 + (size_t)M * 512; ld = 512; }
    else if (DUMP == 4) { s0 = (const bf16_t*)(ws + WS_GATED); s1 = s0 + 512; ld = 1024; }
    else if (DUMP == 8) { s0 = (const bf16_t*)(ws + WS_A); s1 = s0 + 512; ld = 1024; }
    else if (DUMP == 9) { s0 = (const bf16_t*)(ws + WS_ACT) + 1024; s1 = (const bf16_t*)(ws + WS_ACT) + 2304 - 512 + 512; ld = DFF; }
    else if (DUMP == 10) { s0 = (const bf16_t*)(ws + WS_FFN); s1 = s0 + 512; ld = 1024; }
    else if (DUMP == 6) { s0 = (const bf16_t*)(ws + WS_QS); s1 = (const bf16_t*)(ws + WS_KS); ld = 512; }
    else { s0 = (const bf16_t*)(ws + WS_MIXED); s1 = s0 + 512; ld = 1024; }
    for (int it = blockIdx.x * NTHREADS + threadIdx.x; it < MX * 1024; it += gridDim.x * NTHREADS) {
        const int row = it >> 10, col = it & 1023;
        if (DUMP >= 9 && row >= 8192) { p.out[it] = 0.f; continue; }
        const bf16_t v = col < 512 ? s0[(size_t)row * ld + col] : s1[(size_t)row * ld + col - 512];
        p.out[it] = __uint_as_float((unsigned)v << 16);
    }
}

__device__ __forceinline__ void l2_scrub(const Params& p) {
    const f32x4* src = (const f32x4*)p.x + (size_t)(blockIdx.x & 511) * 8192;
    f32x4 a = (f32x4){0.f, 0.f, 0.f, 0.f};
    for (int i = threadIdx.x; i < 8192; i += NTHREADS) a += src[i];
    if (a[0] + a[1] + a[2] + a[3] == 1.2345e-30f) ((float*)(p.ws + WS_CTL))[32 + (threadIdx.x & 7)] = a[0];
}


#define XB_TMO      128
#define XB_XCNT(j)  (256  + 64 * (j))
#define XB_XSUB(j)  (1280 + 64 * (j))
#define XB_XGEN(j)  (2304 + 64 * (j))
#define XB_TOP      3328
#define XB_TOPGEN   3392
#define XCD_BAR_WORDS 3456
#define XB_SPIN_CAP (1u << 18)
__device__ __forceinline__ unsigned xb_ld(unsigned* p)              { return __hip_atomic_load(p, __ATOMIC_RELAXED, __HIP_MEMORY_SCOPE_AGENT); }
__device__ __forceinline__ unsigned xb_add(unsigned* p, unsigned v) { return __hip_atomic_fetch_add(p, v, __ATOMIC_RELAXED, __HIP_MEMORY_SCOPE_AGENT); }
__device__ __forceinline__ unsigned xb_xcc_id() { return (unsigned)__builtin_amdgcn_s_getreg((3 << 11) | 20) & 0xFu; }
#define XB_SPIN(cond, bar) do { unsigned _sp = 0; while (cond) { __builtin_amdgcn_s_sleep(1); \
    if ((++_sp & 255u) == 0u) { if (xb_ld(&(bar)[XB_TMO])) break; if (_sp > XB_SPIN_CAP) { atomicAdd(&(bar)[XB_TMO], 1u); break; } } } } while (0)
struct XcdBarrier { unsigned* bar; unsigned x; volatile LAS unsigned* st; };
__device__ __forceinline__ XcdBarrier xcd_barrier_post(unsigned* bar, volatile LAS unsigned* st) {
    XcdBarrier b; b.bar = bar; b.x = xb_xcc_id(); b.st = st;
    if (threadIdx.x == 0) (void)xb_add(&bar[XB_XCNT(b.x)], 1u);
    return b;
}
__device__ __forceinline__ void xcd_barrier_complete(unsigned* bar, unsigned x, unsigned& nloc, unsigned& nx) {
    const unsigned G = gridDim.x * gridDim.y * gridDim.z;
    unsigned sum, cnt, mine, sp = 0u;
    for (;;) {
        sum = 0u; cnt = 0u; mine = 0u;
#pragma unroll
        for (unsigned j = 0; j < 16; ++j) { const unsigned c = xb_ld(&bar[XB_XCNT(j)]); sum += c; cnt += (c > 0u) ? 1u : 0u; mine = (j == x) ? c : mine; }
        if (sum == G) break;
        __builtin_amdgcn_s_sleep(1);
        if ((++sp & 255u) == 0u) { if (xb_ld(&bar[XB_TMO])) break; if (sp > XB_SPIN_CAP) { atomicAdd(&bar[XB_TMO], 1u); break; } }
    }
    nloc = mine > 0u ? mine : 1u; nx = cnt > 0u ? cnt : 1u;
}
__device__ __forceinline__ void xcd_barrier(const XcdBarrier& b) {
    asm volatile("s_waitcnt vmcnt(0)" ::: "memory");
    __syncthreads();
    if (threadIdx.x == 0) {
        unsigned* bar = b.bar;
        __builtin_amdgcn_s_waitcnt(0);
        unsigned nloc = b.st[0], nx = b.st[1];
        if (nloc == 0u) { xcd_barrier_complete(bar, b.x, nloc, nx); b.st[0] = nloc; b.st[1] = nx; }
        const unsigned old = xb_add(&bar[XB_XSUB(b.x)], 1u);
        const unsigned gen = old / nloc;
        if (old + 1u == (gen + 1u) * nloc) {
            __builtin_amdgcn_fence(__ATOMIC_RELEASE, "agent");
            asm volatile("s_waitcnt vmcnt(0)" ::: "memory");
            const unsigned og = xb_add(&bar[XB_TOP], 1u);
            const unsigned tg = og / nx;
            if (og + 1u == (tg + 1u) * nx) xb_add(&bar[XB_TOPGEN], 1u);
            else XB_SPIN(xb_ld(&bar[XB_TOPGEN]) == tg, bar);
            __builtin_amdgcn_fence(__ATOMIC_ACQUIRE, "agent");
            xb_add(&bar[XB_XGEN(b.x)], 1u);
            asm volatile("s_waitcnt vmcnt(0)" ::: "memory");
        } else {
            XB_SPIN(xb_ld(&bar[XB_XGEN(b.x)]) == gen, bar);
            __builtin_amdgcn_fence(__ATOMIC_ACQUIRE, "agent");
            asm volatile("s_waitcnt vmcnt(0)" ::: "memory");
        }
    }
    __syncthreads();
}

__device__ __forceinline__ void my_grid_sync(const Params& p, unsigned& target) {
    unsigned* bar = (unsigned*)(p.ws + WS_CTL) + 16;
    asm volatile("s_waitcnt vmcnt(0)" ::: "memory");
    __syncthreads();
    target += gridDim.x;
    if (threadIdx.x == 0) {
        __builtin_amdgcn_fence(__ATOMIC_RELEASE, "agent");
        asm volatile("s_waitcnt vmcnt(0)" ::: "memory");
        __hip_atomic_fetch_add(bar, 1u, __ATOMIC_RELAXED, __HIP_MEMORY_SCOPE_AGENT);
        while (__hip_atomic_load(bar, __ATOMIC_RELAXED, __HIP_MEMORY_SCOPE_AGENT) < target) __builtin_amdgcn_s_sleep(2);
        __builtin_amdgcn_fence(__ATOMIC_ACQUIRE, "agent");
        asm volatile("s_waitcnt vmcnt(0)" ::: "memory");
    }
    __syncthreads();
}
__global__ void __launch_bounds__(NTHREADS, 2) fwd_kernel(Params p) {
    extern __shared__ __attribute__((aligned(16))) unsigned char lds_raw[];
    LAS char* lds = (LAS char*)lds_raw;
    cg::grid_group grid = cg::this_grid();
#define IN(k) (p.ph_lo <= (k) && (k) < p.ph_hi)
#define SEAM(k) do { if (IN(k) && IN((k) + 1)) { if (p.ph_hi > 1000) grid.sync(); xcd_barrier(xbar); } } while (0)
    volatile LAS unsigned* xst = (volatile LAS unsigned*)(lds + 65536);
    if (threadIdx.x < 4) xst[threadIdx.x] = 0u;
    __syncthreads();
    const XcdBarrier xbar = xcd_barrier_post((unsigned*)(p.ws + WS_XBAR), xst);
    if (IN(0)) phase0(p, lds);
    SEAM(0);
    if (IN(1)) phase1(p, lds);
    SEAM(1);
    if (IN(2)) phase2(p, lds);
    SEAM(2);
    if (IN(3)) phase_comb(p);
    SEAM(3);
    if (IN(4)) phase3a(p, lds);
    SEAM(4);
    if (IN(5)) phase3b(p, lds);
    SEAM(5);
    if (IN(6)) phase3c(p);
    SEAM(6);
    if (IN(7)) phase4(p, lds);
    SEAM(7);
    if (IN(8)) phase_fix(p);
    SEAM(8);
    if (IN(9)) phase6(p, lds);
    SEAM(9);
    if (IN(10)) phase7(p);
#undef IN
#undef SEAM
}


__global__ void ab_save(const unsigned char* ws, float* out) {
    const u32x4* src = (const u32x4*)(ws + AB_SRC); u32x4* dst = (u32x4*)((unsigned char*)out + (size_t)32 * MiB);
    for (size_t i = blockIdx.x * (size_t)blockDim.x + threadIdx.x; i < (size_t)AB_BYTES / 16; i += (size_t)gridDim.x * blockDim.x) dst[i] = src[i];
}
__global__ void ab_diff(const unsigned char* ws, float* out) {
    const bf16_t* src = (const bf16_t*)(ws + AB_SRC); const bf16_t* sav = (const bf16_t*)((unsigned char*)out + (size_t)32 * MiB);
    for (size_t i = blockIdx.x * (size_t)blockDim.x + threadIdx.x; i < (size_t)8192 * 1024; i += (size_t)gridDim.x * blockDim.x) {
        if (i >= (size_t)AB_BYTES / 2) { out[i] = 0.f; continue; }
        out[i] = src[i] != sav[i] ? 1000.0f : 0.f;
    }
}
__global__ void ab_zero(float* out) {
    for (size_t i = blockIdx.x * (size_t)blockDim.x + threadIdx.x; i < (size_t)8192 * 1024; i += (size_t)gridDim.x * blockDim.x) out[(size_t)8192 * 1024 + i] = 0.f;
}
extern "C" void kernel_launch(void* const* d_in, const int* in_sizes, int n_in, void* d_out, int out_size, void* d_ws, size_t ws_size, hipStream_t stream) {
    static int grid_blocks = 0;
    if (grid_blocks == 0) {
        if (n_in != 12 || ws_size < WS_END) { fprintf(stderr, "kernel_launch: unexpected n_in %d or ws_size %zu (need %zu)\n", n_in, ws_size, (size_t)WS_END); grid_blocks = -1; return; }
        int dev = 0, cus = 0, per_cu = 0;
        (void)hipGetDevice(&dev);
        (void)hipDeviceGetAttribute(&cus, hipDeviceAttributeMultiprocessorCount, dev);
        (void)hipFuncSetAttribute((const void*)fwd_kernel, hipFuncAttributeMaxDynamicSharedMemorySize, LDS_BYTES);
        (void)hipOccupancyMaxActiveBlocksPerMultiprocessor(&per_cu, (const void*)fwd_kernel, NTHREADS, LDS_BYTES);
        if (per_cu < 1) per_cu = 1;
        if (per_cu > 2) per_cu = 2;
        grid_blocks = cus * per_cu;
        (void)hipGetLastError();
    }
    if (grid_blocks < 0) return;
    Params p{};
    p.x = (const float*)d_in[0]; p.meta = (const float*)d_in[1]; p.gains = (const float*)d_in[2]; p.w_in = (const float*)d_in[3];
    p.b_forget = (const float*)d_in[4]; p.w_o_fox = (const float*)d_in[5]; p.w_o_sb = (const float*)d_in[6]; p.w_out = (const float*)d_in[7];
    p.w_up = (const float*)d_in[8]; p.conv_w = (const float*)d_in[9]; p.conv_b = (const float*)d_in[10]; p.w_down = (const float*)d_in[11];
    p.out = (float*)d_out; p.ws = (unsigned char*)d_ws;
#if SINGLE_LAUNCH
    (void)hipMemsetAsync((unsigned char*)d_ws + WS_XBAR, 0, XCD_BAR_WORDS * 4, stream);
    p.ph_lo = 0; p.ph_hi = NPHASE;
    void* args[] = {&p};
    hipError_t e = hipLaunchCooperativeKernel((const void*)fwd_kernel, dim3(grid_blocks), dim3(NTHREADS), args, LDS_BYTES, stream);
    if (e != hipSuccess) fprintf(stderr, "cooperative launch failed: %s (grid %d)\n", hipGetErrorString(e), grid_blocks);
#else
#ifndef STOP_AT
#define STOP_AT NPHASE
#endif
    for (int k = 0; k < STOP_AT; ++k) {
        p.ph_lo = k; p.ph_hi = k + 1;
        hipLaunchKernelGGL(fwd_kernel, dim3(grid_blocks), dim3(NTHREADS), LDS_BYTES, stream, p);
    }
#if ABTEST
    ab_save<<<1024, 256, 0, stream>>>(p.ws, p.out);
    for (int k = AB_FROM; k < STOP_AT; ++k) {
        p.ph_lo = k; p.ph_hi = k + 1;
        hipLaunchKernelGGL(fwd_kernel, dim3(grid_blocks), dim3(NTHREADS), LDS_BYTES, stream, p);
    }
    ab_diff<<<1024, 256, 0, stream>>>(p.ws, p.out);
    ab_zero<<<1024, 256, 0, stream>>>(p.out);
#endif

#endif
}
```

```cpp
#include <hip/hip_runtime.h>
#include <hip/hip_cooperative_groups.h>
#include <cstdio>
#include <cstdint>
namespace cg = cooperative_groups;

#define DUMP 0
#define ABTEST 0
#define AB_FROM 0
#define AB_SRC WS_SSP2
#define AB_BYTES (2 * MiB)
#ifndef SINGLE_LAUNCH
#define SINGLE_LAUNCH 1
#endif

#define LAS __attribute__((address_space(3)))
typedef unsigned short bf16_t;
typedef short bf16x8 __attribute__((ext_vector_type(8)));
typedef float f32x4 __attribute__((ext_vector_type(4)));
typedef float f32x16 __attribute__((ext_vector_type(16)));
typedef unsigned u32x4 __attribute__((ext_vector_type(4)));
typedef unsigned u32x2 __attribute__((ext_vector_type(2)));

constexpr int D = 1024, SEQ = 8192, NMETA = 16, NB = 2;
constexpr int MX = NB * SEQ;
constexpr int MV = MX + NB * NMETA;
constexpr int M = 16512;
constexpr int LPK = 8256;
constexpr int PROJW = 5128, NPROJ = 5120, DFF = 2816, NUP = 5632;
constexpr float EPS = 1e-6f;
constexpr float LOG2E = 1.4426950408889634f, LN2 = 0.6931471805599453f;
constexpr int NTHREADS = 256;
constexpr int LDS_BYTES = 65536 + 16;
constexpr int NPHASE = 11;

constexpr size_t MiB = 1u << 20;
constexpr size_t WS_CTL = 0;
constexpr size_t WS_R1 = 4096, WS_R2 = WS_R1 + 69632, WS_SS2 = WS_R2 + 69632, WS_SS4 = WS_SS2 + 69632;
constexpr size_t WS_LOGF = WS_SS4 + 69632, WS_CK = WS_LOGF + 528384, WS_UPMETA = WS_CK + 528384;
constexpr size_t WS_BTIN = 2 * MiB, WS_BTOF = WS_BTIN + 10 * MiB, WS_BTOS = WS_BTOF + 1 * MiB, WS_BTOUT = WS_BTOS + 1 * MiB,
                 WS_BTUP = WS_BTOUT + 2 * MiB, WS_BTDN = WS_BTUP + 11 * MiB;
constexpr size_t SZ_M1024 = (size_t)M * 1024 * 2, SZ_M512 = (size_t)M * 512 * 2;
constexpr size_t WS_A = 33 * MiB;
constexpr size_t WS_B = WS_A + SZ_M1024;
constexpr size_t WS_C = WS_B + 2 * SZ_M1024;
constexpr size_t WS_QF = WS_C, WS_KF = WS_QF + SZ_M512, WS_QS = WS_KF + SZ_M512, WS_KS = WS_QS + SZ_M512, WS_VFT = WS_KS + SZ_M512, WS_VST = WS_VFT + SZ_M512;
constexpr size_t WS_GATED = WS_C, WS_MIXED = WS_B + SZ_M1024;
constexpr size_t WS_ACT = WS_B;
constexpr size_t WS_FFN = WS_ACT + 132 * MiB;
constexpr size_t WS_SSP2 = 230 * MiB, WS_SSP4 = 232 * MiB;
constexpr size_t WS_HAL = 234 * MiB;
constexpr size_t WS_XBAR = 240 * MiB;
constexpr size_t WS_END = 241 * MiB;

struct Params {
    const float *x, *meta, *gains, *w_in, *b_forget, *w_o_fox, *w_o_sb, *w_out, *w_up, *conv_w, *conv_b, *w_down;
    float* out; unsigned char* ws; int ph_lo, ph_hi;
};

typedef __bf16 bf16x2_t __attribute__((ext_vector_type(2)));
__device__ __forceinline__ unsigned pk_bf16(float lo, float hi) { bf16x2_t v = {(__bf16)lo, (__bf16)hi}; return __builtin_bit_cast(unsigned, v); }
__device__ __forceinline__ float bf_lo(unsigned u) { return __uint_as_float(u << 16); }
__device__ __forceinline__ float bf_hi(unsigned u) { return __uint_as_float(u & 0xffff0000u); }
__device__ __forceinline__ float ex2(float x) { return __builtin_amdgcn_exp2f(x); }
__device__ __forceinline__ float lg2(float x) { return __builtin_amdgcn_logf(x); }
__device__ __forceinline__ float rcp(float x) { return __builtin_amdgcn_rcpf(x); }
__device__ __forceinline__ float sigmoidf_(float v) { return rcp(1.0f + ex2(-v * LOG2E)); }
__device__ __forceinline__ float wave_sum(float v) {
#pragma unroll
    for (int o = 32; o > 0; o >>= 1) v += __shfl_xor(v, o);
    return v;
}
__device__ __forceinline__ int wave_id() { return __builtin_amdgcn_readfirstlane((int)(threadIdx.x >> 6)); }

__device__ __forceinline__ void transpose_tile(LAS char* lds, const float* src, int ldsrc, int srccol, int k0, const float* gain, bf16_t* dst, int K, int n0) {
    LAS bf16_t* T = (LAS bf16_t*)lds;
    const int tid = threadIdx.x, r = tid >> 4, c4 = tid & 15;
#pragma unroll
    for (int p = 0; p < 4; ++p) {
        const int k = r + 16 * p;
        f32x4 v = *(const f32x4*)(src + (size_t)(k0 + k) * ldsrc + srccol + c4 * 4);
        const float g = gain ? gain[k0 + k] : 1.0f;
        const unsigned a = pk_bf16(v[0] * g, v[1] * g), b = pk_bf16(v[2] * g, v[3] * g);
        T[(c4 * 4 + 0) * 72 + k] = (bf16_t)(a & 0xffff); T[(c4 * 4 + 1) * 72 + k] = (bf16_t)(a >> 16);
        T[(c4 * 4 + 2) * 72 + k] = (bf16_t)(b & 0xffff); T[(c4 * 4 + 3) * 72 + k] = (bf16_t)(b >> 16);
    }
    __syncthreads();
    const int n = tid >> 2, kq = tid & 3;
    const u32x4 lo = *(LAS u32x4*)(T + n * 72 + kq * 16), hi = *(LAS u32x4*)(T + n * 72 + kq * 16 + 8);
    bf16_t* d = dst + (size_t)(n0 + n) * K + k0 + kq * 16;
    *(u32x4*)d = lo; *(u32x4*)(d + 8) = hi;
    __syncthreads();
}

__device__ __forceinline__ void phase0(const Params& p, LAS char* lds) {
    unsigned char* ws = p.ws;
    const int tid = threadIdx.x, lane = tid & 63, w = wave_id();
    LAS float* wfT = (LAS float*)lds;
    const float* g0 = p.gains;
    for (int idx = tid; idx < 8192; idx += NTHREADS) { const int h = idx & 7, k = idx >> 3; wfT[h * 1024 + k] = p.w_in[(size_t)k * PROJW + 1536 + h] * g0[k]; }
    __syncthreads();
    bf16_t* xb = (bf16_t*)(ws + WS_A);
    float* r1 = (float*)(ws + WS_R1);
    float* logf_ = (float*)(ws + WS_LOGF);
    for (int r_ = blockIdx.x * 32 + w; r_ < M; r_ += (r_ & 31) < 28 ? 4 : gridDim.x * 32 - 28) {
        const int r = r_;
        if (r >= MV) {
#pragma unroll
            for (int i = 0; i < 4; ++i) *(u32x2*)(xb + (size_t)r * D + lane * 4 + 256 * i) = (u32x2){0u, 0u};
            if (lane == 0) r1[r] = 0.f;
            continue;
        }
        const float* src = r < MX ? p.x + (size_t)r * D : p.meta + (size_t)((r - MX) & 15) * D;
        f32x4 v[4]; float ss = 0.f;
#pragma unroll
        for (int i = 0; i < 4; ++i) { v[i] = __builtin_nontemporal_load((const f32x4*)(src + lane * 4 + 256 * i)); ss += v[i][0] * v[i][0] + v[i][1] * v[i][1] + v[i][2] * v[i][2] + v[i][3] * v[i][3]; }
#pragma unroll
        for (int i = 0; i < 4; ++i) *(u32x2*)(xb + (size_t)r * D + lane * 4 + 256 * i) = (u32x2){pk_bf16(v[i][0], v[i][1]), pk_bf16(v[i][2], v[i][3])};
        ss = wave_sum(ss);
        const float rs = 1.0f / sqrtf(ss * (1.0f / D) + EPS);
        if (lane == 0) r1[r] = rs;
        float mine = 0.f;
#pragma unroll
        for (int h = 0; h < 8; ++h) {
            float a = 0.f;
#pragma unroll
            for (int i = 0; i < 4; ++i) { const f32x4 wv = *(LAS f32x4*)(wfT + h * 1024 + lane * 4 + 256 * i); a += v[i][0] * wv[0] + v[i][1] * wv[1] + v[i][2] * wv[2] + v[i][3] * wv[3]; }
            a = wave_sum(a);
            if (lane == h) mine = a;
        }
        if (lane < 8) {
            const float f = mine * rs + p.b_forget[lane];
            const float lf = fminf(f, 0.f) - log1pf(expf(-fabsf(f)));
            int b, kidx; if (r < MX) { b = r >> 13; kidx = r & 8191; } else { const int j = r - MX; b = j >> 4; kidx = 8192 + (j & 15); }
            logf_[(size_t)(b * 8 + lane) * LPK + kidx] = lf;
        }
    }
    __syncthreads();
    LAS char* tl = lds + 32768;
    const float* g2 = p.gains + 2 * D;
    constexpr int T_IN = 16 * 80, T_OF = 8 * 16, T_OS = 8 * 16, T_OUT = 16 * 16, T_UP = 16 * 88, T_DN = 44 * 16;
    constexpr int T_ALL = T_IN + T_OF + T_OS + T_OUT + T_UP + T_DN;
    for (int t = blockIdx.x; t < T_ALL; t += gridDim.x) {
        int u = t;
        if (u < T_IN) { const int nt = u % 80, kt = u / 80; const int sc = nt * 64 + (nt * 64 >= 1536 ? 8 : 0); transpose_tile(tl, p.w_in, PROJW, sc, kt * 64, g0, (bf16_t*)(ws + WS_BTIN), 1024, nt * 64); continue; }
        u -= T_IN;
        if (u < T_OF) { const int nt = u % 16, kt = u / 16; transpose_tile(tl, p.w_o_fox, 1024, nt * 64, kt * 64, nullptr, (bf16_t*)(ws + WS_BTOF), 512, nt * 64); continue; }
        u -= T_OF;
        if (u < T_OS) { const int nt = u % 16, kt = u / 16; transpose_tile(tl, p.w_o_sb, 1024, nt * 64, kt * 64, nullptr, (bf16_t*)(ws + WS_BTOS), 512, nt * 64); continue; }
        u -= T_OS;
        if (u < T_OUT) { const int nt = u % 16, kt = u / 16; transpose_tile(tl, p.w_out, 1024, nt * 64, kt * 64, nullptr, (bf16_t*)(ws + WS_BTOUT), 1024, nt * 64); continue; }
        u -= T_OUT;
        if (u < T_UP) { const int nt = u % 88, kt = u / 88; transpose_tile(tl, p.w_up, NUP, (nt & 1) * DFF + (nt >> 1) * 64, kt * 64, g2, (bf16_t*)(ws + WS_BTUP), 1024, nt * 64); continue; }
        u -= T_UP;
        { const int nt = u % 16, kt = u / 16; transpose_tile(tl, p.w_down, 1024, nt * 64, kt * 64, nullptr, (bf16_t*)(ws + WS_BTDN), DFF, nt * 64); }
    }
}

template <bool SWAP, bool FULL>
__device__ __forceinline__ void gemm_kloop(LAS char* lds, const bf16_t* Ag, int lda, const bf16_t* Bg, int ldb, int nk, f32x4 (&acc)[4][4], int mlim) {
    const int tid = threadIdx.x, lane = tid & 63, w = wave_id(), wr = w >> 1, wc = w & 1;
    const int row_0 = w * 8 + (lane >> 3), c_0 = (lane & 7) ^ ((row_0 >> 1) & 7);
    const bf16_t* pa0 = Ag + (size_t)row_0 * lda + c_0 * 8; const bf16_t* pb0 = Bg + (size_t)row_0 * ldb + c_0 * 8;
    const size_t sa = (size_t)32 * lda, sb_ = (size_t)32 * ldb;
    const int swz = (lane >> 1) & 7;
    int aoff[2], boff[2];
#pragma unroll
    for (int kh = 0; kh < 2; ++kh) {
        aoff[kh] = (wr * 64 + (lane & 15)) * 128 + (((kh * 4 + (lane >> 4)) ^ swz) << 4);
        boff[kh] = 16384 + (wc * 64 + (lane & 15)) * 128 + (((kh * 4 + (lane >> 4)) ^ swz) << 4);
    }
#define GM_STAGE(s, kt) do { _Pragma("unroll") for (int i_ = 0; i_ < 4; ++i_) { \
        __builtin_amdgcn_global_load_lds((const unsigned*)(pa0 + i_ * sa + (kt) * 64), (LAS unsigned*)(lds + (s) * 32768 + (i_ * 4 + w) * 1024), 16, 0, 0); \
        __builtin_amdgcn_global_load_lds((const unsigned*)(pb0 + i_ * sb_ + (kt) * 64), (LAS unsigned*)(lds + (s) * 32768 + 16384 + (i_ * 4 + w) * 1024), 16, 0, 0); } } while (0)
    GM_STAGE(0, 0);
    for (int kt = 0; kt < nk; ++kt) {
        asm volatile("s_waitcnt vmcnt(0)" ::: "memory");
        __syncthreads();
        const int s = kt & 1;
        if (kt + 1 < nk) GM_STAGE(s ^ 1, kt + 1);
        bf16x8 af[4][2], bf[4][2];
#pragma unroll
        for (int kh = 0; kh < 2; ++kh) {
#pragma unroll
            for (int m = 0; m < 4; ++m) if (FULL || m < mlim) af[m][kh] = *(LAS bf16x8*)(lds + s * 32768 + aoff[kh] + m * 2048);
#pragma unroll
            for (int n = 0; n < 4; ++n) bf[n][kh] = *(LAS bf16x8*)(lds + s * 32768 + boff[kh] + n * 2048);
        }
        __builtin_amdgcn_s_setprio(1);
#pragma unroll
        for (int kh = 0; kh < 2; ++kh)
#pragma unroll
            for (int m = 0; m < 4; ++m) if (FULL || m < mlim) {
#pragma unroll
                for (int n = 0; n < 4; ++n)
                    acc[m][n] = SWAP ? __builtin_amdgcn_mfma_f32_16x16x32_bf16(bf[n][kh], af[m][kh], acc[m][n], 0, 0, 0)
                                     : __builtin_amdgcn_mfma_f32_16x16x32_bf16(af[m][kh], bf[n][kh], acc[m][n], 0, 0, 0);
            }
        __builtin_amdgcn_s_setprio(0);
    }
    __syncthreads();
#undef GM_STAGE
}
template <bool SWAP>
__device__ __forceinline__ void gemm_main(LAS char* lds, const bf16_t* Ag, int lda, const bf16_t* Bg, int ldb, int nk, f32x4 (&acc)[4][4], int mlim = 4) {
    if (mlim == 4) gemm_kloop<SWAP, true>(lds, Ag, lda, Bg, ldb, nk, acc, 4);
    else gemm_kloop<SWAP, false>(lds, Ag, lda, Bg, ldb, nk, acc, mlim);
}
__device__ __forceinline__ void zero_acc(f32x4 (&acc)[4][4]) {
#pragma unroll
    for (int m = 0; m < 4; ++m)
#pragma unroll
        for (int n = 0; n < 4; ++n) acc[m][n] = (f32x4){0.f, 0.f, 0.f, 0.f};
}


__device__ __forceinline__ int tile_at(int it, int ntm, int ntn, int& tm, int& tn) {
    const int G = gridDim.x;
    if (G % 256 != 0) { const int t = it * G + blockIdx.x; if (t >= ntm * ntn) return 0; tm = t / ntn; tn = t % ntn; return 1; }
    const int xcd = blockIdx.x & 7, j = blockIdx.x >> 3, ppx = G >> 8;
    const int pcols = (ntn + 3) >> 2, prows = (ntm + 7) >> 3;
    const int patch = (it * ppx + (j >> 5)) * 8 + xcd;
    if (patch >= prows * pcols) return 0;
    const int wi = j & 31;
    tm = (patch / pcols) * 8 + (wi >> 2); tn = (patch % pcols) * 4 + (wi & 3);
    return (tm < ntm && tn < ntn) ? 1 : 2;
}
__device__ __forceinline__ void cumsum_block(const Params& p, LAS char* lds, int bh) {
    const float* lf = (const float*)(p.ws + WS_LOGF) + (size_t)bh * LPK; float* ck = (float*)(p.ws + WS_CK) + (size_t)bh * LPK;
    LAS float* wsum = (LAS float*)lds;
    const int tid = threadIdx.x, lane = tid & 63, w = wave_id(); constexpr int PER = 33, L = SEQ + NMETA;
    float v[PER];
#pragma unroll
    for (int e = 0; e < PER; ++e) { const int t = e * NTHREADS + tid; const int tc = t < L ? t : L - 1; const float x = lf[tc < 16 ? 8192 + tc : tc - 16]; v[e] = t < L ? x : 0.f; }
    float carry = 0.f;
#pragma unroll
    for (int e = 0; e < PER; ++e) {
        float x = v[e];
#pragma unroll
        for (int o = 1; o < 64; o <<= 1) { const float y = __shfl_up(x, o); if (lane >= o) x += y; }
        if (lane == 63) wsum[(e & 1) * 4 + w] = x;
        __syncthreads();
        const float s0 = wsum[(e & 1) * 4 + 0], s1 = wsum[(e & 1) * 4 + 1], s2 = wsum[(e & 1) * 4 + 2], s3 = wsum[(e & 1) * 4 + 3];
        const float pre = (w > 0 ? s0 : 0.f) + (w > 1 ? s1 : 0.f) + (w > 2 ? s2 : 0.f);
        const int t = e * NTHREADS + tid;
        if (t < L) ck[t < 16 ? 8192 + t : t - 16] = (carry + pre + x) * LOG2E;
        carry += (s0 + s1) + (s2 + s3);
    }
    __syncthreads();
}

__device__ __forceinline__ void phase1(const Params& p, LAS char* lds) {
    unsigned char* ws = p.ws;
    if ((int)blockIdx.x >= (int)gridDim.x - 16) cumsum_block(p, lds, gridDim.x - 1 - blockIdx.x);
    const int lane = threadIdx.x & 63, w = wave_id(), wr = w >> 1, wc = w & 1;
    const bf16_t* xb = (const bf16_t*)(ws + WS_A); const bf16_t* Bt = (const bf16_t*)(ws + WS_BTIN);
    const float* r1 = (const float*)(ws + WS_R1);
    constexpr int NTN = 40, NTM = 129;
    for (int it = 0;; ++it) {
        int tm, tn; int st = tile_at(it, NTM - 1, NTN, tm, tn);
        if (st == 0) { if (it < (1 << 20) && (int)blockIdx.x < NTN) { tm = NTM - 1; tn = blockIdx.x; it = 1 << 20; st = 1; } else break; }
        if (st == 2) continue;
        const int row0 = tm * 128, col0 = tn * 128; const int mlim = tm == NTM - 1 ? (wr == 0 ? 2 : 0) : 4;
        const bool vtile = (tn >= 8 && tn < 12) || (tn >= 20 && tn < 24);
        f32x4 acc[4][4]; zero_acc(acc);
        if (vtile) {
            gemm_main<false>(lds, xb + (size_t)row0 * D, D, Bt + (size_t)col0 * D, D, 16, acc, mlim);
            bf16_t* vT = (bf16_t*)(ws + (tn < 12 ? WS_VFT : WS_VST)); const int cb = tn < 12 ? 1024 : 2560;
            const int g = lane >> 4, gp = ((g & 1) << 1) | (g >> 1);
#pragma unroll
            for (int m = 0; m < 4; ++m) {
                const int rb = row0 + wr * 64 + m * 16; int b, kb16;
                if (rb < MX) { b = rb >> 13; kb16 = rb & 8191; } else { const int j = rb - MX; if (j >= 32) continue; b = j >> 4; kb16 = 8192; }
                const f32x4 rs = *(const f32x4*)(r1 + rb + g * 4);
#pragma unroll
                for (int n = 0; n < 4; ++n) {
                    const int dc = col0 + wc * 64 + n * 16 + (lane & 15) - cb, h = dc >> 6, d = dc & 63;
                    const f32x4 v = acc[m][n] * rs;
                    *(u32x2*)(vT + ((size_t)(b * 8 + h) * 64 + d) * LPK + kb16 + gp * 4) = (u32x2){pk_bf16(v[0], v[1]), pk_bf16(v[2], v[3])};
                }
            }
        } else {
            gemm_main<true>(lds, xb + (size_t)row0 * D, D, Bt + (size_t)col0 * D, D, 16, acc, mlim);
            bf16_t* dst; int ld, cb; float sc = 1.f; bool sg = false;
            if (tn < 4) { dst = (bf16_t*)(ws + WS_QF); ld = 512; cb = 0; sc = 0.125f * LOG2E; }
            else if (tn < 8) { dst = (bf16_t*)(ws + WS_KF); ld = 512; cb = 512; }
            else if (tn < 16) { dst = (bf16_t*)(ws + WS_QS); ld = 512; cb = 1536; sc = 0.125f; }
            else if (tn < 20) { dst = (bf16_t*)(ws + WS_KS); ld = 512; cb = 2048; }
            else if (tn < 32) { dst = (bf16_t*)(ws + WS_B); ld = 1024; cb = 3072; sg = true; }
            else { dst = (bf16_t*)(ws + WS_B + SZ_M1024); ld = 1024; cb = 4096; sg = true; }
            const bool kfox = tn >= 4 && tn < 8;
            float wmax = 0.f;
#pragma unroll
            for (int m = 0; m < 4; ++m) {
                const int row = row0 + wr * 64 + m * 16 + (lane & 15); const float rs = r1[row] * sc;
                float s2 = 0.f;
#pragma unroll
                for (int n = 0; n < 4; ++n) {
                    const int col = col0 + wc * 64 + n * 16 + (lane >> 4) * 4 - cb;
                    f32x4 v = acc[m][n] * rs;
                    if (sg) { v[0] = sigmoidf_(v[0]); v[1] = sigmoidf_(v[1]); v[2] = sigmoidf_(v[2]); v[3] = sigmoidf_(v[3]); }
                    s2 += v[0] * v[0] + v[1] * v[1] + v[2] * v[2] + v[3] * v[3];
                    *(u32x2*)(dst + (size_t)row * ld + col) = (u32x2){pk_bf16(v[0], v[1]), pk_bf16(v[2], v[3])};
                }
                if (kfox) { s2 += __shfl_xor(s2, 16); s2 += __shfl_xor(s2, 32); wmax = fmaxf(wmax, s2); }
            }
            if (kfox) {
#pragma unroll
                for (int o = 1; o < 16; o <<= 1) wmax = fmaxf(wmax, __shfl_xor(wmax, o));
                if (lane == 0) {
                    unsigned* km = (unsigned*)(ws + WS_XBAR) + 32; const int head = (tn - 4) * 2 + wc; const unsigned bits = __float_as_uint(wmax);
                    if (row0 < MX) atomicMax(km + (row0 >> 13) * 8 + head, bits);
                    else { atomicMax(km + head, bits); atomicMax(km + 8 + head, bits); }
                }
            }
        }
    }
}

constexpr int AT_STAGE = 16640;
template <int TYPE>
__device__ __forceinline__ void attn_unit(LAS char* lds, const Params& p, int b, int h, int qb, int part = 0) {
    unsigned char* ws = p.ws;
    const int tid = threadIdx.x, lane = tid & 63, w = wave_id(), ql = lane & 31, hi = lane >> 5;
    const bf16_t* Q = (const bf16_t*)(ws + (TYPE == 0 ? WS_QF : WS_QS));
    const bf16_t* Kp = (const bf16_t*)(ws + (TYPE == 0 ? WS_KF : WS_KS));
    const bf16_t* VT = (const bf16_t*)(ws + (TYPE == 0 ? WS_VFT : WS_VST)) + (size_t)(b * 8 + h) * 64 * LPK;
    const float* cK = (const float*)(ws + WS_CK) + (size_t)(b * 8 + h) * LPK;
    bf16_t* Oo = (bf16_t*)(ws + WS_A + (TYPE == 0 ? 0 : SZ_M512));
    const bool meta_unit = qb < 0;
    const int qrow0 = meta_unit ? MX + 16 * b : b * SEQ + qb * 128;
    const int nt = meta_unit ? 1 : 2 * qb + 3;
    int qrow = qrow0 + 32 * w + ql; if (qrow > M - 1) qrow = M - 1;
    bf16x8 qf[4];
#pragma unroll
    for (int ds = 0; ds < 4; ++ds) qf[ds] = *(const bf16x8*)(Q + (size_t)qrow * 512 + h * 64 + ds * 16 + hi * 8);
    f32x16 O0, O1;
#pragma unroll
    for (int i = 0; i < 16; ++i) { O0[i] = 0.f; O1[i] = 0.f; }
    float m_run = -INFINITY, lsum = 0.f, R = 0.f;
    const int JA = qb + 2;
    const int j0 = part == 2 ? JA : 0, j1 = part == 1 ? JA : nt;
    if (TYPE == 0 && part == 2) {
        float dg = 0.f;
#pragma unroll
        for (int ds = 0; ds < 4; ++ds) {
            const bf16x8 kd = *(const bf16x8*)(Kp + (size_t)qrow * 512 + h * 64 + ds * 16 + hi * 8);
#pragma unroll
            for (int e = 0; e < 8; ++e) dg += __uint_as_float((unsigned)(unsigned short)qf[ds][e] << 16) * __uint_as_float((unsigned)(unsigned short)kd[e] << 16);
        }
        dg += __shfl_xor(dg, 32);
        m_run = dg - cK[qb * 128 + 32 * w + ql] - 1.0f;
    }
    float qbound = 0.f;
    if (TYPE == 0) {
        float q2 = 0.f;
#pragma unroll
        for (int ds = 0; ds < 4; ++ds)
#pragma unroll
            for (int e = 0; e < 8; ++e) { const float x = __uint_as_float((unsigned)(unsigned short)qf[ds][e] << 16); q2 += x * x; }
        q2 += __shfl_xor(q2, 32);
        const unsigned kb = __hip_atomic_load((unsigned*)(ws + WS_XBAR) + 32 + b * 8 + h, __ATOMIC_RELAXED, __HIP_MEMORY_SCOPE_AGENT);
        qbound = sqrtf(q2) * sqrtf(__uint_as_float(kb)) * 1.02f + 1.0f;
    }
    u32x4 kreg[2], vreg[2]; float creg = 0.f;
    const int srow = tid >> 3, spos = tid & 7;
    const int swz_st = (spos ^ ((srow >> 1) & 7)) << 4;
    const int swz = (lane >> 1) & 7;
    LAS unsigned* flags = (LAS unsigned*)(lds + 2 * AT_STAGE);
#define AT_LOAD(j) do { int krow0_, kidx0_; if (!meta_unit && (j) < nt - 1) { const int kt_ = nt - 2 - (j); krow0_ = b * SEQ + 64 * kt_; kidx0_ = 64 * kt_; } else { krow0_ = MX + 16 * b; kidx0_ = 8192; } \
        _Pragma("unroll") for (int i_ = 0; i_ < 2; ++i_) { \
            kreg[i_] = *(const u32x4*)(Kp + (size_t)(krow0_ + srow + 32 * i_) * 512 + h * 64 + spos * 8); \
            vreg[i_] = *(const u32x4*)(VT + (size_t)(srow + 32 * i_) * LPK + kidx0_ + spos * 8); } \
        if (TYPE == 0 && tid < 64) creg = cK[kidx0_ + tid]; } while (0)
#define AT_WRITE(s) do { _Pragma("unroll") for (int i_ = 0; i_ < 2; ++i_) { \
            *(LAS u32x4*)(lds + (s) * AT_STAGE + (srow + 32 * i_) * 128 + swz_st) = kreg[i_]; \
            *(LAS u32x4*)(lds + (s) * AT_STAGE + 8192 + (srow + 32 * i_) * 128 + swz_st) = vreg[i_]; } \
        if (TYPE == 0 && tid < 64) *(LAS float*)(lds + (s) * AT_STAGE + 16384 + tid * 4) = creg; } while (0)
    AT_LOAD(j0); AT_WRITE(j0 & 1);
    __syncthreads();
    for (int j = j0; j < j1; ++j) {
        const bool more = j + 1 < j1;
        if (more) AT_LOAD(j + 1);
        int klim, d0;
        if (meta_unit) { klim = 16; d0 = 0; }
        else if (j == nt - 1) { klim = 16; d0 = 1 << 20; }
        else { klim = 64; d0 = 128 * qb - 64 * (nt - 2 - j); if (d0 >= 64) d0 = 1 << 20; }
        const int limw = 32 * w + d0 - TYPE;
        bool wdone = false, nomax = false;
        if (TYPE == 0) {
            const float clast = *(const LAS float*)(lds + (j & 1) * AT_STAGE + 16384 + (klim - 1) * 4);
            wdone = __all((qbound - clast - m_run) < -126.0f) != 0;
            nomax = __all((qbound - clast) <= m_run) != 0;
        }
        if (limw + 31 >= 0 && !(TYPE == 0 && wdone)) {
            const LAS char* sb = lds + (j & 1) * AT_STAGE;
            int kmax = limw + ql; if (kmax > klim - 1) kmax = klim - 1;
            const bool needmask = (klim < 64) || (limw < 63);
            f32x16 S0, S1;
#pragma unroll
            for (int i = 0; i < 16; ++i) { S0[i] = 0.f; S1[i] = 0.f; }
#pragma unroll
            for (int ds = 0; ds < 4; ++ds) {
                const bf16x8 k0 = *(const LAS bf16x8*)(sb + ql * 128 + (((2 * ds + hi) ^ swz) << 4));
                const bf16x8 k1 = *(const LAS bf16x8*)(sb + (32 + ql) * 128 + (((2 * ds + hi) ^ swz) << 4));
                S0 = __builtin_amdgcn_mfma_f32_32x32x16_bf16(k0, qf[ds], S0, 0, 0, 0);
                S1 = __builtin_amdgcn_mfma_f32_32x32x16_bf16(k1, qf[ds], S1, 0, 0, 0);
            }
            if (TYPE == 0) {
#pragma unroll
                for (int g = 0; g < 4; ++g) {
                    const f32x4 c0 = *(const LAS f32x4*)(sb + 16384 + (8 * g + 4 * hi) * 4), c1 = *(const LAS f32x4*)(sb + 16384 + (32 + 8 * g + 4 * hi) * 4);
#pragma unroll
                    for (int i = 0; i < 4; ++i) { S0[4 * g + i] -= c0[i]; S1[4 * g + i] -= c1[i]; }
                }
                if (needmask) {
#pragma unroll
                    for (int r = 0; r < 16; ++r) { const int kl = (r & 3) + 8 * (r >> 2) + 4 * hi; if (kl > kmax) S0[r] = -INFINITY; if (kl + 32 > kmax) S1[r] = -INFINITY; }
                }
                if (!nomax) {
                    float mx = -INFINITY;
#pragma unroll
                    for (int r = 0; r < 16; ++r) mx = fmaxf(mx, fmaxf(S0[r], S1[r]));
                    mx = fmaxf(mx, __shfl_xor(mx, 32));
                    const float m_new = fmaxf(m_run, mx), alpha = ex2(m_run - m_new);
                    m_run = m_new;
                    lsum *= alpha;
#pragma unroll
                    for (int r = 0; r < 16; ++r) { O0[r] *= alpha; O1[r] *= alpha; }
                }
                float ps = 0.f;
#pragma unroll
                for (int r = 0; r < 16; ++r) { S0[r] = ex2(S0[r] - m_run); S1[r] = ex2(S1[r] - m_run); ps += S0[r] + S1[r]; }
                lsum += ps;
            } else {
                float G0[4], G1[4];
                f32x16 L0, L1;
#pragma unroll
                for (int r = 0; r < 16; ++r) {
                    const int kl = (r & 3) + 8 * (r >> 2) + 4 * hi;
                    const float z0 = S0[r], z1 = S1[r];
                    const float sp0 = fmaxf(z0, 0.f) + lg2(1.0f + ex2(-fabsf(z0) * LOG2E)) * LN2;
                    const float sp1 = fmaxf(z1, 0.f) + lg2(1.0f + ex2(-fabsf(z1) * LOG2E)) * LN2;
                    L0[r] = (!needmask || kl <= kmax) ? -sp0 : 0.f;
                    L1[r] = (!needmask || kl + 32 <= kmax) ? -sp1 : 0.f;
                }
#pragma unroll
                for (int g = 0; g < 4; ++g) {
                    L0[4 * g + 2] += L0[4 * g + 3]; L0[4 * g + 1] += L0[4 * g + 2]; L0[4 * g] += L0[4 * g + 1]; G0[g] = L0[4 * g];
                    L1[4 * g + 2] += L1[4 * g + 3]; L1[4 * g + 1] += L1[4 * g + 2]; L1[4 * g] += L1[4 * g + 1]; G1[g] = L1[4 * g];
                }
                float run = R;
#pragma unroll
                for (int g = 3; g >= 0; --g) {
                    const float gp = __shfl_xor(G1[g], 32);
                    const float off = hi ? run : run + gp;
#pragma unroll
                    for (int i = 0; i < 4; ++i) { const int r = 4 * g + i; const int kl = 32 + i + 8 * g + 4 * hi;
                        const float a = ex2((S1[r] + L1[r] + off) * LOG2E); S1[r] = (!needmask || kl <= kmax) ? a : 0.f; }
                    run += G1[g] + gp;
                }
#pragma unroll
                for (int g = 3; g >= 0; --g) {
                    const float gp = __shfl_xor(G0[g], 32);
                    const float off = hi ? run : run + gp;
#pragma unroll
                    for (int i = 0; i < 4; ++i) { const int r = 4 * g + i; const int kl = i + 8 * g + 4 * hi;
                        const float a = ex2((S0[r] + L0[r] + off) * LOG2E); S0[r] = (!needmask || kl <= kmax) ? a : 0.f; }
                    run += G0[g] + gp;
                }
                R = run;
                wdone = __all(R < -120.0f) != 0;
            }
#pragma unroll
            for (int ks = 0; ks < 4; ++ks) {
                bf16x8 pf; u32x4 pu;
                if (ks < 2) { pu = (u32x4){pk_bf16(S0[8 * ks + 0], S0[8 * ks + 1]), pk_bf16(S0[8 * ks + 2], S0[8 * ks + 3]), pk_bf16(S0[8 * ks + 4], S0[8 * ks + 5]), pk_bf16(S0[8 * ks + 6], S0[8 * ks + 7])}; }
                else { const int k2 = ks - 2; pu = (u32x4){pk_bf16(S1[8 * k2 + 0], S1[8 * k2 + 1]), pk_bf16(S1[8 * k2 + 2], S1[8 * k2 + 3]), pk_bf16(S1[8 * k2 + 4], S1[8 * k2 + 5]), pk_bf16(S1[8 * k2 + 6], S1[8 * k2 + 7])}; }
                pf = __builtin_bit_cast(bf16x8, pu);
                const bf16x8 v0 = *(const LAS bf16x8*)(sb + 8192 + ql * 128 + (((2 * ks + hi) ^ swz) << 4));
                const bf16x8 v1 = *(const LAS bf16x8*)(sb + 8192 + (32 + ql) * 128 + (((2 * ks + hi) ^ swz) << 4));
                O0 = __builtin_amdgcn_mfma_f32_32x32x16_bf16(v0, pf, O0, 0, 0, 0);
                O1 = __builtin_amdgcn_mfma_f32_32x32x16_bf16(v1, pf, O1, 0, 0, 0);
            }
        }
        if (more) AT_WRITE((j + 1) & 1);
        if (lane == 0) flags[(j & 1) * 4 + w] = wdone ? 1u : 0u;
        __syncthreads();
        { const LAS unsigned* fl = flags + (j & 1) * 4; const unsigned f = fl[0] & fl[1] & fl[2] & fl[3]; if (f) break; }
    }
    float inv = 1.0f;
    if (TYPE == 0) { const float l = lsum + __shfl_xor(lsum, 32); inv = 1.0f / l; }
    const bool qvalid = meta_unit ? (w == 0 && ql < 16) : true;
    if (TYPE == 0 && part != 0) {
        float* rec = p.out + ((size_t)((((63 - qb) * 16 + b * 8 + h) * 2 + (part - 1)) * 128 + 32 * w + ql)) * 68;
        const float l = lsum + __shfl_xor(lsum, 32);
#pragma unroll
        for (int g = 0; g < 4; ++g) {
            *(f32x4*)(rec + 8 * g + 4 * hi) = (f32x4){O0[4 * g], O0[4 * g + 1], O0[4 * g + 2], O0[4 * g + 3]};
            *(f32x4*)(rec + 32 + 8 * g + 4 * hi) = (f32x4){O1[4 * g], O1[4 * g + 1], O1[4 * g + 2], O1[4 * g + 3]};
        }
        if (hi == 0) { rec[64] = m_run; rec[65] = l; }
    } else if (qvalid) {
        bf16_t* op = Oo + (size_t)qrow * 512 + h * 64 + 4 * hi;
#pragma unroll
        for (int g = 0; g < 4; ++g) {
            *(u32x2*)(op + 8 * g) = (u32x2){pk_bf16(O0[4 * g] * inv, O0[4 * g + 1] * inv), pk_bf16(O0[4 * g + 2] * inv, O0[4 * g + 3] * inv)};
            *(u32x2*)(op + 32 + 8 * g) = (u32x2){pk_bf16(O1[4 * g] * inv, O1[4 * g + 1] * inv), pk_bf16(O1[4 * g + 2] * inv, O1[4 * g + 3] * inv)};
        }
    }
    __syncthreads();
#undef AT_LOAD
#undef AT_WRITE
}


__device__ __forceinline__ void phase_comb(const Params& p) {
    bf16_t* oa = (bf16_t*)(p.ws + WS_A);
    for (int it = blockIdx.x * NTHREADS + threadIdx.x; it < 512 * 128 * 16; it += gridDim.x * NTHREADS) {
        const int d4 = it & 15, row = (it >> 4) & 127, su = it >> 11;
        const float* ra = p.out + ((size_t)((su * 2) * 128 + row)) * 68; const float* rb = ra + (size_t)128 * 68;
        const float ma = ra[64], la = ra[65], mb = rb[64], lb = rb[65];
        const float m = fmaxf(ma, mb), wa = ex2(ma - m), wb = ex2(mb - m), inv = 1.0f / (la * wa + lb * wb);
        const f32x4 a = *(const f32x4*)(ra + d4 * 4), bq = *(const f32x4*)(rb + d4 * 4);
        const f32x4 o = (a * wa + bq * wb) * inv;
        const int qb = 63 - (su >> 4), bh = su & 15;
        *(u32x2*)(oa + (size_t)((bh >> 3) * SEQ + qb * 128 + row) * 512 + (bh & 7) * 64 + d4 * 4) = (u32x2){pk_bf16(o[0], o[1]), pk_bf16(o[2], o[3])};
    }
}
__device__ __forceinline__ void phase2(const Params& p, LAS char* lds) {
    unsigned* ctr = (unsigned*)(p.ws + WS_XBAR);
    LAS unsigned* shu = (LAS unsigned*)(lds + 2 * AT_STAGE + 64);
    constexpr int NU = 2560 + 32;
    for (;;) {
        if (threadIdx.x == 0) shu[0] = __hip_atomic_fetch_add(ctr, 1u, __ATOMIC_RELAXED, __HIP_MEMORY_SCOPE_AGENT);
        __syncthreads();
        const int u = (int)shu[0];
        __syncthreads();
        if (u >= NU) break;
        if (u < 1280) {
            const int pr = u / 80, r = u - pr * 80;
            if (r < 32) attn_unit<0>(lds, p, (r >> 1) >> 3, (r >> 1) & 7, 63 - 2 * pr, 1 + (r & 1));
            else if (r < 48) attn_unit<0>(lds, p, (r - 32) >> 3, (r - 32) & 7, 31 - pr);
            else { const int q = r - 48; attn_unit<0>(lds, p, (q >> 1) >> 3, (q >> 1) & 7, 62 - 2 * pr, 1 + (q & 1)); }
        }
        else if (u < 1536) { const int v = u - 1280; attn_unit<0>(lds, p, (v & 15) >> 3, v & 7, 15 - (v >> 4)); }
        else if (u < 2560) { const int v = u - 1536; attn_unit<1>(lds, p, (v & 15) >> 3, v & 7, 63 - (v >> 4)); }
        else if (u < 2576) { const int v = u - 2560; attn_unit<0>(lds, p, v >> 3, v & 7, -1); }
        else { const int v = u - 2576; attn_unit<1>(lds, p, v >> 3, v & 7, -1); }
    }
}

__device__ __forceinline__ void phase3a(const Params& p, LAS char* lds) {
    unsigned char* ws = p.ws;
    const int lane = threadIdx.x & 63, w = wave_id(), wr = w >> 1, wc = w & 1;
    const bf16_t* oa = (const bf16_t*)(ws + WS_A); const bf16_t* ob = oa + (size_t)M * 512;
    const bf16_t* ga = (const bf16_t*)(ws + WS_B); const bf16_t* gb = ga + (size_t)M * 1024;
    bf16_t* gated = (bf16_t*)(ws + WS_GATED);
    for (int it = 0;; ++it) {
        int tm, tn; int st = tile_at(it, 128, 8, tm, tn);
        if (st == 0) { if (it < (1 << 20) && (int)blockIdx.x < 8) { tm = 128; tn = blockIdx.x; it = 1 << 20; st = 1; } else break; }
        if (st == 2) continue;
        const int row0 = tm * 128, col0 = tn * 128; const int mlim = tm == 128 ? (wr == 0 ? 2 : 0) : 4;
        f32x4 acc[4][4]; zero_acc(acc);
        gemm_main<true>(lds, oa + (size_t)row0 * 512, 512, (const bf16_t*)(ws + WS_BTOF) + (size_t)col0 * 512, 512, 8, acc, mlim);
#pragma unroll
        for (int m = 0; m < 4; ++m) {
            const int row = row0 + wr * 64 + m * 16 + (lane & 15);
#pragma unroll
            for (int n = 0; n < 4; ++n) {
                const int col = col0 + wc * 64 + n * 16 + (lane >> 4) * 4;
                const u32x2 a = *(const u32x2*)(ga + (size_t)row * 1024 + col);
                const f32x4 x = acc[m][n];
                *(u32x2*)(gated + (size_t)row * 1024 + col) = (u32x2){pk_bf16(bf_lo(a[0]) * x[0], bf_hi(a[0]) * x[1]), pk_bf16(bf_lo(a[1]) * x[2], bf_hi(a[1]) * x[3])};
            }
        }
        zero_acc(acc);
        gemm_main<true>(lds, ob + (size_t)row0 * 512, 512, (const bf16_t*)(ws + WS_BTOS) + (size_t)col0 * 512, 512, 8, acc, mlim);
#pragma unroll
        for (int m = 0; m < 4; ++m) {
            const int row = row0 + wr * 64 + m * 16 + (lane & 15);
#pragma unroll
            for (int n = 0; n < 4; ++n) {
                const int col = col0 + wc * 64 + n * 16 + (lane >> 4) * 4;
                const u32x2 b = *(const u32x2*)(gb + (size_t)row * 1024 + col);
                const f32x4 y = acc[m][n]; const u32x2 q = *(const u32x2*)(gated + (size_t)row * 1024 + col);
                const float o0 = bf_lo(q[0]) + bf_lo(b[0]) * y[0], o1 = bf_hi(q[0]) + bf_hi(b[0]) * y[1];
                const float o2 = bf_lo(q[1]) + bf_lo(b[1]) * y[2], o3 = bf_hi(q[1]) + bf_hi(b[1]) * y[3];
                *(u32x2*)(gated + (size_t)row * 1024 + col) = (u32x2){pk_bf16(o0, o1), pk_bf16(o2, o3)};
            }
        }
    }
}
__device__ __forceinline__ void epi_store_ss(const f32x4 (&acc)[4][4], bf16_t* out, int ldo, int orow0, int col0, float* ssp, int ssrow0, int wr, int wc, int lane) {
#pragma unroll
    for (int m = 0; m < 4; ++m) {
        const int rl = wr * 64 + m * 16 + (lane & 15);
        float s = 0.f;
#pragma unroll
        for (int n = 0; n < 4; ++n) {
            const int col = col0 + wc * 64 + n * 16 + (lane >> 4) * 4;
            const f32x4 v = acc[m][n];
            s += v[0] * v[0] + v[1] * v[1] + v[2] * v[2] + v[3] * v[3];
            *(u32x2*)(out + (size_t)(orow0 + rl) * ldo + col) = (u32x2){pk_bf16(v[0], v[1]), pk_bf16(v[2], v[3])};
        }
#if 1
        s += __shfl_xor(s, 16); s += __shfl_xor(s, 32);
        if (lane < 16) ssp[(size_t)((col0 >> 7) * 2 + wc) * M + ssrow0 + rl] = s;
#endif
    }
}
__device__ __forceinline__ void phase3b(const Params& p, LAS char* lds) {
    unsigned char* ws = p.ws;
    const int lane = threadIdx.x & 63, w = wave_id(), wr = w >> 1, wc = w & 1;
    const bf16_t* gated = (const bf16_t*)(ws + WS_GATED); bf16_t* mixed = (bf16_t*)(ws + WS_MIXED);
    for (int it = 0;; ++it) {
        int tm, tn; int st = tile_at(it, 128, 8, tm, tn);
        if (st == 0) { if (it < (1 << 20) && (int)blockIdx.x < 8) { tm = 128; tn = blockIdx.x; it = 1 << 20; st = 1; } else break; }
        if (st == 2) continue;
        const int row0 = tm * 128, col0 = tn * 128; const int mlim = tm == 128 ? (wr == 0 ? 2 : 0) : 4;
        f32x4 acc[4][4]; zero_acc(acc);
        gemm_main<true>(lds, gated + (size_t)row0 * 1024, 1024, (const bf16_t*)(ws + WS_BTOUT) + (size_t)col0 * 1024, 1024, 16, acc, mlim);
        epi_store_ss(acc, mixed, 1024, row0, col0, (float*)(ws + WS_SSP2), row0, wr, wc, lane);
    }
}
__device__ __forceinline__ void phase3c(const Params& p) {
    unsigned char* ws = p.ws;
    const int lane = threadIdx.x & 63, w = wave_id();
    const bf16_t* mixed = (const bf16_t*)(ws + WS_MIXED); bf16_t* hb = (bf16_t*)(ws + WS_A);
    const float* ssp2 = (const float*)(ws + WS_SSP2); float* r2 = (float*)(ws + WS_R2);
    const float* g1 = p.gains + D;
    f32x4 g[4];
#pragma unroll
    for (int i = 0; i < 4; ++i) g[i] = *(const f32x4*)(g1 + lane * 4 + 256 * i);
    for (int grp = blockIdx.x; grp * 32 < MV; grp += gridDim.x) {
#pragma unroll 1
        for (int k = 0; k < 8; k += 2) {
            int r[2]; bool ok[2]; f32x4 v[2][4]; u32x2 mx[2][4]; float sq[2];
#pragma unroll
            for (int j = 0; j < 2; ++j) {
                r[j] = grp * 32 + w + 4 * (k + j); ok[j] = r[j] < MV; const int rr = ok[j] ? r[j] : 0;
                const float* src = rr < MX ? p.x + (size_t)rr * D : p.meta + (size_t)((rr - MX) & 15) * D;
                sq[j] = lane < 16 ? ssp2[(size_t)lane * M + rr] : 0.f;
#pragma unroll
                for (int i = 0; i < 4; ++i) { v[j][i] = __builtin_nontemporal_load((const f32x4*)(src + lane * 4 + 256 * i)); mx[j][i] = __builtin_nontemporal_load((const u32x2*)(mixed + (size_t)rr * D + lane * 4 + 256 * i)); }
            }
#pragma unroll
            for (int j = 0; j < 2; ++j) {
                const float a = 1.0f / sqrtf(wave_sum(sq[j]) * (1.0f / D) + EPS);
                float ss = 0.f;
#pragma unroll
                for (int i = 0; i < 4; ++i) {
                    const int col = lane * 4 + 256 * i;
                    f32x4 hh;
                    hh[0] = v[j][i][0] + bf_lo(mx[j][i][0]) * a * g[i][0]; hh[1] = v[j][i][1] + bf_hi(mx[j][i][0]) * a * g[i][1];
                    hh[2] = v[j][i][2] + bf_lo(mx[j][i][1]) * a * g[i][2]; hh[3] = v[j][i][3] + bf_hi(mx[j][i][1]) * a * g[i][3];
                    ss += hh[0] * hh[0] + hh[1] * hh[1] + hh[2] * hh[2] + hh[3] * hh[3];
                    if (ok[j]) {
                        *(u32x2*)(hb + (size_t)r[j] * D + col) = (u32x2){pk_bf16(hh[0], hh[1]), pk_bf16(hh[2], hh[3])};
                        if (r[j] < MX) __builtin_nontemporal_store(hh, (f32x4*)(p.out + (size_t)r[j] * D + col));
                    }
                }
                ss = wave_sum(ss);
                if (ok[j] && lane == 0) r2[r[j]] = 1.0f / sqrtf(ss * (1.0f / D) + EPS);
            }
        }
    }
}
constexpr int UST = 272;
__device__ __forceinline__ f32x4 unpack4(const u32x2 u) { return (f32x4){bf_lo(u[0]), bf_hi(u[0]), bf_lo(u[1]), bf_hi(u[1])}; }
struct ConvW { f32x4 w0g, w1g, w2g, bg, w0v, w1v, w2v, bv; };
__device__ __forceinline__ ConvW load_convw(const Params& p, int c) {
    ConvW q;
    q.w0g = *(const f32x4*)(p.conv_w + c); q.w1g = *(const f32x4*)(p.conv_w + NUP + c); q.w2g = *(const f32x4*)(p.conv_w + 2 * NUP + c); q.bg = *(const f32x4*)(p.conv_b + c);
    q.w0v = *(const f32x4*)(p.conv_w + DFF + c); q.w1v = *(const f32x4*)(p.conv_w + NUP + DFF + c); q.w2v = *(const f32x4*)(p.conv_w + 2 * NUP + DFF + c); q.bv = *(const f32x4*)(p.conv_b + DFF + c);
    return q;
}
__device__ __forceinline__ u32x2 conv_gelu4(const ConvW& q, const f32x4 g2, const f32x4 g1, const f32x4 g0, const f32x4 v2, const f32x4 v1, const f32x4 v0) {
    float o[4];
#pragma unroll
    for (int e = 0; e < 4; ++e) {
        const float ug = q.bg[e] + q.w0g[e] * g2[e] + q.w1g[e] * g1[e] + q.w2g[e] * g0[e];
        const float uv = q.bv[e] + q.w0v[e] * v2[e] + q.w1v[e] * v1[e] + q.w2v[e] * v0[e];
        const float t = 0.7978845608028654f * (ug + 0.044715f * ug * ug * ug);
        o[e] = ug * rcp(1.0f + ex2(-2.0f * LOG2E * t)) * uv;
    }
    return (u32x2){pk_bf16(o[0], o[1]), pk_bf16(o[2], o[3])};
}
__device__ __forceinline__ void phase4(const Params& p, LAS char* lds) {
    unsigned char* ws = p.ws;
    const int tid = threadIdx.x, lane = tid & 63, w = wave_id(), wr = w >> 1, wc = w & 1;
    const bf16_t* hb = (const bf16_t*)(ws + WS_A); const bf16_t* Bt = (const bf16_t*)(ws + WS_BTUP);
    const float* r2 = (const float*)(ws + WS_R2);
    bf16_t* act = (bf16_t*)(ws + WS_ACT); bf16_t* hal = (bf16_t*)(ws + WS_HAL);
    for (int it = 0;; ++it) {
        int tm, tn; int st = tile_at(it, 128, 44, tm, tn);
        if (st == 0) { if (it < (1 << 20) && (int)blockIdx.x < 44) { tm = 128; tn = blockIdx.x; it = 1 << 20; st = 1; } else break; }
        if (st == 2) continue;
        const bool mt = tm == 128; const int row0 = mt ? MX : tm * 128, col0 = tn * 128;
        f32x4 acc[4][4]; zero_acc(acc);
        gemm_main<true>(lds, hb + (size_t)row0 * D, D, Bt + (size_t)col0 * D, D, 16, acc, mt ? (wr == 0 ? 2 : 0) : 4);
#pragma unroll
        for (int m = 0; m < 4; ++m) {
            const int rl = wr * 64 + m * 16 + (lane & 15); const float rs = r2[row0 + rl];
#pragma unroll
            for (int n = 0; n < 4; ++n) {
                const int cl = wc * 64 + n * 16 + (lane >> 4) * 4; const f32x4 v = acc[m][n] * rs;
                *(LAS u32x2*)(lds + rl * UST + cl * 2) = (u32x2){pk_bf16(v[0], v[1]), pk_bf16(v[2], v[3])};
            }
        }
        __syncthreads();
        if (!mt) {
            const int cg = tid & 15, rb = tid >> 4, c = tn * 64 + cg * 4;
            const ConvW q = load_convw(p, c);
            const int hr = rb == 0 ? 0 : rb * 8 - 2;
            f32x4 g2 = unpack4(*(const LAS u32x2*)(lds + hr * UST + cg * 8)), v2 = unpack4(*(const LAS u32x2*)(lds + hr * UST + 128 + cg * 8));
            f32x4 g1 = unpack4(*(const LAS u32x2*)(lds + (hr + 1) * UST + cg * 8)), v1 = unpack4(*(const LAS u32x2*)(lds + (hr + 1) * UST + 128 + cg * 8));
            for (int r = hr + 2; r < rb * 8 + 8; ++r) {
                const f32x4 g0 = unpack4(*(const LAS u32x2*)(lds + r * UST + cg * 8)), v0 = unpack4(*(const LAS u32x2*)(lds + r * UST + 128 + cg * 8));
                *(u32x2*)(act + (size_t)(row0 + r) * DFF + c) = conv_gelu4(q, g2, g1, g0, v2, v1, v0);
                g2 = g1; g1 = g0; v2 = v1; v1 = v0;
            }
            if (tid < 64) { const int qq = tid >> 4, ch = tid & 15, rl = qq < 2 ? qq : 124 + qq;
                *(u32x4*)(hal + ((size_t)tm * 4 + qq) * NUP + col0 + ch * 8) = *(const LAS u32x4*)(lds + rl * UST + ch * 16); }
        } else {
            if (tid < 64) { const int qq = tid >> 4, ch = tid & 15, rl = (qq >> 1) * 16 + 14 + (qq & 1);
                *(u32x4*)(hal + ((size_t)(128 + (qq >> 1)) * 4 + 2 + (qq & 1)) * NUP + col0 + ch * 8) = *(const LAS u32x4*)(lds + rl * UST + ch * 16); }
        }
        __syncthreads();
    }
}
__device__ __forceinline__ void phase_fix(const Params& p) {
    unsigned char* ws = p.ws;
    const bf16_t* hal = (const bf16_t*)(ws + WS_HAL); bf16_t* act = (bf16_t*)(ws + WS_ACT);
    constexpr int NCG = DFF / 4;
    for (int it = blockIdx.x * NTHREADS + threadIdx.x; it < 128 * NCG; it += gridDim.x * NTHREADS) {
        const int tmg = it / NCG, c = (it % NCG) * 4, colg = (c >> 6) * 128 + (c & 63), colv = colg + 64;
        const bf16_t* own = hal + (size_t)tmg * 4 * NUP;
        const bf16_t* prv = hal + (size_t)((tmg & 63) ? tmg - 1 : 128 + (tmg >> 6)) * 4 * NUP;
        const ConvW q = load_convw(p, c);
        const f32x4 pg2 = unpack4(*(const u32x2*)(prv + 2 * NUP + colg)), pv2 = unpack4(*(const u32x2*)(prv + 2 * NUP + colv));
        const f32x4 pg3 = unpack4(*(const u32x2*)(prv + 3 * NUP + colg)), pv3 = unpack4(*(const u32x2*)(prv + 3 * NUP + colv));
        const f32x4 og0 = unpack4(*(const u32x2*)(own + colg)), ov0 = unpack4(*(const u32x2*)(own + colv));
        const f32x4 og1 = unpack4(*(const u32x2*)(own + NUP + colg)), ov1 = unpack4(*(const u32x2*)(own + NUP + colv));
        *(u32x2*)(act + (size_t)(tmg * 128) * DFF + c) = conv_gelu4(q, pg2, pg3, og0, pv2, pv3, ov0);
        *(u32x2*)(act + (size_t)(tmg * 128 + 1) * DFF + c) = conv_gelu4(q, pg3, og0, og1, pv3, ov0, ov1);
    }
}
__device__ __forceinline__ void phase6(const Params& p, LAS char* lds) {
    unsigned char* ws = p.ws;
    const int lane = threadIdx.x & 63, w = wave_id(), wr = w >> 1, wc = w & 1;
    const bf16_t* act = (const bf16_t*)(ws + WS_ACT); bf16_t* ffn = (bf16_t*)(ws + WS_FFN);
    for (int it = 0;; ++it) {
        int tm, tn; const int st = tile_at(it, 128, 8, tm, tn); if (st == 0) break; if (st == 2) continue;
        const int col0 = tn * 128;
        f32x4 acc[4][4]; zero_acc(acc);
        gemm_main<true>(lds, act + (size_t)(tm * 128) * DFF, DFF, (const bf16_t*)(ws + WS_BTDN) + (size_t)col0 * DFF, DFF, 44, acc);
        epi_store_ss(acc, ffn, 1024, tm * 128, col0, (float*)(ws + WS_SSP4), tm * 128, wr, wc, lane);
    }
}
__device__ __forceinline__ void phase7(const Params& p) {
    unsigned char* ws = p.ws;
    const int lane = threadIdx.x & 63, w = wave_id();
    const bf16_t* ffn = (const bf16_t*)(ws + WS_FFN); const float* ssp4 = (const float*)(ws + WS_SSP4); const float* g3 = p.gains + 3 * D;
    f32x4 g[4];
#pragma unroll
    for (int i = 0; i < 4; ++i) g[i] = *(const f32x4*)(g3 + lane * 4 + 256 * i);
    for (int r0 = (blockIdx.x * 4 + w) * 2; r0 < MX; r0 += gridDim.x * 8) {
        f32x4 hh[2][4]; u32x2 f[2][4]; float sq[2];
#pragma unroll
        for (int j = 0; j < 2; ++j) {
            const int row = r0 + j;
            sq[j] = lane < 16 ? ssp4[(size_t)lane * M + row] : 0.f;
#pragma unroll
            for (int i = 0; i < 4; ++i) { hh[j][i] = __builtin_nontemporal_load((const f32x4*)(p.out + (size_t)row * D + lane * 4 + 256 * i)); f[j][i] = __builtin_nontemporal_load((const u32x2*)(ffn + (size_t)row * D + lane * 4 + 256 * i)); }
        }
#pragma unroll
        for (int j = 0; j < 2; ++j) {
            const float a = 1.0f / sqrtf(wave_sum(sq[j]) * (1.0f / D) + EPS);
#pragma unroll
            for (int i = 0; i < 4; ++i) {
                f32x4 o;
                o[0] = hh[j][i][0] + bf_lo(f[j][i][0]) * a * g[i][0]; o[1] = hh[j][i][1] + bf_hi(f[j][i][0]) * a * g[i][1];
                o[2] = hh[j][i][2] + bf_lo(f[j][i][1]) * a * g[i][2]; o[3] = hh[j][i][3] + bf_hi(f[j][i][1]) * a * g[i][3];
                __builtin_nontemporal_store(o, (f32x4*)(p.out + (size_t)(r0 + j) * D + lane * 4 + 256 * i));
            }
        }
    }
}


#ifndef DUMP
#define DUMP 0
#endif
__device__ __forceinline__ void phase_dump(const Params& p) {
    unsigned char* ws = p.ws;
    const bf16_t* s0; const bf16_t* s1; int ld;
    if (DUMP == 1) { s0 = (const bf16_t*)(ws + WS_B); s1 = s0 + 512; ld = 1024; }
    else if (DUMP == 2) { s0 = (const bf16_t*)(ws + WS_QF); s1 = (const bf16_t*)(ws + WS_KF); ld = 512; }
    else if (DUMP == 3) { s0 = (const bf16_t*)(ws + WS_A); s1 = s0 + (size_t)M * 512; ld = 512; }
    else if (DUMP == 4) { s0 = (const bf16_t*)(ws + WS_GATED); s1 = s0 + 512; ld = 1024; }
    else if (DUMP == 8) { s0 = (const bf16_t*)(ws + WS_A); s1 = s0 + 512; ld = 1024; }
    else if (DUMP == 9) { s0 = (const bf16_t*)(ws + WS_ACT) + 1024; s1 = (const bf16_t*)(ws + WS_ACT) + 2304 - 512 + 512; ld = DFF; }
    else if (DUMP == 10) { s0 = (const bf16_t*)(ws + WS_FFN); s1 = s0 + 512; ld = 1024; }
    else if (DUMP == 6) { s0 = (const bf16_t*)(ws + WS_QS); s1 = (const bf16_t*)(ws + WS_KS); ld = 512; }
    else { s0 = (const bf16_t*)(ws + WS_MIXED); s1 = s0 + 512; ld = 1024; }
    for (int it = blockIdx.x * NTHREADS + threadIdx.x; it < MX * 1024; it += gridDim.x * NTHREADS) {
        const int row = it >> 10, col = it & 1023;
        if (DUMP >= 9 && row >= 8192) { p.out[it] = 0.f; continue; }
        const bf16_t v = col < 512 ? s0[(size_t)row * ld + col] : s1[(size_t)row * ld + col - 512];
        p.out[it] = __uint_as_float((unsigned)v << 16);
    }
}

__device__ __forceinline__ void l2_scrub(const Params& p) {
    const f32x4* src = (const f32x4*)p.x + (size_t)(blockIdx.x & 511) * 8192;
    f32x4 a = (f32x4){0.f, 0.f, 0.f, 0.f};
    for (int i = threadIdx.x; i < 8192; i += NTHREADS) a += src[i];
    if (a[0] + a[1] + a[2] + a[3] == 1.2345e-30f) ((float*)(p.ws + WS_CTL))[32 + (threadIdx.x & 7)] = a[0];
}


#define XB_TMO      128
#define XB_XCNT(j)  (256  + 64 * (j))
#define XB_XSUB(j)  (1280 + 64 * (j))
#define XB_XGEN(j)  (2304 + 64 * (j))
#define XB_TOP      3328
#define XB_TOPGEN   3392
#define XCD_BAR_WORDS 3456
#define XB_SPIN_CAP (1u << 18)
__device__ __forceinline__ unsigned xb_ld(unsigned* p)              { return __hip_atomic_load(p, __ATOMIC_RELAXED, __HIP_MEMORY_SCOPE_AGENT); }
__device__ __forceinline__ unsigned xb_add(unsigned* p, unsigned v) { return __hip_atomic_fetch_add(p, v, __ATOMIC_RELAXED, __HIP_MEMORY_SCOPE_AGENT); }
__device__ __forceinline__ unsigned xb_xcc_id() { return (unsigned)__builtin_amdgcn_s_getreg((3 << 11) | 20) & 0xFu; }
#define XB_SPIN(cond, bar) do { unsigned _sp = 0; while (cond) { __builtin_amdgcn_s_sleep(1); \
    if ((++_sp & 255u) == 0u) { if (xb_ld(&(bar)[XB_TMO])) break; if (_sp > XB_SPIN_CAP) { atomicAdd(&(bar)[XB_TMO], 1u); break; } } } } while (0)
struct XcdBarrier { unsigned* bar; unsigned x; volatile LAS unsigned* st; };
__device__ __forceinline__ XcdBarrier xcd_barrier_post(unsigned* bar, volatile LAS unsigned* st) {
    XcdBarrier b; b.bar = bar; b.x = xb_xcc_id(); b.st = st;
    if (threadIdx.x == 0) (void)xb_add(&bar[XB_XCNT(b.x)], 1u);
    return b;
}
__device__ __forceinline__ void xcd_barrier_complete(unsigned* bar, unsigned x, unsigned& nloc, unsigned& nx) {
    const unsigned G = gridDim.x * gridDim.y * gridDim.z;
    unsigned sum, cnt, mine, sp = 0u;
    for (;;) {
        sum = 0u; cnt = 0u; mine = 0u;
#pragma unroll
        for (unsigned j = 0; j < 16; ++j) { const unsigned c = xb_ld(&bar[XB_XCNT(j)]); sum += c; cnt += (c > 0u) ? 1u : 0u; mine = (j == x) ? c : mine; }
        if (sum == G) break;
        __builtin_amdgcn_s_sleep(1);
        if ((++sp & 255u) == 0u) { if (xb_ld(&bar[XB_TMO])) break; if (sp > XB_SPIN_CAP) { atomicAdd(&bar[XB_TMO], 1u); break; } }
    }
    nloc = mine > 0u ? mine : 1u; nx = cnt > 0u ? cnt : 1u;
}
__device__ __forceinline__ void xcd_barrier(const XcdBarrier& b) {
    asm volatile("s_waitcnt vmcnt(0)" ::: "memory");
    __syncthreads();
    if (threadIdx.x == 0) {
        unsigned* bar = b.bar;
        __builtin_amdgcn_s_waitcnt(0);
        unsigned nloc = b.st[0], nx = b.st[1];
        if (nloc == 0u) { xcd_barrier_complete(bar, b.x, nloc, nx); b.st[0] = nloc; b.st[1] = nx; }
        const unsigned old = xb_add(&bar[XB_XSUB(b.x)], 1u);
        const unsigned gen = old / nloc;
        if (old + 1u == (gen + 1u) * nloc) {
            __builtin_amdgcn_fence(__ATOMIC_RELEASE, "agent");
            asm volatile("s_waitcnt vmcnt(0)" ::: "memory");
            const unsigned og = xb_add(&bar[XB_TOP], 1u);
            const unsigned tg = og / nx;
            if (og + 1u == (tg + 1u) * nx) xb_add(&bar[XB_TOPGEN], 1u);
            else XB_SPIN(xb_ld(&bar[XB_TOPGEN]) == tg, bar);
            __builtin_amdgcn_fence(__ATOMIC_ACQUIRE, "agent");
            xb_add(&bar[XB_XGEN(b.x)], 1u);
            asm volatile("s_waitcnt vmcnt(0)" ::: "memory");
        } else {
            XB_SPIN(xb_ld(&bar[XB_XGEN(b.x)]) == gen, bar);
            __builtin_amdgcn_fence(__ATOMIC_ACQUIRE, "agent");
            asm volatile("s_waitcnt vmcnt(0)" ::: "memory");
        }
    }
    __syncthreads();
}

__device__ __forceinline__ void my_grid_sync(const Params& p, unsigned& target) {
    unsigned* bar = (unsigned*)(p.ws + WS_CTL) + 16;
    asm volatile("s_waitcnt vmcnt(0)" ::: "memory");
    __syncthreads();
    target += gridDim.x;
    if (threadIdx.x == 0) {
        __builtin_amdgcn_fence(__ATOMIC_RELEASE, "agent");
        asm volatile("s_waitcnt vmcnt(0)" ::: "memory");
        __hip_atomic_fetch_add(bar, 1u, __ATOMIC_RELAXED, __HIP_MEMORY_SCOPE_AGENT);
        while (__hip_atomic_load(bar, __ATOMIC_RELAXED, __HIP_MEMORY_SCOPE_AGENT) < target) __builtin_amdgcn_s_sleep(2);
        __builtin_amdgcn_fence(__ATOMIC_ACQUIRE, "agent");
        asm volatile("s_waitcnt vmcnt(0)" ::: "memory");
    }
    __syncthreads();
}
__global__ void __launch_bounds__(NTHREADS, 2) fwd_kernel(Params p) {
    extern __shared__ __attribute__((aligned(16))) unsigned char lds_raw[];
    LAS char* lds = (LAS char*)lds_raw;
    cg::grid_group grid = cg::this_grid();
#define IN(k) (p.ph_lo <= (k) && (k) < p.ph_hi)
#define SEAM(k) do { if (IN(k) && IN((k) + 1)) { if (p.ph_hi > 1000) grid.sync(); xcd_barrier(xbar); } } while (0)
    volatile LAS unsigned* xst = (volatile LAS unsigned*)(lds + 65536);
    if (threadIdx.x < 4) xst[threadIdx.x] = 0u;
    __syncthreads();
    const XcdBarrier xbar = xcd_barrier_post((unsigned*)(p.ws + WS_XBAR), xst);
    if (IN(0)) phase0(p, lds);
    SEAM(0);
    if (IN(1)) phase1(p, lds);
    SEAM(1);
    if (IN(2)) phase2(p, lds);
    SEAM(2);
    if (IN(3)) phase_comb(p);
    SEAM(3);
    if (IN(4)) phase3a(p, lds);
    SEAM(4);
    if (IN(5)) phase3b(p, lds);
    SEAM(5);
    if (IN(6)) phase3c(p);
    SEAM(6);
    if (IN(7)) phase4(p, lds);
    SEAM(7);
    if (IN(8)) phase_fix(p);
    SEAM(8);
    if (IN(9)) phase6(p, lds);
    SEAM(9);
    if (IN(10)) phase7(p);
#undef IN
#undef SEAM
}


__global__ void ab_save(const unsigned char* ws, float* out) {
    const u32x4* src = (const u32x4*)(ws + AB_SRC); u32x4* dst = (u32x4*)((unsigned char*)out + (size_t)32 * MiB);
    for (size_t i = blockIdx.x * (size_t)blockDim.x + threadIdx.x; i < (size_t)AB_BYTES / 16; i += (size_t)gridDim.x * blockDim.x) dst[i] = src[i];
}
__global__ void ab_diff(const unsigned char* ws, float* out) {
    const bf16_t* src = (const bf16_t*)(ws + AB_SRC); const bf16_t* sav = (const bf16_t*)((unsigned char*)out + (size_t)32 * MiB);
    for (size_t i = blockIdx.x * (size_t)blockDim.x + threadIdx.x; i < (size_t)8192 * 1024; i += (size_t)gridDim.x * blockDim.x) {
        if (i >= (size_t)AB_BYTES / 2) { out[i] = 0.f; continue; }
        out[i] = src[i] != sav[i] ? 1000.0f : 0.f;
    }
}
__global__ void ab_zero(float* out) {
    for (size_t i = blockIdx.x * (size_t)blockDim.x + threadIdx.x; i < (size_t)8192 * 1024; i += (size_t)gridDim.x * blockDim.x) out[(size_t)8192 * 1024 + i] = 0.f;
}
extern "C" void kernel_launch(void* const* d_in, const int* in_sizes, int n_in, void* d_out, int out_size, void* d_ws, size_t ws_size, hipStream_t stream) {
    static int grid_blocks = 0;
    if (grid_blocks == 0) {
        if (n_in != 12 || ws_size < WS_END) { fprintf(stderr, "kernel_launch: unexpected n_in %d or ws_size %zu (need %zu)\n", n_in, ws_size, (size_t)WS_END); grid_blocks = -1; return; }
        int dev = 0, cus = 0, per_cu = 0;
        (void)hipGetDevice(&dev);
        (void)hipDeviceGetAttribute(&cus, hipDeviceAttributeMultiprocessorCount, dev);
        (void)hipFuncSetAttribute((const void*)fwd_kernel, hipFuncAttributeMaxDynamicSharedMemorySize, LDS_BYTES);
        (void)hipOccupancyMaxActiveBlocksPerMultiprocessor(&per_cu, (const void*)fwd_kernel, NTHREADS, LDS_BYTES);
        if (per_cu < 1) per_cu = 1;
        if (per_cu > 2) per_cu = 2;
        grid_blocks = cus * per_cu;
        (void)hipGetLastError();
    }
    if (grid_blocks < 0) return;
    Params p{};
    p.x = (const float*)d_in[0]; p.meta = (const float*)d_in[1]; p.gains = (const float*)d_in[2]; p.w_in = (const float*)d_in[3];
    p.b_forget = (const float*)d_in[4]; p.w_o_fox = (const float*)d_in[5]; p.w_o_sb = (const float*)d_in[6]; p.w_out = (const float*)d_in[7];
    p.w_up = (const float*)d_in[8]; p.conv_w = (const float*)d_in[9]; p.conv_b = (const float*)d_in[10]; p.w_down = (const float*)d_in[11];
    p.out = (float*)d_out; p.ws = (unsigned char*)d_ws;
#if SINGLE_LAUNCH
    (void)hipMemsetAsync((unsigned char*)d_ws + WS_XBAR, 0, XCD_BAR_WORDS * 4, stream);
    p.ph_lo = 0; p.ph_hi = NPHASE;
    void* args[] = {&p};
    hipError_t e = hipLaunchCooperativeKernel((const void*)fwd_kernel, dim3(grid_blocks), dim3(NTHREADS), args, LDS_BYTES, stream);
    if (e != hipSuccess) fprintf(stderr, "cooperative launch failed: %s (grid %d)\n", hipGetErrorString(e), grid_blocks);
#else
#ifndef STOP_AT
#define STOP_AT NPHASE
#endif
    for (int k = 0; k < STOP_AT; ++k) {
        p.ph_lo = k; p.ph_hi = k + 1;
        hipLaunchKernelGGL(fwd_kernel, dim3(grid_blocks), dim3(NTHREADS), LDS_BYTES, stream, p);
    }
#if ABTEST
    ab_save<<<1024, 256, 0, stream>>>(p.ws, p.out);
    for (int k = AB_FROM; k < STOP_AT; ++k) {
        p.ph_lo = k; p.ph_hi = k + 1;
        hipLaunchKernelGGL(fwd_kernel, dim3(grid_blocks), dim3(NTHREADS), LDS_BYTES, stream, p);
    }
    ab_diff<<<1024, 256, 0, stream>>>(p.ws, p.out);
    ab_zero<<<1024, 256, 0, stream>>>(p.out);
#endif

#endif
}
```

```cpp
#include <hip/hip_runtime.h>
#include <hip/hip_cooperative_groups.h>
#include <cstdio>
#include <cstdint>
namespace cg = cooperative_groups;

#define DUMP 0
#define ABTEST 0
#define AB_FROM 0
#define AB_SRC WS_SSP2
#define AB_BYTES (2 * MiB)
#ifndef SINGLE_LAUNCH
#define SINGLE_LAUNCH 1
#endif

#define LAS __attribute__((address_space(3)))
typedef unsigned short bf16_t;
typedef short bf16x8 __attribute__((ext_vector_type(8)));
typedef float f32x4 __attribute__((ext_vector_type(4)));
typedef float f32x16 __attribute__((ext_vector_type(16)));
typedef unsigned u32x4 __attribute__((ext_vector_type(4)));
typedef unsigned u32x2 __attribute__((ext_vector_type(2)));

constexpr int D = 1024, SEQ = 8192, NMETA = 16, NB = 2;
constexpr int MX = NB * SEQ;
constexpr int MV = MX + NB * NMETA;
constexpr int M = 16512;
constexpr int LPK = 8256;
constexpr int PROJW = 5128, NPROJ = 5120, DFF = 2816, NUP = 5632;
constexpr float EPS = 1e-6f;
constexpr float LOG2E = 1.4426950408889634f, LN2 = 0.6931471805599453f;
constexpr int NTHREADS = 256;
constexpr int LDS_BYTES = 65536 + 16;
constexpr int NPHASE = 11;

constexpr size_t MiB = 1u << 20;
constexpr size_t WS_CTL = 0;
constexpr size_t WS_R1 = 4096, WS_R2 = WS_R1 + 69632, WS_SS2 = WS_R2 + 69632, WS_SS4 = WS_SS2 + 69632;
constexpr size_t WS_LOGF = WS_SS4 + 69632, WS_CK = WS_LOGF + 528384, WS_UPMETA = WS_CK + 528384;
constexpr size_t WS_BTIN = 2 * MiB, WS_BTOF = WS_BTIN + 10 * MiB, WS_BTOS = WS_BTOF + 1 * MiB, WS_BTOUT = WS_BTOS + 1 * MiB,
                 WS_BTUP = WS_BTOUT + 2 * MiB, WS_BTDN = WS_BTUP + 11 * MiB;
constexpr size_t SZ_M1024 = (size_t)M * 1024 * 2, SZ_M512 = (size_t)M * 512 * 2;
constexpr size_t WS_A = 33 * MiB;
constexpr size_t WS_B = WS_A + SZ_M1024;
constexpr size_t WS_C = WS_B + 2 * SZ_M1024;
constexpr size_t WS_QF = WS_C, WS_KF = WS_QF + SZ_M512, WS_QS = WS_KF + SZ_M512, WS_KS = WS_QS + SZ_M512, WS_VFT = WS_KS + SZ_M512, WS_VST = WS_VFT + SZ_M512;
constexpr size_t WS_GATED = WS_C, WS_MIXED = WS_B + SZ_M1024;
constexpr size_t WS_ACT = WS_B;
constexpr size_t WS_FFN = WS_ACT + 132 * MiB;
constexpr size_t WS_SSP2 = 230 * MiB, WS_SSP4 = 232 * MiB;
constexpr size_t WS_HAL = 234 * MiB;
constexpr size_t WS_XBAR = 240 * MiB;
constexpr size_t WS_END = 241 * MiB;

struct Params {
    const float *x, *meta, *gains, *w_in, *b_forget, *w_o_fox, *w_o_sb, *w_out, *w_up, *conv_w, *conv_b, *w_down;
    float* out; unsigned char* ws; int ph_lo, ph_hi;
};

typedef __bf16 bf16x2_t __attribute__((ext_vector_type(2)));
__device__ __forceinline__ unsigned pk_bf16(float lo, float hi) { bf16x2_t v = {(__bf16)lo, (__bf16)hi}; return __builtin_bit_cast(unsigned, v); }
__device__ __forceinline__ float bf_lo(unsigned u) { return __uint_as_float(u << 16); }
__device__ __forceinline__ float bf_hi(unsigned u) { return __uint_as_float(u & 0xffff0000u); }
__device__ __forceinline__ float ex2(float x) { return __builtin_amdgcn_exp2f(x); }
__device__ __forceinline__ float lg2(float x) { return __builtin_amdgcn_logf(x); }
__device__ __forceinline__ float rcp(float x) { return __builtin_amdgcn_rcpf(x); }
__device__ __forceinline__ float sigmoidf_(float v) { return rcp(1.0f + ex2(-v * LOG2E)); }
__device__ __forceinline__ float wave_sum(float v) {
#pragma unroll
    for (int o = 32; o > 0; o >>= 1) v += __shfl_xor(v, o);
    return v;
}
__device__ __forceinline__ int wave_id() { return __builtin_amdgcn_readfirstlane((int)(threadIdx.x >> 6)); }

__device__ __forceinline__ void transpose_tile(LAS char* lds, const float* src, int ldsrc, int srccol, int k0, const float* gain, bf16_t* dst, int K, int n0) {
    LAS bf16_t* T = (LAS bf16_t*)lds;
    const int tid = threadIdx.x, r = tid >> 4, c4 = tid & 15;
#pragma unroll
    for (int p = 0; p < 4; ++p) {
        const int k = r + 16 * p;
        f32x4 v = *(const f32x4*)(src + (size_t)(k0 + k) * ldsrc + srccol + c4 * 4);
        const float g = gain ? gain[k0 + k] : 1.0f;
        const unsigned a = pk_bf16(v[0] * g, v[1] * g), b = pk_bf16(v[2] * g, v[3] * g);
        T[(c4 * 4 + 0) * 72 + k] = (bf16_t)(a & 0xffff); T[(c4 * 4 + 1) * 72 + k] = (bf16_t)(a >> 16);
        T[(c4 * 4 + 2) * 72 + k] = (bf16_t)(b & 0xffff); T[(c4 * 4 + 3) * 72 + k] = (bf16_t)(b >> 16);
    }
    __syncthreads();
    const int n = tid >> 2, kq = tid & 3;
    const u32x4 lo = *(LAS u32x4*)(T + n * 72 + kq * 16), hi = *(LAS u32x4*)(T + n * 72 + kq * 16 + 8);
    bf16_t* d = dst + (size_t)(n0 + n) * K + k0 + kq * 16;
    *(u32x4*)d = lo; *(u32x4*)(d + 8) = hi;
    __syncthreads();
}

__device__ __forceinline__ void phase0(const Params& p, LAS char* lds) {
    unsigned char* ws = p.ws;
    const int tid = threadIdx.x, lane = tid & 63, w = wave_id();
    LAS float* wfT = (LAS float*)lds;
    const float* g0 = p.gains;
    for (int idx = tid; idx < 8192; idx += NTHREADS) { const int h = idx & 7, k = idx >> 3; wfT[h * 1024 + k] = p.w_in[(size_t)k * PROJW + 1536 + h] * g0[k]; }
    __syncthreads();
    bf16_t* xb = (bf16_t*)(ws + WS_A);
    float* r1 = (float*)(ws + WS_R1);
    float* logf_ = (float*)(ws + WS_LOGF);
    for (int grp = blockIdx.x; grp * 32 < M; grp += gridDim.x) {
#pragma unroll 1
        for (int k = 0; k < 8; k += 2) {
            int r[2]; f32x4 v[2][4];
#pragma unroll
            for (int j = 0; j < 2; ++j) {
                r[j] = grp * 32 + w + 4 * (k + j);
                const int rr = r[j] < MV ? r[j] : 0;
                const float* src = rr < MX ? p.x + (size_t)rr * D : p.meta + (size_t)((rr - MX) & 15) * D;
#pragma unroll
                for (int i = 0; i < 4; ++i) v[j][i] = __builtin_nontemporal_load((const f32x4*)(src + lane * 4 + 256 * i));
            }
#pragma unroll
            for (int j = 0; j < 2; ++j) {
                const int rw = r[j];
                if (rw >= MV) {
#pragma unroll
                    for (int i = 0; i < 4; ++i) *(u32x2*)(xb + (size_t)rw * D + lane * 4 + 256 * i) = (u32x2){0u, 0u};
                    if (lane == 0) r1[rw] = 0.f;
                    continue;
                }
                float ss = 0.f;
#pragma unroll
                for (int i = 0; i < 4; ++i) {
                    ss += v[j][i][0] * v[j][i][0] + v[j][i][1] * v[j][i][1] + v[j][i][2] * v[j][i][2] + v[j][i][3] * v[j][i][3];
                    *(u32x2*)(xb + (size_t)rw * D + lane * 4 + 256 * i) = (u32x2){pk_bf16(v[j][i][0], v[j][i][1]), pk_bf16(v[j][i][2], v[j][i][3])};
                }
                ss = wave_sum(ss);
                const float rs = 1.0f / sqrtf(ss * (1.0f / D) + EPS);
                if (lane == 0) r1[rw] = rs;
                float mine = 0.f;
#pragma unroll
                for (int h = 0; h < 8; ++h) {
                    float acc_ = 0.f;
#pragma unroll
                    for (int i = 0; i < 4; ++i) { const f32x4 wv = *(LAS f32x4*)(wfT + h * 1024 + lane * 4 + 256 * i); acc_ += v[j][i][0] * wv[0] + v[j][i][1] * wv[1] + v[j][i][2] * wv[2] + v[j][i][3] * wv[3]; }
                    acc_ = wave_sum(acc_);
                    if (lane == h) mine = acc_;
                }
                if (lane < 8) {
                    const float f = mine * rs + p.b_forget[lane];
                    const float lf = fminf(f, 0.f) - log1pf(expf(-fabsf(f)));
                    int bb, kidx; if (rw < MX) { bb = rw >> 13; kidx = rw & 8191; } else { const int jj = rw - MX; bb = jj >> 4; kidx = 8192 + (jj & 15); }
                    logf_[(size_t)(bb * 8 + lane) * LPK + kidx] = lf;
                }
            }
        }
    }
    __syncthreads();
    LAS char* tl = lds + 32768;
    const float* g2 = p.gains + 2 * D;
    constexpr int T_IN = 16 * 80, T_OF = 8 * 16, T_OS = 8 * 16, T_OUT = 16 * 16, T_UP = 16 * 88, T_DN = 44 * 16;
    constexpr int T_ALL = T_IN + T_OF + T_OS + T_OUT + T_UP + T_DN;
    for (int t = blockIdx.x; t < T_ALL; t += gridDim.x) {
        int u = t;
        if (u < T_IN) { const int nt = u % 80, kt = u / 80; const int sc = nt * 64 + (nt * 64 >= 1536 ? 8 : 0); transpose_tile(tl, p.w_in, PROJW, sc, kt * 64, g0, (bf16_t*)(ws + WS_BTIN), 1024, nt * 64); continue; }
        u -= T_IN;
        if (u < T_OF) { const int nt = u % 16, kt = u / 16; transpose_tile(tl, p.w_o_fox, 1024, nt * 64, kt * 64, nullptr, (bf16_t*)(ws + WS_BTOF), 512, nt * 64); continue; }
        u -= T_OF;
        if (u < T_OS) { const int nt = u % 16, kt = u / 16; transpose_tile(tl, p.w_o_sb, 1024, nt * 64, kt * 64, nullptr, (bf16_t*)(ws + WS_BTOS), 512, nt * 64); continue; }
        u -= T_OS;
        if (u < T_OUT) { const int nt = u % 16, kt = u / 16; transpose_tile(tl, p.w_out, 1024, nt * 64, kt * 64, nullptr, (bf16_t*)(ws + WS_BTOUT), 1024, nt * 64); continue; }
        u -= T_OUT;
        if (u < T_UP) { const int nt = u % 88, kt = u / 88; transpose_tile(tl, p.w_up, NUP, (nt & 1) * DFF + (nt >> 1) * 64, kt * 64, g2, (bf16_t*)(ws + WS_BTUP), 1024, nt * 64); continue; }
        u -= T_UP;
        { const int nt = u % 16, kt = u / 16; transpose_tile(tl, p.w_down, 1024, nt * 64, kt * 64, nullptr, (bf16_t*)(ws + WS_BTDN), DFF, nt * 64); }
    }
}

template <bool SWAP, bool FULL>
__device__ __forceinline__ void gemm_kloop(LAS char* lds, const bf16_t* Ag, int lda, const bf16_t* Bg, int ldb, int nk, f32x4 (&acc)[4][4], int mlim) {
    const int tid = threadIdx.x, lane = tid & 63, w = wave_id(), wr = w >> 1, wc = w & 1;
    const int row_0 = w * 8 + (lane >> 3), c_0 = (lane & 7) ^ ((row_0 >> 1) & 7);
    const bf16_t* pa0 = Ag + (size_t)row_0 * lda + c_0 * 8; const bf16_t* pb0 = Bg + (size_t)row_0 * ldb + c_0 * 8;
    const size_t sa = (size_t)32 * lda, sb_ = (size_t)32 * ldb;
    const int swz = (lane >> 1) & 7;
    int aoff[2], boff[2];
#pragma unroll
    for (int kh = 0; kh < 2; ++kh) {
        aoff[kh] = (wr * 64 + (lane & 15)) * 128 + (((kh * 4 + (lane >> 4)) ^ swz) << 4);
        boff[kh] = 16384 + (wc * 64 + (lane & 15)) * 128 + (((kh * 4 + (lane >> 4)) ^ swz) << 4);
    }
#define GM_STAGE(s, kt) do { _Pragma("unroll") for (int i_ = 0; i_ < 4; ++i_) { \
        __builtin_amdgcn_global_load_lds((const unsigned*)(pa0 + i_ * sa + (kt) * 64), (LAS unsigned*)(lds + (s) * 32768 + (i_ * 4 + w) * 1024), 16, 0, 0); \
        __builtin_amdgcn_global_load_lds((const unsigned*)(pb0 + i_ * sb_ + (kt) * 64), (LAS unsigned*)(lds + (s) * 32768 + 16384 + (i_ * 4 + w) * 1024), 16, 0, 0); } } while (0)
    GM_STAGE(0, 0);
    for (int kt = 0; kt < nk; ++kt) {
        asm volatile("s_waitcnt vmcnt(0)" ::: "memory");
        __syncthreads();
        const int s = kt & 1;
        if (kt + 1 < nk) GM_STAGE(s ^ 1, kt + 1);
        bf16x8 af[4][2], bf[4][2];
#pragma unroll
        for (int kh = 0; kh < 2; ++kh) {
#pragma unroll
            for (int m = 0; m < 4; ++m) if (FULL || m < mlim) af[m][kh] = *(LAS bf16x8*)(lds + s * 32768 + aoff[kh] + m * 2048);
#pragma unroll
            for (int n = 0; n < 4; ++n) bf[n][kh] = *(LAS bf16x8*)(lds + s * 32768 + boff[kh] + n * 2048);
        }
        __builtin_amdgcn_s_setprio(1);
#pragma unroll
        for (int kh = 0; kh < 2; ++kh)
#pragma unroll
            for (int m = 0; m < 4; ++m) if (FULL || m < mlim) {
#pragma unroll
                for (int n = 0; n < 4; ++n)
                    acc[m][n] = SWAP ? __builtin_amdgcn_mfma_f32_16x16x32_bf16(bf[n][kh], af[m][kh], acc[m][n], 0, 0, 0)
                                     : __builtin_amdgcn_mfma_f32_16x16x32_bf16(af[m][kh], bf[n][kh], acc[m][n], 0, 0, 0);
            }
        __builtin_amdgcn_s_setprio(0);
    }
    __syncthreads();
#undef GM_STAGE
}
template <bool SWAP>
__device__ __forceinline__ void gemm_main(LAS char* lds, const bf16_t* Ag, int lda, const bf16_t* Bg, int ldb, int nk, f32x4 (&acc)[4][4], int mlim = 4) {
    if (mlim == 4) gemm_kloop<SWAP, true>(lds, Ag, lda, Bg, ldb, nk, acc, 4);
    else gemm_kloop<SWAP, false>(lds, Ag, lda, Bg, ldb, nk, acc, mlim);
}
__device__ __forceinline__ void zero_acc(f32x4 (&acc)[4][4]) {
#pragma unroll
    for (int m = 0; m < 4; ++m)
#pragma unroll
        for (int n = 0; n < 4; ++n) acc[m][n] = (f32x4){0.f, 0.f, 0.f, 0.f};
}


__device__ __forceinline__ int tile_at(int it, int ntm, int ntn, int& tm, int& tn) {
    const int G = gridDim.x;
    if (G % 256 != 0) { const int t = it * G + blockIdx.x; if (t >= ntm * ntn) return 0; tm = t / ntn; tn = t % ntn; return 1; }
    const int xcd = blockIdx.x & 7, j = blockIdx.x >> 3, ppx = G >> 8;
    const int pcols = (ntn + 3) >> 2, prows = (ntm + 7) >> 3;
    const int patch = (it * ppx + (j >> 5)) * 8 + xcd;
    if (patch >= prows * pcols) return 0;
    const int wi = j & 31;
    tm = (patch / pcols) * 8 + (wi >> 2); tn = (patch % pcols) * 4 + (wi & 3);
    return (tm < ntm && tn < ntn) ? 1 : 2;
}
__device__ __forceinline__ void cumsum_block(const Params& p, LAS char* lds, int bh) {
    const float* lf = (const float*)(p.ws + WS_LOGF) + (size_t)bh * LPK; float* ck = (float*)(p.ws + WS_CK) + (size_t)bh * LPK;
    LAS float* wsum = (LAS float*)lds;
    const int tid = threadIdx.x, lane = tid & 63, w = wave_id(); constexpr int PER = 33, L = SEQ + NMETA;
    float v[PER];
#pragma unroll
    for (int e = 0; e < PER; ++e) { const int t = e * NTHREADS + tid; const int tc = t < L ? t : L - 1; const float x = lf[tc < 16 ? 8192 + tc : tc - 16]; v[e] = t < L ? x : 0.f; }
    float carry = 0.f;
#pragma unroll
    for (int e = 0; e < PER; ++e) {
        float x = v[e];
#pragma unroll
        for (int o = 1; o < 64; o <<= 1) { const float y = __shfl_up(x, o); if (lane >= o) x += y; }
        if (lane == 63) wsum[(e & 1) * 4 + w] = x;
        __syncthreads();
        const float s0 = wsum[(e & 1) * 4 + 0], s1 = wsum[(e & 1) * 4 + 1], s2 = wsum[(e & 1) * 4 + 2], s3 = wsum[(e & 1) * 4 + 3];
        const float pre = (w > 0 ? s0 : 0.f) + (w > 1 ? s1 : 0.f) + (w > 2 ? s2 : 0.f);
        const int t = e * NTHREADS + tid;
        if (t < L) ck[t < 16 ? 8192 + t : t - 16] = (carry + pre + x) * LOG2E;
        carry += (s0 + s1) + (s2 + s3);
    }
    __syncthreads();
}

__device__ __forceinline__ void phase1(const Params& p, LAS char* lds) {
    unsigned char* ws = p.ws;
    if ((int)blockIdx.x >= (int)gridDim.x - 16) cumsum_block(p, lds, gridDim.x - 1 - blockIdx.x);
    const int lane = threadIdx.x & 63, w = wave_id(), wr = w >> 1, wc = w & 1;
    const bf16_t* xb = (const bf16_t*)(ws + WS_A); const bf16_t* Bt = (const bf16_t*)(ws + WS_BTIN);
    const float* r1 = (const float*)(ws + WS_R1);
    constexpr int NTN = 40, NTM = 129;
    for (int it = 0;; ++it) {
        int tm, tn; int st = tile_at(it, NTM - 1, NTN, tm, tn);
        if (st == 0) { if (it < (1 << 20) && (int)blockIdx.x < NTN) { tm = NTM - 1; tn = blockIdx.x; it = 1 << 20; st = 1; } else break; }
        if (st == 2) continue;
        const int row0 = tm * 128, col0 = tn * 128; const int mlim = tm == NTM - 1 ? (wr == 0 ? 2 : 0) : 4;
        const bool vtile = (tn >= 8 && tn < 12) || (tn >= 20 && tn < 24);
        f32x4 acc[4][4]; zero_acc(acc);
        if (vtile) {
            gemm_main<false>(lds, xb + (size_t)row0 * D, D, Bt + (size_t)col0 * D, D, 16, acc, mlim);
            bf16_t* vT = (bf16_t*)(ws + (tn < 12 ? WS_VFT : WS_VST)); const int cb = tn < 12 ? 1024 : 2560;
            const int g = lane >> 4, gp = ((g & 1) << 1) | (g >> 1);
#pragma unroll
            for (int m = 0; m < 4; ++m) {
                const int rb = row0 + wr * 64 + m * 16; int b, kb16;
                if (rb < MX) { b = rb >> 13; kb16 = rb & 8191; } else { const int j = rb - MX; if (j >= 32) continue; b = j >> 4; kb16 = 8192; }
                const f32x4 rs = *(const f32x4*)(r1 + rb + g * 4);
#pragma unroll
                for (int n = 0; n < 4; ++n) {
                    const int dc = col0 + wc * 64 + n * 16 + (lane & 15) - cb, h = dc >> 6, d = dc & 63;
                    const f32x4 v = acc[m][n] * rs;
                    *(u32x2*)(vT + ((size_t)(b * 8 + h) * 64 + d) * LPK + kb16 + gp * 4) = (u32x2){pk_bf16(v[0], v[1]), pk_bf16(v[2], v[3])};
                }
            }
        } else {
            gemm_main<true>(lds, xb + (size_t)row0 * D, D, Bt + (size_t)col0 * D, D, 16, acc, mlim);
            bf16_t* dst; int ld, cb; float sc = 1.f; bool sg = false;
            if (tn < 4) { dst = (bf16_t*)(ws + WS_QF); ld = 512; cb = 0; sc = 0.125f * LOG2E; }
            else if (tn < 8) { dst = (bf16_t*)(ws + WS_KF); ld = 512; cb = 512; }
            else if (tn < 16) { dst = (bf16_t*)(ws + WS_QS); ld = 512; cb = 1536; sc = 0.125f; }
            else if (tn < 20) { dst = (bf16_t*)(ws + WS_KS); ld = 512; cb = 2048; }
            else if (tn < 32) { dst = (bf16_t*)(ws + WS_B); ld = 1024; cb = 3072; sg = true; }
            else { dst = (bf16_t*)(ws + WS_B + SZ_M1024); ld = 1024; cb = 4096; sg = true; }
            const bool kfox = tn >= 4 && tn < 8;
            float wmax = 0.f;
#pragma unroll
            for (int m = 0; m < 4; ++m) {
                const int row = row0 + wr * 64 + m * 16 + (lane & 15); const float rs = r1[row] * sc;
                float s2 = 0.f;
#pragma unroll
                for (int n = 0; n < 4; ++n) {
                    const int col = col0 + wc * 64 + n * 16 + (lane >> 4) * 4 - cb;
                    f32x4 v = acc[m][n] * rs;
                    if (sg) { v[0] = sigmoidf_(v[0]); v[1] = sigmoidf_(v[1]); v[2] = sigmoidf_(v[2]); v[3] = sigmoidf_(v[3]); }
                    s2 += v[0] * v[0] + v[1] * v[1] + v[2] * v[2] + v[3] * v[3];
                    *(u32x2*)(dst + (size_t)row * ld + col) = (u32x2){pk_bf16(v[0], v[1]), pk_bf16(v[2], v[3])};
                }
                if (kfox) { s2 += __shfl_xor(s2, 16); s2 += __shfl_xor(s2, 32); wmax = fmaxf(wmax, s2); }
            }
            if (kfox) {
#pragma unroll
                for (int o = 1; o < 16; o <<= 1) wmax = fmaxf(wmax, __shfl_xor(wmax, o));
                if (lane == 0) {
                    unsigned* km = (unsigned*)(ws + WS_XBAR) + 32; const int head = (tn - 4) * 2 + wc; const unsigned bits = __float_as_uint(wmax);
                    if (row0 < MX) atomicMax(km + (row0 >> 13) * 8 + head, bits);
                    else { atomicMax(km + head, bits); atomicMax(km + 8 + head, bits); }
                }
            }
        }
    }
}

constexpr int AT_STAGE = 16640;
template <int TYPE>
__device__ __forceinline__ void attn_unit(LAS char* lds, const Params& p, int b, int h, int qb, int part = 0) {
    unsigned char* ws = p.ws;
    const int tid = threadIdx.x, lane = tid & 63, w = wave_id(), ql = lane & 31, hi = lane >> 5;
    const bf16_t* Q = (const bf16_t*)(ws + (TYPE == 0 ? WS_QF : WS_QS));
    const bf16_t* Kp = (const bf16_t*)(ws + (TYPE == 0 ? WS_KF : WS_KS));
    const bf16_t* VT = (const bf16_t*)(ws + (TYPE == 0 ? WS_VFT : WS_VST)) + (size_t)(b * 8 + h) * 64 * LPK;
    const float* cK = (const float*)(ws + WS_CK) + (size_t)(b * 8 + h) * LPK;
    bf16_t* Oo = (bf16_t*)(ws + WS_A + (TYPE == 0 ? 0 : SZ_M512));
    const bool meta_unit = qb < 0;
    const int qrow0 = meta_unit ? MX + 16 * b : b * SEQ + qb * 128;
    const int nt = meta_unit ? 1 : 2 * qb + 3;
    int qrow = qrow0 + 32 * w + ql; if (qrow > M - 1) qrow = M - 1;
    bf16x8 qf[4];
#pragma unroll
    for (int ds = 0; ds < 4; ++ds) qf[ds] = *(const bf16x8*)(Q + (size_t)qrow * 512 + h * 64 + ds * 16 + hi * 8);
    f32x16 O0, O1;
#pragma unroll
    for (int i = 0; i < 16; ++i) { O0[i] = 0.f; O1[i] = 0.f; }
    float m_run = -INFINITY, lsum = 0.f, R = 0.f;
    const int JA = qb + 2;
    const int j0 = part == 2 ? JA : 0, j1 = part == 1 ? JA : nt;
    if (TYPE == 0 && part == 2) {
        float dg = 0.f;
#pragma unroll
        for (int ds = 0; ds < 4; ++ds) {
            const bf16x8 kd = *(const bf16x8*)(Kp + (size_t)qrow * 512 + h * 64 + ds * 16 + hi * 8);
#pragma unroll
            for (int e = 0; e < 8; ++e) dg += __uint_as_float((unsigned)(unsigned short)qf[ds][e] << 16) * __uint_as_float((unsigned)(unsigned short)kd[e] << 16);
        }
        dg += __shfl_xor(dg, 32);
        m_run = dg - cK[qb * 128 + 32 * w + ql] - 1.0f;
    }
    float qbound = 0.f;
    if (TYPE == 0) {
        float q2 = 0.f;
#pragma unroll
        for (int ds = 0; ds < 4; ++ds)
#pragma unroll
            for (int e = 0; e < 8; ++e) { const float x = __uint_as_float((unsigned)(unsigned short)qf[ds][e] << 16); q2 += x * x; }
        q2 += __shfl_xor(q2, 32);
        const unsigned kb = __hip_atomic_load((unsigned*)(ws + WS_XBAR) + 32 + b * 8 + h, __ATOMIC_RELAXED, __HIP_MEMORY_SCOPE_AGENT);
        qbound = sqrtf(q2) * sqrtf(__uint_as_float(kb)) * 1.02f + 1.0f;
    }
    u32x4 kreg[2], vreg[2]; float creg = 0.f;
    const int srow = tid >> 3, spos = tid & 7;
    const int swz_st = (spos ^ ((srow >> 1) & 7)) << 4;
    const int swz = (lane >> 1) & 7;
    LAS unsigned* flags = (LAS unsigned*)(lds + 2 * AT_STAGE);
#define AT_LOAD(j) do { int krow0_, kidx0_; if (!meta_unit && (j) < nt - 1) { const int kt_ = nt - 2 - (j); krow0_ = b * SEQ + 64 * kt_; kidx0_ = 64 * kt_; } else { krow0_ = MX + 16 * b; kidx0_ = 8192; } \
        _Pragma("unroll") for (int i_ = 0; i_ < 2; ++i_) { \
            kreg[i_] = *(const u32x4*)(Kp + (size_t)(krow0_ + srow + 32 * i_) * 512 + h * 64 + spos * 8); \
            vreg[i_] = *(const u32x4*)(VT + (size_t)(srow + 32 * i_) * LPK + kidx0_ + spos * 8); } \
        if (TYPE == 0 && tid < 64) creg = cK[kidx0_ + tid]; } while (0)
#define AT_WRITE(s) do { _Pragma("unroll") for (int i_ = 0; i_ < 2; ++i_) { \
            *(LAS u32x4*)(lds + (s) * AT_STAGE + (srow + 32 * i_) * 128 + swz_st) = kreg[i_]; \
            *(LAS u32x4*)(lds + (s) * AT_STAGE + 8192 + (srow + 32 * i_) * 128 + swz_st) = vreg[i_]; } \
        if (TYPE == 0 && tid < 64) *(LAS float*)(lds + (s) * AT_STAGE + 16384 + tid * 4) = creg; } while (0)
    AT_LOAD(j0); AT_WRITE(j0 & 1);
    __syncthreads();
    for (int j = j0; j < j1; ++j) {
        const bool more = j + 1 < j1;
        if (more) AT_LOAD(j + 1);
        int klim, d0;
        if (meta_unit) { klim = 16; d0 = 0; }
        else if (j == nt - 1) { klim = 16; d0 = 1 << 20; }
        else { klim = 64; d0 = 128 * qb - 64 * (nt - 2 - j); if (d0 >= 64) d0 = 1 << 20; }
        const int limw = 32 * w + d0 - TYPE;
        bool wdone = false, nomax = false;
        if (TYPE == 0) {
            const float clast = *(const LAS float*)(lds + (j & 1) * AT_STAGE + 16384 + (klim - 1) * 4);
            wdone = __all((qbound - clast - m_run) < -126.0f) != 0;
            nomax = __all((qbound - clast) <= m_run) != 0;
        }
        if (limw + 31 >= 0 && !(TYPE == 0 && wdone)) {
            const LAS char* sb = lds + (j & 1) * AT_STAGE;
            int kmax = limw + ql; if (kmax > klim - 1) kmax = klim - 1;
            const bool needmask = (klim < 64) || (limw < 63);
            f32x16 S0, S1;
#pragma unroll
            for (int i = 0; i < 16; ++i) { S0[i] = 0.f; S1[i] = 0.f; }
#pragma unroll
            for (int ds = 0; ds < 4; ++ds) {
                const bf16x8 k0 = *(const LAS bf16x8*)(sb + ql * 128 + (((2 * ds + hi) ^ swz) << 4));
                const bf16x8 k1 = *(const LAS bf16x8*)(sb + (32 + ql) * 128 + (((2 * ds + hi) ^ swz) << 4));
                S0 = __builtin_amdgcn_mfma_f32_32x32x16_bf16(k0, qf[ds], S0, 0, 0, 0);
                S1 = __builtin_amdgcn_mfma_f32_32x32x16_bf16(k1, qf[ds], S1, 0, 0, 0);
            }
            if (TYPE == 0) {
#pragma unroll
                for (int g = 0; g < 4; ++g) {
                    const f32x4 c0 = *(const LAS f32x4*)(sb + 16384 + (8 * g + 4 * hi) * 4), c1 = *(const LAS f32x4*)(sb + 16384 + (32 + 8 * g + 4 * hi) * 4);
#pragma unroll
                    for (int i = 0; i < 4; ++i) { S0[4 * g + i] -= c0[i]; S1[4 * g + i] -= c1[i]; }
                }
                if (needmask) {
#pragma unroll
                    for (int r = 0; r < 16; ++r) { const int kl = (r & 3) + 8 * (r >> 2) + 4 * hi; if (kl > kmax) S0[r] = -INFINITY; if (kl + 32 > kmax) S1[r] = -INFINITY; }
                }
                if (!nomax) {
                    float mx = -INFINITY;
#pragma unroll
                    for (int r = 0; r < 16; ++r) mx = fmaxf(mx, fmaxf(S0[r], S1[r]));
                    mx = fmaxf(mx, __shfl_xor(mx, 32));
                    const float m_new = fmaxf(m_run, mx), alpha = ex2(m_run - m_new);
                    m_run = m_new;
                    lsum *= alpha;
#pragma unroll
                    for (int r = 0; r < 16; ++r) { O0[r] *= alpha; O1[r] *= alpha; }
                }
                float ps = 0.f;
#pragma unroll
                for (int r = 0; r < 16; ++r) { S0[r] = ex2(S0[r] - m_run); S1[r] = ex2(S1[r] - m_run); ps += S0[r] + S1[r]; }
                lsum += ps;
            } else {
                float G0[4], G1[4];
                f32x16 L0, L1;
#pragma unroll
                for (int r = 0; r < 16; ++r) {
                    const int kl = (r & 3) + 8 * (r >> 2) + 4 * hi;
                    const float z0 = S0[r], z1 = S1[r];
                    const float sp0 = fmaxf(z0, 0.f) + lg2(1.0f + ex2(-fabsf(z0) * LOG2E)) * LN2;
                    const float sp1 = fmaxf(z1, 0.f) + lg2(1.0f + ex2(-fabsf(z1) * LOG2E)) * LN2;
                    L0[r] = (!needmask || kl <= kmax) ? -sp0 : 0.f;
                    L1[r] = (!needmask || kl + 32 <= kmax) ? -sp1 : 0.f;
                }
#pragma unroll
                for (int g = 0; g < 4; ++g) {
                    L0[4 * g + 2] += L0[4 * g + 3]; L0[4 * g + 1] += L0[4 * g + 2]; L0[4 * g] += L0[4 * g + 1]; G0[g] = L0[4 * g];
                    L1[4 * g + 2] += L1[4 * g + 3]; L1[4 * g + 1] += L1[4 * g + 2]; L1[4 * g] += L1[4 * g + 1]; G1[g] = L1[4 * g];
                }
                float run = R;
#pragma unroll
                for (int g = 3; g >= 0; --g) {
                    const float gp = __shfl_xor(G1[g], 32);
                    const float off = hi ? run : run + gp;
#pragma unroll
                    for (int i = 0; i < 4; ++i) { const int r = 4 * g + i; const int kl = 32 + i + 8 * g + 4 * hi;
                        const float a = ex2((S1[r] + L1[r] + off) * LOG2E); S1[r] = (!needmask || kl <= kmax) ? a : 0.f; }
                    run += G1[g] + gp;
                }
#pragma unroll
                for (int g = 3; g >= 0; --g) {
                    const float gp = __shfl_xor(G0[g], 32);
                    const float off = hi ? run : run + gp;
#pragma unroll
                    for (int i = 0; i < 4; ++i) { const int r = 4 * g + i; const int kl = i + 8 * g + 4 * hi;
                        const float a = ex2((S0[r] + L0[r] + off) * LOG2E); S0[r] = (!needmask || kl <= kmax) ? a : 0.f; }
                    run += G0[g] + gp;
                }
                R = run;
                wdone = __all(R < -120.0f) != 0;
            }
#pragma unroll
            for (int ks = 0; ks < 4; ++ks) {
                bf16x8 pf; u32x4 pu;
                if (ks < 2) { pu = (u32x4){pk_bf16(S0[8 * ks + 0], S0[8 * ks + 1]), pk_bf16(S0[8 * ks + 2], S0[8 * ks + 3]), pk_bf16(S0[8 * ks + 4], S0[8 * ks + 5]), pk_bf16(S0[8 * ks + 6], S0[8 * ks + 7])}; }
                else { const int k2 = ks - 2; pu = (u32x4){pk_bf16(S1[8 * k2 + 0], S1[8 * k2 + 1]), pk_bf16(S1[8 * k2 + 2], S1[8 * k2 + 3]), pk_bf16(S1[8 * k2 + 4], S1[8 * k2 + 5]), pk_bf16(S1[8 * k2 + 6], S1[8 * k2 + 7])}; }
                pf = __builtin_bit_cast(bf16x8, pu);
                const bf16x8 v0 = *(const LAS bf16x8*)(sb + 8192 + ql * 128 + (((2 * ks + hi) ^ swz) << 4));
                const bf16x8 v1 = *(const LAS bf16x8*)(sb + 8192 + (32 + ql) * 128 + (((2 * ks + hi) ^ swz) << 4));
                O0 = __builtin_amdgcn_mfma_f32_32x32x16_bf16(v0, pf, O0, 0, 0, 0);
                O1 = __builtin_amdgcn_mfma_f32_32x32x16_bf16(v1, pf, O1, 0, 0, 0);
            }
        }
        if (more) AT_WRITE((j + 1) & 1);
        if (lane == 0) flags[(j & 1) * 4 + w] = wdone ? 1u : 0u;
        __syncthreads();
        { const LAS unsigned* fl = flags + (j & 1) * 4; const unsigned f = fl[0] & fl[1] & fl[2] & fl[3]; if (f) break; }
    }
    float inv = 1.0f;
    if (TYPE == 0) { const float l = lsum + __shfl_xor(lsum, 32); inv = 1.0f / l; }
    const bool qvalid = meta_unit ? (w == 0 && ql < 16) : true;
    if (TYPE == 0 && part != 0) {
        float* rec = p.out + ((size_t)((((63 - qb) * 16 + b * 8 + h) * 2 + (part - 1)) * 128 + 32 * w + ql)) * 68;
        const float l = lsum + __shfl_xor(lsum, 32);
#pragma unroll
        for (int g = 0; g < 4; ++g) {
            *(f32x4*)(rec + 8 * g + 4 * hi) = (f32x4){O0[4 * g], O0[4 * g + 1], O0[4 * g + 2], O0[4 * g + 3]};
            *(f32x4*)(rec + 32 + 8 * g + 4 * hi) = (f32x4){O1[4 * g], O1[4 * g + 1], O1[4 * g + 2], O1[4 * g + 3]};
        }
        if (hi == 0) { rec[64] = m_run; rec[65] = l; }
    } else if (qvalid) {
        bf16_t* op = Oo + (size_t)qrow * 512 + h * 64 + 4 * hi;
#pragma unroll
        for (int g = 0; g < 4; ++g) {
            *(u32x2*)(op + 8 * g) = (u32x2){pk_bf16(O0[4 * g] * inv, O0[4 * g + 1] * inv), pk_bf16(O0[4 * g + 2] * inv, O0[4 * g + 3] * inv)};
            *(u32x2*)(op + 32 + 8 * g) = (u32x2){pk_bf16(O1[4 * g] * inv, O1[4 * g + 1] * inv), pk_bf16(O1[4 * g + 2] * inv, O1[4 * g + 3] * inv)};
        }
    }
    __syncthreads();
#undef AT_LOAD
#undef AT_WRITE
}


__device__ __forceinline__ void phase_comb(const Params& p) {
    bf16_t* oa = (bf16_t*)(p.ws + WS_A);
    for (int it = blockIdx.x * NTHREADS + threadIdx.x; it < 512 * 128 * 16; it += gridDim.x * NTHREADS) {
        const int d4 = it & 15, row = (it >> 4) & 127, su = it >> 11;
        const float* ra = p.out + ((size_t)((su * 2) * 128 + row)) * 68; const float* rb = ra + (size_t)128 * 68;
        const float ma = ra[64], la = ra[65], mb = rb[64], lb = rb[65];
        const float m = fmaxf(ma, mb), wa = ex2(ma - m), wb = ex2(mb - m), inv = 1.0f / (la * wa + lb * wb);
        const f32x4 a = *(const f32x4*)(ra + d4 * 4), bq = *(const f32x4*)(rb + d4 * 4);
        const f32x4 o = (a * wa + bq * wb) * inv;
        const int qb = 63 - (su >> 4), bh = su & 15;
        *(u32x2*)(oa + (size_t)((bh >> 3) * SEQ + qb * 128 + row) * 512 + (bh & 7) * 64 + d4 * 4) = (u32x2){pk_bf16(o[0], o[1]), pk_bf16(o[2], o[3])};
    }
}
__device__ __forceinline__ void phase2(const Params& p, LAS char* lds) {
    unsigned* ctr = (unsigned*)(p.ws + WS_XBAR);
    LAS unsigned* shu = (LAS unsigned*)(lds + 2 * AT_STAGE + 64);
    constexpr int NU = 2560 + 32;
    for (;;) {
        if (threadIdx.x == 0) shu[0] = __hip_atomic_fetch_add(ctr, 1u, __ATOMIC_RELAXED, __HIP_MEMORY_SCOPE_AGENT);
        __syncthreads();
        const int u = (int)shu[0];
        __syncthreads();
        if (u >= NU) break;
        if (u < 1280) {
            const int pr = u / 80, r = u - pr * 80;
            if (r < 32) attn_unit<0>(lds, p, (r >> 1) >> 3, (r >> 1) & 7, 63 - 2 * pr, 1 + (r & 1));
            else if (r < 48) attn_unit<0>(lds, p, (r - 32) >> 3, (r - 32) & 7, 31 - pr);
            else { const int q = r - 48; attn_unit<0>(lds, p, (q >> 1) >> 3, (q >> 1) & 7, 62 - 2 * pr, 1 + (q & 1)); }
        }
        else if (u < 1536) { const int v = u - 1280; attn_unit<0>(lds, p, (v & 15) >> 3, v & 7, 15 - (v >> 4)); }
        else if (u < 2560) { const int v = u - 1536; attn_unit<1>(lds, p, (v & 15) >> 3, v & 7, 63 - (v >> 4)); }
        else if (u < 2576) { const int v = u - 2560; attn_unit<0>(lds, p, v >> 3, v & 7, -1); }
        else { const int v = u - 2576; attn_unit<1>(lds, p, v >> 3, v & 7, -1); }
    }
}

__device__ __forceinline__ void phase3a(const Params& p, LAS char* lds) {
    unsigned char* ws = p.ws;
    const int lane = threadIdx.x & 63, w = wave_id(), wr = w >> 1, wc = w & 1;
    const bf16_t* oa = (const bf16_t*)(ws + WS_A); const bf16_t* ob = oa + (size_t)M * 512;
    const bf16_t* ga = (const bf16_t*)(ws + WS_B); const bf16_t* gb = ga + (size_t)M * 1024;
    bf16_t* gated = (bf16_t*)(ws + WS_GATED);
    for (int it = 0;; ++it) {
        int tm, tn; int st = tile_at(it, 128, 8, tm, tn);
        if (st == 0) { if (it < (1 << 20) && (int)blockIdx.x < 8) { tm = 128; tn = blockIdx.x; it = 1 << 20; st = 1; } else break; }
        if (st == 2) continue;
        const int row0 = tm * 128, col0 = tn * 128; const int mlim = tm == 128 ? (wr == 0 ? 2 : 0) : 4;
        f32x4 acc[4][4]; zero_acc(acc);
        gemm_main<true>(lds, oa + (size_t)row0 * 512, 512, (const bf16_t*)(ws + WS_BTOF) + (size_t)col0 * 512, 512, 8, acc, mlim);
#pragma unroll
        for (int m = 0; m < 4; ++m) {
            const int row = row0 + wr * 64 + m * 16 + (lane & 15);
#pragma unroll
            for (int n = 0; n < 4; ++n) {
                const int col = col0 + wc * 64 + n * 16 + (lane >> 4) * 4;
                const u32x2 a = *(const u32x2*)(ga + (size_t)row * 1024 + col);
                const f32x4 x = acc[m][n];
                *(u32x2*)(gated + (size_t)row * 1024 + col) = (u32x2){pk_bf16(bf_lo(a[0]) * x[0], bf_hi(a[0]) * x[1]), pk_bf16(bf_lo(a[1]) * x[2], bf_hi(a[1]) * x[3])};
            }
        }
        zero_acc(acc);
        gemm_main<true>(lds, ob + (size_t)row0 * 512, 512, (const bf16_t*)(ws + WS_BTOS) + (size_t)col0 * 512, 512, 8, acc, mlim);
#pragma unroll
        for (int m = 0; m < 4; ++m) {
            const int row = row0 + wr * 64 + m * 16 + (lane & 15);
#pragma unroll
            for (int n = 0; n < 4; ++n) {
                const int col = col0 + wc * 64 + n * 16 + (lane >> 4) * 4;
                const u32x2 b = *(const u32x2*)(gb + (size_t)row * 1024 + col);
                const f32x4 y = acc[m][n]; const u32x2 q = *(const u32x2*)(gated + (size_t)row * 1024 + col);
                const float o0 = bf_lo(q[0]) + bf_lo(b[0]) * y[0], o1 = bf_hi(q[0]) + bf_hi(b[0]) * y[1];
                const float o2 = bf_lo(q[1]) + bf_lo(b[1]) * y[2], o3 = bf_hi(q[1]) + bf_hi(b[1]) * y[3];
                *(u32x2*)(gated + (size_t)row * 1024 + col) = (u32x2){pk_bf16(o0, o1), pk_bf16(o2, o3)};
            }
        }
    }
}
__device__ __forceinline__ void epi_store_ss(const f32x4 (&acc)[4][4], bf16_t* out, int ldo, int orow0, int col0, float* ssp, int ssrow0, int wr, int wc, int lane) {
#pragma unroll
    for (int m = 0; m < 4; ++m) {
        const int rl = wr * 64 + m * 16 + (lane & 15);
        float s = 0.f;
#pragma unroll
        for (int n = 0; n < 4; ++n) {
            const int col = col0 + wc * 64 + n * 16 + (lane >> 4) * 4;
            const f32x4 v = acc[m][n];
            s += v[0] * v[0] + v[1] * v[1] + v[2] * v[2] + v[3] * v[3];
            *(u32x2*)(out + (size_t)(orow0 + rl) * ldo + col) = (u32x2){pk_bf16(v[0], v[1]), pk_bf16(v[2], v[3])};
        }
#if 1
        s += __shfl_xor(s, 16); s += __shfl_xor(s, 32);
        if (lane < 16) ssp[(size_t)((col0 >> 7) * 2 + wc) * M + ssrow0 + rl] = s;
#endif
    }
}
__device__ __forceinline__ void phase3b(const Params& p, LAS char* lds) {
    unsigned char* ws = p.ws;
    const int lane = threadIdx.x & 63, w = wave_id(), wr = w >> 1, wc = w & 1;
    const bf16_t* gated = (const bf16_t*)(ws + WS_GATED); bf16_t* mixed = (bf16_t*)(ws + WS_MIXED);
    for (int it = 0;; ++it) {
        int tm, tn; int st = tile_at(it, 128, 8, tm, tn);
        if (st == 0) { if (it < (1 << 20) && (int)blockIdx.x < 8) { tm = 128; tn = blockIdx.x; it = 1 << 20; st = 1; } else break; }
        if (st == 2) continue;
        const int row0 = tm * 128, col0 = tn * 128; const int mlim = tm == 128 ? (wr == 0 ? 2 : 0) : 4;
        f32x4 acc[4][4]; zero_acc(acc);
        gemm_main<true>(lds, gated + (size_t)row0 * 1024, 1024, (const bf16_t*)(ws + WS_BTOUT) + (size_t)col0 * 1024, 1024, 16, acc, mlim);
        epi_store_ss(acc, mixed, 1024, row0, col0, (float*)(ws + WS_SSP2), row0, wr, wc, lane);
    }
}
__device__ __forceinline__ void phase3c(const Params& p) {
    unsigned char* ws = p.ws;
    const int lane = threadIdx.x & 63, w = wave_id();
    const bf16_t* mixed = (const bf16_t*)(ws + WS_MIXED); bf16_t* hb = (bf16_t*)(ws + WS_A);
    const float* ssp2 = (const float*)(ws + WS_SSP2); float* r2 = (float*)(ws + WS_R2);
    const float* g1 = p.gains + D;
    f32x4 g[4];
#pragma unroll
    for (int i = 0; i < 4; ++i) g[i] = *(const f32x4*)(g1 + lane * 4 + 256 * i);
    for (int grp = blockIdx.x; grp * 32 < MV; grp += gridDim.x) {
#pragma unroll 1
        for (int k = 0; k < 8; k += 2) {
            int r[2]; bool ok[2]; f32x4 v[2][4]; u32x2 mx[2][4]; float sq[2];
#pragma unroll
            for (int j = 0; j < 2; ++j) {
                r[j] = grp * 32 + w + 4 * (k + j); ok[j] = r[j] < MV; const int rr = ok[j] ? r[j] : 0;
                const float* src = rr < MX ? p.x + (size_t)rr * D : p.meta + (size_t)((rr - MX) & 15) * D;
                sq[j] = lane < 16 ? ssp2[(size_t)lane * M + rr] : 0.f;
#pragma unroll
                for (int i = 0; i < 4; ++i) { v[j][i] = __builtin_nontemporal_load((const f32x4*)(src + lane * 4 + 256 * i)); mx[j][i] = __builtin_nontemporal_load((const u32x2*)(mixed + (size_t)rr * D + lane * 4 + 256 * i)); }
            }
#pragma unroll
            for (int j = 0; j < 2; ++j) {
                const float a = 1.0f / sqrtf(wave_sum(sq[j]) * (1.0f / D) + EPS);
                float ss = 0.f;
#pragma unroll
                for (int i = 0; i < 4; ++i) {
                    const int col = lane * 4 + 256 * i;
                    f32x4 hh;
                    hh[0] = v[j][i][0] + bf_lo(mx[j][i][0]) * a * g[i][0]; hh[1] = v[j][i][1] + bf_hi(mx[j][i][0]) * a * g[i][1];
                    hh[2] = v[j][i][2] + bf_lo(mx[j][i][1]) * a * g[i][2]; hh[3] = v[j][i][3] + bf_hi(mx[j][i][1]) * a * g[i][3];
                    ss += hh[0] * hh[0] + hh[1] * hh[1] + hh[2] * hh[2] + hh[3] * hh[3];
                    if (ok[j]) {
                        *(u32x2*)(hb + (size_t)r[j] * D + col) = (u32x2){pk_bf16(hh[0], hh[1]), pk_bf16(hh[2], hh[3])};
                        if (r[j] < MX) __builtin_nontemporal_store(hh, (f32x4*)(p.out + (size_t)r[j] * D + col));
                    }
                }
                ss = wave_sum(ss);
                if (ok[j] && lane == 0) r2[r[j]] = 1.0f / sqrtf(ss * (1.0f / D) + EPS);
            }
        }
    }
}
constexpr int UST = 272;
__device__ __forceinline__ f32x4 unpack4(const u32x2 u) { return (f32x4){bf_lo(u[0]), bf_hi(u[0]), bf_lo(u[1]), bf_hi(u[1])}; }
struct ConvW { f32x4 w0g, w1g, w2g, bg, w0v, w1v, w2v, bv; };
__device__ __forceinline__ ConvW load_convw(const Params& p, int c) {
    ConvW q;
    q.w0g = *(const f32x4*)(p.conv_w + c); q.w1g = *(const f32x4*)(p.conv_w + NUP + c); q.w2g = *(const f32x4*)(p.conv_w + 2 * NUP + c); q.bg = *(const f32x4*)(p.conv_b + c);
    q.w0v = *(const f32x4*)(p.conv_w + DFF + c); q.w1v = *(const f32x4*)(p.conv_w + NUP + DFF + c); q.w2v = *(const f32x4*)(p.conv_w + 2 * NUP + DFF + c); q.bv = *(const f32x4*)(p.conv_b + DFF + c);
    return q;
}
__device__ __forceinline__ u32x2 conv_gelu4(const ConvW& q, const f32x4 g2, const f32x4 g1, const f32x4 g0, const f32x4 v2, const f32x4 v1, const f32x4 v0) {
    float o[4];
#pragma unroll
    for (int e = 0; e < 4; ++e) {
        const float ug = q.bg[e] + q.w0g[e] * g2[e] + q.w1g[e] * g1[e] + q.w2g[e] * g0[e];
        const float uv = q.bv[e] + q.w0v[e] * v2[e] + q.w1v[e] * v1[e] + q.w2v[e] * v0[e];
        const float t = 0.7978845608028654f * (ug + 0.044715f * ug * ug * ug);
        o[e] = ug * rcp(1.0f + ex2(-2.0f * LOG2E * t)) * uv;
    }
    return (u32x2){pk_bf16(o[0], o[1]), pk_bf16(o[2], o[3])};
}
__device__ __forceinline__ void phase4(const Params& p, LAS char* lds) {
    unsigned char* ws = p.ws;
    const int tid = threadIdx.x, lane = tid & 63, w = wave_id(), wr = w >> 1, wc = w & 1;
    const bf16_t* hb = (const bf16_t*)(ws + WS_A); const bf16_t* Bt = (const bf16_t*)(ws + WS_BTUP);
    const float* r2 = (const float*)(ws + WS_R2);
    bf16_t* act = (bf16_t*)(ws + WS_ACT); bf16_t* hal = (bf16_t*)(ws + WS_HAL);
    for (int it = 0;; ++it) {
        int tm, tn; int st = tile_at(it, 128, 44, tm, tn);
        if (st == 0) { if (it < (1 << 20) && (int)blockIdx.x < 44) { tm = 128; tn = blockIdx.x; it = 1 << 20; st = 1; } else break; }
        if (st == 2) continue;
        const bool mt = tm == 128; const int row0 = mt ? MX : tm * 128, col0 = tn * 128;
        f32x4 acc[4][4]; zero_acc(acc);
        gemm_main<true>(lds, hb + (size_t)row0 * D, D, Bt + (size_t)col0 * D, D, 16, acc, mt ? (wr == 0 ? 2 : 0) : 4);
#pragma unroll
        for (int m = 0; m < 4; ++m) {
            const int rl = wr * 64 + m * 16 + (lane & 15); const float rs = r2[row0 + rl];
#pragma unroll
            for (int n = 0; n < 4; ++n) {
                const int cl = wc * 64 + n * 16 + (lane >> 4) * 4; const f32x4 v = acc[m][n] * rs;
                *(LAS u32x2*)(lds + rl * UST + cl * 2) = (u32x2){pk_bf16(v[0], v[1]), pk_bf16(v[2], v[3])};
            }
        }
        __syncthreads();
        if (!mt) {
            const int cg = tid & 15, rb = tid >> 4, c = tn * 64 + cg * 4;
            const ConvW q = load_convw(p, c);
            const int hr = rb == 0 ? 0 : rb * 8 - 2;
            f32x4 g2 = unpack4(*(const LAS u32x2*)(lds + hr * UST + cg * 8)), v2 = unpack4(*(const LAS u32x2*)(lds + hr * UST + 128 + cg * 8));
            f32x4 g1 = unpack4(*(const LAS u32x2*)(lds + (hr + 1) * UST + cg * 8)), v1 = unpack4(*(const LAS u32x2*)(lds + (hr + 1) * UST + 128 + cg * 8));
            for (int r = hr + 2; r < rb * 8 + 8; ++r) {
                const f32x4 g0 = unpack4(*(const LAS u32x2*)(lds + r * UST + cg * 8)), v0 = unpack4(*(const LAS u32x2*)(lds + r * UST + 128 + cg * 8));
                *(u32x2*)(act + (size_t)(row0 + r) * DFF + c) = conv_gelu4(q, g2, g1, g0, v2, v1, v0);
                g2 = g1; g1 = g0; v2 = v1; v1 = v0;
            }
            if (tid < 64) { const int qq = tid >> 4, ch = tid & 15, rl = qq < 2 ? qq : 124 + qq;
                *(u32x4*)(hal + ((size_t)tm * 4 + qq) * NUP + col0 + ch * 8) = *(const LAS u32x4*)(lds + rl * UST + ch * 16); }
        } else {
            if (tid < 64) { const int qq = tid >> 4, ch = tid & 15, rl = (qq >> 1) * 16 + 14 + (qq & 1);
                *(u32x4*)(hal + ((size_t)(128 + (qq >> 1)) * 4 + 2 + (qq & 1)) * NUP + col0 + ch * 8) = *(const LAS u32x4*)(lds + rl * UST + ch * 16); }
        }
        __syncthreads();
    }
}
__device__ __forceinline__ void phase_fix(const Params& p) {
    unsigned char* ws = p.ws;
    const bf16_t* hal = (const bf16_t*)(ws + WS_HAL); bf16_t* act = (bf16_t*)(ws + WS_ACT);
    constexpr int NCG = DFF / 4;
    for (int it = blockIdx.x * NTHREADS + threadIdx.x; it < 128 * NCG; it += gridDim.x * NTHREADS) {
        const int tmg = it / NCG, c = (it % NCG) * 4, colg = (c >> 6) * 128 + (c & 63), colv = colg + 64;
        const bf16_t* own = hal + (size_t)tmg * 4 * NUP;
        const bf16_t* prv = hal + (size_t)((tmg & 63) ? tmg - 1 : 128 + (tmg >> 6)) * 4 * NUP;
        const ConvW q = load_convw(p, c);
        const f32x4 pg2 = unpack4(*(const u32x2*)(prv + 2 * NUP + colg)), pv2 = unpack4(*(const u32x2*)(prv + 2 * NUP + colv));
        const f32x4 pg3 = unpack4(*(const u32x2*)(prv + 3 * NUP + colg)), pv3 = unpack4(*(const u32x2*)(prv + 3 * NUP + colv));
        const f32x4 og0 = unpack4(*(const u32x2*)(own + colg)), ov0 = unpack4(*(const u32x2*)(own + colv));
        const f32x4 og1 = unpack4(*(const u32x2*)(own + NUP + colg)), ov1 = unpack4(*(const u32x2*)(own + NUP + colv));
        *(u32x2*)(act + (size_t)(tmg * 128) * DFF + c) = conv_gelu4(q, pg2, pg3, og0, pv2, pv3, ov0);
        *(u32x2*)(act + (size_t)(tmg * 128 + 1) * DFF + c) = conv_gelu4(q, pg3, og0, og1, pv3, ov0, ov1);
    }
}
__device__ __forceinline__ void phase6(const Params& p, LAS char* lds) {
    unsigned char* ws = p.ws;
    const int lane = threadIdx.x & 63, w = wave_id(), wr = w >> 1, wc = w & 1;
    const bf16_t* act = (const bf16_t*)(ws + WS_ACT); bf16_t* ffn = (bf16_t*)(ws + WS_FFN);
    for (int it = 0;; ++it) {
        int tm, tn; const int st = tile_at(it, 128, 8, tm, tn); if (st == 0) break; if (st == 2) continue;
        const int col0 = tn * 128;
        f32x4 acc[4][4]; zero_acc(acc);
        gemm_main<true>(lds, act + (size_t)(tm * 128) * DFF, DFF, (const bf16_t*)(ws + WS_BTDN) + (size_t)col0 * DFF, DFF, 44, acc);
        epi_store_ss(acc, ffn, 1024, tm * 128, col0, (float*)(ws + WS_SSP4), tm * 128, wr, wc, lane);
    }
}
__device__ __forceinline__ void phase7(const Params& p) {
    unsigned char* ws = p.ws;
    const int lane = threadIdx.x & 63, w = wave_id();
    const bf16_t* ffn = (const bf16_t*)(ws + WS_FFN); const float* ssp4 = (const float*)(ws + WS_SSP4); const float* g3 = p.gains + 3 * D;
    f32x4 g[4];
#pragma unroll
    for (int i = 0; i < 4; ++i) g[i] = *(const f32x4*)(g3 + lane * 4 + 256 * i);
    for (int r0 = (blockIdx.x * 4 + w) * 2; r0 < MX; r0 += gridDim.x * 8) {
        f32x4 hh[2][4]; u32x2 f[2][4]; float sq[2];
#pragma unroll
        for (int j = 0; j < 2; ++j) {
            const int row = r0 + j;
            sq[j] = lane < 16 ? ssp4[(size_t)lane * M + row] : 0.f;
#pragma unroll
            for (int i = 0; i < 4; ++i) { hh[j][i] = __builtin_nontemporal_load((const f32x4*)(p.out + (size_t)row * D + lane * 4 + 256 * i)); f[j][i] = __builtin_nontemporal_load((const u32x2*)(ffn + (size_t)row * D + lane * 4 + 256 * i)); }
        }
#pragma unroll
        for (int j = 0; j < 2; ++j) {
            const float a = 1.0f / sqrtf(wave_sum(sq[j]) * (1.0f / D) + EPS);
#pragma unroll
            for (int i = 0; i < 4; ++i) {
                f32x4 o;
                o[0] = hh[j][i][0] + bf_lo(f[j][i][0]) * a * g[i][0]; o[1] = hh[j][i][1] + bf_hi(f[j][i][0]) * a * g[i][1];
                o[2] = hh[j][i][2] + bf_lo(f[j][i][1]) * a * g[i][2]; o[3] = hh[j][i][3] + bf_hi(f[j][i][1]) * a * g[i][3];
                __builtin_nontemporal_store(o, (f32x4*)(p.out + (size_t)(r0 + j) * D + lane * 4 + 256 * i));
            }
        }
    }
}


#ifndef DUMP
#define DUMP 0
#endif
__device__ __forceinline__ void phase_dump(const Params& p) {
    unsigned char* ws = p.ws;
    const bf16_t* s0; const bf16_t* s1; int ld;
    if (DUMP == 1) { s0 = (const bf16_t*)(ws + WS_B); s1 = s0 + 512; ld = 1024; }
    else if (DUMP == 2) { s0 = (const bf16_t*)(ws + WS_QF); s1 = (const bf16_t*)(ws + WS_KF); ld = 512; }
    else if (DUMP == 3) { s0 = (const bf16_t*)(ws + WS_A); s1 = s0 + (size_t)M * 512; ld = 512; }
    else if (DUMP == 4) { s0 = (const bf16_t*)(ws + WS_GATED); s1 = s0 + 512; ld = 1024; }
    else if (DUMP == 8) { s0 = (const bf16_t*)(ws + WS_A); s1 = s0 + 512; ld = 1024; }
    else if (DUMP == 9) { s0 = (const bf16_t*)(ws + WS_ACT) + 1024; s1 = (const bf16_t*)(ws + WS_ACT) + 2304 - 512 + 512; ld = DFF; }
    else if (DUMP == 10) { s0 = (const bf16_t*)(ws + WS_FFN); s1 = s0 + 512; ld = 1024; }
    else if (DUMP == 6) { s0 = (const bf16_t*)(ws + WS_QS); s1 = (const bf16_t*)(ws + WS_KS); ld = 512; }
    else { s0 = (const bf16_t*)(ws + WS_MIXED); s1 = s0 + 512; ld = 1024; }
    for (int it = blockIdx.x * NTHREADS + threadIdx.x; it < MX * 1024; it += gridDim.x * NTHREADS) {
        const int row = it >> 10, col = it & 1023;
        if (DUMP >= 9 && row >= 8192) { p.out[it] = 0.f; continue; }
        const bf16_t v = col < 512 ? s0[(size_t)row * ld + col] : s1[(size_t)row * ld + col - 512];
        p.out[it] = __uint_as_float((unsigned)v << 16);
    }
}

__device__ __forceinline__ void l2_scrub(const Params& p) {
    const f32x4* src = (const f32x4*)p.x + (size_t)(blockIdx.x & 511) * 8192;
    f32x4 a = (f32x4){0.f, 0.f, 0.f, 0.f};
    for (int i = threadIdx.x; i < 8192; i += NTHREADS) a += src[i];
    if (a[0] + a[1] + a[2] + a[3] == 1.2345e-30f) ((float*)(p.ws + WS_CTL))[32 + (threadIdx.x & 7)] = a[0];
}


#define XB_TMO      128
#define XB_XCNT(j)  (256  + 64 * (j))
#define XB_XSUB(j)  (1280 + 64 * (j))
#define XB_XGEN(j)  (2304 + 64 * (j))
#define XB_TOP      3328
#define XB_TOPGEN   3392
#define XCD_BAR_WORDS 3456
#define XB_SPIN_CAP (1u << 18)
__device__ __forceinline__ unsigned xb_ld(unsigned* p)              { return __hip_atomic_load(p, __ATOMIC_RELAXED, __HIP_MEMORY_SCOPE_AGENT); }
__device__ __forceinline__ unsigned xb_add(unsigned* p, unsigned v) { return __hip_atomic_fetch_add(p, v, __ATOMIC_RELAXED, __HIP_MEMORY_SCOPE_AGENT); }
__device__ __forceinline__ unsigned xb_xcc_id() { return (unsigned)__builtin_amdgcn_s_getreg((3 << 11) | 20) & 0xFu; }
#define XB_SPIN(cond, bar) do { unsigned _sp = 0; while (cond) { __builtin_amdgcn_s_sleep(1); \
    if ((++_sp & 255u) == 0u) { if (xb_ld(&(bar)[XB_TMO])) break; if (_sp > XB_SPIN_CAP) { atomicAdd(&(bar)[XB_TMO], 1u); break; } } } } while (0)
struct XcdBarrier { unsigned* bar; unsigned x; volatile LAS unsigned* st; };
__device__ __forceinline__ XcdBarrier xcd_barrier_post(unsigned* bar, volatile LAS unsigned* st) {
    XcdBarrier b; b.bar = bar; b.x = xb_xcc_id(); b.st = st;
    if (threadIdx.x == 0) (void)xb_add(&bar[XB_XCNT(b.x)], 1u);
    return b;
}
__device__ __forceinline__ void xcd_barrier_complete(unsigned* bar, unsigned x, unsigned& nloc, unsigned& nx) {
    const unsigned G = gridDim.x * gridDim.y * gridDim.z;
    unsigned sum, cnt, mine, sp = 0u;
    for (;;) {
        sum = 0u; cnt = 0u; mine = 0u;
#pragma unroll
        for (unsigned j = 0; j < 16; ++j) { const unsigned c = xb_ld(&bar[XB_XCNT(j)]); sum += c; cnt += (c > 0u) ? 1u : 0u; mine = (j == x) ? c : mine; }
        if (sum == G) break;
        __builtin_amdgcn_s_sleep(1);
        if ((++sp & 255u) == 0u) { if (xb_ld(&bar[XB_TMO])) break; if (sp > XB_SPIN_CAP) { atomicAdd(&bar[XB_TMO], 1u); break; } }
    }
    nloc = mine > 0u ? mine : 1u; nx = cnt > 0u ? cnt : 1u;
}
__device__ __forceinline__ void xcd_barrier(const XcdBarrier& b) {
    asm volatile("s_waitcnt vmcnt(0)" ::: "memory");
    __syncthreads();
    if (threadIdx.x == 0) {
        unsigned* bar = b.bar;
        __builtin_amdgcn_s_waitcnt(0);
        unsigned nloc = b.st[0], nx = b.st[1];
        if (nloc == 0u) { xcd_barrier_complete(bar, b.x, nloc, nx); b.st[0] = nloc; b.st[1] = nx; }
        const unsigned old = xb_add(&bar[XB_XSUB(b.x)], 1u);
        const unsigned gen = old / nloc;
        if (old + 1u == (gen + 1u) * nloc) {
            __builtin_amdgcn_fence(__ATOMIC_RELEASE, "agent");
            asm volatile("s_waitcnt vmcnt(0)" ::: "memory");
            const unsigned og = xb_add(&bar[XB_TOP], 1u);
            const unsigned tg = og / nx;
            if (og + 1u == (tg + 1u) * nx) xb_add(&bar[XB_TOPGEN], 1u);
            else XB_SPIN(xb_ld(&bar[XB_TOPGEN]) == tg, bar);
            __builtin_amdgcn_fence(__ATOMIC_ACQUIRE, "agent");
            xb_add(&bar[XB_XGEN(b.x)], 1u);
            asm volatile("s_waitcnt vmcnt(0)" ::: "memory");
        } else {
            XB_SPIN(xb_ld(&bar[XB_XGEN(b.x)]) == gen, bar);
            __builtin_amdgcn_fence(__ATOMIC_ACQUIRE, "agent");
            asm volatile("s_waitcnt vmcnt(0)" ::: "memory");
        }
    }
    __syncthreads();
}

__device__ __forceinline__ void my_grid_sync(const Params& p, unsigned& target) {
    unsigned* bar = (unsigned*)(p.ws + WS_CTL) + 16;
    asm volatile("s_waitcnt vmcnt(0)" ::: "memory");
    __syncthreads();
    target += gridDim.x;
    if (threadIdx.x == 0) {
        __builtin_amdgcn_fence(__ATOMIC_RELEASE, "agent");
        asm volatile("s_waitcnt vmcnt(0)" ::: "memory");
        __hip_atomic_fetch_add(bar, 1u, __ATOMIC_RELAXED, __HIP_MEMORY_SCOPE_AGENT);
        while (__hip_atomic_load(bar, __ATOMIC_RELAXED, __HIP_MEMORY_SCOPE_AGENT) < target) __builtin_amdgcn_s_sleep(2);
        __builtin_amdgcn_fence(__ATOMIC_ACQUIRE, "agent");
        asm volatile("s_waitcnt vmcnt(0)" ::: "memory");
    }
    __syncthreads();
}
__global__ void __launch_bounds__(NTHREADS, 2) fwd_kernel(Params p) {
    extern __shared__ __attribute__((aligned(16))) unsigned char lds_raw[];
    LAS char* lds = (LAS char*)lds_raw;
    cg::grid_group grid = cg::this_grid();
#define IN(k) (p.ph_lo <= (k) && (k) < p.ph_hi)
#define SEAM(k) do { if (IN(k) && IN((k) + 1)) { if (p.ph_hi > 1000) grid.sync(); xcd_barrier(xbar); } } while (0)
    volatile LAS unsigned* xst = (volatile LAS unsigned*)(lds + 65536);
    if (threadIdx.x < 4) xst[threadIdx.x] = 0u;
    __syncthreads();
    const XcdBarrier xbar = xcd_barrier_post((unsigned*)(p.ws + WS_XBAR), xst);
    if (IN(0)) phase0(p, lds);
    SEAM(0);
    if (IN(1)) phase1(p, lds);
    SEAM(1);
    if (IN(2)) phase2(p, lds);
    SEAM(2);
    if (IN(3)) phase_comb(p);
    SEAM(3);
    if (IN(4)) phase3a(p, lds);
    SEAM(4);
    if (IN(5)) phase3b(p, lds);
    SEAM(5);
    if (IN(6)) phase3c(p);
    SEAM(6);
    if (IN(7)) phase4(p, lds);
    SEAM(7);
    if (IN(8)) phase_fix(p);
    SEAM(8);
    if (IN(9)) phase6(p, lds);
    SEAM(9);
    if (IN(10)) phase7(p);
#undef IN
#undef SEAM
}


__global__ void ab_save(const unsigned char* ws, float* out) {
    const u32x4* src = (const u32x4*)(ws + AB_SRC); u32x4* dst = (u32x4*)((unsigned char*)out + (size_t)32 * MiB);
    for (size_t i = blockIdx.x * (size_t)blockDim.x + threadIdx.x; i < (size_t)AB_BYTES / 16; i += (size_t)gridDim.x * blockDim.x) dst[i] = src[i];
}
__global__ void ab_diff(const unsigned char* ws, float* out) {
    const bf16_t* src = (const bf16_t*)(ws + AB_SRC); const bf16_t* sav = (const bf16_t*)((unsigned char*)out + (size_t)32 * MiB);
    for (size_t i = blockIdx.x * (size_t)blockDim.x + threadIdx.x; i < (size_t)8192 * 1024; i += (size_t)gridDim.x * blockDim.x) {
        if (i >= (size_t)AB_BYTES / 2) { out[i] = 0.f; continue; }
        out[i] = src[i] != sav[i] ? 1000.0f : 0.f;
    }
}
__global__ void ab_zero(float* out) {
    for (size_t i = blockIdx.x * (size_t)blockDim.x + threadIdx.x; i < (size_t)8192 * 1024; i += (size_t)gridDim.x * blockDim.x) out[(size_t)8192 * 1024 + i] = 0.f;
}
extern "C" void kernel_launch(void* const* d_in, const int* in_sizes, int n_in, void* d_out, int out_size, void* d_ws, size_t ws_size, hipStream_t stream) {
    static int grid_blocks = 0;
    if (grid_blocks == 0) {
        if (n_in != 12 || ws_size < WS_END) { fprintf(stderr, "kernel_launch: unexpected n_in %d or ws_size %zu (need %zu)\n", n_in, ws_size, (size_t)WS_END); grid_blocks = -1; return; }
        int dev = 0, cus = 0, per_cu = 0;
        (void)hipGetDevice(&dev);
        (void)hipDeviceGetAttribute(&cus, hipDeviceAttributeMultiprocessorCount, dev);
        (void)hipFuncSetAttribute((const void*)fwd_kernel, hipFuncAttributeMaxDynamicSharedMemorySize, LDS_BYTES);
        (void)hipOccupancyMaxActiveBlocksPerMultiprocessor(&per_cu, (const void*)fwd_kernel, NTHREADS, LDS_BYTES);
        if (per_cu < 1) per_cu = 1;
        if (per_cu > 2) per_cu = 2;
        grid_blocks = cus * per_cu;
        (void)hipGetLastError();
    }
    if (grid_blocks < 0) return;
    Params p{};
    p.x = (const float*)d_in[0]; p.meta = (const float*)d_in[1]; p.gains = (const float*)d_in[2]; p.w_in = (const float*)d_in[3];
    p.b_forget = (const float*)d_in[4]; p.w_o_fox = (const float*)d_in[5]; p.w_o_sb = (const float*)d_in[6]; p.w_out = (const float*)d_in[7];
    p.w_up = (const float*)d_in[8]; p.conv_w = (const float*)d_in[9]; p.conv_b = (const float*)d_in[10]; p.w_down = (const float*)d_in[11];
    p.out = (float*)d_out; p.ws = (unsigned char*)d_ws;
#if SINGLE_LAUNCH
    (void)hipMemsetAsync((unsigned char*)d_ws + WS_XBAR, 0, XCD_BAR_WORDS * 4, stream);
    p.ph_lo = 0; p.ph_hi = NPHASE;
    void* args[] = {&p};
    hipError_t e = hipLaunchCooperativeKernel((const void*)fwd_kernel, dim3(grid_blocks), dim3(NTHREADS), args, LDS_BYTES, stream);
    if (e != hipSuccess) fprintf(stderr, "cooperative launch failed: %s (grid %d)\n", hipGetErrorString(e), grid_blocks);
#else
#ifndef STOP_AT
#define STOP_AT NPHASE
#endif
    for (int k = 0; k < STOP_AT; ++k) {
        p.ph_lo = k; p.ph_hi = k + 1;
        hipLaunchKernelGGL(fwd_kernel, dim3(grid_blocks), dim3(NTHREADS), LDS_BYTES, stream, p);
    }
#if ABTEST
    ab_save<<<1024, 256, 0, stream>>>(p.ws, p.out);
    for (int k = AB_FROM; k < STOP_AT; ++k) {
        p.ph_lo = k; p.ph_hi = k + 1;
        hipLaunchKernelGGL(fwd_kernel, dim3(grid_blocks), dim3(NTHREADS), LDS_BYTES, stream, p);
    }
    ab_diff<<<1024, 256, 0, stream>>>(p.ws, p.out);
    ab_zero<<<1024, 256, 0, stream>>>(p.out);
#endif

#endif
}
```

```cpp
#include <hip/hip_runtime.h>
#include <hip/hip_cooperative_groups.h>
#include <cstdio>
#include <cstdint>
namespace cg = cooperative_groups;

#define DUMP 0
#define ABTEST 0
#define AB_FROM 0
#define AB_SRC WS_SSP2
#define AB_BYTES (2 * MiB)
#ifndef SINGLE_LAUNCH
#define SINGLE_LAUNCH 1
#endif

#define LAS __attribute__((address_space(3)))
typedef unsigned short bf16_t;
typedef short bf16x8 __attribute__((ext_vector_type(8)));
typedef float f32x4 __attribute__((ext_vector_type(4)));
typedef float f32x16 __attribute__((ext_vector_type(16)));
typedef unsigned u32x4 __attribute__((ext_vector_type(4)));
typedef unsigned u32x2 __attribute__((ext_vector_type(2)));

constexpr int D = 1024, SEQ = 8192, NMETA = 16, NB = 2;
constexpr int MX = NB * SEQ;
constexpr int MV = MX + NB * NMETA;
constexpr int M = 16512;
constexpr int LPK = 8256;
constexpr int PROJW = 5128, NPROJ = 5120, DFF = 2816, NUP = 5632;
constexpr float EPS = 1e-6f;
constexpr float LOG2E = 1.4426950408889634f, LN2 = 0.6931471805599453f;
constexpr int NTHREADS = 256;
constexpr int LDS_BYTES = 65536 + 16;
constexpr int NPHASE = 11;

constexpr size_t MiB = 1u << 20;
constexpr size_t WS_CTL = 0;
constexpr size_t WS_R1 = 4096, WS_R2 = WS_R1 + 69632, WS_SS2 = WS_R2 + 69632, WS_SS4 = WS_SS2 + 69632;
constexpr size_t WS_LOGF = WS_SS4 + 69632, WS_CK = WS_LOGF + 528384, WS_UPMETA = WS_CK + 528384;
constexpr size_t WS_BTIN = 2 * MiB, WS_BTOF = WS_BTIN + 10 * MiB, WS_BTOS = WS_BTOF + 1 * MiB, WS_BTOUT = WS_BTOS + 1 * MiB,
                 WS_BTUP = WS_BTOUT + 2 * MiB, WS_BTDN = WS_BTUP + 11 * MiB;
constexpr size_t SZ_M1024 = (size_t)M * 1024 * 2, SZ_M512 = (size_t)M * 512 * 2;
constexpr size_t WS_A = 33 * MiB;
constexpr size_t WS_B = WS_A + SZ_M1024;
constexpr size_t WS_C = WS_B + 2 * SZ_M1024;
constexpr size_t WS_QF = WS_C, WS_KF = WS_QF + SZ_M512, WS_QS = WS_KF + SZ_M512, WS_KS = WS_QS + SZ_M512, WS_VFT = WS_KS + SZ_M512, WS_VST = WS_VFT + SZ_M512;
constexpr size_t WS_GATED = WS_C, WS_MIXED = WS_B + SZ_M1024;
constexpr size_t WS_ACT = WS_B;
constexpr size_t WS_FFN = WS_ACT + 132 * MiB;
constexpr size_t WS_SSP2 = 230 * MiB, WS_SSP4 = 232 * MiB;
constexpr size_t WS_HAL = 234 * MiB;
constexpr size_t WS_XBAR = 240 * MiB;
constexpr size_t WS_END = 241 * MiB;

struct Params {
    const float *x, *meta, *gains, *w_in, *b_forget, *w_o_fox, *w_o_sb, *w_out, *w_up, *conv_w, *conv_b, *w_down;
    float* out; unsigned char* ws; int ph_lo, ph_hi;
};

typedef __bf16 bf16x2_t __attribute__((ext_vector_type(2)));
__device__ __forceinline__ unsigned pk_bf16(float lo, float hi) { bf16x2_t v = {(__bf16)lo, (__bf16)hi}; return __builtin_bit_cast(unsigned, v); }
__device__ __forceinline__ float bf_lo(unsigned u) { return __uint_as_float(u << 16); }
__device__ __forceinline__ float bf_hi(unsigned u) { return __uint_as_float(u & 0xffff0000u); }
__device__ __forceinline__ float ex2(float x) { return __builtin_amdgcn_exp2f(x); }
__device__ __forceinline__ float lg2(float x) { return __builtin_amdgcn_logf(x); }
__device__ __forceinline__ float rcp(float x) { return __builtin_amdgcn_rcpf(x); }
__device__ __forceinline__ float sigmoidf_(float v) { return rcp(1.0f + ex2(-v * LOG2E)); }
__device__ __forceinline__ float wave_sum(float v) {
#pragma unroll
    for (int o = 32; o > 0; o >>= 1) v += __shfl_xor(v, o);
    return v;
}
__device__ __forceinline__ int wave_id() { return __builtin_amdgcn_readfirstlane((int)(threadIdx.x >> 6)); }

__device__ __forceinline__ void transpose_tile(LAS char* lds, const float* src, int ldsrc, int srccol, int k0, const float* gain, bf16_t* dst, int K, int n0) {
    LAS bf16_t* T = (LAS bf16_t*)lds;
    const int tid = threadIdx.x, r = tid >> 4, c4 = tid & 15;
#pragma unroll
    for (int p = 0; p < 4; ++p) {
        const int k = r + 16 * p;
        f32x4 v = *(const f32x4*)(src + (size_t)(k0 + k) * ldsrc + srccol + c4 * 4);
        const float g = gain ? gain[k0 + k] : 1.0f;
        const unsigned a = pk_bf16(v[0] * g, v[1] * g), b = pk_bf16(v[2] * g, v[3] * g);
        T[(c4 * 4 + 0) * 72 + k] = (bf16_t)(a & 0xffff); T[(c4 * 4 + 1) * 72 + k] = (bf16_t)(a >> 16);
        T[(c4 * 4 + 2) * 72 + k] = (bf16_t)(b & 0xffff); T[(c4 * 4 + 3) * 72 + k] = (bf16_t)(b >> 16);
    }
    __syncthreads();
    const int n = tid >> 2, kq = tid & 3;
    const u32x4 lo = *(LAS u32x4*)(T + n * 72 + kq * 16), hi = *(LAS u32x4*)(T + n * 72 + kq * 16 + 8);
    bf16_t* d = dst + (size_t)(n0 + n) * K + k0 + kq * 16;
    *(u32x4*)d = lo; *(u32x4*)(d + 8) = hi;
    __syncthreads();
}

__device__ __forceinline__ void phase0(const Params& p, LAS char* lds) {
    unsigned char* ws = p.ws;
    const int tid = threadIdx.x, lane = tid & 63, w = wave_id();
    LAS float* wfT = (LAS float*)lds;
    const float* g0 = p.gains;
    for (int idx = tid; idx < 8192; idx += NTHREADS) { const int h = idx & 7, k = idx >> 3; wfT[h * 1024 + k] = p.w_in[(size_t)k * PROJW + 1536 + h] * g0[k]; }
    __syncthreads();
    bf16_t* xb = (bf16_t*)(ws + WS_A);
    float* r1 = (float*)(ws + WS_R1);
    float* logf_ = (float*)(ws + WS_LOGF);
    for (int grp = blockIdx.x; grp * 32 < M; grp += gridDim.x) {
#pragma unroll 1
        for (int k = 0; k < 8; k += 2) {
            int r[2]; f32x4 v[2][4];
#pragma unroll
            for (int j = 0; j < 2; ++j) {
                r[j] = grp * 32 + w + 4 * (k + j);
                const int rr = r[j] < MV ? r[j] : 0;
                const float* src = rr < MX ? p.x + (size_t)rr * D : p.meta + (size_t)((rr - MX) & 15) * D;
#pragma unroll
                for (int i = 0; i < 4; ++i) v[j][i] = __builtin_nontemporal_load((const f32x4*)(src + lane * 4 + 256 * i));
            }
#pragma unroll
            for (int j = 0; j < 2; ++j) {
                const int rw = r[j];
                if (rw >= MV) {
#pragma unroll
                    for (int i = 0; i < 4; ++i) *(u32x2*)(xb + (size_t)rw * D + lane * 4 + 256 * i) = (u32x2){0u, 0u};
                    if (lane == 0) r1[rw] = 0.f;
                    continue;
                }
                float ss = 0.f;
#pragma unroll
                for (int i = 0; i < 4; ++i) {
                    ss += v[j][i][0] * v[j][i][0] + v[j][i][1] * v[j][i][1] + v[j][i][2] * v[j][i][2] + v[j][i][3] * v[j][i][3];
                    *(u32x2*)(xb + (size_t)rw * D + lane * 4 + 256 * i) = (u32x2){pk_bf16(v[j][i][0], v[j][i][1]), pk_bf16(v[j][i][2], v[j][i][3])};
                }
                ss = wave_sum(ss);
                const float rs = 1.0f / sqrtf(ss * (1.0f / D) + EPS);
                if (lane == 0) r1[rw] = rs;
                float mine = 0.f;
#pragma unroll
                for (int h = 0; h < 8; ++h) {
                    float acc_ = 0.f;
#pragma unroll
                    for (int i = 0; i < 4; ++i) { const f32x4 wv = *(LAS f32x4*)(wfT + h * 1024 + lane * 4 + 256 * i); acc_ += v[j][i][0] * wv[0] + v[j][i][1] * wv[1] + v[j][i][2] * wv[2] + v[j][i][3] * wv[3]; }
                    acc_ = wave_sum(acc_);
                    if (lane == h) mine = acc_;
                }
                if (lane < 8) {
                    const float f = mine * rs + p.b_forget[lane];
                    const float lf = fminf(f, 0.f) - log1pf(expf(-fabsf(f)));
                    int bb, kidx; if (rw < MX) { bb = rw >> 13; kidx = rw & 8191; } else { const int jj = rw - MX; bb = jj >> 4; kidx = 8192 + (jj & 15); }
                    logf_[(size_t)(bb * 8 + lane) * LPK + kidx] = lf;
                }
            }
        }
    }
    __syncthreads();
    LAS char* tl = lds + 32768;
    const float* g2 = p.gains + 2 * D;
    constexpr int T_IN = 16 * 80, T_OF = 8 * 16, T_OS = 8 * 16, T_OUT = 16 * 16, T_UP = 16 * 88, T_DN = 44 * 16;
    constexpr int T_ALL = T_IN + T_OF + T_OS + T_OUT + T_UP + T_DN;
    for (int t = blockIdx.x; t < T_ALL; t += gridDim.x) {
        int u = t;
        if (u < T_IN) { const int nt = u % 80, kt = u / 80; const int sc = nt * 64 + (nt * 64 >= 1536 ? 8 : 0); transpose_tile(tl, p.w_in, PROJW, sc, kt * 64, g0, (bf16_t*)(ws + WS_BTIN), 1024, nt * 64); continue; }
        u -= T_IN;
        if (u < T_OF) { const int nt = u % 16, kt = u / 16; transpose_tile(tl, p.w_o_fox, 1024, nt * 64, kt * 64, nullptr, (bf16_t*)(ws + WS_BTOF), 512, nt * 64); continue; }
        u -= T_OF;
        if (u < T_OS) { const int nt = u % 16, kt = u / 16; transpose_tile(tl, p.w_o_sb, 1024, nt * 64, kt * 64, nullptr, (bf16_t*)(ws + WS_BTOS), 512, nt * 64); continue; }
        u -= T_OS;
        if (u < T_OUT) { const int nt = u % 16, kt = u / 16; transpose_tile(tl, p.w_out, 1024, nt * 64, kt * 64, nullptr, (bf16_t*)(ws + WS_BTOUT), 1024, nt * 64); continue; }
        u -= T_OUT;
        if (u < T_UP) { const int nt = u % 88, kt = u / 88; transpose_tile(tl, p.w_up, NUP, (nt & 1) * DFF + (nt >> 1) * 64, kt * 64, g2, (bf16_t*)(ws + WS_BTUP), 1024, nt * 64); continue; }
        u -= T_UP;
        { const int nt = u % 16, kt = u / 16; transpose_tile(tl, p.w_down, 1024, nt * 64, kt * 64, nullptr, (bf16_t*)(ws + WS_BTDN), DFF, nt * 64); }
    }
}

template <bool SWAP, bool FULL>
__device__ __forceinline__ void gemm_kloop(LAS char* lds, const bf16_t* Ag, int lda, const bf16_t* Bg, int ldb, int nk, f32x4 (&acc)[4][4], int mlim) {
    const int tid = threadIdx.x, lane = tid & 63, w = wave_id(), wr = w >> 1, wc = w & 1;
    const int row_0 = w * 8 + (lane >> 3), c_0 = (lane & 7) ^ ((row_0 >> 1) & 7);
    const bf16_t* pa0 = Ag + (size_t)row_0 * lda + c_0 * 8; const bf16_t* pb0 = Bg + (size_t)row_0 * ldb + c_0 * 8;
    const size_t sa = (size_t)32 * lda, sb_ = (size_t)32 * ldb;
    const int swz = (lane >> 1) & 7;
    int aoff[2], boff[2];
#pragma unroll
    for (int kh = 0; kh < 2; ++kh) {
        aoff[kh] = (wr * 64 + (lane & 15)) * 128 + (((kh * 4 + (lane >> 4)) ^ swz) << 4);
        boff[kh] = 16384 + (wc * 64 + (lane & 15)) * 128 + (((kh * 4 + (lane >> 4)) ^ swz) << 4);
    }
#define GM_STAGE(s, kt) do { _Pragma("unroll") for (int i_ = 0; i_ < 4; ++i_) { \
        __builtin_amdgcn_global_load_lds((const unsigned*)(pa0 + i_ * sa + (kt) * 64), (LAS unsigned*)(lds + (s) * 32768 + (i_ * 4 + w) * 1024), 16, 0, 0); \
        __builtin_amdgcn_global_load_lds((const unsigned*)(pb0 + i_ * sb_ + (kt) * 64), (LAS unsigned*)(lds + (s) * 32768 + 16384 + (i_ * 4 + w) * 1024), 16, 0, 0); } } while (0)
    GM_STAGE(0, 0);
    for (int kt = 0; kt < nk; ++kt) {
        asm volatile("s_waitcnt vmcnt(0)" ::: "memory");
        __syncthreads();
        const int s = kt & 1;
        if (kt + 1 < nk) GM_STAGE(s ^ 1, kt + 1);
        bf16x8 af[4][2], bf[4][2];
#pragma unroll
        for (int kh = 0; kh < 2; ++kh) {
#pragma unroll
            for (int m = 0; m < 4; ++m) if (FULL || m < mlim) af[m][kh] = *(LAS bf16x8*)(lds + s * 32768 + aoff[kh] + m * 2048);
#pragma unroll
            for (int n = 0; n < 4; ++n) bf[n][kh] = *(LAS bf16x8*)(lds + s * 32768 + boff[kh] + n * 2048);
        }
        __builtin_amdgcn_s_setprio(1);
#pragma unroll
        for (int kh = 0; kh < 2; ++kh)
#pragma unroll
            for (int m = 0; m < 4; ++m) if (FULL || m < mlim) {
#pragma unroll
                for (int n = 0; n < 4; ++n)
                    acc[m][n] = SWAP ? __builtin_amdgcn_mfma_f32_16x16x32_bf16(bf[n][kh], af[m][kh], acc[m][n], 0, 0, 0)
                                     : __builtin_amdgcn_mfma_f32_16x16x32_bf16(af[m][kh], bf[n][kh], acc[m][n], 0, 0, 0);
            }
        __builtin_amdgcn_s_setprio(0);
    }
    __syncthreads();
#undef GM_STAGE
}
template <bool SWAP>
__device__ __forceinline__ void gemm_main(LAS char* lds, const bf16_t* Ag, int lda, const bf16_t* Bg, int ldb, int nk, f32x4 (&acc)[4][4], int mlim = 4) {
    if (mlim == 4) gemm_kloop<SWAP, true>(lds, Ag, lda, Bg, ldb, nk, acc, 4);
    else gemm_kloop<SWAP, false>(lds, Ag, lda, Bg, ldb, nk, acc, mlim);
}
__device__ __forceinline__ void zero_acc(f32x4 (&acc)[4][4]) {
#pragma unroll
    for (int m = 0; m < 4; ++m)
#pragma unroll
        for (int n = 0; n < 4; ++n) acc[m][n] = (f32x4){0.f, 0.f, 0.f, 0.f};
}


__device__ __forceinline__ int tile_at(int it, int ntm, int ntn, int& tm, int& tn) {
    const int G = gridDim.x;
    if (G % 256 != 0) { const int t = it * G + blockIdx.x; if (t >= ntm * ntn) return 0; tm = t / ntn; tn = t % ntn; return 1; }
    const int xcd = blockIdx.x & 7, j = blockIdx.x >> 3, ppx = G >> 8;
    const int pcols = (ntn + 3) >> 2, prows = (ntm + 7) >> 3;
    const int patch = (it * ppx + (j >> 5)) * 8 + xcd;
    if (patch >= prows * pcols) return 0;
    const int wi = j & 31;
    tm = (patch / pcols) * 8 + (wi >> 2); tn = (patch % pcols) * 4 + (wi & 3);
    return (tm < ntm && tn < ntn) ? 1 : 2;
}
__device__ __forceinline__ void cumsum_block(const Params& p, LAS char* lds, int bh) {
    const float* lf = (const float*)(p.ws + WS_LOGF) + (size_t)bh * LPK; float* ck = (float*)(p.ws + WS_CK) + (size_t)bh * LPK;
    LAS float* wsum = (LAS float*)lds;
    const int tid = threadIdx.x, lane = tid & 63, w = wave_id(); constexpr int PER = 33, L = SEQ + NMETA;
    float v[PER];
#pragma unroll
    for (int e = 0; e < PER; ++e) { const int t = e * NTHREADS + tid; const int tc = t < L ? t : L - 1; const float x = lf[tc < 16 ? 8192 + tc : tc - 16]; v[e] = t < L ? x : 0.f; }
    float carry = 0.f;
#pragma unroll
    for (int e = 0; e < PER; ++e) {
        float x = v[e];
#pragma unroll
        for (int o = 1; o < 64; o <<= 1) { const float y = __shfl_up(x, o); if (lane >= o) x += y; }
        if (lane == 63) wsum[(e & 1) * 4 + w] = x;
        __syncthreads();
        const float s0 = wsum[(e & 1) * 4 + 0], s1 = wsum[(e & 1) * 4 + 1], s2 = wsum[(e & 1) * 4 + 2], s3 = wsum[(e & 1) * 4 + 3];
        const float pre = (w > 0 ? s0 : 0.f) + (w > 1 ? s1 : 0.f) + (w > 2 ? s2 : 0.f);
        const int t = e * NTHREADS + tid;
        if (t < L) ck[t < 16 ? 8192 + t : t - 16] = (carry + pre + x) * LOG2E;
        carry += (s0 + s1) + (s2 + s3);
    }
    __syncthreads();
}

__device__ __forceinline__ void phase1(const Params& p, LAS char* lds) {
    unsigned char* ws = p.ws;
    if ((int)blockIdx.x >= (int)gridDim.x - 16) cumsum_block(p, lds, gridDim.x - 1 - blockIdx.x);
    const int lane = threadIdx.x & 63, w = wave_id(), wr = w >> 1, wc = w & 1;
    const bf16_t* xb = (const bf16_t*)(ws + WS_A); const bf16_t* Bt = (const bf16_t*)(ws + WS_BTIN);
    const float* r1 = (const float*)(ws + WS_R1);
    constexpr int NTN = 40, NTM = 129;
    for (int it = 0;; ++it) {
        int tm, tn; int st = tile_at(it, NTM - 1, NTN, tm, tn);
        if (st == 0) { if (it < (1 << 20) && (int)blockIdx.x < NTN) { tm = NTM - 1; tn = blockIdx.x; it = 1 << 20; st = 1; } else break; }
        if (st == 2) continue;
        const int row0 = tm * 128, col0 = tn * 128; const int mlim = tm == NTM - 1 ? (wr == 0 ? 2 : 0) : 4;
        const bool vtile = (tn >= 8 && tn < 12) || (tn >= 20 && tn < 24);
        f32x4 acc[4][4]; zero_acc(acc);
        if (vtile) {
            gemm_main<false>(lds, xb + (size_t)row0 * D, D, Bt + (size_t)col0 * D, D, 16, acc, mlim);
            bf16_t* vT = (bf16_t*)(ws + (tn < 12 ? WS_VFT : WS_VST)); const int cb = tn < 12 ? 1024 : 2560;
            const int g = lane >> 4, gp = ((g & 1) << 1) | (g >> 1);
#pragma unroll
            for (int m = 0; m < 4; ++m) {
                const int rb = row0 + wr * 64 + m * 16; int b, kb16;
                if (rb < MX) { b = rb >> 13; kb16 = rb & 8191; } else { const int j = rb - MX; if (j >= 32) continue; b = j >> 4; kb16 = 8192; }
                const f32x4 rs = *(const f32x4*)(r1 + rb + g * 4);
#pragma unroll
                for (int n = 0; n < 4; ++n) {
                    const int dc = col0 + wc * 64 + n * 16 + (lane & 15) - cb, h = dc >> 6, d = dc & 63;
                    const f32x4 v = acc[m][n] * rs;
                    *(u32x2*)(vT + ((size_t)(b * 8 + h) * 64 + d) * LPK + kb16 + gp * 4) = (u32x2){pk_bf16(v[0], v[1]), pk_bf16(v[2], v[3])};
                }
            }
        } else {
            gemm_main<true>(lds, xb + (size_t)row0 * D, D, Bt + (size_t)col0 * D, D, 16, acc, mlim);
            bf16_t* dst; int ld, cb; float sc = 1.f; bool sg = false;
            if (tn < 4) { dst = (bf16_t*)(ws + WS_QF); ld = 512; cb = 0; sc = 0.125f * LOG2E; }
            else if (tn < 8) { dst = (bf16_t*)(ws + WS_KF); ld = 512; cb = 512; }
            else if (tn < 16) { dst = (bf16_t*)(ws + WS_QS); ld = 512; cb = 1536; sc = 0.125f; }
            else if (tn < 20) { dst = (bf16_t*)(ws + WS_KS); ld = 512; cb = 2048; }
            else if (tn < 32) { dst = (bf16_t*)(ws + WS_B); ld = 1024; cb = 3072; sg = true; }
            else { dst = (bf16_t*)(ws + WS_B + SZ_M1024); ld = 1024; cb = 4096; sg = true; }
            const bool kfox = tn >= 4 && tn < 8;
            float wmax = 0.f;
#pragma unroll
            for (int m = 0; m < 4; ++m) {
                const int row = row0 + wr * 64 + m * 16 + (lane & 15); const float rs = r1[row] * sc;
                float s2 = 0.f;
#pragma unroll
                for (int n = 0; n < 4; ++n) {
                    const int col = col0 + wc * 64 + n * 16 + (lane >> 4) * 4 - cb;
                    f32x4 v = acc[m][n] * rs;
                    if (sg) { v[0] = sigmoidf_(v[0]); v[1] = sigmoidf_(v[1]); v[2] = sigmoidf_(v[2]); v[3] = sigmoidf_(v[3]); }
                    s2 += v[0] * v[0] + v[1] * v[1] + v[2] * v[2] + v[3] * v[3];
                    *(u32x2*)(dst + (size_t)row * ld + col) = (u32x2){pk_bf16(v[0], v[1]), pk_bf16(v[2], v[3])};
                }
                if (kfox) { s2 += __shfl_xor(s2, 16); s2 += __shfl_xor(s2, 32); wmax = fmaxf(wmax, s2); }
            }
            if (kfox) {
#pragma unroll
                for (int o = 1; o < 16; o <<= 1) wmax = fmaxf(wmax, __shfl_xor(wmax, o));
                if (lane == 0) {
                    unsigned* km = (unsigned*)(ws + WS_XBAR) + 32; const int head = (tn - 4) * 2 + wc; const unsigned bits = __float_as_uint(wmax);
                    if (row0 < MX) atomicMax(km + (row0 >> 13) * 8 + head, bits);
                    else { atomicMax(km + head, bits); atomicMax(km + 8 + head, bits); }
                }
            }
        }
    }
}

constexpr int AT_STAGE = 16640;
template <int TYPE>
__device__ __forceinline__ void attn_unit(LAS char* lds, const Params& p, int b, int h, int qb, int part = 0) {
    unsigned char* ws = p.ws;
    const int tid = threadIdx.x, lane = tid & 63, w = wave_id(), ql = lane & 31, hi = lane >> 5;
    const bf16_t* Q = (const bf16_t*)(ws + (TYPE == 0 ? WS_QF : WS_QS));
    const bf16_t* Kp = (const bf16_t*)(ws + (TYPE == 0 ? WS_KF : WS_KS));
    const bf16_t* VT = (const bf16_t*)(ws + (TYPE == 0 ? WS_VFT : WS_VST)) + (size_t)(b * 8 + h) * 64 * LPK;
    const float* cK = (const float*)(ws + WS_CK) + (size_t)(b * 8 + h) * LPK;
    bf16_t* Oo = (bf16_t*)(ws + WS_A + (TYPE == 0 ? 0 : SZ_M512));
    const bool meta_unit = qb < 0;
    const int qrow0 = meta_unit ? MX + 16 * b : b * SEQ + qb * 128;
    const int nt = meta_unit ? 1 : 2 * qb + 3;
    int qrow = qrow0 + 32 * w + ql; if (qrow > M - 1) qrow = M - 1;
    bf16x8 qf[4];
#pragma unroll
    for (int ds = 0; ds < 4; ++ds) qf[ds] = *(const bf16x8*)(Q + (size_t)qrow * 512 + h * 64 + ds * 16 + hi * 8);
    f32x16 O0, O1;
#pragma unroll
    for (int i = 0; i < 16; ++i) { O0[i] = 0.f; O1[i] = 0.f; }
    float m_run = -INFINITY, lsum = 0.f, R = 0.f;
    const int JA = qb + 2;
    const int j0 = part == 2 ? JA : 0, j1 = part == 1 ? JA : nt;
    if (TYPE == 0 && part == 2) {
        float dg = 0.f;
#pragma unroll
        for (int ds = 0; ds < 4; ++ds) {
            const bf16x8 kd = *(const bf16x8*)(Kp + (size_t)qrow * 512 + h * 64 + ds * 16 + hi * 8);
#pragma unroll
            for (int e = 0; e < 8; ++e) dg += __uint_as_float((unsigned)(unsigned short)qf[ds][e] << 16) * __uint_as_float((unsigned)(unsigned short)kd[e] << 16);
        }
        dg += __shfl_xor(dg, 32);
        m_run = dg - cK[qb * 128 + 32 * w + ql] - 1.0f;
    }
    float qbound = 0.f;
    if (TYPE == 0) {
        float q2 = 0.f;
#pragma unroll
        for (int ds = 0; ds < 4; ++ds)
#pragma unroll
            for (int e = 0; e < 8; ++e) { const float x = __uint_as_float((unsigned)(unsigned short)qf[ds][e] << 16); q2 += x * x; }
        q2 += __shfl_xor(q2, 32);
        const unsigned kb = __hip_atomic_load((unsigned*)(ws + WS_XBAR) + 32 + b * 8 + h, __ATOMIC_RELAXED, __HIP_MEMORY_SCOPE_AGENT);
        qbound = sqrtf(q2) * sqrtf(__uint_as_float(kb)) * 1.02f + 1.0f;
    }
    u32x4 kreg[2], vreg[2]; float creg = 0.f;
    const int srow = tid >> 3, spos = tid & 7;
    const int swz_st = (spos ^ ((srow >> 1) & 7)) << 4;
    const int swz = (lane >> 1) & 7;
    LAS unsigned* flags = (LAS unsigned*)(lds + 2 * AT_STAGE);
#define AT_LOAD(j) do { int krow0_, kidx0_; if (!meta_unit && (j) < nt - 1) { const int kt_ = nt - 2 - (j); krow0_ = b * SEQ + 64 * kt_; kidx0_ = 64 * kt_; } else { krow0_ = MX + 16 * b; kidx0_ = 8192; } \
        _Pragma("unroll") for (int i_ = 0; i_ < 2; ++i_) { \
            kreg[i_] = *(const u32x4*)(Kp + (size_t)(krow0_ + srow + 32 * i_) * 512 + h * 64 + spos * 8); \
            vreg[i_] = *(const u32x4*)(VT + (size_t)(srow + 32 * i_) * LPK + kidx0_ + spos * 8); } \
        if (TYPE == 0 && tid < 64) creg = cK[kidx0_ + tid]; } while (0)
#define AT_WRITE(s) do { _Pragma("unroll") for (int i_ = 0; i_ < 2; ++i_) { \
            *(LAS u32x4*)(lds + (s) * AT_STAGE + (srow + 32 * i_) * 128 + swz_st) = kreg[i_]; \
            *(LAS u32x4*)(lds + (s) * AT_STAGE + 8192 + (srow + 32 * i_) * 128 + swz_st) = vreg[i_]; } \
        if (TYPE == 0 && tid < 64) *(LAS float*)(lds + (s) * AT_STAGE + 16384 + tid * 4) = creg; } while (0)
    AT_LOAD(j0); AT_WRITE(j0 & 1);
    __syncthreads();
    for (int j = j0; j < j1; ++j) {
        const bool more = j + 1 < j1;
        if (more) AT_LOAD(j + 1);
        int klim, d0;
        if (meta_unit) { klim = 16; d0 = 0; }
        else if (j == nt - 1) { klim = 16; d0 = 1 << 20; }
        else { klim = 64; d0 = 128 * qb - 64 * (nt - 2 - j); if (d0 >= 64) d0 = 1 << 20; }
        const int limw = 32 * w + d0 - TYPE;
        bool wdone = false, nomax = false;
        if (TYPE == 0) {
            const float clast = *(const LAS float*)(lds + (j & 1) * AT_STAGE + 16384 + (klim - 1) * 4);
            wdone = __all((qbound - clast - m_run) < -126.0f) != 0;
            nomax = __all((qbound - clast) <= m_run) != 0;
        }
        if (limw + 31 >= 0 && !(TYPE == 0 && wdone)) {
            const LAS char* sb = lds + (j & 1) * AT_STAGE;
            int kmax = limw + ql; if (kmax > klim - 1) kmax = klim - 1;
            const bool needmask = (klim < 64) || (limw < 63);
            f32x16 S0, S1;
#pragma unroll
            for (int i = 0; i < 16; ++i) { S0[i] = 0.f; S1[i] = 0.f; }
#pragma unroll
            for (int ds = 0; ds < 4; ++ds) {
                const bf16x8 k0 = *(const LAS bf16x8*)(sb + ql * 128 + (((2 * ds + hi) ^ swz) << 4));
                const bf16x8 k1 = *(const LAS bf16x8*)(sb + (32 + ql) * 128 + (((2 * ds + hi) ^ swz) << 4));
                S0 = __builtin_amdgcn_mfma_f32_32x32x16_bf16(k0, qf[ds], S0, 0, 0, 0);
                S1 = __builtin_amdgcn_mfma_f32_32x32x16_bf16(k1, qf[ds], S1, 0, 0, 0);
            }
            if (TYPE == 0) {
#pragma unroll
                for (int g = 0; g < 4; ++g) {
                    const f32x4 c0 = *(const LAS f32x4*)(sb + 16384 + (8 * g + 4 * hi) * 4), c1 = *(const LAS f32x4*)(sb + 16384 + (32 + 8 * g + 4 * hi) * 4);
#pragma unroll
                    for (int i = 0; i < 4; ++i) { S0[4 * g + i] -= c0[i]; S1[4 * g + i] -= c1[i]; }
                }
                if (needmask) {
#pragma unroll
                    for (int r = 0; r < 16; ++r) { const int kl = (r & 3) + 8 * (r >> 2) + 4 * hi; if (kl > kmax) S0[r] = -INFINITY; if (kl + 32 > kmax) S1[r] = -INFINITY; }
                }
                if (!nomax) {
                    float mx = -INFINITY;
#pragma unroll
                    for (int r = 0; r < 16; ++r) mx = fmaxf(mx, fmaxf(S0[r], S1[r]));
                    mx = fmaxf(mx, __shfl_xor(mx, 32));
                    const float m_new = fmaxf(m_run, mx), alpha = ex2(m_run - m_new);
                    m_run = m_new;
                    lsum *= alpha;
#pragma unroll
                    for (int r = 0; r < 16; ++r) { O0[r] *= alpha; O1[r] *= alpha; }
                }
                float ps = 0.f;
#pragma unroll
                for (int r = 0; r < 16; ++r) { S0[r] = ex2(S0[r] - m_run); S1[r] = ex2(S1[r] - m_run); ps += S0[r] + S1[r]; }
                lsum += ps;
            } else {
                float G0[4], G1[4];
                f32x16 L0, L1;
#pragma unroll
                for (int r = 0; r < 16; ++r) {
                    const int kl = (r & 3) + 8 * (r >> 2) + 4 * hi;
                    const float z0 = S0[r], z1 = S1[r];
                    const float sp0 = fmaxf(z0, 0.f) + lg2(1.0f + ex2(-fabsf(z0) * LOG2E)) * LN2;
                    const float sp1 = fmaxf(z1, 0.f) + lg2(1.0f + ex2(-fabsf(z1) * LOG2E)) * LN2;
                    L0[r] = (!needmask || kl <= kmax) ? -sp0 : 0.f;
                    L1[r] = (!needmask || kl + 32 <= kmax) ? -sp1 : 0.f;
                }
#pragma unroll
                for (int g = 0; g < 4; ++g) {
                    L0[4 * g + 2] += L0[4 * g + 3]; L0[4 * g + 1] += L0[4 * g + 2]; L0[4 * g] += L0[4 * g + 1]; G0[g] = L0[4 * g];
                    L1[4 * g + 2] += L1[4 * g + 3]; L1[4 * g + 1] += L1[4 * g + 2]; L1[4 * g] += L1[4 * g + 1]; G1[g] = L1[4 * g];
                }
                float run = R;
#pragma unroll
                for (int g = 3; g >= 0; --g) {
                    const float gp = __shfl_xor(G1[g], 32);
                    const float off = hi ? run : run + gp;
#pragma unroll
                    for (int i = 0; i < 4; ++i) { const int r = 4 * g + i; const int kl = 32 + i + 8 * g + 4 * hi;
                        const float a = ex2((S1[r] + L1[r] + off) * LOG2E); S1[r] = (!needmask || kl <= kmax) ? a : 0.f; }
                    run += G1[g] + gp;
                }
#pragma unroll
                for (int g = 3; g >= 0; --g) {
                    const float gp = __shfl_xor(G0[g], 32);
                    const float off = hi ? run : run + gp;
#pragma unroll
                    for (int i = 0; i < 4; ++i) { const int r = 4 * g + i; const int kl = i + 8 * g + 4 * hi;
                        const float a = ex2((S0[r] + L0[r] + off) * LOG2E); S0[r] = (!needmask || kl <= kmax) ? a : 0.f; }
                    run += G0[g] + gp;
                }
                R = run;
                wdone = __all(R < -120.0f) != 0;
            }
#pragma unroll
            for (int ks = 0; ks < 4; ++ks) {
                bf16x8 pf; u32x4 pu;
                if (ks < 2) { pu = (u32x4){pk_bf16(S0[8 * ks + 0], S0[8 * ks + 1]), pk_bf16(S0[8 * ks + 2], S0[8 * ks + 3]), pk_bf16(S0[8 * ks + 4], S0[8 * ks + 5]), pk_bf16(S0[8 * ks + 6], S0[8 * ks + 7])}; }
                else { const int k2 = ks - 2; pu = (u32x4){pk_bf16(S1[8 * k2 + 0], S1[8 * k2 + 1]), pk_bf16(S1[8 * k2 + 2], S1[8 * k2 + 3]), pk_bf16(S1[8 * k2 + 4], S1[8 * k2 + 5]), pk_bf16(S1[8 * k2 + 6], S1[8 * k2 + 7])}; }
                pf = __builtin_bit_cast(bf16x8, pu);
                const bf16x8 v0 = *(const LAS bf16x8*)(sb + 8192 + ql * 128 + (((2 * ks + hi) ^ swz) << 4));
                const bf16x8 v1 = *(const LAS bf16x8*)(sb + 8192 + (32 + ql) * 128 + (((2 * ks + hi) ^ swz) << 4));
                O0 = __builtin_amdgcn_mfma_f32_32x32x16_bf16(v0, pf, O0, 0, 0, 0);
                O1 = __builtin_amdgcn_mfma_f32_32x32x16_bf16(v1, pf, O1, 0, 0, 0);
            }
        }
        if (more) AT_WRITE((j + 1) & 1);
        if (lane == 0) flags[(j & 1) * 4 + w] = wdone ? 1u : 0u;
        __syncthreads();
        { const LAS unsigned* fl = flags + (j & 1) * 4; const unsigned f = fl[0] & fl[1] & fl[2] & fl[3]; if (f) break; }
    }
    float inv = 1.0f;
    if (TYPE == 0) { const float l = lsum + __shfl_xor(lsum, 32); inv = 1.0f / l; }
    const bool qvalid = meta_unit ? (w == 0 && ql < 16) : true;
    if (TYPE == 0 && part != 0) {
        float* rec = p.out + ((size_t)((((63 - qb) * 16 + b * 8 + h) * 2 + (part - 1)) * 128 + 32 * w + ql)) * 68;
        const float l = lsum + __shfl_xor(lsum, 32);
#pragma unroll
        for (int g = 0; g < 4; ++g) {
            *(f32x4*)(rec + 8 * g + 4 * hi) = (f32x4){O0[4 * g], O0[4 * g + 1], O0[4 * g + 2], O0[4 * g + 3]};
            *(f32x4*)(rec + 32 + 8 * g + 4 * hi) = (f32x4){O1[4 * g], O1[4 * g + 1], O1[4 * g + 2], O1[4 * g + 3]};
        }
        if (hi == 0) { rec[64] = m_run; rec[65] = l; }
    } else if (qvalid) {
        bf16_t* op = Oo + (size_t)qrow * 512 + h * 64 + 4 * hi;
#pragma unroll
        for (int g = 0; g < 4; ++g) {
            *(u32x2*)(op + 8 * g) = (u32x2){pk_bf16(O0[4 * g] * inv, O0[4 * g + 1] * inv), pk_bf16(O0[4 * g + 2] * inv, O0[4 * g + 3] * inv)};
            *(u32x2*)(op + 32 + 8 * g) = (u32x2){pk_bf16(O1[4 * g] * inv, O1[4 * g + 1] * inv), pk_bf16(O1[4 * g + 2] * inv, O1[4 * g + 3] * inv)};
        }
    }
    __syncthreads();
#undef AT_LOAD
#undef AT_WRITE
}


__device__ __forceinline__ void phase_comb(const Params& p) {
    bf16_t* oa = (bf16_t*)(p.ws + WS_A);
    for (int it = blockIdx.x * NTHREADS + threadIdx.x; it < 512 * 128 * 16; it += gridDim.x * NTHREADS) {
        const int d4 = it & 15, row = (it >> 4) & 127, su = it >> 11;
        const float* ra = p.out + ((size_t)((su * 2) * 128 + row)) * 68; const float* rb = ra + (size_t)128 * 68;
        const float ma = ra[64], la = ra[65], mb = rb[64], lb = rb[65];
        const float m = fmaxf(ma, mb), wa = ex2(ma - m), wb = ex2(mb - m), inv = 1.0f / (la * wa + lb * wb);
        const f32x4 a = __builtin_nontemporal_load((const f32x4*)(ra + d4 * 4)), bq = __builtin_nontemporal_load((const f32x4*)(rb + d4 * 4));
        const f32x4 o = (a * wa + bq * wb) * inv;
        const int qb = 63 - (su >> 4), bh = su & 15;
        *(u32x2*)(oa + (size_t)((bh >> 3) * SEQ + qb * 128 + row) * 512 + (bh & 7) * 64 + d4 * 4) = (u32x2){pk_bf16(o[0], o[1]), pk_bf16(o[2], o[3])};
    }
}
__device__ __forceinline__ void phase2(const Params& p, LAS char* lds) {
    unsigned* ctr = (unsigned*)(p.ws + WS_XBAR);
    LAS unsigned* shu = (LAS unsigned*)(lds + 2 * AT_STAGE + 64);
    constexpr int NU = 2560 + 32;
    for (;;) {
        if (threadIdx.x == 0) shu[0] = __hip_atomic_fetch_add(ctr, 1u, __ATOMIC_RELAXED, __HIP_MEMORY_SCOPE_AGENT);
        __syncthreads();
        const int u = (int)shu[0];
        __syncthreads();
        if (u >= NU) break;
        if (u < 1280) {
            const int pr = u / 80, r = u - pr * 80;
            if (r < 32) attn_unit<0>(lds, p, (r >> 1) >> 3, (r >> 1) & 7, 63 - 2 * pr, 1 + (r & 1));
            else if (r < 48) attn_unit<0>(lds, p, (r - 32) >> 3, (r - 32) & 7, 31 - pr);
            else { const int q = r - 48; attn_unit<0>(lds, p, (q >> 1) >> 3, (q >> 1) & 7, 62 - 2 * pr, 1 + (q & 1)); }
        }
        else if (u < 1536) { const int v = u - 1280; attn_unit<0>(lds, p, (v & 15) >> 3, v & 7, 15 - (v >> 4)); }
        else if (u < 2560) { const int v = u - 1536; attn_unit<1>(lds, p, (v & 15) >> 3, v & 7, 63 - (v >> 4)); }
        else if (u < 2576) { const int v = u - 2560; attn_unit<0>(lds, p, v >> 3, v & 7, -1); }
        else { const int v = u - 2576; attn_unit<1>(lds, p, v >> 3, v & 7, -1); }
    }
}

__device__ __forceinline__ void phase3a(const Params& p, LAS char* lds) {
    unsigned char* ws = p.ws;
    const int lane = threadIdx.x & 63, w = wave_id(), wr = w >> 1, wc = w & 1;
    const bf16_t* oa = (const bf16_t*)(ws + WS_A); const bf16_t* ob = oa + (size_t)M * 512;
    const bf16_t* ga = (const bf16_t*)(ws + WS_B); const bf16_t* gb = ga + (size_t)M * 1024;
    bf16_t* gated = (bf16_t*)(ws + WS_GATED);
    for (int it = 0;; ++it) {
        int tm, tn; int st = tile_at(it, 128, 8, tm, tn);
        if (st == 0) { if (it < (1 << 20) && (int)blockIdx.x < 8) { tm = 128; tn = blockIdx.x; it = 1 << 20; st = 1; } else break; }
        if (st == 2) continue;
        const int row0 = tm * 128, col0 = tn * 128; const int mlim = tm == 128 ? (wr == 0 ? 2 : 0) : 4;
        f32x4 acc[4][4]; zero_acc(acc);
        gemm_main<true>(lds, oa + (size_t)row0 * 512, 512, (const bf16_t*)(ws + WS_BTOF) + (size_t)col0 * 512, 512, 8, acc, mlim);
#pragma unroll
        for (int m = 0; m < 4; ++m) {
            const int row = row0 + wr * 64 + m * 16 + (lane & 15);
#pragma unroll
            for (int n = 0; n < 4; ++n) {
                const int col = col0 + wc * 64 + n * 16 + (lane >> 4) * 4;
                const u32x2 a = *(const u32x2*)(ga + (size_t)row * 1024 + col);
                const f32x4 x = acc[m][n];
                *(u32x2*)(gated + (size_t)row * 1024 + col) = (u32x2){pk_bf16(bf_lo(a[0]) * x[0], bf_hi(a[0]) * x[1]), pk_bf16(bf_lo(a[1]) * x[2], bf_hi(a[1]) * x[3])};
            }
        }
        zero_acc(acc);
        gemm_main<true>(lds, ob + (size_t)row0 * 512, 512, (const bf16_t*)(ws + WS_BTOS) + (size_t)col0 * 512, 512, 8, acc, mlim);
#pragma unroll
        for (int m = 0; m < 4; ++m) {
            const int row = row0 + wr * 64 + m * 16 + (lane & 15);
#pragma unroll
            for (int n = 0; n < 4; ++n) {
                const int col = col0 + wc * 64 + n * 16 + (lane >> 4) * 4;
                const u32x2 b = *(const u32x2*)(gb + (size_t)row * 1024 + col);
                const f32x4 y = acc[m][n]; const u32x2 q = *(const u32x2*)(gated + (size_t)row * 1024 + col);
                const float o0 = bf_lo(q[0]) + bf_lo(b[0]) * y[0], o1 = bf_hi(q[0]) + bf_hi(b[0]) * y[1];
                const float o2 = bf_lo(q[1]) + bf_lo(b[1]) * y[2], o3 = bf_hi(q[1]) + bf_hi(b[1]) * y[3];
                *(u32x2*)(gated + (size_t)row * 1024 + col) = (u32x2){pk_bf16(o0, o1), pk_bf16(o2, o3)};
            }
        }
    }
}
__device__ __forceinline__ void epi_store_ss(const f32x4 (&acc)[4][4], bf16_t* out, int ldo, int orow0, int col0, float* ssp, int ssrow0, int wr, int wc, int lane) {
#pragma unroll
    for (int m = 0; m < 4; ++m) {
        const int rl = wr * 64 + m * 16 + (lane & 15);
        float s = 0.f;
#pragma unroll
        for (int n = 0; n < 4; ++n) {
            const int col = col0 + wc * 64 + n * 16 + (lane >> 4) * 4;
            const f32x4 v = acc[m][n];
            s += v[0] * v[0] + v[1] * v[1] + v[2] * v[2] + v[3] * v[3];
            *(u32x2*)(out + (size_t)(orow0 + rl) * ldo + col) = (u32x2){pk_bf16(v[0], v[1]), pk_bf16(v[2], v[3])};
        }
#if 1
        s += __shfl_xor(s, 16); s += __shfl_xor(s, 32);
        if (lane < 16) ssp[(size_t)((col0 >> 7) * 2 + wc) * M + ssrow0 + rl] = s;
#endif
    }
}
__device__ __forceinline__ void phase3b(const Params& p, LAS char* lds) {
    unsigned char* ws = p.ws;
    const int lane = threadIdx.x & 63, w = wave_id(), wr = w >> 1, wc = w & 1;
    const bf16_t* gated = (const bf16_t*)(ws + WS_GATED); bf16_t* mixed = (bf16_t*)(ws + WS_MIXED);
    for (int it = 0;; ++it) {
        int tm, tn; int st = tile_at(it, 128, 8, tm, tn);
        if (st == 0) { if (it < (1 << 20) && (int)blockIdx.x < 8) { tm = 128; tn = blockIdx.x; it = 1 << 20; st = 1; } else break; }
        if (st == 2) continue;
        const int row0 = tm * 128, col0 = tn * 128; const int mlim = tm == 128 ? (wr == 0 ? 2 : 0) : 4;
        f32x4 acc[4][4]; zero_acc(acc);
        gemm_main<true>(lds, gated + (size_t)row0 * 1024, 1024, (const bf16_t*)(ws + WS_BTOUT) + (size_t)col0 * 1024, 1024, 16, acc, mlim);
        epi_store_ss(acc, mixed, 1024, row0, col0, (float*)(ws + WS_SSP2), row0, wr, wc, lane);
    }
}
__device__ __forceinline__ void phase3c(const Params& p) {
    unsigned char* ws = p.ws;
    const int lane = threadIdx.x & 63, w = wave_id();
    const bf16_t* mixed = (const bf16_t*)(ws + WS_MIXED); bf16_t* hb = (bf16_t*)(ws + WS_A);
    const float* ssp2 = (const float*)(ws + WS_SSP2); float* r2 = (float*)(ws + WS_R2);
    const float* g1 = p.gains + D;
    f32x4 g[4];
#pragma unroll
    for (int i = 0; i < 4; ++i) g[i] = *(const f32x4*)(g1 + lane * 4 + 256 * i);
    for (int grp = blockIdx.x; grp * 32 < MV; grp += gridDim.x) {
#pragma unroll 1
        for (int k = 0; k < 8; k += 2) {
            int r[2]; bool ok[2]; f32x4 v[2][4]; u32x2 mx[2][4]; float sq[2];
#pragma unroll
            for (int j = 0; j < 2; ++j) {
                r[j] = grp * 32 + w + 4 * (k + j); ok[j] = r[j] < MV; const int rr = ok[j] ? r[j] : 0;
                const float* src = rr < MX ? p.x + (size_t)rr * D : p.meta + (size_t)((rr - MX) & 15) * D;
                sq[j] = lane < 16 ? ssp2[(size_t)lane * M + rr] : 0.f;
#pragma unroll
                for (int i = 0; i < 4; ++i) { v[j][i] = __builtin_nontemporal_load((const f32x4*)(src + lane * 4 + 256 * i)); mx[j][i] = __builtin_nontemporal_load((const u32x2*)(mixed + (size_t)rr * D + lane * 4 + 256 * i)); }
            }
#pragma unroll
            for (int j = 0; j < 2; ++j) {
                const float a = 1.0f / sqrtf(wave_sum(sq[j]) * (1.0f / D) + EPS);
                float ss = 0.f;
#pragma unroll
                for (int i = 0; i < 4; ++i) {
                    const int col = lane * 4 + 256 * i;
                    f32x4 hh;
                    hh[0] = v[j][i][0] + bf_lo(mx[j][i][0]) * a * g[i][0]; hh[1] = v[j][i][1] + bf_hi(mx[j][i][0]) * a * g[i][1];
                    hh[2] = v[j][i][2] + bf_lo(mx[j][i][1]) * a * g[i][2]; hh[3] = v[j][i][3] + bf_hi(mx[j][i][1]) * a * g[i][3];
                    ss += hh[0] * hh[0] + hh[1] * hh[1] + hh[2] * hh[2] + hh[3] * hh[3];
                    if (ok[j]) {
                        *(u32x2*)(hb + (size_t)r[j] * D + col) = (u32x2){pk_bf16(hh[0], hh[1]), pk_bf16(hh[2], hh[3])};
                        if (r[j] < MX) __builtin_nontemporal_store(hh, (f32x4*)(p.out + (size_t)r[j] * D + col));
                    }
                }
                ss = wave_sum(ss);
                if (ok[j] && lane == 0) r2[r[j]] = 1.0f / sqrtf(ss * (1.0f / D) + EPS);
            }
        }
    }
}
constexpr int UST = 272;
__device__ __forceinline__ f32x4 unpack4(const u32x2 u) { return (f32x4){bf_lo(u[0]), bf_hi(u[0]), bf_lo(u[1]), bf_hi(u[1])}; }
struct ConvW { f32x4 w0g, w1g, w2g, bg, w0v, w1v, w2v, bv; };
__device__ __forceinline__ ConvW load_convw(const Params& p, int c) {
    ConvW q;
    q.w0g = *(const f32x4*)(p.conv_w + c); q.w1g = *(const f32x4*)(p.conv_w + NUP + c); q.w2g = *(const f32x4*)(p.conv_w + 2 * NUP + c); q.bg = *(const f32x4*)(p.conv_b + c);
    q.w0v = *(const f32x4*)(p.conv_w + DFF + c); q.w1v = *(const f32x4*)(p.conv_w + NUP + DFF + c); q.w2v = *(const f32x4*)(p.conv_w + 2 * NUP + DFF + c); q.bv = *(const f32x4*)(p.conv_b + DFF + c);
    return q;
}
__device__ __forceinline__ u32x2 conv_gelu4(const ConvW& q, const f32x4 g2, const f32x4 g1, const f32x4 g0, const f32x4 v2, const f32x4 v1, const f32x4 v0) {
    float o[4];
#pragma unroll
    for (int e = 0; e < 4; ++e) {
        const float ug = q.bg[e] + q.w0g[e] * g2[e] + q.w1g[e] * g1[e] + q.w2g[e] * g0[e];
        const float uv = q.bv[e] + q.w0v[e] * v2[e] + q.w1v[e] * v1[e] + q.w2v[e] * v0[e];
        const float t = 0.7978845608028654f * (ug + 0.044715f * ug * ug * ug);
        o[e] = ug * rcp(1.0f + ex2(-2.0f * LOG2E * t)) * uv;
    }
    return (u32x2){pk_bf16(o[0], o[1]), pk_bf16(o[2], o[3])};
}
__device__ __forceinline__ void phase4(const Params& p, LAS char* lds) {
    unsigned char* ws = p.ws;
    const int tid = threadIdx.x, lane = tid & 63, w = wave_id(), wr = w >> 1, wc = w & 1;
    const bf16_t* hb = (const bf16_t*)(ws + WS_A); const bf16_t* Bt = (const bf16_t*)(ws + WS_BTUP);
    const float* r2 = (const float*)(ws + WS_R2);
    bf16_t* act = (bf16_t*)(ws + WS_ACT); bf16_t* hal = (bf16_t*)(ws + WS_HAL);
    for (int it = 0;; ++it) {
        int tm, tn; int st = tile_at(it, 128, 44, tm, tn);
        if (st == 0) { if (it < (1 << 20) && (int)blockIdx.x < 44) { tm = 128; tn = blockIdx.x; it = 1 << 20; st = 1; } else break; }
        if (st == 2) continue;
        const bool mt = tm == 128; const int row0 = mt ? MX : tm * 128, col0 = tn * 128;
        f32x4 acc[4][4]; zero_acc(acc);
        gemm_main<true>(lds, hb + (size_t)row0 * D, D, Bt + (size_t)col0 * D, D, 16, acc, mt ? (wr == 0 ? 2 : 0) : 4);
#pragma unroll
        for (int m = 0; m < 4; ++m) {
            const int rl = wr * 64 + m * 16 + (lane & 15); const float rs = r2[row0 + rl];
#pragma unroll
            for (int n = 0; n < 4; ++n) {
                const int cl = wc * 64 + n * 16 + (lane >> 4) * 4; const f32x4 v = acc[m][n] * rs;
                *(LAS u32x2*)(lds + rl * UST + cl * 2) = (u32x2){pk_bf16(v[0], v[1]), pk_bf16(v[2], v[3])};
            }
        }
        __syncthreads();
        if (!mt) {
            const int cg = tid & 15, rb = tid >> 4, c = tn * 64 + cg * 4;
            const ConvW q = load_convw(p, c);
            const int hr = rb == 0 ? 0 : rb * 8 - 2;
            f32x4 g2 = unpack4(*(const LAS u32x2*)(lds + hr * UST + cg * 8)), v2 = unpack4(*(const LAS u32x2*)(lds + hr * UST + 128 + cg * 8));
            f32x4 g1 = unpack4(*(const LAS u32x2*)(lds + (hr + 1) * UST + cg * 8)), v1 = unpack4(*(const LAS u32x2*)(lds + (hr + 1) * UST + 128 + cg * 8));
            for (int r = hr + 2; r < rb * 8 + 8; ++r) {
                const f32x4 g0 = unpack4(*(const LAS u32x2*)(lds + r * UST + cg * 8)), v0 = unpack4(*(const LAS u32x2*)(lds + r * UST + 128 + cg * 8));
                *(u32x2*)(act + (size_t)(row0 + r) * DFF + c) = conv_gelu4(q, g2, g1, g0, v2, v1, v0);
                g2 = g1; g1 = g0; v2 = v1; v1 = v0;
            }
            if (tid < 64) { const int qq = tid >> 4, ch = tid & 15, rl = qq < 2 ? qq : 124 + qq;
                *(u32x4*)(hal + ((size_t)tm * 4 + qq) * NUP + col0 + ch * 8) = *(const LAS u32x4*)(lds + rl * UST + ch * 16); }
        } else {
            if (tid < 64) { const int qq = tid >> 4, ch = tid & 15, rl = (qq >> 1) * 16 + 14 + (qq & 1);
                *(u32x4*)(hal + ((size_t)(128 + (qq >> 1)) * 4 + 2 + (qq & 1)) * NUP + col0 + ch * 8) = *(const LAS u32x4*)(lds + rl * UST + ch * 16); }
        }
        __syncthreads();
    }
}
__device__ __forceinline__ void phase_fix(const Params& p) {
    unsigned char* ws = p.ws;
    const bf16_t* hal = (const bf16_t*)(ws + WS_HAL); bf16_t* act = (bf16_t*)(ws + WS_ACT);
    constexpr int NCG = DFF / 4;
    for (int it = blockIdx.x * NTHREADS + threadIdx.x; it < 128 * NCG; it += gridDim.x * NTHREADS) {
        const int tmg = it / NCG, c = (it % NCG) * 4, colg = (c >> 6) * 128 + (c & 63), colv = colg + 64;
        const bf16_t* own = hal + (size_t)tmg * 4 * NUP;
        const bf16_t* prv = hal + (size_t)((tmg & 63) ? tmg - 1 : 128 + (tmg >> 6)) * 4 * NUP;
        const ConvW q = load_convw(p, c);
        const f32x4 pg2 = unpack4(*(const u32x2*)(prv + 2 * NUP + colg)), pv2 = unpack4(*(const u32x2*)(prv + 2 * NUP + colv));
        const f32x4 pg3 = unpack4(*(const u32x2*)(prv + 3 * NUP + colg)), pv3 = unpack4(*(const u32x2*)(prv + 3 * NUP + colv));
        const f32x4 og0 = unpack4(*(const u32x2*)(own + colg)), ov0 = unpack4(*(const u32x2*)(own + colv));
        const f32x4 og1 = unpack4(*(const u32x2*)(own + NUP + colg)), ov1 = unpack4(*(const u32x2*)(own + NUP + colv));
        *(u32x2*)(act + (size_t)(tmg * 128) * DFF + c) = conv_gelu4(q, pg2, pg3, og0, pv2, pv3, ov0);
        *(u32x2*)(act + (size_t)(tmg * 128 + 1) * DFF + c) = conv_gelu4(q, pg3, og0, og1, pv3, ov0, ov1);
    }
}
__device__ __forceinline__ void phase6(const Params& p, LAS char* lds) {
    unsigned char* ws = p.ws;
    const int lane = threadIdx.x & 63, w = wave_id(), wr = w >> 1, wc = w & 1;
    const bf16_t* act = (const bf16_t*)(ws + WS_ACT); bf16_t* ffn = (bf16_t*)(ws + WS_FFN);
    for (int it = 0;; ++it) {
        int tm, tn; const int st = tile_at(it, 128, 8, tm, tn); if (st == 0) break; if (st == 2) continue;
        const int col0 = tn * 128;
        f32x4 acc[4][4]; zero_acc(acc);
        gemm_main<true>(lds, act + (size_t)(tm * 128) * DFF, DFF, (const bf16_t*)(ws + WS_BTDN) + (size_t)col0 * DFF, DFF, 44, acc);
        epi_store_ss(acc, ffn, 1024, tm * 128, col0, (float*)(ws + WS_SSP4), tm * 128, wr, wc, lane);
    }
}
__device__ __forceinline__ void phase7(const Params& p) {
    unsigned char* ws = p.ws;
    const int lane = threadIdx.x & 63, w = wave_id();
    const bf16_t* ffn = (const bf16_t*)(ws + WS_FFN); const float* ssp4 = (const float*)(ws + WS_SSP4); const float* g3 = p.gains + 3 * D;
    f32x4 g[4];
#pragma unroll
    for (int i = 0; i < 4; ++i) g[i] = *(const f32x4*)(g3 + lane * 4 + 256 * i);
    for (int r0 = (blockIdx.x * 4 + w) * 2; r0 < MX; r0 += gridDim.x * 8) {
        f32x4 hh[2][4]; u32x2 f[2][4]; float sq[2];
#pragma unroll
        for (int j = 0; j < 2; ++j) {
            const int row = r0 + j;
            sq[j] = lane < 16 ? ssp4[(size_t)lane * M + row] : 0.f;
#pragma unroll
            for (int i = 0; i < 4; ++i) { hh[j][i] = __builtin_nontemporal_load((const f32x4*)(p.out + (size_t)row * D + lane * 4 + 256 * i)); f[j][i] = __builtin_nontemporal_load((const u32x2*)(ffn + (size_t)row * D + lane * 4 + 256 * i)); }
        }
#pragma unroll
        for (int j = 0; j < 2; ++j) {
            const float a = 1.0f / sqrtf(wave_sum(sq[j]) * (1.0f / D) + EPS);
#pragma unroll
            for (int i = 0; i < 4; ++i) {
                f32x4 o;
                o[0] = hh[j][i][0] + bf_lo(f[j][i][0]) * a * g[i][0]; o[1] = hh[j][i][1] + bf_hi(f[j][i][0]) * a * g[i][1];
                o[2] = hh[j][i][2] + bf_lo(f[j][i][1]) * a * g[i][2]; o[3] = hh[j][i][3] + bf_hi(f[j][i][1]) * a * g[i][3];
                __builtin_nontemporal_store(o, (f32x4*)(p.out + (size_t)(r0 + j) * D + lane * 4 + 256 * i));
            }
        }
    }
}


#ifndef DUMP
#define DUMP 0
#endif
__device__ __forceinline__ void phase_dump(const Params& p) {
    unsigned char* ws = p.ws;
    const bf16_t* s0; const bf16_t* s1; int ld;
    if (DUMP == 1) { s0 = (const bf16_t*)(ws + WS_B); s1 = s0 + 512; ld = 1024; }
    else if (DUMP == 2) { s0 = (const bf16_t*)(ws + WS_QF); s1 = (const bf16_t*)(ws + WS_KF); ld = 512; }
    else if (DUMP == 3) { s0 = (const bf16_t*)(ws + WS_A); s1 = s0 + (size_t)M * 512; ld = 512; }
    else if (DUMP == 4) { s0 = (const bf16_t*)(ws + WS_GATED); s1 = s0 + 512; ld = 1024; }
    else if (DUMP == 8) { s0 = (const bf16_t*)(ws + WS_A); s1 = s0 + 512; ld = 1024; }
    else if (DUMP == 9) { s0 = (const bf16_t*)(ws + WS_ACT) + 1024; s1 = (const bf16_t*)(ws + WS_ACT) + 2304 - 512 + 512; ld = DFF; }
    else if (DUMP == 10) { s0 = (const bf16_t*)(ws + WS_FFN); s1 = s0 + 512; ld = 1024; }
    else if (DUMP == 6) { s0 = (const bf16_t*)(ws + WS_QS); s1 = (const bf16_t*)(ws + WS_KS); ld = 512; }
    else { s0 = (const bf16_t*)(ws + WS_MIXED); s1 = s0 + 512; ld = 1024; }
    for (int it = blockIdx.x * NTHREADS + threadIdx.x; it < MX * 1024; it += gridDim.x * NTHREADS) {
        const int row = it >> 10, col = it & 1023;
        if (DUMP >= 9 && row >= 8192) { p.out[it] = 0.f; continue; }
        const bf16_t v = col < 512 ? s0[(size_t)row * ld + col] : s1[(size_t)row * ld + col - 512];
        p.out[it] = __uint_as_float((unsigned)v << 16);
    }
}

__device__ __forceinline__ void l2_scrub(const Params& p) {
    const f32x4* src = (const f32x4*)p.x + (size_t)(blockIdx.x & 511) * 8192;
    f32x4 a = (f32x4){0.f, 0.f, 0.f, 0.f};
    for (int i = threadIdx.x; i < 8192; i += NTHREADS) a += src[i];
    if (a[0] + a[1] + a[2] + a[3] == 1.2345e-30f) ((float*)(p.ws + WS_CTL))[32 + (threadIdx.x & 7)] = a[0];
}


#define XB_TMO      128
#define XB_XCNT(j)  (256  + 64 * (j))
#define XB_XSUB(j)  (1280 + 64 * (j))
#define XB_XGEN(j)  (2304 + 64 * (j))
#define XB_TOP      3328
#define XB_TOPGEN   3392
#define XCD_BAR_WORDS 3456
#define XB_SPIN_CAP (1u << 18)
__device__ __forceinline__ unsigned xb_ld(unsigned* p)              { return __hip_atomic_load(p, __ATOMIC_RELAXED, __HIP_MEMORY_SCOPE_AGENT); }
__device__ __forceinline__ unsigned xb_add(unsigned* p, unsigned v) { return __hip_atomic_fetch_add(p, v, __ATOMIC_RELAXED, __HIP_MEMORY_SCOPE_AGENT); }
__device__ __forceinline__ unsigned xb_xcc_id() { return (unsigned)__builtin_amdgcn_s_getreg((3 << 11) | 20) & 0xFu; }
#define XB_SPIN(cond, bar) do { unsigned _sp = 0; while (cond) { __builtin_amdgcn_s_sleep(1); \
    if ((++_sp & 255u) == 0u) { if (xb_ld(&(bar)[XB_TMO])) break; if (_sp > XB_SPIN_CAP) { atomicAdd(&(bar)[XB_TMO], 1u); break; } } } } while (0)
struct XcdBarrier { unsigned* bar; unsigned x; volatile LAS unsigned* st; };
__device__ __forceinline__ XcdBarrier xcd_barrier_post(unsigned* bar, volatile LAS unsigned* st) {
    XcdBarrier b; b.bar = bar; b.x = xb_xcc_id(); b.st = st;
    if (threadIdx.x == 0) (void)xb_add(&bar[XB_XCNT(b.x)], 1u);
    return b;
}
__device__ __forceinline__ void xcd_barrier_complete(unsigned* bar, unsigned x, unsigned& nloc, unsigned& nx) {
    const unsigned G = gridDim.x * gridDim.y * gridDim.z;
    unsigned sum, cnt, mine, sp = 0u;
    for (;;) {
        sum = 0u; cnt = 0u; mine = 0u;
#pragma unroll
        for (unsigned j = 0; j < 16; ++j) { const unsigned c = xb_ld(&bar[XB_XCNT(j)]); sum += c; cnt += (c > 0u) ? 1u : 0u; mine = (j == x) ? c : mine; }
        if (sum == G) break;
        __builtin_amdgcn_s_sleep(1);
        if ((++sp & 255u) == 0u) { if (xb_ld(&bar[XB_TMO])) break; if (sp > XB_SPIN_CAP) { atomicAdd(&bar[XB_TMO], 1u); break; } }
    }
    nloc = mine > 0u ? mine : 1u; nx = cnt > 0u ? cnt : 1u;
}
__device__ __forceinline__ void xcd_barrier(const XcdBarrier& b) {
    asm volatile("s_waitcnt vmcnt(0)" ::: "memory");
    __syncthreads();
    if (threadIdx.x == 0) {
        unsigned* bar = b.bar;
        __builtin_amdgcn_s_waitcnt(0);
        unsigned nloc = b.st[0], nx = b.st[1];
        if (nloc == 0u) { xcd_barrier_complete(bar, b.x, nloc, nx); b.st[0] = nloc; b.st[1] = nx; }
        const unsigned old = xb_add(&bar[XB_XSUB(b.x)], 1u);
        const unsigned gen = old / nloc;
        if (old + 1u == (gen + 1u) * nloc) {
            __builtin_amdgcn_fence(__ATOMIC_RELEASE, "agent");
            asm volatile("s_waitcnt vmcnt(0)" ::: "memory");
            const unsigned og = xb_add(&bar[XB_TOP], 1u);
            const unsigned tg = og / nx;
            if (og + 1u == (tg + 1u) * nx) xb_add(&bar[XB_TOPGEN], 1u);
            else XB_SPIN(xb_ld(&bar[XB_TOPGEN]) == tg, bar);
            __builtin_amdgcn_fence(__ATOMIC_ACQUIRE, "agent");
            xb_add(&bar[XB_XGEN(b.x)], 1u);
            asm volatile("s_waitcnt vmcnt(0)" ::: "memory");
        } else {
            XB_SPIN(xb_ld(&bar[XB_XGEN(b.x)]) == gen, bar);
            __builtin_amdgcn_fence(__ATOMIC_ACQUIRE, "agent");
            asm volatile("s_waitcnt vmcnt(0)" ::: "memory");
        }
    }
    __syncthreads();
}

__device__ __forceinline__ void my_grid_sync(const Params& p, unsigned& target) {
    unsigned* bar = (unsigned*)(p.ws + WS_CTL) + 16;
    asm volatile("s_waitcnt vmcnt(0)" ::: "memory");
    __syncthreads();
    target += gridDim.x;
    if (threadIdx.x == 0) {
        __builtin_amdgcn_fence(__ATOMIC_RELEASE, "agent");
        asm volatile("s_waitcnt vmcnt(0)" ::: "memory");
        __hip_atomic_fetch_add(bar, 1u, __ATOMIC_RELAXED, __HIP_MEMORY_SCOPE_AGENT);
        while (__hip_atomic_load(bar, __ATOMIC_RELAXED, __HIP_MEMORY_SCOPE_AGENT) < target) __builtin_amdgcn_s_sleep(2);
        __builtin_amdgcn_fence(__ATOMIC_ACQUIRE, "agent");
        asm volatile("s_waitcnt vmcnt(0)" ::: "memory");
    }
    __syncthreads();
}
__global__ void __launch_bounds__(NTHREADS, 2) fwd_kernel(Params p) {
    extern __shared__ __attribute__((aligned(16))) unsigned char lds_raw[];
    LAS char* lds = (LAS char*)lds_raw;
    cg::grid_group grid = cg::this_grid();
#define IN(k) (p.ph_lo <= (k) && (k) < p.ph_hi)
#define SEAM(k) do { if (IN(k) && IN((k) + 1)) { if (p.ph_hi > 1000) grid.sync(); xcd_barrier(xbar); } } while (0)
    volatile LAS unsigned* xst = (volatile LAS unsigned*)(lds + 65536);
    if (threadIdx.x < 4) xst[threadIdx.x] = 0u;
    __syncthreads();
    const XcdBarrier xbar = xcd_barrier_post((unsigned*)(p.ws + WS_XBAR), xst);
    if (IN(0)) phase0(p, lds);
    SEAM(0);
    if (IN(1)) phase1(p, lds);
    SEAM(1);
    if (IN(2)) phase2(p, lds);
    SEAM(2);
    if (IN(3)) phase_comb(p);
    SEAM(3);
    if (IN(4)) phase3a(p, lds);
    SEAM(4);
    if (IN(5)) phase3b(p, lds);
    SEAM(5);
    if (IN(6)) phase3c(p);
    SEAM(6);
    if (IN(7)) phase4(p, lds);
    SEAM(7);
    if (IN(8)) phase_fix(p);
    SEAM(8);
    if (IN(9)) phase6(p, lds);
    SEAM(9);
    if (IN(10)) phase7(p);
#undef IN
#undef SEAM
}


__global__ void ab_save(const unsigned char* ws, float* out) {
    const u32x4* src = (const u32x4*)(ws + AB_SRC); u32x4* dst = (u32x4*)((unsigned char*)out + (size_t)32 * MiB);
    for (size_t i = blockIdx.x * (size_t)blockDim.x + threadIdx.x; i < (size_t)AB_BYTES / 16; i += (size_t)gridDim.x * blockDim.x) dst[i] = src[i];
}
__global__ void ab_diff(const unsigned char* ws, float* out) {
    const bf16_t* src = (const bf16_t*)(ws + AB_SRC); const bf16_t* sav = (const bf16_t*)((unsigned char*)out + (size_t)32 * MiB);
    for (size_t i = blockIdx.x * (size_t)blockDim.x + threadIdx.x; i < (size_t)8192 * 1024; i += (size_t)gridDim.x * blockDim.x) {
        if (i >= (size_t)AB_BYTES / 2) { out[i] = 0.f; continue; }
        out[i] = src[i] != sav[i] ? 1000.0f : 0.f;
    }
}
__global__ void ab_zero(float* out) {
    for (size_t i = blockIdx.x * (size_t)blockDim.x + threadIdx.x; i < (size_t)8192 * 1024; i += (size_t)gridDim.x * blockDim.x) out[(size_t)8192 * 1024 + i] = 0.f;
}
extern "C" void kernel_launch(void* const* d_in, const int* in_sizes, int n_in, void* d_out, int out_size, void* d_ws, size_t ws_size, hipStream_t stream) {
    static int grid_blocks = 0;
    if (grid_blocks == 0) {
        if (n_in != 12 || ws_size < WS_END) { fprintf(stderr, "kernel_launch: unexpected n_in %d or ws_size %zu (need %zu)\n", n_in, ws_size, (size_t)WS_END); grid_blocks = -1; return; }
        int dev = 0, cus = 0, per_cu = 0;
        (void)hipGetDevice(&dev);
        (void)hipDeviceGetAttribute(&cus, hipDeviceAttributeMultiprocessorCount, dev);
        (void)hipFuncSetAttribute((const void*)fwd_kernel, hipFuncAttributeMaxDynamicSharedMemorySize, LDS_BYTES);
        (void)hipOccupancyMaxActiveBlocksPerMultiprocessor(&per_cu, (const void*)fwd_kernel, NTHREADS, LDS_BYTES);
        if (per_cu < 1) per_cu = 1;
        if (per_cu > 2) per_cu = 2;
        grid_blocks = cus * per_cu;
        (void)hipGetLastError();
    }
    if (grid_blocks < 0) return;
    Params p{};
    p.x = (const float*)d_in[0]; p.meta = (const float*)d_in[1]; p.gains = (const float*)d_in[2]; p.w_in = (const float*)d_in[3];
    p.b_forget = (const float*)d_in[4]; p.w_o_fox = (const float*)d_in[5]; p.w_o_sb = (const float*)d_in[6]; p.w_out = (const float*)d_in[7];
    p.w_up = (const float*)d_in[8]; p.conv_w = (const float*)d_in[9]; p.conv_b = (const float*)d_in[10]; p.w_down = (const float*)d_in[11];
    p.out = (float*)d_out; p.ws = (unsigned char*)d_ws;
#if SINGLE_LAUNCH
    (void)hipMemsetAsync((unsigned char*)d_ws + WS_XBAR, 0, XCD_BAR_WORDS * 4, stream);
    p.ph_lo = 0; p.ph_hi = NPHASE;
    void* args[] = {&p};
    hipError_t e = hipLaunchCooperativeKernel((const void*)fwd_kernel, dim3(grid_blocks), dim3(NTHREADS), args, LDS_BYTES, stream);
    if (e != hipSuccess) fprintf(stderr, "cooperative launch failed: %s (grid %d)\n", hipGetErrorString(e), grid_blocks);
#else
#ifndef STOP_AT
#define STOP_AT NPHASE
#endif
    for (int k = 0; k < STOP_AT; ++k) {
        p.ph_lo = k; p.ph_hi = k + 1;
        hipLaunchKernelGGL(fwd_kernel, dim3(grid_blocks), dim3(NTHREADS), LDS_BYTES, stream, p);
    }
#if ABTEST
    ab_save<<<1024, 256, 0, stream>>>(p.ws, p.out);
    for (int k = AB_FROM; k < STOP_AT; ++k) {
        p.ph_lo = k; p.ph_hi = k + 1;
        hipLaunchKernelGGL(fwd_kernel, dim3(grid_blocks), dim3(NTHREADS), LDS_BYTES, stream, p);
    }
    ab_diff<<<1024, 256, 0, stream>>>(p.ws, p.out);
    ab_zero<<<1024, 256, 0, stream>>>(p.out);
#endif

#endif
}
```
